# Optimizing an MI355X kernel written in HIP

```python
import math
import jax, jax.numpy as jnp
from jax import lax
import numpy as np

D_MODEL = 1024
BATCH = 8
SEQ = 8192
DEPTH = 2

D_FF = 2816
N_EVEN = (DEPTH + 1) // 2
N_ODD = DEPTH // 2
S5_WIDTH = D_MODEL // 2
S5_GROUP = 16
S5_GROUPS = S5_WIDTH // S5_GROUP
S5_STATE = 64
GLA_HEADS = 4
GLA_DK = D_MODEL // 4 // GLA_HEADS
GLA_DV = D_MODEL // 2 // GLA_HEADS
GLA_RANK = 16
GLA_GATE_NORM = 16.0
RET_HEADS = 8
RET_DK = D_MODEL // RET_HEADS
RET_DV = 2 * D_MODEL // RET_HEADS
ROPE_BASE = 10000.0
CHUNK = 64
EPS = 1e-6

AB_IN = S5_WIDTH + 2 * GLA_HEADS * GLA_DK + 2 * GLA_HEADS * GLA_DV + 2 * GLA_RANK
AB_OUT = S5_WIDTH + GLA_HEADS * GLA_DV
RET_IN = 2 * RET_HEADS * RET_DK + 2 * RET_HEADS * RET_DV
RET_OUT = RET_HEADS * RET_DV

kernel_name = 'hybrid_s5_gla_retention_macaron_encoder'


def rmsnorm(x, g):
    xf = x.astype(jnp.float32)
    y = xf * lax.rsqrt(jnp.mean(xf * xf, axis=-1, keepdims=True) + EPS)
    return (y * g.astype(jnp.float32)).astype(x.dtype)


def head_rmsnorm(o, g):
    y = o * lax.rsqrt(jnp.mean(o * o, axis=-1, keepdims=True) + EPS)
    return y * g.astype(jnp.float32).reshape(o.shape[-2], o.shape[-1])


def swiglu_ffn(h, w1, w2):
    gate, up = jnp.split(h @ w1, 2, axis=-1)
    return (jax.nn.silu(gate) * up) @ w2


def to_heads(t, n_heads):
    b, l, _ = t.shape
    return t.reshape(b, l, n_heads, -1).transpose(0, 2, 1, 3)


def flip_seq(t):
    return jnp.flip(t, axis=2)


def _complex_affine_combine(e1, e2):
    a1r, a1i, b1r, b1i = e1
    a2r, a2i, b2r, b2i = e2
    return (a2r * a1r - a2i * a1i,
            a2r * a1i + a2i * a1r,
            a2r * b1r - a2i * b1i + b2r,
            a2r * b1i + a2i * b1r + b2i)


def s5_bidirectional(u, lam_re, lam_im, b_re, b_im, c_re, c_im, log_dt, d_skip):
    f32 = jnp.float32
    uf = u.astype(f32)
    seq_len = u.shape[1]
    y = uf * d_skip.astype(f32).reshape(S5_GROUPS, S5_GROUP)
    for direction in range(2):
        lr = jnp.minimum(lam_re[direction].astype(f32), -1e-4)
        li = lam_im[direction].astype(f32)
        dt = jnp.exp(log_dt[direction].astype(f32))[:, None]
        mag = jnp.exp(lr * dt)
        ar = mag * jnp.cos(li * dt)
        ai = mag * jnp.sin(li * dt)
        den = lr * lr + li * li
        cr = ((ar - 1.0) * lr + ai * li) / den
        ci = (ai * lr - (ar - 1.0) * li) / den
        br = b_re[direction].astype(f32)
        bi = b_im[direction].astype(f32)
        bbr = cr[..., None] * br - ci[..., None] * bi
        bbi = cr[..., None] * bi + ci[..., None] * br
        bu_r = jnp.einsum('blgp,gnp->blgn', uf, bbr)
        bu_i = jnp.einsum('blgp,gnp->blgn', uf, bbi)
        a_r = jnp.broadcast_to(ar[None, None], (1, seq_len) + ar.shape)
        a_i = jnp.broadcast_to(ai[None, None], (1, seq_len) + ai.shape)
        _, _, xr, xi = lax.associative_scan(_complex_affine_combine, (a_r, a_i, bu_r, bu_i),
                                            reverse=(direction == 1), axis=1)
        y = y + jnp.einsum('blgn,gpn->blgp', xr, c_re[direction].astype(f32)) \
              - jnp.einsum('blgn,gpn->blgp', xi, c_im[direction].astype(f32))
    return y


def gla_chunked(q, k, v, g, strict):
    b_, h_, l_, dk = q.shape
    dv = v.shape[-1]
    n = l_ // CHUNK
    q = q.reshape(b_, h_, n, CHUNK, dk)
    k = k.reshape(b_, h_, n, CHUNK, dk)
    v = v.reshape(b_, h_, n, CHUNK, dv)
    g = g.reshape(b_, h_, n, CHUNK, dk)
    cum = jnp.cumsum(g, axis=3)
    q_dec = q * jnp.exp(cum)
    k_inv = k * jnp.exp(-cum)
    mask = jnp.tril(jnp.ones((CHUNK, CHUNK), dtype=bool), k=-1 if strict else 0)
    scores = jnp.where(mask, jnp.einsum('bhnid,bhnjd->bhnij', q_dec, k_inv), 0.0)
    o_intra = jnp.einsum('bhnij,bhnjv->bhniv', scores, v)
    last = cum[:, :, :, -1:, :]
    kv = jnp.einsum('bhnjd,bhnjv->bhndv', k * jnp.exp(last - cum), v)
    chunk_decay = jnp.exp(last[:, :, :, 0, :])

    def step(state, inp):
        dec, kv_c = inp
        return dec[..., None] * state + kv_c, state

    _, s_before = lax.scan(step, jnp.zeros((b_, h_, dk, dv), jnp.float32),
                           (jnp.moveaxis(chunk_decay, 2, 0), jnp.moveaxis(kv, 2, 0)))
    s_before = jnp.moveaxis(s_before, 0, 2)
    o_inter = jnp.einsum('bhnid,bhndv->bhniv', q_dec, s_before)
    return (o_intra + o_inter).reshape(b_, h_, l_, dv)


def retention_chunkwise(q, k, v, log_gamma, strict):
    b_, h_, l_, dk = q.shape
    dv = v.shape[-1]
    n = l_ // CHUNK
    q = q.reshape(b_, h_, n, CHUNK, dk)
    k = k.reshape(b_, h_, n, CHUNK, dk)
    v = v.reshape(b_, h_, n, CHUNK, dv)
    idx_i = jnp.arange(CHUNK)
    diff_i = idx_i[:, None] - idx_i[None, :]
    mask = diff_i >= (1 if strict else 0)
    idx = idx_i.astype(jnp.float32)
    diff = jnp.maximum(diff_i, 0).astype(jnp.float32)
    decay_mat = jnp.where(mask[None], jnp.exp(diff[None] * log_gamma[:, None, None]), 0.0)
    scores = jnp.einsum('bhnid,bhnjd->bhnij', q, k) * decay_mat[None, :, None]
    o_intra = jnp.einsum('bhnij,bhnjv->bhniv', scores, v)
    zeta = jnp.exp((CHUNK - 1.0 - idx)[None, :] * log_gamma[:, None])
    xi = jnp.exp((idx + 1.0)[None, :] * log_gamma[:, None])
    kv = jnp.einsum('bhnjd,bhnjv,hj->bhndv', k, v, zeta)
    chunk_decay = jnp.exp(CHUNK * log_gamma)

    def step(state, kv_c):
        return chunk_decay[None, :, None, None] * state + kv_c, state

    _, r_before = lax.scan(step, jnp.zeros((b_, h_, dk, dv), jnp.float32), jnp.moveaxis(kv, 2, 0))
    r_before = jnp.moveaxis(r_before, 0, 2)
    o_inter = jnp.einsum('bhnid,bhndv,hi->bhniv', q, r_before, xi)
    return (o_intra + o_inter).reshape(b_, h_, l_, dv)


def rotary(t):
    dk = t.shape[-1]
    half = dk // 2
    pos = jnp.arange(t.shape[2], dtype=jnp.float32)
    inv = jnp.exp(-math.log(ROPE_BASE) * jnp.arange(half, dtype=jnp.float32) / half)
    ang = pos[:, None] * inv[None, :]
    cos, sin = jnp.cos(ang), jnp.sin(ang)
    t1, t2 = t[..., :half], t[..., half:]
    return jnp.concatenate([t1 * cos - t2 * sin, t1 * sin + t2 * cos], axis=-1)


def s5_gla_mixer(h, w_in, lam_re, lam_im, b_re, b_im, c_re, c_im, log_dt, d_skip, w_glu,
                 w_gk, b_gk, gla_norm, w_out):
    b_, l_, _ = h.shape
    hk = GLA_HEADS * GLA_DK
    hv = GLA_HEADS * GLA_DV
    proj = h @ w_in
    cuts = [S5_WIDTH, S5_WIDTH + hk, S5_WIDTH + 2 * hk, S5_WIDTH + 2 * hk + hv, S5_WIDTH + 2 * hk + 2 * hv]
    u, q, k, v, og, glo = jnp.split(proj, cuts, axis=-1)
    y = s5_bidirectional(u.reshape(b_, l_, S5_GROUPS, S5_GROUP), lam_re, lam_im, b_re, b_im,
                         c_re, c_im, log_dt, d_skip).reshape(b_, l_, S5_WIDTH)
    gy = jax.nn.gelu(y).astype(h.dtype)
    s5_out = gy * jax.nn.sigmoid(gy @ w_glu)
    glo = glo.reshape(b_, l_, 2, GLA_RANK)
    gk = jnp.einsum('blsr,srk->blsk', glo, w_gk) + b_gk
    gk = jax.nn.log_sigmoid(gk.astype(jnp.float32)) / GLA_GATE_NORM
    qh = to_heads(q, GLA_HEADS).astype(jnp.float32) * GLA_DK ** -0.5
    kh = to_heads(k, GLA_HEADS).astype(jnp.float32)
    vh = to_heads(v, GLA_HEADS).astype(jnp.float32)
    gf = to_heads(gk[:, :, 0], GLA_HEADS)
    gb = to_heads(gk[:, :, 1], GLA_HEADS)
    o_f = gla_chunked(qh, kh, vh, gf, strict=False)
    o_b = flip_seq(gla_chunked(flip_seq(qh), flip_seq(kh), flip_seq(vh), flip_seq(gb), strict=True))
    o = head_rmsnorm((o_f + o_b).transpose(0, 2, 1, 3), gla_norm).reshape(b_, l_, hv)
    gla_out = o.astype(h.dtype) * jax.nn.silu(og)
    return jnp.concatenate([s5_out, gla_out], axis=-1) @ w_out


def retention_mixer(h, w_in, ret_norm, w_out):
    b_, l_, _ = h.shape
    hk = RET_HEADS * RET_DK
    hv = RET_HEADS * RET_DV
    q, k, v, og = jnp.split(h @ w_in, [hk, 2 * hk, 2 * hk + hv], axis=-1)
    qh = rotary(to_heads(q, RET_HEADS).astype(jnp.float32))
    kh = rotary(to_heads(k, RET_HEADS).astype(jnp.float32)) * RET_DK ** -0.5
    vh = to_heads(v, RET_HEADS).astype(jnp.float32)
    lg_f = jnp.log1p(-jnp.exp2(-5.0 - jnp.arange(RET_HEADS, dtype=jnp.float32)))
    lg_b = lg_f[::-1]
    o_f = retention_chunkwise(qh, kh, vh, lg_f, strict=False)
    o_b = flip_seq(retention_chunkwise(flip_seq(qh), flip_seq(kh), flip_seq(vh), lg_b, strict=True))
    o = head_rmsnorm((o_f + o_b).transpose(0, 2, 1, 3), ret_norm).reshape(b_, l_, hv)
    return (o.astype(h.dtype) * jax.nn.silu(og)) @ w_out


def setup_inputs(seed: int = 0) -> dict:
    key = jax.random.key(seed)
    ks = jax.random.split(key, 32)
    f32 = jnp.float32

    def nrm(k, shape, scale):
        return jax.random.normal(k, shape, f32) * scale

    def gain(k, shape):
        return 1.0 + 0.02 * jax.random.normal(k, shape, f32)

    n_idx = jnp.arange(S5_STATE, dtype=f32)
    return {
        'x': nrm(ks[0], (BATCH, SEQ, D_MODEL), 1.0),
        'ffn1_norm': gain(ks[1], (DEPTH, D_MODEL)),
        'ffn1_w1': nrm(ks[2], (DEPTH, D_MODEL, 2 * D_FF), D_MODEL ** -0.5),
        'ffn1_w2': nrm(ks[3], (DEPTH, D_FF, D_MODEL), D_FF ** -0.5),
        'mix_norm': gain(ks[4], (DEPTH, D_MODEL)),
        'ffn2_norm': gain(ks[5], (DEPTH, D_MODEL)),
        'ffn2_w1': nrm(ks[6], (DEPTH, D_MODEL, 2 * D_FF), D_MODEL ** -0.5),
        'ffn2_w2': nrm(ks[7], (DEPTH, D_FF, D_MODEL), D_FF ** -0.5),
        'ab_w_in': nrm(ks[8], (N_EVEN, D_MODEL, AB_IN), D_MODEL ** -0.5),
        's5_lambda_re': -0.5 + 0.01 * jax.random.normal(ks[9], (N_EVEN, 2, S5_GROUPS, S5_STATE), f32),
        's5_lambda_im': math.pi * n_idx + 0.01 * jax.random.normal(ks[10], (N_EVEN, 2, S5_GROUPS, S5_STATE), f32),
        's5_b_re': nrm(ks[11], (N_EVEN, 2, S5_GROUPS, S5_STATE, S5_GROUP), (2 * S5_GROUP) ** -0.5),
        's5_b_im': nrm(ks[12], (N_EVEN, 2, S5_GROUPS, S5_STATE, S5_GROUP), (2 * S5_GROUP) ** -0.5),
        's5_c_re': nrm(ks[13], (N_EVEN, 2, S5_GROUPS, S5_GROUP, S5_STATE), (2 * S5_STATE) ** -0.5),
        's5_c_im': nrm(ks[14], (N_EVEN, 2, S5_GROUPS, S5_GROUP, S5_STATE), (2 * S5_STATE) ** -0.5),
        's5_log_dt': jax.random.uniform(ks[15], (N_EVEN, 2, S5_GROUPS), f32, math.log(1e-3), math.log(1e-1)),
        's5_d': nrm(ks[16], (N_EVEN, S5_WIDTH), 1.0),
        's5_w_glu': nrm(ks[17], (N_EVEN, S5_WIDTH, S5_WIDTH), S5_WIDTH ** -0.5),
        'gla_w_gk': nrm(ks[18], (N_EVEN, 2, GLA_RANK, GLA_HEADS * GLA_DK), GLA_RANK ** -0.5),
        'gla_b_gk': nrm(ks[19], (N_EVEN, 2, GLA_HEADS * GLA_DK), 0.1),
        'gla_norm': gain(ks[20], (N_EVEN, GLA_HEADS * GLA_DV)),
        'ab_w_out': nrm(ks[21], (N_EVEN, AB_OUT, D_MODEL), AB_OUT ** -0.5),
        'ret_w_in': nrm(ks[22], (N_ODD, D_MODEL, RET_IN), D_MODEL ** -0.5),
        'ret_norm': gain(ks[23], (N_ODD, RET_OUT)),
        'ret_w_out': nrm(ks[24], (N_ODD, RET_OUT, D_MODEL), RET_OUT ** -0.5),
        'final_norm': gain(ks[25], (D_MODEL,)),
    }


def reference(x, ffn1_norm, ffn1_w1, ffn1_w2, mix_norm, ffn2_norm, ffn2_w1, ffn2_w2,
              ab_w_in, s5_lambda_re, s5_lambda_im, s5_b_re, s5_b_im, s5_c_re, s5_c_im,
              s5_log_dt, s5_d, s5_w_glu, gla_w_gk, gla_b_gk, gla_norm, ab_w_out,
              ret_w_in, ret_norm, ret_w_out, final_norm):
    for i in range(DEPTH):
        j = i // 2
        x = x + 0.5 * swiglu_ffn(rmsnorm(x, ffn1_norm[i]), ffn1_w1[i], ffn1_w2[i])
        h = rmsnorm(x, mix_norm[i])
        if i % 2 == 0:
            x = x + s5_gla_mixer(h, ab_w_in[j], s5_lambda_re[j], s5_lambda_im[j], s5_b_re[j], s5_b_im[j],
                                 s5_c_re[j], s5_c_im[j], s5_log_dt[j], s5_d[j], s5_w_glu[j],
                                 gla_w_gk[j], gla_b_gk[j], gla_norm[j], ab_w_out[j])
        else:
            x = x + retention_mixer(h, ret_w_in[j], ret_norm[j], ret_w_out[j])
        x = x + 0.5 * swiglu_ffn(rmsnorm(x, ffn2_norm[i]), ffn2_w1[i], ffn2_w2[i])
    return rmsnorm(x, final_norm)
```

```cpp
#include <hip/hip_runtime.h>
#include <hip/hip_cooperative_groups.h>
#include <cstdio>
#include <cstdint>
namespace cg = cooperative_groups;

#ifndef ONE_LAUNCH
#define ONE_LAUNCH 1
#endif

#ifndef PHASE_MASK
#define PHASE_MASK 0xffffffffffull
#endif
#define EN(n) (((PHASE_MASK) >> (n)) & 1ull)
#ifndef PROBE_MASK
#define PROBE_MASK 0ull
#endif
#define LAS __attribute__((address_space(3)))
typedef unsigned short bf16_t;
typedef short bf16x8 __attribute__((ext_vector_type(8)));
typedef float f32x4 __attribute__((ext_vector_type(4)));
typedef float f32x2 __attribute__((ext_vector_type(2)));
typedef unsigned u32x2 __attribute__((ext_vector_type(2)));
typedef unsigned u32x4 __attribute__((ext_vector_type(4)));
__device__ __forceinline__ u32x4 mk4(unsigned a, unsigned b, unsigned c, unsigned d) { return (u32x4){a, b, c, d}; }
__device__ __forceinline__ u32x2 mk2(unsigned a, unsigned b) { return (u32x2){a, b}; }
__device__ __forceinline__ f32x2 mkf2(float a, float b) { return (f32x2){a, b}; }

constexpr int NTHR = 512;
constexpr int LDS_BYTES = 147456;
constexpr int NPHASE = 32;

struct Params { const float* in[26]; float* out; unsigned char* ws; };
typedef const __attribute__((address_space(4))) Params* CP;

constexpr size_t MiB = 1ull << 20;
constexpr size_t OFF_W1 = 0, SZ_W1 = 11 * MiB;
constexpr size_t OFF_W2 = 44 * MiB, SZ_W2 = 5 * MiB + MiB / 2;
constexpr size_t OFF_WIN0 = 66 * MiB;
constexpr size_t OFF_WGLU = 70 * MiB + MiB / 2;
constexpr size_t OFF_WOUT0 = 71 * MiB;
constexpr size_t OFF_WIN1 = 73 * MiB;
constexpr size_t OFF_WOUT1 = 85 * MiB;
constexpr size_t OFF_ROPE = 89 * MiB;
constexpr size_t OFF_KTAB = 93 * MiB;
constexpr size_t OFF_S5P = 97 * MiB;
constexpr size_t OFF_XN = 98 * MiB;
constexpr size_t OFF_R = 226 * MiB;
constexpr size_t OFF_ACT = OFF_R;
constexpr size_t OFF_PQ = OFF_R;
constexpr size_t OFF_AS5 = OFF_R + 224 * MiB;
constexpr size_t OFF_E = OFF_R + 304 * MiB;
constexpr size_t OFF_KG = OFF_R + 352 * MiB;
constexpr size_t OFF_H = OFF_R + 432 * MiB;
constexpr size_t OFF_GST = OFF_R + 448 * MiB;
constexpr size_t OFF_GDEC = OFF_R + 704 * MiB;
constexpr size_t OFF_GY = OFF_R + 706 * MiB;
constexpr size_t OFF_PROJ1 = OFF_R;
constexpr size_t OFF_RST = OFF_R + 384 * MiB;
constexpr size_t OFF_SSQ = 998 * MiB;
constexpr int SSN = 65536 * 16;
constexpr size_t OFF_XB2 = OFF_R + 448 * MiB;
constexpr size_t OFF_OBUF = OFF_R + 640 * MiB;

__device__ __forceinline__ int otid() { int t = threadIdx.x; asm volatile("" : "+v"(t)); return t; }
__device__ __forceinline__ int obid() { int t = blockIdx.x; asm volatile("" : "+s"(t)); return t; }
__device__ __forceinline__ bf16_t f2bf(float f) { unsigned u = __float_as_uint(f); u += 0x7FFFu + ((u >> 16) & 1u); return (bf16_t)(u >> 16); }
__device__ __forceinline__ float bf2f(unsigned b) { return __uint_as_float(b << 16); }
typedef __bf16 bf16x2_t __attribute__((ext_vector_type(2)));
typedef float f32x2_t __attribute__((ext_vector_type(2)));
__device__ __forceinline__ unsigned pack2(float lo, float hi) { const f32x2_t v = {lo, hi}; const bf16x2_t b = __builtin_convertvector(v, bf16x2_t); return __builtin_bit_cast(unsigned, b); }
__device__ __forceinline__ float bflo(unsigned w) { return __uint_as_float(w << 16); }
__device__ __forceinline__ float bfhi(unsigned w) { return __uint_as_float(w & 0xffff0000u); }
__device__ __forceinline__ float fast_sigmoid(float x) { return __builtin_amdgcn_rcpf(1.0f + __expf(-x)); }
__device__ __forceinline__ float silu_f(float x) { return x * fast_sigmoid(x); }
__device__ __forceinline__ float gelu_tanh(float x) { const float u = 0.7978845608028654f * (x + 0.044715f * x * x * x); return x * fast_sigmoid(2.0f * u); }

namespace pg8 {
constexpr int BM = 256, BK = 64, HALF = 128, HTB = HALF * BK * 2, STAGE_BYTES = 8 * HTB, NXCD = 8, WGM = 8;
__device__ __forceinline__ int lds_byte(int r, int c) { const int st = (r >> 4) * 2 + (c >> 5), rr = r & 15, cc = c & 31, ob = rr * 64 + cc * 2; return st * 1024 + (ob ^ (((ob >> 9) & 1) << 5)); }
__device__ __forceinline__ void stage_rc(int b, int& R, int& C) { const int st = b / 1024, sb = b % 1024, swz = sb ^ (((sb >> 9) & 1) << 5); R = (st >> 1) * 16 + swz / 64; C = (st & 1) * 32 + (swz % 64) / 2; }

__device__ __forceinline__ int perm32(int rho) { const int n = rho >> 4, i = rho & 15; return 8 * (i >> 2) + 4 * n + (i & 3); }
struct Unit { int pm, pn, bz; };
struct Gemm { const bf16_t* A; const bf16_t* Bt; int lda, ldb, K, nM, nN, nB; size_t strideA, strideB; };

struct Sched {
    int nM, nN, nwg, total, G, c;
    __device__ void init(int nM_, int nN_, int nB_, int G_, int c_) { nM = nM_; nN = nN_; nwg = nM * nN; total = nwg * nB_; G = G_; c = c_; }
    __device__ bool next(int i, Unit& u) const {
        const long L = (long)i * G + c; if (L >= total) return false;
        u.bz = (int)(L / nwg); int wgid = (int)(L % nwg);
        { const int q = nwg / NXCD, r = nwg % NXCD, xcd = wgid % NXCD, off = wgid / NXCD; wgid = (xcd < r ? xcd * (q + 1) : r * (q + 1) + (xcd - r) * q) + off; }
        const int nig = WGM * nN, gid = wgid / nig, fm = gid * WGM, gsz = (nM - fm) < WGM ? (nM - fm) : WGM;
        u.pm = fm + ((wgid % nig) % gsz); u.pn = (wgid % nig) / gsz; return true;
    }
};

template <class Epi>
__device__ __forceinline__ void gemm_phase(LAS unsigned char* lds, const Gemm g, const Epi& E) {
    const int tid = otid(), wid = __builtin_amdgcn_readfirstlane(tid >> 6), lane = tid & 63, wr = wid >> 2, wc = wid & 3, fr = lane & 15, fq = lane >> 4;
    const int nt = g.K / BK;
    Sched S; S.init(g.nM, g.nN, g.nB, (int)gridDim.x, obid());
    unsigned voffA[2], voffB[2];
#pragma unroll
    for (int i = 0; i < 2; ++i) { int R, C; stage_rc(tid * 16 + i * 8192, R, C); const int Rb = Epi::PERM ? ((R & ~31) + perm32(R & 31)) : R;
        voffA[i] = (unsigned)(R * g.lda + C) * 2u; voffB[i] = (unsigned)(Rb * g.ldb + C) * 2u; }
    const size_t kstep = (size_t)(BK * 2);
    const size_t hstepA = (size_t)HALF * g.lda * 2, hstepB = (size_t)HALF * g.ldb * 2;
    const size_t tstepA = 2 * hstepA, tstepB = 2 * hstepB;
    const unsigned ldsw = (unsigned)wid * 1024u;
    const int aoff = lds_byte(wr * 64 + fr, fq * 8), boff = lds_byte(wc * 32 + fr, fq * 8);
#define PG8_SA(b, h) (((b) * 2 + (h)) * HTB)
#define PG8_SB(b, h) ((4 + (b) * 2 + (h)) * HTB)
#define PG8_STAGE(bufoff, gbase, voff) do { _Pragma("unroll") for (int _i = 0; _i < 2; ++_i) \
        __builtin_amdgcn_global_load_lds((const unsigned*)((const char*)(gbase) + (voff)[_i]), (LAS unsigned*)(lds + (bufoff) + ldsw + _i * 8192), 16, 0, 0); } while (0)
#define PG8_LDA(dst, b, h) do { _Pragma("unroll") for (int m = 0; m < 4; ++m) _Pragma("unroll") for (int k = 0; k < 2; ++k) dst[m][k] = *(const LAS bf16x8*)(lds + PG8_SA(b, h) + aoff + m * 2048 + k * 1024); } while (0)
#define PG8_LDB(dst, b, h) do { _Pragma("unroll") for (int n = 0; n < 2; ++n) _Pragma("unroll") for (int k = 0; k < 2; ++k) dst[n][k] = *(const LAS bf16x8*)(lds + PG8_SB(b, h) + boff + n * 2048 + k * 1024); } while (0)
#define PG8_MMA(ai, bj, At, Bt) do { __builtin_amdgcn_s_setprio(1); _Pragma("unroll") for (int m = 0; m < 4; ++m) _Pragma("unroll") for (int n = 0; n < 2; ++n) _Pragma("unroll") for (int k = 0; k < 2; ++k) \
        acc[ai][bj][m][n] = __builtin_amdgcn_mfma_f32_16x16x32_bf16(Bt[n][k], At[m][k], acc[ai][bj][m][n], 0, 0, 0); __builtin_amdgcn_s_setprio(0); } while (0)
#define PG8_WAIT_V(n) asm volatile("s_waitcnt vmcnt(" #n ")" ::: "memory")
#define PG8_WAIT_L(n) asm volatile("s_waitcnt lgkmcnt(" #n ")" ::: "memory")
#define PG8_BAR __builtin_amdgcn_s_barrier()
#define PG8_SCHED __builtin_amdgcn_sched_barrier(0)
    Unit cur, nxt; int ui = 0;
    if (!S.next(0, cur)) return;
    int tag0 = -1, tag1 = -1, tag2 = -1, tag3 = -1; LAS float* rstab = (LAS float*)(lds + STAGE_BYTES);
    if constexpr (Epi::RSTD) {
        { Unit t_; for (int i = 0; S.next(i, t_); ++i) { const int pm = t_.pm; if (pm == tag0 || pm == tag1 || pm == tag2 || pm == tag3) continue;
                if (tag0 < 0) tag0 = pm; else if (tag1 < 0) tag1 = pm; else if (tag2 < 0) tag2 = pm; else tag3 = pm; } }
#pragma unroll
        for (int sl = 0; sl < 2; ++sl) { const int slot = (tid >> 8) + 2 * sl; const int pm = slot == 0 ? tag0 : slot == 1 ? tag1 : slot == 2 ? tag2 : tag3;
            if (pm >= 0) { const f32x4* p = (const f32x4*)(E.SS + ((size_t)pm * 256 + (tid & 255)) * 16); const f32x4 a = p[0], b = p[1], c = p[2], d = p[3]; const f32x4 t = (a + b) + (c + d);
                rstab[slot * 256 + (tid & 255)] = rsqrtf(((t[0] + t[1]) + (t[2] + t[3])) * (1.0f / 1024.0f) + 1e-6f); } }
        __syncthreads();
    }
    f32x4 acc[2][2][4][2];
#pragma unroll
    for (int a = 0; a < 2; ++a)
#pragma unroll
        for (int b = 0; b < 2; ++b)
#pragma unroll
            for (int m = 0; m < 4; ++m)
#pragma unroll
                for (int n = 0; n < 2; ++n) acc[a][b][m][n] = (f32x4){0.f, 0.f, 0.f, 0.f};
    bf16x8 At[4][2], B0[2][2], B1[2][2];
    const char* cA = (const char*)g.A + (size_t)cur.bz * g.strideA * 2 + (size_t)cur.pm * tstepA;
    const char* cB = (const char*)g.Bt + (size_t)cur.bz * g.strideB * 2 + (size_t)cur.pn * tstepB;
    PG8_STAGE(PG8_SB(0, 0), cB, voffB); PG8_STAGE(PG8_SB(0, 1), cB + hstepB, voffB); PG8_STAGE(PG8_SA(0, 0), cA, voffA); PG8_STAGE(PG8_SA(0, 1), cA + hstepA, voffA);
    if (wr == 1) PG8_BAR;
    PG8_WAIT_V(2); PG8_BAR;
    PG8_STAGE(PG8_SB(1, 0), cB + kstep, voffB); PG8_STAGE(PG8_SA(1, 0), cA + kstep, voffA); PG8_STAGE(PG8_SB(1, 1), cB + hstepB + kstep, voffB);
    PG8_WAIT_V(6); PG8_BAR;
    for (;;) {
        const bool has_next = S.next(ui + 1, nxt);
        const char* nA = has_next ? (const char*)g.A + (size_t)nxt.bz * g.strideA * 2 + (size_t)nxt.pm * tstepA : cA;
        const char* nB = has_next ? (const char*)g.Bt + (size_t)nxt.bz * g.strideB * 2 + (size_t)nxt.pn * tstepB : cB;
        for (int t = 0; t < nt; t += 2) {
            const bool last = (t == nt - 2);
            const char* a1 = cA + (size_t)(t + 1) * kstep;
            const char* a2 = last ? nA : cA + (size_t)(t + 2) * kstep; const char* b2 = last ? nB : cB + (size_t)(t + 2) * kstep;
            const char* a3 = a2 + kstep; const char* b3 = b2 + kstep;
            PG8_LDB(B0, 0, 0); PG8_LDB(B1, 0, 1); PG8_SCHED; PG8_LDA(At, 0, 0); PG8_STAGE(PG8_SA(1, 1), a1 + hstepA, voffA);
            PG8_WAIT_V(8); PG8_WAIT_L(0); PG8_BAR; PG8_MMA(0, 0, At, B0); PG8_MMA(0, 1, At, B1); PG8_BAR; PG8_SCHED;
            PG8_LDA(At, 0, 1); PG8_STAGE(PG8_SB(0, 0), b2, voffB); PG8_STAGE(PG8_SB(0, 1), b2 + hstepB, voffB); PG8_STAGE(PG8_SA(0, 0), a2, voffA);
            PG8_WAIT_V(8); PG8_WAIT_L(0); PG8_BAR; PG8_MMA(1, 0, At, B0); PG8_MMA(1, 1, At, B1); PG8_BAR; PG8_SCHED;
            PG8_LDB(B0, 1, 0); PG8_LDB(B1, 1, 1); PG8_SCHED; PG8_LDA(At, 1, 0); PG8_STAGE(PG8_SA(0, 1), a2 + hstepA, voffA);
            PG8_WAIT_V(8); PG8_WAIT_L(0); PG8_BAR; PG8_MMA(0, 0, At, B0); PG8_MMA(0, 1, At, B1); PG8_BAR; PG8_SCHED;
            PG8_LDA(At, 1, 1); PG8_STAGE(PG8_SB(1, 0), b3, voffB); PG8_STAGE(PG8_SB(1, 1), b3 + hstepB, voffB); PG8_STAGE(PG8_SA(1, 0), a3, voffA);
            PG8_WAIT_V(8); PG8_WAIT_L(0); PG8_BAR; PG8_MMA(1, 0, At, B0); PG8_MMA(1, 1, At, B1); PG8_BAR; PG8_SCHED;
        }
        if (wr == 0) PG8_BAR;
        E(acc, cur, wr, wc, fr, fq, rstab + (cur.pm == tag1 ? 256 : cur.pm == tag2 ? 512 : cur.pm == tag3 ? 768 : 0));
        if (!has_next) break;
#pragma unroll
        for (int a = 0; a < 2; ++a)
#pragma unroll
            for (int b = 0; b < 2; ++b)
#pragma unroll
                for (int m = 0; m < 4; ++m)
#pragma unroll
                    for (int n = 0; n < 2; ++n) acc[a][b][m][n] = (f32x4){0.f, 0.f, 0.f, 0.f};
        cur = nxt; cA = nA; cB = nB; ++ui;
        if (wr == 1) PG8_BAR;
    }
    PG8_WAIT_V(0);
    PG8_BAR;
#undef PG8_SA
#undef PG8_SB
#undef PG8_STAGE
#undef PG8_LDA
#undef PG8_LDB
#undef PG8_MMA
#undef PG8_WAIT_V
#undef PG8_WAIT_L
#undef PG8_BAR
#undef PG8_SCHED
}
}
using pg8::Unit;
typedef const f32x4 (&AccRef)[2][2][4][2];

struct EpiSwiGLU {
    static constexpr bool PERM = true, RSTD = true;
    bf16_t* O; const float* SS;
    __device__ __forceinline__ void operator()(AccRef acc, const Unit& u, int wr, int wc, int fr, int fq, const LAS float* rsl) const {
        const int row0 = u.pm * 256 + wr * 64 + fr, col0 = u.pn * 128 + wc * 32 + 8 * fq;
#pragma unroll
        for (int ai = 0; ai < 2; ++ai)
#pragma unroll
            for (int m = 0; m < 4; ++m) { bf16_t* rowp = O + (size_t)(row0 + ai * 128 + m * 16) * 2816 + col0; uint4 w; const float rs = rsl[ai * 128 + wr * 64 + m * 16 + fr];
                { const f32x4 gt = rs * acc[ai][0][m][0], up = rs * acc[ai][1][m][0]; w.x = pack2(silu_f(gt[0]) * up[0], silu_f(gt[1]) * up[1]); w.y = pack2(silu_f(gt[2]) * up[2], silu_f(gt[3]) * up[3]); }
                { const f32x4 gt = rs * acc[ai][0][m][1], up = rs * acc[ai][1][m][1]; w.z = pack2(silu_f(gt[0]) * up[0], silu_f(gt[1]) * up[1]); w.w = pack2(silu_f(gt[2]) * up[2], silu_f(gt[3]) * up[3]); }
                *(uint4*)rowp = w; }
    }
};
template <bool STATS> struct EpiResid {
    static constexpr bool PERM = true, RSTD = false;
    const float* Xin; float* X; bf16_t* XB; float* SS; float alpha;
    __device__ __forceinline__ void operator()(AccRef acc, const Unit& u, int wr, int wc, int fr, int fq, const LAS float* rsl) const {
        const int row0 = u.pm * 256 + wr * 64 + fr, col0 = u.pn * 256 + wc * 32 + 8 * fq;
#pragma unroll
        for (int ai = 0; ai < 2; ++ai)
#pragma unroll
            for (int m = 0; m < 4; ++m) { const size_t ro = (size_t)(row0 + ai * 128 + m * 16) * 1024 + col0; float sq = 0.f;
#pragma unroll
                for (int bj = 0; bj < 2; ++bj) { const size_t o = ro + bj * 128; const f32x4 x0 = *(const f32x4*)(Xin + o), x1 = *(const f32x4*)(Xin + o + 4);
                    const f32x4 y0 = x0 + alpha * acc[ai][bj][m][0], y1 = x1 + alpha * acc[ai][bj][m][1]; *(f32x4*)(X + o) = y0; *(f32x4*)(X + o + 4) = y1;
                    if (STATS) { uint4 w; w.x = pack2(y0[0], y0[1]); w.y = pack2(y0[2], y0[3]); w.z = pack2(y1[0], y1[1]); w.w = pack2(y1[2], y1[3]); *(uint4*)(XB + o) = w;
                        sq += y0[0] * y0[0] + y0[1] * y0[1] + y0[2] * y0[2] + y0[3] * y0[3] + y1[0] * y1[0] + y1[1] * y1[1] + y1[2] * y1[2] + y1[3] * y1[3]; } }
                if (STATS) { sq += __shfl_xor(sq, 16); sq += __shfl_xor(sq, 32); if (fq == 0) SS[(size_t)(row0 + ai * 128 + m * 16) * 16 + u.pn * 4 + wc] = sq; } }
    }
};
struct EpiBf16 {
    static constexpr bool PERM = true, RSTD = true;
    bf16_t* O; int ldc; const float* SS;
    __device__ __forceinline__ void operator()(AccRef acc, const Unit& u, int wr, int wc, int fr, int fq, const LAS float* rsl) const {
        const int row0 = u.pm * 256 + wr * 64 + fr, col0 = u.pn * 256 + wc * 32 + 8 * fq;
#pragma unroll
        for (int ai = 0; ai < 2; ++ai)
#pragma unroll
            for (int m = 0; m < 4; ++m) { bf16_t* rowp = O + (size_t)(row0 + ai * 128 + m * 16) * ldc + col0; const float rs = rsl[ai * 128 + wr * 64 + m * 16 + fr];
#pragma unroll
                for (int bj = 0; bj < 2; ++bj) { const f32x4 v0 = rs * acc[ai][bj][m][0], v1 = rs * acc[ai][bj][m][1]; uint4 w; w.x = pack2(v0[0], v0[1]); w.y = pack2(v0[2], v0[3]); w.z = pack2(v1[0], v1[1]); w.w = pack2(v1[2], v1[3]);
                    *(uint4*)(rowp + bj * 128) = w; } }
    }
};
struct EpiWin0 {
    static constexpr bool PERM = true, RSTD = true;
    bf16_t* AS5; bf16_t* PQ; const float* SS;
    __device__ __forceinline__ void operator()(AccRef acc, const Unit& u, int wr, int wc, int fr, int fq, const LAS float* rsl) const {
        const int row0 = u.pm * 256 + wr * 64 + fr, col0 = u.pn * 256 + wc * 32 + 8 * fq;
#pragma unroll
        for (int ai = 0; ai < 2; ++ai)
#pragma unroll
            for (int m = 0; m < 4; ++m) { const int r = row0 + ai * 128 + m * 16; const float rs = rsl[ai * 128 + wr * 64 + m * 16 + fr];
#pragma unroll
                for (int bj = 0; bj < 2; ++bj) { const int c = col0 + bj * 128; const f32x4 v0 = rs * acc[ai][bj][m][0], v1 = rs * acc[ai][bj][m][1];
                    uint4 w; w.x = pack2(v0[0], v0[1]); w.y = pack2(v0[2], v0[3]); w.z = pack2(v1[0], v1[1]); w.w = pack2(v1[2], v1[3]);
                    if (u.pn < 2) *(uint4*)(AS5 + ((size_t)((c >> 4) * 1024 + (r >> 6))) * 1280 + (r & 63) * 16 + (c & 15)) = w;
                    else *(uint4*)(PQ + (size_t)r * 1792 + (c - 512)) = w; } }
    }
};
struct EpiGLU {
    static constexpr bool PERM = true, RSTD = false;
    const bf16_t* GY; bf16_t* MIX;
    __device__ __forceinline__ void operator()(AccRef acc, const Unit& u, int wr, int wc, int fr, int fq, const LAS float* rsl) const {
        const int row0 = u.pm * 256 + wr * 64 + fr, col0 = u.pn * 256 + wc * 32 + 8 * fq;
#pragma unroll
        for (int ai = 0; ai < 2; ++ai)
#pragma unroll
            for (int m = 0; m < 4; ++m) { const int r = row0 + ai * 128 + m * 16;
#pragma unroll
                for (int bj = 0; bj < 2; ++bj) { const int c = col0 + bj * 128; const f32x4 v0 = acc[ai][bj][m][0], v1 = acc[ai][bj][m][1];
                    const uint4 gy = *(const uint4*)(GY + (size_t)r * 512 + c); uint4 w;
                    w.x = pack2(bflo(gy.x) * fast_sigmoid(v0[0]), bfhi(gy.x) * fast_sigmoid(v0[1])); w.y = pack2(bflo(gy.y) * fast_sigmoid(v0[2]), bfhi(gy.y) * fast_sigmoid(v0[3]));
                    w.z = pack2(bflo(gy.z) * fast_sigmoid(v1[0]), bfhi(gy.z) * fast_sigmoid(v1[1])); w.w = pack2(bflo(gy.w) * fast_sigmoid(v1[2]), bfhi(gy.w) * fast_sigmoid(v1[3]));
                    *(uint4*)(MIX + (size_t)r * 1024 + c) = w; } }
    }
};
struct EpiS5E {
    static constexpr bool PERM = false, RSTD = false;
    float* E;
    __device__ __forceinline__ void operator()(AccRef acc, const Unit& u, int wr, int wc, int fr, int fq, const LAS float* rsl) const {
        const int row0 = u.pm * 256 + wr * 64 + fr, col0 = wc * 32 + 4 * fq;
#pragma unroll
        for (int ai = 0; ai < 2; ++ai)
#pragma unroll
            for (int m = 0; m < 4; ++m) { float* rowp = E + ((size_t)u.bz * 1024 + row0 + ai * 128 + m * 16) * 256 + col0;
#pragma unroll
                for (int bj = 0; bj < 2; ++bj)
#pragma unroll
                    for (int n = 0; n < 2; ++n) *(f32x4*)(rowp + bj * 128 + n * 16) = acc[ai][bj][m][n]; }
    }
};
struct EpiS5Y {
    static constexpr bool PERM = true, RSTD = false;
    bf16_t* GY;
    __device__ __forceinline__ void operator()(AccRef acc, const Unit& u, int wr, int wc, int fr, int fq, const LAS float* rsl) const {
        const int row0 = u.pm * 256 + wr * 64 + fr, col0 = u.pn * 256 + wc * 32 + 8 * fq;
#pragma unroll
        for (int ai = 0; ai < 2; ++ai)
#pragma unroll
            for (int m = 0; m < 4; ++m) { const int bc = row0 + ai * 128 + m * 16;
#pragma unroll
                for (int bj = 0; bj < 2; ++bj) { const int c = col0 + bj * 128; const f32x4 v0 = acc[ai][bj][m][0], v1 = acc[ai][bj][m][1]; uint4 w;
                    w.x = pack2(gelu_tanh(v0[0]), gelu_tanh(v0[1])); w.y = pack2(gelu_tanh(v0[2]), gelu_tanh(v0[3])); w.z = pack2(gelu_tanh(v1[0]), gelu_tanh(v1[1])); w.w = pack2(gelu_tanh(v1[2]), gelu_tanh(v1[3]));
                    *(uint4*)(GY + ((size_t)bc * 64 + (c >> 4)) * 512 + u.bz * 16 + (c & 15)) = w; } }
    }
};

__device__ void transpose_job(const float* __restrict__ src, int K, int Nsrc, bf16_t* __restrict__ dst, int Ndst, int mode, LAS float* tile, int b0, int nb, const float* __restrict__ gain) {
    const int tid = otid();
    const int ntk = K >> 8, nt = (Ndst >> 6) * ntk;
    for (int t = obid() - b0; t < nt; t += nb) {
        const int tn = t / ntk, tk = t % ntk, n0 = tn * 64, k0 = tk * 256;
        int ns0 = n0;
        if (mode == 1) { const int tt = n0 >> 8, j = n0 & 255; ns0 = (j < 128) ? (tt * 128 + j) : (2816 + tt * 128 + (j - 128)); }
        const int r = tid >> 4, c4 = (tid & 15) * 4;
        float4 v[8];
#pragma unroll
        for (int rr = 0; rr < 8; ++rr) { v[rr] = make_float4(0.f, 0.f, 0.f, 0.f);
            if (ns0 + c4 + 3 < Nsrc) v[rr] = *(const float4*)(src + (size_t)(k0 + r + rr * 32) * Nsrc + ns0 + c4);
            if (gain) { const float gk = gain[k0 + r + rr * 32]; v[rr].x *= gk; v[rr].y *= gk; v[rr].z *= gk; v[rr].w *= gk; } }
#pragma unroll
        for (int rr = 0; rr < 8; ++rr) { const int kk = r + rr * 32; LAS float* tp = tile + (kk >> 6) * (64 * 65) + (kk & 63) * 65 + c4;
            tp[0] = v[rr].x; tp[1] = v[rr].y; tp[2] = v[rr].z; tp[3] = v[rr].w; }
        __syncthreads();
        const int n = tid >> 3, kq = (tid & 7) * 8;
#pragma unroll
        for (int kt = 0; kt < 4; ++kt) { const LAS float* tp = tile + kt * (64 * 65); uint4 w;
            w.x = pack2(tp[(kq + 0) * 65 + n], tp[(kq + 1) * 65 + n]); w.y = pack2(tp[(kq + 2) * 65 + n], tp[(kq + 3) * 65 + n]);
            w.z = pack2(tp[(kq + 4) * 65 + n], tp[(kq + 5) * 65 + n]); w.w = pack2(tp[(kq + 6) * 65 + n], tp[(kq + 7) * 65 + n]);
            *(uint4*)(dst + (size_t)(n0 + n) * K + k0 + kt * 64 + kq) = w; }
        __syncthreads();
    }
}

__device__ void s5_pre(CP P, int g, int dir, int part, LAS unsigned char* lds) {
    LAS f32x2* pw = (LAS f32x2*)lds;
    LAS f32x2* Bb = pw + 65 * 64;
    LAS f32x2* Cc = Bb + 64 * 16;
    const int tid = otid();
    float* Ktab = (float*)(P->ws + OFF_KTAB); float* AT = (float*)(P->ws + OFF_S5P);
    bf16_t* KG = (bf16_t*)(P->ws + OFF_KG); bf16_t* H = (bf16_t*)(P->ws + OFF_H);
    if (tid < 64) { const int n = tid, gi = (dir * 32 + g) * 64 + n;
        const double lr = fmin((double)P->in[9][gi], -1e-4), li = (double)P->in[10][gi], dt = (double)expf(P->in[15][dir * 32 + g]);
        const double em1 = (double)expm1f((float)(lr * dt)), mag = 1.0 + em1;
        double rev = li * dt * 0.15915494309189535; rev -= rint(rev); const float th = (float)(rev * 6.283185307179586), thh = 0.5f * th;
        const double sn_ = (double)sinf(th), shalf = (double)sinf(thh), cm1 = -2.0 * shalf * shalf;
        const double ar = mag * (1.0 + cm1), ai = mag * sn_, arm1 = em1 + cm1 + em1 * cm1, den = lr * lr + li * li;
        const double cr = (arm1 * lr + ai * li) / den, ci = (ai * lr - arm1 * li) / den;
#pragma unroll 1
        for (int p = 0; p < 16; ++p) { const double br = (double)P->in[11][gi * 16 + p], bi = (double)P->in[12][gi * 16 + p];
            Bb[n * 16 + p] = mkf2((float)(cr * br - ci * bi), (float)(cr * bi + ci * br)); }
        double xr = 1.0, xi = 0.0;
#pragma unroll 1
        for (int d = 0; d <= 64; ++d) { pw[d * 64 + n] = mkf2((float)xr, (float)xi); const double t0 = xr * ar - xi * ai; xi = xr * ai + xi * ar; xr = t0; }
        const f32x2 a64 = pw[64 * 64 + n];
        if (part == 0) { AT[((g * 2 + dir) * 64 + n) * 2 + 0] = a64.x; AT[((g * 2 + dir) * 64 + n) * 2 + 1] = a64.y; } }
#pragma unroll 1
    for (int idx = tid; idx < 16 * 64; idx += NTHR) { const int p = idx >> 6, n = idx & 63; const int ci_ = ((dir * 32 + g) * 16 + p) * 64 + n;
        Cc[idx] = mkf2(P->in[13][ci_], P->in[14][ci_]); }
    __syncthreads();
    { const int dq = tid >> 8, p = (tid >> 4) & 15, pp = tid & 15;
#pragma unroll 1
        for (int dd = 0; dd < 16; ++dd) { const int d = part * 32 + dq * 16 + dd; float acc = 0.f;
#pragma unroll 4
            for (int n = 0; n < 64; ++n) { const f32x2 w = pw[d * 64 + n], bb = Bb[n * 16 + pp], c = Cc[p * 64 + n];
                const float zr = w.x * bb.x - w.y * bb.y, zi = w.x * bb.y + w.y * bb.x; acc += c.x * zr - c.y * zi; }
            Ktab[((size_t)((g * 2 + dir) * 64 + d)) * 256 + p * 16 + pp] = acc; } }
#pragma unroll 1
    for (int idx = tid; idx < 512 * 64; idx += NTHR) { const int row = part * 512 + (idx >> 6), n = idx & 63, t = row >> 4, p = row & 15, d = dir == 0 ? t + 1 : 64 - t;
        const f32x2 w = pw[d * 64 + n], c = Cc[p * 64 + n]; const float gr = c.x * w.x - c.y * w.y, gi = c.x * w.y + c.y * w.x;
        *(unsigned*)(KG + ((size_t)(g * 1024 + row)) * 1280 + 1024 + dir * 128 + n * 2) = pack2(gr, -gi); }
#pragma unroll 1
    for (int idx = tid; idx < 32 * 64 * 8; idx += NTHR) { const int pp2 = (idx & 7) * 2, s = (idx >> 3) & 63, n = part * 32 + (idx >> 9), d = dir == 0 ? 63 - s : s;
        const f32x2 w = pw[d * 64 + n], b0 = Bb[n * 16 + pp2], b1 = Bb[n * 16 + pp2 + 1];
        const float hr0 = w.x * b0.x - w.y * b0.y, hi0 = w.x * b0.y + w.y * b0.x, hr1 = w.x * b1.x - w.y * b1.y, hi1 = w.x * b1.y + w.y * b1.x;
        const size_t row0 = (size_t)g * 256 + dir * 128 + n * 2;
        *(unsigned*)(H + row0 * 1024 + s * 16 + pp2) = pack2(hr0, hr1); *(unsigned*)(H + (row0 + 1) * 1024 + s * 16 + pp2) = pack2(hi0, hi1); }
    __syncthreads();
}

template <bool FINAL> __device__ void phase_norm(const float* __restrict__ x, const float* __restrict__ g, bf16_t* __restrict__ xb, float* __restrict__ ss_out, float* __restrict__ outf, int b0, int nb, int rbeg, int rend);
__device__ void phase_prologue(CP P, LAS unsigned char* lds) {
    const int tid = otid(), bq = obid();
    if (bq < 128) { if (EN(20)) s5_pre(P, bq >> 2, (bq >> 1) & 1, bq & 1, lds);
        phase_norm<false>(P->in[0], nullptr, (bf16_t*)(P->ws + OFF_XN), (float*)(P->ws + OFF_SSQ), nullptr, 0, 128, 0, 40960); return; }
    const int b0 = 128, nb = (int)gridDim.x - 128;
    if (EN(21)) { float* cs = (float*)(P->ws + OFF_ROPE); float* sn = cs + 8192 * 64;
        for (int idx = (bq - b0) * NTHR + tid; idx < 8192 * 64; idx += nb * NTHR) { const int pos = idx >> 6, f = idx & 63;
            const float inv = expf(-9.210340371976184f * (float)f * (1.0f / 64.0f)); const float ang = (float)pos * inv;
            cs[idx] = cosf(ang); sn[idx] = sinf(ang); } }
    phase_norm<false>(P->in[0], nullptr, (bf16_t*)(P->ws + OFF_XN), (float*)(P->ws + OFF_SSQ), nullptr, b0, nb, 40960, 65536);
    LAS float* tile = (LAS float*)lds;
    if (EN(22)) for (int l = 0; l < 2; ++l) {
        transpose_job(P->in[2] + (size_t)l * 1024 * 5632, 1024, 5632, (bf16_t*)(P->ws + OFF_W1 + (size_t)(2 * l) * SZ_W1), 5632, 1, tile, b0, nb, P->in[1] + l * 1024);
        transpose_job(P->in[6] + (size_t)l * 1024 * 5632, 1024, 5632, (bf16_t*)(P->ws + OFF_W1 + (size_t)(2 * l + 1) * SZ_W1), 5632, 1, tile, b0, nb, P->in[5] + l * 1024);
        transpose_job(P->in[3] + (size_t)l * 2816 * 1024, 2816, 1024, (bf16_t*)(P->ws + OFF_W2 + (size_t)(2 * l) * SZ_W2), 1024, 0, tile, b0, nb, nullptr);
        transpose_job(P->in[7] + (size_t)l * 2816 * 1024, 2816, 1024, (bf16_t*)(P->ws + OFF_W2 + (size_t)(2 * l + 1) * SZ_W2), 1024, 0, tile, b0, nb, nullptr);
    }
    if (EN(22)) transpose_job(P->in[8], 1024, 2080, (bf16_t*)(P->ws + OFF_WIN0), 2304, 0, tile, b0, nb, P->in[4]);
    if (EN(22)) transpose_job(P->in[17], 512, 512, (bf16_t*)(P->ws + OFF_WGLU), 512, 0, tile, b0, nb, nullptr);
    if (EN(22)) transpose_job(P->in[21], 1024, 1024, (bf16_t*)(P->ws + OFF_WOUT0), 1024, 0, tile, b0, nb, nullptr);
    if (EN(22)) transpose_job(P->in[22], 1024, 6144, (bf16_t*)(P->ws + OFF_WIN1), 6144, 0, tile, b0, nb, P->in[4] + 1024);
    if (EN(22)) transpose_job(P->in[24], 2048, 1024, (bf16_t*)(P->ws + OFF_WOUT1), 1024, 0, tile, b0, nb, nullptr);
}

__device__ void phase_kmat(CP P) {
    const float* Ktab = (const float*)(P->ws + OFF_KTAB); bf16_t* KG = (bf16_t*)(P->ws + OFF_KG); const float* dsk = P->in[16];
    for (int idx = obid() * NTHR + otid(); idx < 32 * 1024 * 512; idx += gridDim.x * NTHR) {
        const int kp = idx & 511, row = (idx >> 9) & 1023, g = idx >> 19, t = row >> 4, p = row & 15, k = kp * 2, s = k >> 4, pp = k & 15;
        float v0 = 0.f, v1 = 0.f;
        if (s <= t) { const float* b = Ktab + ((size_t)((g * 2 + 0) * 64 + (t - s))) * 256 + p * 16 + pp; v0 += b[0]; v1 += b[1]; }
        if (s >= t) { const float* b = Ktab + ((size_t)((g * 2 + 1) * 64 + (s - t))) * 256 + p * 16 + pp; v0 += b[0]; v1 += b[1]; }
        if (s == t) { const float dv = dsk[g * 16 + p]; if (pp == p) v0 += dv; if (pp + 1 == p) v1 += dv; }
        *(unsigned*)(KG + ((size_t)(g * 1024 + row)) * 1280 + k) = pack2(v0, v1);
    }
}

template <bool FINAL>
__device__ void phase_norm(const float* __restrict__ x, const float* __restrict__ g, bf16_t* __restrict__ xb, float* __restrict__ ss_out, float* __restrict__ outf, int b0, int nb, int rbeg, int rend) {
    const int tid_ = otid(), lane = tid_ & 63, wid = tid_ >> 6; const int bq = obid() - b0;
    if (bq < 0) return;
    f32x4 gv[4];
#pragma unroll
    for (int i = 0; i < 4; ++i) gv[i] = FINAL ? *(const f32x4*)(g + (lane + 64 * i) * 4) : (f32x4){1.f, 1.f, 1.f, 1.f};
    for (int row0 = rbeg + bq * 8 + wid; row0 < rend; row0 += nb * 16) {
        const int row1 = row0 + nb * 8; const bool has1 = row1 < rend;
        const float* xr0 = x + (size_t)row0 * 1024; const float* xr1 = x + (size_t)(has1 ? row1 : row0) * 1024; f32x4 v[4], u[4]; float ss = 0.f, st = 0.f;
#pragma unroll
        for (int i = 0; i < 4; ++i) { v[i] = *(const f32x4*)(xr0 + (lane + 64 * i) * 4); u[i] = *(const f32x4*)(xr1 + (lane + 64 * i) * 4); }
#pragma unroll
        for (int i = 0; i < 4; ++i) { ss += v[i][0] * v[i][0] + v[i][1] * v[i][1] + v[i][2] * v[i][2] + v[i][3] * v[i][3]; st += u[i][0] * u[i][0] + u[i][1] * u[i][1] + u[i][2] * u[i][2] + u[i][3] * u[i][3]; }
#pragma unroll
        for (int o = 32; o > 0; o >>= 1) { ss += __shfl_xor(ss, o); st += __shfl_xor(st, o); }
#pragma unroll
        for (int rr = 0; rr < 2; ++rr) { if (rr == 1 && !has1) break; const int row = rr ? row1 : row0; const float sv = rr ? st : ss;
            if (FINAL) { const float rstd = rsqrtf(sv * (1.0f / 1024.0f) + 1e-6f);
#pragma unroll
                for (int i = 0; i < 4; ++i) *(f32x4*)(outf + (size_t)row * 1024 + (lane + 64 * i) * 4) = (rr ? u[i] : v[i]) * rstd * gv[i]; }
            else { if (lane < 16) ss_out[(size_t)row * 16 + lane] = lane == 0 ? sv : 0.f;
#pragma unroll
                for (int i = 0; i < 4; ++i) { const f32x4 y = rr ? u[i] : v[i]; uint2 w; w.x = pack2(y[0], y[1]); w.y = pack2(y[2], y[3]); *(uint2*)(xb + (size_t)row * 1024 + (lane + 64 * i) * 4) = w; } } }
    }
}

__device__ __forceinline__ f32x4 mma16(const LAS bf16_t* As, int lda, const LAS bf16_t* Bs, int ldb, int K, f32x4 acc, int lane) {
    const int r = lane & 15, q = lane >> 4;
#pragma unroll
    for (int k = 0; k < K; k += 32) { const bf16x8 a = *(const LAS bf16x8*)(As + r * lda + k + q * 8); const bf16x8 b = *(const LAS bf16x8*)(Bs + r * ldb + k + q * 8);
        acc = __builtin_amdgcn_mfma_f32_16x16x32_bf16(b, a, acc, 0, 0, 0); }
    return acc;
}


typedef short s16x4 __attribute__((ext_vector_type(4)));
__device__ __forceinline__ bf16x8 frag_tr(const LAS bf16_t* T, int ld, int lane) {
    const int g = lane >> 4, qq = (lane & 15) >> 2, p = lane & 3;
    LAS bf16_t* a = (LAS bf16_t*)T + (8 * g + qq) * ld + 4 * p;
    const s16x4 lo = __builtin_amdgcn_ds_read_tr16_b64_v4i16((LAS s16x4*)a);
    const s16x4 hi = __builtin_amdgcn_ds_read_tr16_b64_v4i16((LAS s16x4*)(a + 4 * ld));
    return (bf16x8){lo[0], lo[1], lo[2], lo[3], hi[0], hi[1], hi[2], hi[3]};
}

__device__ __forceinline__ void lds_barrier() { asm volatile("s_waitcnt lgkmcnt(0)" ::: "memory"); __builtin_amdgcn_s_barrier(); asm volatile("" ::: "memory"); }

__device__ void phase_s5_scan(CP P) {
    const float* E = (const float*)(P->ws + OFF_E); const float* AT = (const float*)(P->ws + OFF_S5P); bf16_t* AS5 = (bf16_t*)(P->ws + OFF_AS5);
    const int tid_ = otid(); if (tid_ >= 128) return;
    for (int idx = obid() * 128 + tid_; idx < 32 * 8 * 2 * 64; idx += gridDim.x * 128) {
        const int n = idx & 63, dir = (idx >> 6) & 1, b = (idx >> 7) & 7, g = idx >> 10;
        const float ar = AT[((g * 2 + dir) * 64 + n) * 2], ai = AT[((g * 2 + dir) * 64 + n) * 2 + 1];
        float xr = 0.f, xi = 0.f;
#pragma unroll 16
        for (int cc = 0; cc < 128; ++cc) { const int c = dir == 0 ? cc : 127 - cc; const size_t bc = (size_t)g * 1024 + b * 128 + c;
            *(unsigned*)(AS5 + bc * 1280 + 1024 + dir * 128 + n * 2) = pack2(xr, xi);
            const float2 e = *(const float2*)(E + bc * 256 + dir * 128 + n * 2);
            const float t0 = ar * xr - ai * xi + e.x; xi = ar * xi + ai * xr + e.y; xr = t0; }
    }
}

__device__ __forceinline__ void gla_gates(CP P, const bf16_t* PQ, int m0, int h, LAS unsigned char* lds) {
    LAS float* gl = (LAS float*)lds; LAS float* tot = (LAS float*)(lds + 8192); LAS float* G = (LAS float*)(lds + 17408);
    const int tid = otid();
    const int dir = tid >> 8, d = tid & 63, tq = (tid >> 6) & 3;
    { const int idx = tid * 4, t = idx >> 5, r = idx & 31; const uint2 raw = *(const uint2*)(PQ + (size_t)(m0 + t) * 1792 + 1536 + r);
        *(LAS f32x4*)(gl + idx) = (f32x4){bflo(raw.x), bfhi(raw.x), bflo(raw.y), bfhi(raw.y)}; }
    float w[16];
#pragma unroll
    for (int r = 0; r < 16; ++r) w[r] = P->in[18][(dir * 16 + r) * 256 + h * 64 + d];
    const float b = P->in[19][dir * 256 + h * 64 + d];
    lds_barrier();
    float c[16];
#pragma unroll
    for (int i = 0; i < 16; ++i) { const int t = tq * 16 + i; float z = b;
#pragma unroll
        for (int r4 = 0; r4 < 4; ++r4) { const f32x4 g4 = *(const LAS f32x4*)(gl + t * 32 + dir * 16 + r4 * 4);
            z += g4[0] * w[r4 * 4] + g4[1] * w[r4 * 4 + 1] + g4[2] * w[r4 * 4 + 2] + g4[3] * w[r4 * 4 + 3]; }
        c[i] = (fminf(z, 0.f) - __logf(1.0f + __expf(-fabsf(z)))) * (1.0f / 16.0f); }
    if (dir == 0) {
#pragma unroll
        for (int i = 1; i < 16; ++i) c[i] += c[i - 1];
        tot[(dir * 4 + tq) * 64 + d] = c[15]; }
    else {
#pragma unroll
        for (int i = 14; i >= 0; --i) c[i] += c[i + 1];
        tot[(dir * 4 + tq) * 64 + d] = c[0]; }
    lds_barrier();
    float off = 0.f;
#pragma unroll
    for (int q = 0; q < 4; ++q) { const float tv = tot[(dir * 4 + q) * 64 + d]; off += ((dir == 0) ? (q < tq) : (q > tq)) ? tv : 0.f; }
#pragma unroll
    for (int i = 0; i < 16; ++i) G[(dir * 64 + tq * 16 + i) * 64 + d] = c[i] + off;
    lds_barrier();
}

__device__ void gla_a_unit(CP P, int unit, LAS unsigned char* lds) {
    const int c = unit & 127, h = (unit >> 7) & 3, b = unit >> 9, m0 = b * 8192 + c * 64;
    const bf16_t* PQ = (const bf16_t*)(P->ws + OFF_PQ); bf16_t* GST = (bf16_t*)(P->ws + OFF_GST); float* GDEC = (float*)(P->ws + OFF_GDEC);
    const int tid = otid(), lane = tid & 63, wid = tid >> 6;
    const int t = tid >> 3, d8 = (tid & 7) * 8, v16 = (tid & 7) * 16;
    const uint4 kraw = *(const uint4*)(PQ + (size_t)(m0 + t) * 1792 + 256 + h * 64 + d8);
    const uint4 vr0 = *(const uint4*)(PQ + (size_t)(m0 + t) * 1792 + 512 + h * 128 + v16), vr1 = *(const uint4*)(PQ + (size_t)(m0 + t) * 1792 + 512 + h * 128 + v16 + 8);
    gla_gates(P, PQ, m0, h, lds);
    LAS float* G = (LAS float*)(lds + 17408);
    LAS bf16_t* kA = (LAS bf16_t*)(lds + 50176);
    LAS bf16_t* Vs = (LAS bf16_t*)(lds + 67584);
    { const unsigned rw[4] = {kraw.x, kraw.y, kraw.z, kraw.w}; float ef[8], eb[8];
#pragma unroll
        for (int q = 0; q < 2; ++q) { const f32x4 lf = *(const LAS f32x4*)(G + 63 * 64 + d8 + q * 4), cf = *(const LAS f32x4*)(G + t * 64 + d8 + q * 4);
            const f32x4 lb = *(const LAS f32x4*)(G + 64 * 64 + d8 + q * 4), cb = *(const LAS f32x4*)(G + (64 + t) * 64 + d8 + q * 4);
#pragma unroll
            for (int j = 0; j < 4; ++j) { ef[q * 4 + j] = __expf(lf[j] - cf[j]); eb[q * 4 + j] = __expf(lb[j] - cb[j]); } }
        unsigned of[4], ob[4];
#pragma unroll
        for (int i = 0; i < 4; ++i) { const float k0 = bflo(rw[i]), k1 = bfhi(rw[i]); of[i] = pack2(k0 * ef[2 * i], k1 * ef[2 * i + 1]); ob[i] = pack2(k0 * eb[2 * i], k1 * eb[2 * i + 1]); }
        *(LAS u32x4*)(kA + t * 136 + d8) = mk4(of[0], of[1], of[2], of[3]); *(LAS u32x4*)(kA + t * 136 + 64 + d8) = mk4(ob[0], ob[1], ob[2], ob[3]);
        *(LAS u32x4*)(Vs + t * 136 + v16) = mk4(vr0.x, vr0.y, vr0.z, vr0.w); *(LAS u32x4*)(Vs + t * 136 + v16 + 8) = mk4(vr1.x, vr1.y, vr1.z, vr1.w); }
    if (tid < 128) { const int dir = tid >> 6, d = tid & 63; const float last = dir == 0 ? G[63 * 64 + d] : G[64 * 64 + d];
        GDEC[((size_t)(((b * 4 + h) * 2 + dir) * 128 + c)) * 64 + d] = __expf(last); }
    lds_barrier();
    { f32x4 acc[8];
#pragma unroll
        for (int nt = 0; nt < 8; ++nt) acc[nt] = (f32x4){0.f, 0.f, 0.f, 0.f};
#pragma unroll
        for (int ks = 0; ks < 2; ++ks) { const bf16x8 af = frag_tr(kA + ks * 32 * 136 + wid * 16, 136, lane);
#pragma unroll
            for (int nt = 0; nt < 8; ++nt) { const bf16x8 bfr = frag_tr(Vs + ks * 32 * 136 + nt * 16, 136, lane); acc[nt] = __builtin_amdgcn_mfma_f32_16x16x32_bf16(bfr, af, acc[nt], 0, 0, 0); } }
        const int row = wid * 16 + (lane & 15), dir = row >> 6, d = row & 63; bf16_t* out = GST + ((size_t)(((b * 4 + h) * 2 + dir) * 128 + c)) * 8192 + d * 128 + 4 * (lane >> 4);
#pragma unroll
        for (int nt = 0; nt < 8; ++nt) { uint2 w; w.x = pack2(acc[nt][0], acc[nt][1]); w.y = pack2(acc[nt][2], acc[nt][3]); *(uint2*)(out + nt * 16) = w; } }
    lds_barrier();
}

__device__ void phase_gla_b(CP P) {
    bf16_t* GST = (bf16_t*)(P->ws + OFF_GST); const float* GDEC = (const float*)(P->ws + OFF_GDEC);
    for (int idx = obid() * NTHR + otid(); idx < 64 * 1024; idx += gridDim.x * NTHR) {
        const int bhd = idx >> 10, e = (idx & 1023) * 8, d = e >> 7, dir = bhd & 1;
        f32x4 S0 = (f32x4){0.f, 0.f, 0.f, 0.f}, S1 = S0;
#pragma unroll 8
        for (int cc = 0; cc < 128; ++cc) { const int c = dir == 0 ? cc : 127 - cc; bf16_t* p = GST + ((size_t)(bhd * 128 + c)) * 8192 + e;
            const uint4 t = *(const uint4*)p; const float dec = GDEC[((size_t)(bhd * 128 + c)) * 64 + d];
            uint4 o; o.x = pack2(S0[0], S0[1]); o.y = pack2(S0[2], S0[3]); o.z = pack2(S1[0], S1[1]); o.w = pack2(S1[2], S1[3]); *(uint4*)p = o;
            S0 = dec * S0 + (f32x4){bflo(t.x), bfhi(t.x), bflo(t.y), bfhi(t.y)}; S1 = dec * S1 + (f32x4){bflo(t.z), bfhi(t.z), bflo(t.w), bfhi(t.w)}; }
    }
}

__device__ void gla_c_unit(CP P, int unit, LAS unsigned char* lds) {
    const int c = unit & 127, h = (unit >> 7) & 3, b = unit >> 9, m0 = b * 8192 + c * 64;
    const bf16_t* PQ = (const bf16_t*)(P->ws + OFF_PQ); const bf16_t* GST = (const bf16_t*)(P->ws + OFF_GST); bf16_t* MIX = (bf16_t*)(P->ws + OFF_XN);
    const int tid = otid(), lane = tid & 63, wid = tid >> 6;
    const int t = tid >> 3, d8 = (tid & 7) * 8, v16 = (tid & 7) * 16;
    const uint4 rq = *(const uint4*)(PQ + (size_t)(m0 + t) * 1792 + h * 64 + d8), rk = *(const uint4*)(PQ + (size_t)(m0 + t) * 1792 + 256 + h * 64 + d8);
    const uint4 vr0 = *(const uint4*)(PQ + (size_t)(m0 + t) * 1792 + 512 + h * 128 + v16), vr1 = *(const uint4*)(PQ + (size_t)(m0 + t) * 1792 + 512 + h * 128 + v16 + 8);
    const uint4 ogr0 = *(const uint4*)(PQ + (size_t)(m0 + t) * 1792 + 1024 + h * 128 + v16), ogr1 = *(const uint4*)(PQ + (size_t)(m0 + t) * 1792 + 1024 + h * 128 + v16 + 8);
    uint4 sr[4];
#pragma unroll
    for (int i = 0; i < 4; ++i) { const int idx = tid + i * NTHR, v8 = (idx & 15) * 8, d = (idx >> 4) & 63, dir = idx >> 10;
        sr[i] = *(const uint4*)(GST + ((size_t)(((b * 4 + h) * 2 + dir) * 128 + c)) * 8192 + d * 128 + v8); }
    gla_gates(P, PQ, m0, h, lds);
    LAS float* G = (LAS float*)(lds + 17408);
    LAS bf16_t* Ps = (LAS bf16_t*)lds;
    LAS bf16_t* qf = (LAS bf16_t*)(lds + 51200);
    LAS bf16_t* kf = qf + 64 * 72; LAS bf16_t* qb = kf + 64 * 72; LAS bf16_t* kb = qb + 64 * 72;
    LAS bf16_t* Vs = (LAS bf16_t*)(lds + 88064);
    LAS bf16_t* Ss = (LAS bf16_t*)(lds + 105472);
    { const unsigned qw[4] = {rq.x, rq.y, rq.z, rq.w}, kw[4] = {rk.x, rk.y, rk.z, rk.w};
        unsigned oqf[4], okf[4], oqb[4], okb[4]; float cf[8], cb[8];
#pragma unroll
        for (int q = 0; q < 2; ++q) { const f32x4 a = *(const LAS f32x4*)(G + t * 64 + d8 + q * 4), bb = *(const LAS f32x4*)(G + (64 + t) * 64 + d8 + q * 4);
#pragma unroll
            for (int j = 0; j < 4; ++j) { cf[q * 4 + j] = a[j]; cb[q * 4 + j] = bb[j]; } }
#pragma unroll
        for (int i = 0; i < 4; ++i) { const float cf0 = cf[2 * i], cf1 = cf[2 * i + 1], cb0 = cb[2 * i], cb1 = cb[2 * i + 1];
            const float q0 = bflo(qw[i]) * 0.125f, q1 = bfhi(qw[i]) * 0.125f, k0 = bflo(kw[i]), k1 = bfhi(kw[i]);
            oqf[i] = pack2(q0 * __expf(cf0), q1 * __expf(cf1)); okf[i] = pack2(k0 * __expf(-cf0), k1 * __expf(-cf1));
            oqb[i] = pack2(q0 * __expf(cb0), q1 * __expf(cb1)); okb[i] = pack2(k0 * __expf(-cb0), k1 * __expf(-cb1)); }
        *(LAS u32x4*)(qf + t * 72 + d8) = mk4(oqf[0], oqf[1], oqf[2], oqf[3]); *(LAS u32x4*)(kf + t * 72 + d8) = mk4(okf[0], okf[1], okf[2], okf[3]);
        *(LAS u32x4*)(qb + t * 72 + d8) = mk4(oqb[0], oqb[1], oqb[2], oqb[3]); *(LAS u32x4*)(kb + t * 72 + d8) = mk4(okb[0], okb[1], okb[2], okb[3]);
        *(LAS u32x4*)(Vs + t * 136 + v16) = mk4(vr0.x, vr0.y, vr0.z, vr0.w); *(LAS u32x4*)(Vs + t * 136 + v16 + 8) = mk4(vr1.x, vr1.y, vr1.z, vr1.w); }
#pragma unroll
    for (int i = 0; i < 4; ++i) { const int idx = tid + i * NTHR, v8 = (idx & 15) * 8, d = (idx >> 4) & 63, dir = idx >> 10;
        *(LAS u32x4*)(Ss + (dir * 64 + d) * 136 + v8) = mk4(sr[i].x, sr[i].y, sr[i].z, sr[i].w); }
    lds_barrier();
#pragma unroll
    for (int tl = 0; tl < 2; ++tl) { const int tile = wid * 2 + tl, mi = tile >> 2, ni = tile & 3; f32x4 pf = (f32x4){0.f, 0.f, 0.f, 0.f}, pb = pf;
        pf = mma16(qf + mi * 16 * 72, 72, kf + ni * 16 * 72, 72, 64, pf, lane); pb = mma16(qb + mi * 16 * 72, 72, kb + ni * 16 * 72, 72, 64, pb, lane);
        const int i = mi * 16 + (lane & 15), j0 = ni * 16 + 4 * (lane >> 4); float pv[4];
#pragma unroll
        for (int jj = 0; jj < 4; ++jj) pv[jj] = (j0 + jj <= i) ? pf[jj] : pb[jj];
        *(LAS u32x2*)(Ps + i * 72 + j0) = mk2(pack2(pv[0], pv[1]), pack2(pv[2], pv[3])); }
    lds_barrier();
    { const int mi = wid & 3, nb = (wid >> 2) * 4; LAS float* ost = G; f32x4 acc[4];
#pragma unroll
        for (int nt = 0; nt < 4; ++nt) acc[nt] = (f32x4){0.f, 0.f, 0.f, 0.f};
#pragma unroll
        for (int ks = 0; ks < 2; ++ks) {
            const bf16x8 ap = *(const LAS bf16x8*)(Ps + (mi * 16 + (lane & 15)) * 72 + ks * 32 + (lane >> 4) * 8);
            const bf16x8 af = *(const LAS bf16x8*)(qf + (mi * 16 + (lane & 15)) * 72 + ks * 32 + (lane >> 4) * 8);
            const bf16x8 ab = *(const LAS bf16x8*)(qb + (mi * 16 + (lane & 15)) * 72 + ks * 32 + (lane >> 4) * 8);
#pragma unroll
            for (int nt = 0; nt < 4; ++nt) { const int ni = nb + nt;
                acc[nt] = __builtin_amdgcn_mfma_f32_16x16x32_bf16(frag_tr(Vs + ks * 32 * 136 + ni * 16, 136, lane), ap, acc[nt], 0, 0, 0);
                acc[nt] = __builtin_amdgcn_mfma_f32_16x16x32_bf16(frag_tr(Ss + ks * 32 * 136 + ni * 16, 136, lane), af, acc[nt], 0, 0, 0);
                acc[nt] = __builtin_amdgcn_mfma_f32_16x16x32_bf16(frag_tr(Ss + (64 + ks * 32) * 136 + ni * 16, 136, lane), ab, acc[nt], 0, 0, 0); } }
#pragma unroll
        for (int nt = 0; nt < 4; ++nt) *(LAS f32x4*)(ost + (mi * 16 + (lane & 15)) * 132 + (nb + nt) * 16 + 4 * (lane >> 4)) = acc[nt]; }
    lds_barrier();
    { LAS float* ost = G; float o[16]; float ss = 0.f;
#pragma unroll
        for (int i = 0; i < 4; ++i) { const f32x4 v = *(const LAS f32x4*)(ost + t * 132 + v16 + i * 4); o[4 * i] = v[0]; o[4 * i + 1] = v[1]; o[4 * i + 2] = v[2]; o[4 * i + 3] = v[3]; ss += v[0] * v[0] + v[1] * v[1] + v[2] * v[2] + v[3] * v[3]; }
        ss += __shfl_xor(ss, 1); ss += __shfl_xor(ss, 2); ss += __shfl_xor(ss, 4);
        const float rstd = rsqrtf(ss * (1.0f / 128.0f) + 1e-6f);
        const float* gn = P->in[20] + h * 128 + v16;
        bf16_t* op = MIX + (size_t)(m0 + t) * 1024 + 512 + h * 128 + v16;
#pragma unroll
        for (int hh = 0; hh < 2; ++hh) { const uint4 raw = hh ? ogr1 : ogr0; const unsigned rw[4] = {raw.x, raw.y, raw.z, raw.w}; unsigned ow[4];
#pragma unroll
            for (int i = 0; i < 4; ++i) { const int e = hh * 8 + 2 * i; const float g0 = bflo(rw[i]), g1 = bfhi(rw[i]);
                ow[i] = pack2(o[e] * rstd * gn[e] * silu_f(g0), o[e + 1] * rstd * gn[e + 1] * silu_f(g1)); }
            *(uint4*)(op + hh * 8) = make_uint4(ow[0], ow[1], ow[2], ow[3]); } }
    lds_barrier();
}

__device__ __forceinline__ float ret_lg(int h) {
    float v = -0.0317486983145803f;
    v = h == 1 ? -0.015748356968139168f : v; v = h == 2 ? -0.007843177461025893f : v; v = h == 3 ? -0.003913899321136329f : v; v = h == 4 ? -0.0019550348358033506f : v;
    v = h == 5 ? -0.0009770396478266127f : v; v = h == 6 ? -0.0004884004981088745f : v; v = h == 7 ? -0.0002441704321739145f : v; return v;
}

struct KRaw { uint4 a, b; f32x4 c0, c1, s0, s1; };
__device__ __forceinline__ KRaw rot_load(const bf16_t* rowp, const float* cs, const float* sn, int dq) {
    KRaw k; k.a = *(const uint4*)(rowp + dq); k.b = *(const uint4*)(rowp + 64 + dq);
    k.c0 = *(const f32x4*)(cs + dq); k.c1 = *(const f32x4*)(cs + dq + 4); k.s0 = *(const f32x4*)(sn + dq); k.s1 = *(const f32x4*)(sn + dq + 4); return k;
}
__device__ __forceinline__ void rot_apply(const KRaw& k, float (&r1)[8], float (&r2)[8]) {
    const unsigned aw[4] = {k.a.x, k.a.y, k.a.z, k.a.w}, bw[4] = {k.b.x, k.b.y, k.b.z, k.b.w};
#pragma unroll
    for (int i = 0; i < 8; ++i) { const float t1 = (i & 1) ? bfhi(aw[i >> 1]) : bflo(aw[i >> 1]), t2 = (i & 1) ? bfhi(bw[i >> 1]) : bflo(bw[i >> 1]);
        const float cv = i < 4 ? k.c0[i & 3] : k.c1[i & 3], sv = i < 4 ? k.s0[i & 3] : k.s1[i & 3]; r1[i] = t1 * cv - t2 * sv; r2[i] = t1 * sv + t2 * cv; }
}
__device__ __forceinline__ void load_rot(const bf16_t* rowp, const float* cs, const float* sn, int dq, float (&r1)[8], float (&r2)[8]) { const KRaw k = rot_load(rowp, cs, sn, dq); rot_apply(k, r1, r2); }

__device__ void ret_a_unit(CP P, int hf, int unit, LAS unsigned char* lds) {
    const int vh = (unit >> 3) & 1, ur = (unit & 7) | ((unit >> 4) << 3), sc = ur & 31, h = (ur >> 5) & 7, bl = ur >> 8;
    const bf16_t* PR = (const bf16_t*)(P->ws + OFF_PROJ1); bf16_t* RST = (bf16_t*)(P->ws + OFF_RST);
    const float* cs = (const float*)(P->ws + OFF_ROPE); const float* sn = cs + 8192 * 64;
    const int tid = otid(), lane = tid & 63, wid = tid >> 6;
    const size_t r0 = (size_t)bl * 8192 + sc * 256;
    const float lgf = ret_lg(h), lgb = ret_lg(7 - h);
    LAS bf16_t* kf = (LAS bf16_t*)lds;
    LAS bf16_t* kb = (LAS bf16_t*)(lds + 17408);
    LAS bf16_t* Vs = (LAS bf16_t*)(lds + 34816);
    f32x4 acc[4][4];
#pragma unroll
    for (int a = 0; a < 4; ++a)
#pragma unroll
        for (int n = 0; n < 4; ++n) acc[a][n] = (f32x4){0.f, 0.f, 0.f, 0.f};
    const int mb = (wid >> 1) * 4, nb = (wid & 1) * 4;
    const LAS bf16_t* kA = (mb >= 8) ? kb : kf; const int dt0 = (mb & 7) * 16;
    const int pj = tid >> 3, pdq = (tid & 7) * 8, pv16 = (tid & 7) * 16;
    const bf16_t* kbase = PR + (r0 + pj) * 6144 + 1024 + h * 128; const bf16_t* vbase = PR + (r0 + pj) * 6144 + 2048 + h * 256 + vh * 128 + pv16;
    KRaw kr = rot_load(kbase, cs + (sc * 256 + pj) * 64, sn + (sc * 256 + pj) * 64, pdq);
    uint4 vr0 = *(const uint4*)(vbase), vr1 = *(const uint4*)(vbase + 8);
    for (int jb = 0; jb < 4; ++jb) {
        { const int j = pj, dq = pdq, J = jb * 64 + j; float r1[8], r2[8];
            rot_apply(kr, r1, r2);
            const float sf = 0.08838834764831845f * __expf((float)(255 - J) * lgf), sb = 0.08838834764831845f * __expf((float)J * lgb);
            *(LAS u32x4*)(kf + j * 136 + dq) = mk4(pack2(r1[0] * sf, r1[1] * sf), pack2(r1[2] * sf, r1[3] * sf), pack2(r1[4] * sf, r1[5] * sf), pack2(r1[6] * sf, r1[7] * sf));
            *(LAS u32x4*)(kf + j * 136 + 64 + dq) = mk4(pack2(r2[0] * sf, r2[1] * sf), pack2(r2[2] * sf, r2[3] * sf), pack2(r2[4] * sf, r2[5] * sf), pack2(r2[6] * sf, r2[7] * sf));
            *(LAS u32x4*)(kb + j * 136 + dq) = mk4(pack2(r1[0] * sb, r1[1] * sb), pack2(r1[2] * sb, r1[3] * sb), pack2(r1[4] * sb, r1[5] * sb), pack2(r1[6] * sb, r1[7] * sb));
            *(LAS u32x4*)(kb + j * 136 + 64 + dq) = mk4(pack2(r2[0] * sb, r2[1] * sb), pack2(r2[2] * sb, r2[3] * sb), pack2(r2[4] * sb, r2[5] * sb), pack2(r2[6] * sb, r2[7] * sb));
            *(LAS u32x4*)(Vs + j * 136 + pv16) = mk4(vr0.x, vr0.y, vr0.z, vr0.w); *(LAS u32x4*)(Vs + j * 136 + pv16 + 8) = mk4(vr1.x, vr1.y, vr1.z, vr1.w); }
        lds_barrier();
        if (jb < 3) { const int J = (jb + 1) * 64 + pj; kr = rot_load(kbase + (size_t)(jb + 1) * 64 * 6144, cs + (sc * 256 + J) * 64, sn + (sc * 256 + J) * 64, pdq);
            vr0 = *(const uint4*)(vbase + (size_t)(jb + 1) * 64 * 6144); vr1 = *(const uint4*)(vbase + (size_t)(jb + 1) * 64 * 6144 + 8); }
#pragma unroll
        for (int ks = 0; ks < 2; ++ks) { bf16x8 af[4], bfr[4];
#pragma unroll
            for (int a = 0; a < 4; ++a) af[a] = frag_tr(kA + ks * 32 * 136 + dt0 + a * 16, 136, lane);
#pragma unroll
            for (int n = 0; n < 4; ++n) bfr[n] = frag_tr(Vs + ks * 32 * 136 + (nb + n) * 16, 136, lane);
#pragma unroll
            for (int a = 0; a < 4; ++a)
#pragma unroll
                for (int n = 0; n < 4; ++n) acc[a][n] = __builtin_amdgcn_mfma_f32_16x16x32_bf16(bfr[n], af[a], acc[a][n], 0, 0, 0); }
        lds_barrier();
    }
#pragma unroll
    for (int a = 0; a < 4; ++a) { const int row = (mb + a) * 16 + (lane & 15), dir = row >> 7, d = row & 127;
        bf16_t* out = RST + ((size_t)(((bl * 8 + h) * 2 + dir) * 32 + sc)) * 32768 + d * 256 + vh * 128 + 4 * (lane >> 4);
#pragma unroll
        for (int n = 0; n < 4; ++n) { uint2 w; w.x = pack2(acc[a][n][0], acc[a][n][1]); w.y = pack2(acc[a][n][2], acc[a][n][3]); *(uint2*)(out + (nb + n) * 16) = w; } }
}

__device__ void phase_ret_b(CP P) {
    bf16_t* RST = (bf16_t*)(P->ws + OFF_RST);
    for (int idx = obid() * NTHR + otid(); idx < 64 * 4096; idx += gridDim.x * NTHR) {
        const int bhd = idx >> 12, e = (idx & 4095) * 8, dir = bhd & 1, h = (bhd >> 1) & 7;
        const float dec = __expf(256.0f * ret_lg(dir == 0 ? h : 7 - h));
        f32x4 S0 = (f32x4){0.f, 0.f, 0.f, 0.f}, S1 = S0;
#pragma unroll 8
        for (int cc = 0; cc < 32; ++cc) { const int c = dir == 0 ? cc : 31 - cc; bf16_t* p = RST + ((size_t)(bhd * 32 + c)) * 32768 + e;
            const uint4 t = *(const uint4*)p; uint4 o; o.x = pack2(S0[0], S0[1]); o.y = pack2(S0[2], S0[3]); o.z = pack2(S1[0], S1[1]); o.w = pack2(S1[2], S1[3]); *(uint4*)p = o;
            S0 = dec * S0 + (f32x4){bflo(t.x), bfhi(t.x), bflo(t.y), bfhi(t.y)}; S1 = dec * S1 + (f32x4){bflo(t.z), bfhi(t.z), bflo(t.w), bfhi(t.w)}; }
    }
}

__device__ __forceinline__ bf16x8 frag_tr_p(const LAS bf16_t* T, int ld, int lane) {
    const int g = lane >> 4, qq = (lane & 15) >> 2, p = lane & 3;
    LAS bf16_t* a = (LAS bf16_t*)T + (4 * g + qq) * ld + 4 * p;
    const s16x4 lo = __builtin_amdgcn_ds_read_tr16_b64_v4i16((LAS s16x4*)a);
    const s16x4 hi = __builtin_amdgcn_ds_read_tr16_b64_v4i16((LAS s16x4*)(a + 16 * ld));
    return (bf16x8){lo[0], lo[1], lo[2], lo[3], hi[0], hi[1], hi[2], hi[3]};
}
typedef unsigned u32x4b __attribute__((ext_vector_type(4)));

__device__ void ret_c_unit(CP P, int hf, int unit, LAS unsigned char* lds) {
    const int rh = (unit >> 3) & 1, ur = (unit & 7) | ((unit >> 4) << 3), sc = ur & 31, h = (ur >> 5) & 7, bl = ur >> 8;
    const bf16_t* PR = (const bf16_t*)(P->ws + OFF_PROJ1); const bf16_t* RST = (const bf16_t*)(P->ws + OFF_RST);
    const float* cs = (const float*)(P->ws + OFF_ROPE); const float* sn = cs + 8192 * 64;
    const int tid = otid(), lane = tid & 63, wid = tid >> 6;
    const size_t r0 = (size_t)bl * 8192 + sc * 256;
    const float lgf = ret_lg(h), lgb = ret_lg(7 - h);
    LAS bf16_t* qs = (LAS bf16_t*)lds;
    LAS bf16_t* ksb = (LAS bf16_t*)(lds + 34816);
    LAS bf16_t* Vsb = (LAS bf16_t*)(lds + 69632);
    LAS float* red = (LAS float*)(lds + 137216);
#pragma unroll
    for (int rep = 0; rep < 2; ++rep) { const int i = (tid >> 3) + rep * 64, dq = (tid & 7) * 8, I = rh * 128 + i, pos = sc * 256 + I; float r1[8], r2[8];
        load_rot(PR + (r0 + I) * 6144 + h * 128, cs + pos * 64, sn + pos * 64, dq, r1, r2);
        *(LAS u32x4*)(qs + i * 136 + dq) = mk4(pack2(r1[0], r1[1]), pack2(r1[2], r1[3]), pack2(r1[4], r1[5]), pack2(r1[6], r1[7]));
        *(LAS u32x4*)(qs + i * 136 + 64 + dq) = mk4(pack2(r2[0], r2[1]), pack2(r2[2], r2[3]), pack2(r2[4], r2[5]), pack2(r2[6], r2[7])); }
    f32x4 acc[2][8];
#pragma unroll
    for (int r = 0; r < 2; ++r)
#pragma unroll
        for (int n = 0; n < 8; ++n) acc[r][n] = (f32x4){0.f, 0.f, 0.f, 0.f};
    const int mi2 = (wid & 3) * 2, nb = (wid >> 2) * 8;
    const int pj = tid >> 3, pdq = (tid & 7) * 8, pv32 = (tid & 7) * 32;
    const bf16_t* kbase = PR + (r0 + pj) * 6144 + 1024 + h * 128; const bf16_t* vbase = PR + (r0 + pj) * 6144 + 2048 + h * 256 + pv32;
    KRaw kr = rot_load(kbase, cs + (sc * 256 + pj) * 64, sn + (sc * 256 + pj) * 64, pdq);
    uint4 vr[4];
#pragma unroll
    for (int hh = 0; hh < 4; ++hh) vr[hh] = *(const uint4*)(vbase + hh * 8);
    uint4 st[4];
    const bf16_t* sbase = RST + ((size_t)((bl * 8 + h) * 2) * 32 + sc) * 32768;
    for (int kb = 0; kb < 4; ++kb) {
        LAS bf16_t* ks = ksb + (kb & 1) * (64 * 136); LAS bf16_t* Vs = Vsb + (kb & 1) * (64 * 264);
        { const int j = pj, dq = pdq; float r1[8], r2[8];
            rot_apply(kr, r1, r2);
            const float s = 0.08838834764831845f;
            *(LAS u32x4*)(ks + j * 136 + dq) = mk4(pack2(r1[0] * s, r1[1] * s), pack2(r1[2] * s, r1[3] * s), pack2(r1[4] * s, r1[5] * s), pack2(r1[6] * s, r1[7] * s));
            *(LAS u32x4*)(ks + j * 136 + 64 + dq) = mk4(pack2(r2[0] * s, r2[1] * s), pack2(r2[2] * s, r2[3] * s), pack2(r2[4] * s, r2[5] * s), pack2(r2[6] * s, r2[7] * s));
#pragma unroll
            for (int hh = 0; hh < 4; ++hh) *(LAS u32x4*)(Vs + j * 264 + pv32 + hh * 8) = mk4(vr[hh].x, vr[hh].y, vr[hh].z, vr[hh].w); }
        lds_barrier();
        if (kb < 3) { const int J = (kb + 1) * 64 + pj; kr = rot_load(kbase + (size_t)(kb + 1) * 64 * 6144, cs + (sc * 256 + J) * 64, sn + (sc * 256 + J) * 64, pdq);
#pragma unroll
            for (int hh = 0; hh < 4; ++hh) vr[hh] = *(const uint4*)(vbase + (size_t)(kb + 1) * 64 * 6144 + hh * 8); }
        else {
#pragma unroll
            for (int i = 0; i < 4; ++i) { const int idx = tid + i * NTHR, v8 = (idx & 31) * 8, dd = idx >> 5; st[i] = *(const uint4*)(sbase + dd * 256 + v8); } }
        bf16x8 pf[2][2];
#pragma unroll
        for (int r = 0; r < 2; ++r) { f32x4 s4[4]; const int I = rh * 128 + (mi2 + r) * 16 + (lane & 15);
#pragma unroll
            for (int tj = 0; tj < 4; ++tj) s4[tj] = (f32x4){0.f, 0.f, 0.f, 0.f};
#pragma unroll
            for (int k = 0; k < 4; ++k) { const bf16x8 aq = *(const LAS bf16x8*)(qs + ((mi2 + r) * 16 + (lane & 15)) * 136 + k * 32 + (lane >> 4) * 8);
#pragma unroll
                for (int tj = 0; tj < 4; ++tj) { const bf16x8 bq = *(const LAS bf16x8*)(ks + (tj * 16 + (lane & 15)) * 136 + k * 32 + (lane >> 4) * 8);
                    s4[tj] = __builtin_amdgcn_mfma_f32_16x16x32_bf16(bq, aq, s4[tj], 0, 0, 0); } }
#pragma unroll
            for (int tj = 0; tj < 4; ++tj)
#pragma unroll
                for (int jj = 0; jj < 4; ++jj) { const int df = I - (kb * 64 + tj * 16 + 4 * (lane >> 4) + jj); const float dm = df >= 0 ? __expf((float)df * lgf) : __expf((float)(-df) * lgb); s4[tj][jj] *= dm; }
#pragma unroll
            for (int k2 = 0; k2 < 2; ++k2) { const f32x4 a0 = s4[2 * k2], a1 = s4[2 * k2 + 1];
                const u32x4b pw_ = (u32x4b){pack2(a0[0], a0[1]), pack2(a0[2], a0[3]), pack2(a1[0], a1[1]), pack2(a1[2], a1[3])}; pf[r][k2] = __builtin_bit_cast(bf16x8, pw_); }
            __builtin_amdgcn_sched_barrier(0); }
        __builtin_amdgcn_sched_barrier(0);
#pragma unroll
        for (int k2 = 0; k2 < 2; ++k2)
#pragma unroll
            for (int n = 0; n < 8; ++n) { const bf16x8 bfr = frag_tr_p(Vs + k2 * 32 * 264 + (nb + n) * 16, 264, lane);
#pragma unroll
                for (int r = 0; r < 2; ++r) acc[r][n] = __builtin_amdgcn_mfma_f32_16x16x32_bf16(bfr, pf[r][k2], acc[r][n], 0, 0, 0); }
        __builtin_amdgcn_sched_barrier(0);
    }
    uint2 ogr[2][8];
    float xf[2], xb[2];
#pragma unroll
    for (int r = 0; r < 2; ++r) { const int I = rh * 128 + (mi2 + r) * 16 + (lane & 15); xf[r] = __expf((float)(I + 1) * lgf); xb[r] = __expf((float)(256 - I) * lgb);
        const bf16_t* ogp = PR + (r0 + I) * 6144 + 4096 + h * 256 + 4 * (lane >> 4);
#pragma unroll
        for (int n = 0; n < 8; ++n) ogr[r][n] = *(const uint2*)(ogp + (nb + n) * 16); }
    for (int sl = 0; sl < 4; ++sl) { const int dir = sl >> 1, dh = sl & 1; LAS bf16_t* Vs = Vsb + (sl & 1) * (64 * 264);
#pragma unroll
        for (int i = 0; i < 4; ++i) { const int idx = tid + i * NTHR, v8 = (idx & 31) * 8, dd = idx >> 5; *(LAS u32x4*)(Vs + dd * 264 + v8) = mk4(st[i].x, st[i].y, st[i].z, st[i].w); }
        lds_barrier();
        if (sl < 3) { const int nd = (sl + 1) >> 1, nh = (sl + 1) & 1; const bf16_t* sp = sbase + (size_t)nd * 32 * 32768 + (size_t)nh * 64 * 256;
#pragma unroll
            for (int i = 0; i < 4; ++i) { const int idx = tid + i * NTHR, v8 = (idx & 31) * 8, dd = idx >> 5; st[i] = *(const uint4*)(sp + dd * 256 + v8); } }
#pragma unroll
        for (int k2 = 0; k2 < 2; ++k2) { bf16x8 af[2];
#pragma unroll
            for (int r = 0; r < 2; ++r) { const u32x4 w = *(const LAS u32x4*)(qs + ((mi2 + r) * 16 + (lane & 15)) * 136 + dh * 64 + k2 * 32 + (lane >> 4) * 8); const float xs = dir == 0 ? xf[r] : xb[r];
                const u32x4b sw = (u32x4b){pack2(bflo(w[0]) * xs, bfhi(w[0]) * xs), pack2(bflo(w[1]) * xs, bfhi(w[1]) * xs), pack2(bflo(w[2]) * xs, bfhi(w[2]) * xs), pack2(bflo(w[3]) * xs, bfhi(w[3]) * xs)};
                af[r] = __builtin_bit_cast(bf16x8, sw); }
#pragma unroll
            for (int n = 0; n < 8; ++n) { const bf16x8 bfr = frag_tr(Vs + k2 * 32 * 264 + (nb + n) * 16, 264, lane);
#pragma unroll
                for (int r = 0; r < 2; ++r) acc[r][n] = __builtin_amdgcn_mfma_f32_16x16x32_bf16(bfr, af[r], acc[r][n], 0, 0, 0); } }
    }
    { float ss[2];
#pragma unroll
        for (int r = 0; r < 2; ++r) { ss[r] = 0.f;
#pragma unroll
            for (int n = 0; n < 8; ++n) ss[r] += acc[r][n][0] * acc[r][n][0] + acc[r][n][1] * acc[r][n][1] + acc[r][n][2] * acc[r][n][2] + acc[r][n][3] * acc[r][n][3];
            ss[r] += __shfl_xor(ss[r], 16); ss[r] += __shfl_xor(ss[r], 32);
            if ((lane >> 4) == 0) red[((mi2 + r) * 16 + (lane & 15)) * 2 + (wid >> 2)] = ss[r]; }
        lds_barrier();
#pragma unroll
        for (int r = 0; r < 2; ++r) { const int i = (mi2 + r) * 16 + (lane & 15);
            const float rstd = rsqrtf((red[i * 2] + red[i * 2 + 1]) * (1.0f / 256.0f) + 1e-6f);
            const float* gn = P->in[23] + h * 256 + 4 * (lane >> 4);
            bf16_t* op = (bf16_t*)(P->ws + OFF_OBUF) + (r0 + rh * 128 + i) * 2048 + h * 256 + 4 * (lane >> 4);
#pragma unroll
            for (int n = 0; n < 8; ++n) { const int v = (nb + n) * 16; const uint2 og = ogr[r][n]; const f32x4 g4 = *(const f32x4*)(gn + v);
                uint2 w; w.x = pack2(acc[r][n][0] * rstd * g4[0] * silu_f(bflo(og.x)), acc[r][n][1] * rstd * g4[1] * silu_f(bfhi(og.x)));
                w.y = pack2(acc[r][n][2] * rstd * g4[2] * silu_f(bflo(og.y)), acc[r][n][3] * rstd * g4[3] * silu_f(bfhi(og.y)));
                *(uint2*)(op + v) = w; } } }
    lds_barrier();
}

__global__ void __launch_bounds__(NTHR, 2) mega(Params Pval, int ph0, int ph1) {
    extern __shared__ __attribute__((aligned(16))) unsigned char lds_raw[];
    LAS unsigned char* lds = (LAS unsigned char*)lds_raw;
    for (int ph = ph0; ph < ph1; ++ph) {
        CP P = (CP)__builtin_amdgcn_kernarg_segment_ptr(); asm volatile("" : "+s"(P));
        unsigned char* ws = P->ws;
        bf16_t* XN = (bf16_t*)(ws + OFF_XN); bf16_t* ACT = (bf16_t*)(ws + OFF_ACT); float* X = P->out;
        if (ph == 1 || ph == 4 || ph == 11 || ph == 14 || ph == 17 || ph == 28) continue;
        const int reps = (((unsigned long long)(PROBE_MASK) >> ph) & 1ull) ? 2 : 1;
        for (int rep = 0; rep < reps; ++rep) {
        float* SSQ = (float*)(ws + OFF_SSQ); bf16_t* XB2 = (bf16_t*)(ws + OFF_XB2);
        int ffn = -1, sub = 0;
        if (ph >= 2 && ph <= 3) { ffn = 0; sub = ph - 1; } else if (ph >= 12 && ph <= 13) { ffn = 1; sub = ph - 11; }
        else if (ph >= 15 && ph <= 16) { ffn = 2; sub = ph - 14; } else if (ph >= 29 && ph <= 30) { ffn = 3; sub = ph - 28; }
        if (ph == 0) { if (EN(0)) phase_prologue(P, lds); }
        else if (ffn >= 0) {
            const float* xin = (ffn == 0) ? P->in[0] : X;
            const float* ssin = SSQ + (size_t)(ffn == 0 ? 0 : ffn == 1 ? 2 : ffn == 2 ? 3 : 5) * SSN;
            if (sub == 1) { if (EN(2)) { if (ffn == 0) phase_kmat(P);
                pg8::Gemm g{ffn == 1 ? XB2 : XN, (const bf16_t*)(ws + OFF_W1 + (size_t)ffn * SZ_W1), 1024, 1024, 1024, 256, 22, 1, 0, 0}; EpiSwiGLU e{ACT, ssin}; pg8::gemm_phase(lds, g, e); } }
            else { if (EN(3)) { pg8::Gemm g{ACT, (const bf16_t*)(ws + OFF_W2 + (size_t)ffn * SZ_W2), 2816, 2816, 2816, 256, 4, 1, 0, 0};
                float* ssout = SSQ + (size_t)(ffn == 0 ? 1 : ffn == 1 ? 3 : 4) * SSN;
                if (ffn == 3) { EpiResid<false> e{xin, X, nullptr, nullptr, 0.5f}; pg8::gemm_phase(lds, g, e); }
                else { EpiResid<true> e{xin, X, XN, ssout, 0.5f}; pg8::gemm_phase(lds, g, e); } } }
        }
        else if (ph == 5) { if (EN(4)) { pg8::Gemm g{XN, (const bf16_t*)(ws + OFF_WIN0), 1024, 1024, 1024, 256, 9, 1, 0, 0}; EpiWin0 e{(bf16_t*)(ws + OFF_AS5), (bf16_t*)(ws + OFF_PQ), SSQ + SSN}; pg8::gemm_phase(lds, g, e); } }
        else if (ph == 6) { if (EN(5)) {
            if (EN(16)) { pg8::Gemm g{(const bf16_t*)(ws + OFF_AS5), (const bf16_t*)(ws + OFF_H), 1280, 1024, 1024, 4, 1, 32, (size_t)1024 * 1280, (size_t)256 * 1024}; EpiS5E e{(float*)(ws + OFF_E)}; pg8::gemm_phase(lds, g, e); }
            __syncthreads();
            if (EN(17)) for (int u = obid(); u < 4096; u += gridDim.x) gla_a_unit(P, u, lds);
        } }
        else if (ph == 7) { if (EN(6)) { phase_s5_scan(P); phase_gla_b(P); } }
        else if (ph == 8) { if (EN(7)) {
            if (EN(18)) { pg8::Gemm g{(const bf16_t*)(ws + OFF_AS5), (const bf16_t*)(ws + OFF_KG), 1280, 1280, 1280, 4, 4, 32, (size_t)1024 * 1280, (size_t)1024 * 1280}; EpiS5Y e{(bf16_t*)(ws + OFF_GY)}; pg8::gemm_phase(lds, g, e); }
            __syncthreads();
            if (EN(19)) for (int u = obid(); u < 4096; u += gridDim.x) gla_c_unit(P, u, lds);
        } }
        else if (ph == 9) { if (EN(8)) { pg8::Gemm g{(const bf16_t*)(ws + OFF_GY), (const bf16_t*)(ws + OFF_WGLU), 512, 512, 512, 256, 2, 1, 0, 0}; EpiGLU e{(const bf16_t*)(ws + OFF_GY), XN}; pg8::gemm_phase(lds, g, e); } }
        else if (ph == 10) { if (EN(9)) { pg8::Gemm g{XN, (const bf16_t*)(ws + OFF_WOUT0), 1024, 1024, 1024, 256, 4, 1, 0, 0}; EpiResid<true> e{X, X, XB2, SSQ + 2 * SSN, 1.0f}; pg8::gemm_phase(lds, g, e); } }
        else if (ph >= 18 && ph <= 27) {
            const int hf = (ph - 18) / 5, s = (ph - 18) % 5;
            if (s == 0) { if (EN(10)) { pg8::Gemm g{XN + (size_t)hf * 32768 * 1024, (const bf16_t*)(ws + OFF_WIN1), 1024, 1024, 1024, 128, 24, 1, 0, 0}; EpiBf16 e{(bf16_t*)(ws + OFF_PROJ1), 6144, SSQ + 4 * SSN + (size_t)hf * 32768 * 16}; pg8::gemm_phase(lds, g, e); } }
            else if (s == 1) { if (EN(11)) for (int u = obid(); u < 2048; u += gridDim.x) ret_a_unit(P, hf, u, lds); }
            else if (s == 2) { if (EN(12)) phase_ret_b(P); }
            else if (s == 3) { if (EN(13)) for (int u = obid(); u < 2048; u += gridDim.x) ret_c_unit(P, hf, u, lds); }
            else { if (EN(14)) { pg8::Gemm g{(const bf16_t*)(ws + OFF_OBUF), (const bf16_t*)(ws + OFF_WOUT1), 2048, 2048, 2048, 128, 4, 1, 0, 0};
                float* Xh = X + (size_t)hf * 32768 * 1024; EpiResid<true> e{Xh, Xh, XN + (size_t)hf * 32768 * 1024, SSQ + 5 * SSN + (size_t)hf * 32768 * 16, 1.0f}; pg8::gemm_phase(lds, g, e); } }
        }
        else if (ph == 31) { if (EN(15)) phase_norm<true>(X, P->in[25], nullptr, nullptr, X, 0, (int)gridDim.x, 0, 65536); }
        if (rep + 1 < reps) __syncthreads();
        }
        if (ph + 1 < ph1) cg::this_grid().sync();
    }
}

extern "C" void kernel_launch(void* const* d_in, const int* in_sizes, int n_in, void* d_out, int out_size, void* d_ws, size_t ws_size, hipStream_t stream) {
    static int inited = 0;
    if (!inited) { (void)hipFuncSetAttribute((const void*)mega, hipFuncAttributeMaxDynamicSharedMemorySize, LDS_BYTES); inited = 1; }
    Params p{};
    for (int i = 0; i < 26; ++i) p.in[i] = (const float*)d_in[i];
    p.out = (float*)d_out; p.ws = (unsigned char*)d_ws;
    if (ws_size < OFF_R + 770 * MiB) fprintf(stderr, "kernel_launch: workspace too small (%zu)\n", ws_size);
    const int grid = 256;
#if ONE_LAUNCH
    int ph0 = 0, ph1 = NPHASE; void* args[] = {&p, &ph0, &ph1};
    hipError_t e = hipLaunchCooperativeKernel((const void*)mega, dim3(grid), dim3(NTHR), args, LDS_BYTES, stream);
    if (e != hipSuccess) fprintf(stderr, "cooperative launch failed: %s\n", hipGetErrorString(e));
#else
    for (int ph = 0; ph < NPHASE; ++ph) hipLaunchKernelGGL(mega, dim3(grid), dim3(NTHR), LDS_BYTES, stream, p, ph, ph + 1);
#endif
}
```

```cpp
#include <hip/hip_runtime.h>
#include <hip/hip_cooperative_groups.h>
#include <cstdio>
#include <cstdint>
namespace cg = cooperative_groups;

#ifndef ONE_LAUNCH
#define ONE_LAUNCH 1
#endif

#ifndef PHASE_MASK
#define PHASE_MASK 0xffffffffffull
#endif
#define EN(n) (((PHASE_MASK) >> (n)) & 1ull)
#ifndef PROBE_MASK
#define PROBE_MASK 0ull
#endif
#define LAS __attribute__((address_space(3)))
typedef unsigned short bf16_t;
typedef short bf16x8 __attribute__((ext_vector_type(8)));
typedef float f32x4 __attribute__((ext_vector_type(4)));
typedef float f32x2 __attribute__((ext_vector_type(2)));
typedef unsigned u32x2 __attribute__((ext_vector_type(2)));
typedef unsigned u32x4 __attribute__((ext_vector_type(4)));
__device__ __forceinline__ u32x4 mk4(unsigned a, unsigned b, unsigned c, unsigned d) { return (u32x4){a, b, c, d}; }
__device__ __forceinline__ u32x2 mk2(unsigned a, unsigned b) { return (u32x2){a, b}; }
__device__ __forceinline__ f32x2 mkf2(float a, float b) { return (f32x2){a, b}; }

constexpr int NTHR = 512;
constexpr int LDS_BYTES = 147456;
constexpr int NPHASE = 32;

struct Params { const float* in[26]; float* out; unsigned char* ws; };
typedef const __attribute__((address_space(4))) Params* CP;

constexpr size_t MiB = 1ull << 20;
constexpr size_t OFF_W1 = 0, SZ_W1 = 11 * MiB;
constexpr size_t OFF_W2 = 44 * MiB, SZ_W2 = 5 * MiB + MiB / 2;
constexpr size_t OFF_WIN0 = 66 * MiB;
constexpr size_t OFF_WGLU = 70 * MiB + MiB / 2;
constexpr size_t OFF_WOUT0 = 71 * MiB;
constexpr size_t OFF_WIN1 = 73 * MiB;
constexpr size_t OFF_WOUT1 = 85 * MiB;
constexpr size_t OFF_ROPE = 89 * MiB;
constexpr size_t OFF_KTAB = 93 * MiB;
constexpr size_t OFF_S5P = 97 * MiB;
constexpr size_t OFF_XN = 98 * MiB;
constexpr size_t OFF_R = 226 * MiB;
constexpr size_t OFF_ACT = OFF_R;
constexpr size_t OFF_PQ = OFF_R;
constexpr size_t OFF_AS5 = OFF_R + 224 * MiB;
constexpr size_t OFF_E = OFF_R + 304 * MiB;
constexpr size_t OFF_KG = OFF_R + 352 * MiB;
constexpr size_t OFF_H = OFF_R + 432 * MiB;
constexpr size_t OFF_GST = OFF_R + 448 * MiB;
constexpr size_t OFF_GDEC = OFF_R + 704 * MiB;
constexpr size_t OFF_GY = OFF_R + 706 * MiB;
constexpr size_t OFF_PROJ1 = OFF_R;
constexpr size_t OFF_RST = OFF_R + 384 * MiB;
constexpr size_t OFF_SSQ = 998 * MiB;
constexpr int SSN = 65536 * 16;
constexpr size_t OFF_XB2 = OFF_R + 448 * MiB;
constexpr size_t OFF_BAR = 1023 * MiB;
constexpr size_t OFF_OBUF = OFF_R + 640 * MiB;

__device__ __forceinline__ int otid() { int t = threadIdx.x; asm volatile("" : "+v"(t)); return t; }
__device__ __forceinline__ int obid() { int t = blockIdx.x; asm volatile("" : "+s"(t)); return t; }
__device__ __forceinline__ bf16_t f2bf(float f) { unsigned u = __float_as_uint(f); u += 0x7FFFu + ((u >> 16) & 1u); return (bf16_t)(u >> 16); }
__device__ __forceinline__ float bf2f(unsigned b) { return __uint_as_float(b << 16); }
typedef __bf16 bf16x2_t __attribute__((ext_vector_type(2)));
typedef float f32x2_t __attribute__((ext_vector_type(2)));
__device__ __forceinline__ unsigned pack2(float lo, float hi) { const f32x2_t v = {lo, hi}; const bf16x2_t b = __builtin_convertvector(v, bf16x2_t); return __builtin_bit_cast(unsigned, b); }
__device__ __forceinline__ float bflo(unsigned w) { return __uint_as_float(w << 16); }
__device__ __forceinline__ float bfhi(unsigned w) { return __uint_as_float(w & 0xffff0000u); }
__device__ __forceinline__ float fast_sigmoid(float x) { return __builtin_amdgcn_rcpf(1.0f + __expf(-x)); }
__device__ __forceinline__ float silu_f(float x) { return x * fast_sigmoid(x); }
__device__ __forceinline__ float gelu_tanh(float x) { const float u = 0.7978845608028654f * (x + 0.044715f * x * x * x); return x * fast_sigmoid(2.0f * u); }

namespace pg8 {
constexpr int BM = 256, BK = 64, HALF = 128, HTB = HALF * BK * 2, STAGE_BYTES = 8 * HTB, NXCD = 8, WGM = 8;
__device__ __forceinline__ int lds_byte(int r, int c) { const int st = (r >> 4) * 2 + (c >> 5), rr = r & 15, cc = c & 31, ob = rr * 64 + cc * 2; return st * 1024 + (ob ^ (((ob >> 9) & 1) << 5)); }
__device__ __forceinline__ void stage_rc(int b, int& R, int& C) { const int st = b / 1024, sb = b % 1024, swz = sb ^ (((sb >> 9) & 1) << 5); R = (st >> 1) * 16 + swz / 64; C = (st & 1) * 32 + (swz % 64) / 2; }

__device__ __forceinline__ int perm32(int rho) { const int n = rho >> 4, i = rho & 15; return 8 * (i >> 2) + 4 * n + (i & 3); }
struct Unit { int pm, pn, bz; };
struct Gemm { const bf16_t* A; const bf16_t* Bt; int lda, ldb, K, nM, nN, nB; size_t strideA, strideB; };

struct Sched {
    int nM, nN, nwg, total, G, c;
    __device__ void init(int nM_, int nN_, int nB_, int G_, int c_) { nM = nM_; nN = nN_; nwg = nM * nN; total = nwg * nB_; G = G_; c = c_; }
    __device__ bool next(int i, Unit& u) const {
        const long L = (long)i * G + c; if (L >= total) return false;
        u.bz = (int)(L / nwg); int wgid = (int)(L % nwg);
        { const int q = nwg / NXCD, r = nwg % NXCD, xcd = wgid % NXCD, off = wgid / NXCD; wgid = (xcd < r ? xcd * (q + 1) : r * (q + 1) + (xcd - r) * q) + off; }
        const int nig = WGM * nN, gid = wgid / nig, fm = gid * WGM, gsz = (nM - fm) < WGM ? (nM - fm) : WGM;
        u.pm = fm + ((wgid % nig) % gsz); u.pn = (wgid % nig) / gsz; return true;
    }
};

template <class Epi>
__device__ __forceinline__ void gemm_phase(LAS unsigned char* lds, const Gemm g, const Epi& E) {
    const int tid = otid(), wid = __builtin_amdgcn_readfirstlane(tid >> 6), lane = tid & 63, wr = wid >> 2, wc = wid & 3, fr = lane & 15, fq = lane >> 4;
    const int nt = g.K / BK;
    Sched S; S.init(g.nM, g.nN, g.nB, (int)gridDim.x, obid());
    unsigned voffA[2], voffB[2];
#pragma unroll
    for (int i = 0; i < 2; ++i) { int R, C; stage_rc(tid * 16 + i * 8192, R, C); const int Rb = Epi::PERM ? ((R & ~31) + perm32(R & 31)) : R;
        voffA[i] = (unsigned)(R * g.lda + C) * 2u; voffB[i] = (unsigned)(Rb * g.ldb + C) * 2u; }
    const size_t kstep = (size_t)(BK * 2);
    const size_t hstepA = (size_t)HALF * g.lda * 2, hstepB = (size_t)HALF * g.ldb * 2;
    const size_t tstepA = 2 * hstepA, tstepB = 2 * hstepB;
    const unsigned ldsw = (unsigned)wid * 1024u;
    const int aoff = lds_byte(wr * 64 + fr, fq * 8), boff = lds_byte(wc * 32 + fr, fq * 8);
#define PG8_SA(b, h) (((b) * 2 + (h)) * HTB)
#define PG8_SB(b, h) ((4 + (b) * 2 + (h)) * HTB)
#define PG8_STAGE(bufoff, gbase, voff) do { _Pragma("unroll") for (int _i = 0; _i < 2; ++_i) \
        __builtin_amdgcn_global_load_lds((const unsigned*)((const char*)(gbase) + (voff)[_i]), (LAS unsigned*)(lds + (bufoff) + ldsw + _i * 8192), 16, 0, 0); } while (0)
#define PG8_LDA(dst, b, h) do { _Pragma("unroll") for (int m = 0; m < 4; ++m) _Pragma("unroll") for (int k = 0; k < 2; ++k) dst[m][k] = *(const LAS bf16x8*)(lds + PG8_SA(b, h) + aoff + m * 2048 + k * 1024); } while (0)
#define PG8_LDB(dst, b, h) do { _Pragma("unroll") for (int n = 0; n < 2; ++n) _Pragma("unroll") for (int k = 0; k < 2; ++k) dst[n][k] = *(const LAS bf16x8*)(lds + PG8_SB(b, h) + boff + n * 2048 + k * 1024); } while (0)
#define PG8_MMA(ai, bj, At, Bt) do { __builtin_amdgcn_s_setprio(1); _Pragma("unroll") for (int m = 0; m < 4; ++m) _Pragma("unroll") for (int n = 0; n < 2; ++n) _Pragma("unroll") for (int k = 0; k < 2; ++k) \
        acc[ai][bj][m][n] = __builtin_amdgcn_mfma_f32_16x16x32_bf16(Bt[n][k], At[m][k], acc[ai][bj][m][n], 0, 0, 0); __builtin_amdgcn_s_setprio(0); } while (0)
#define PG8_WAIT_V(n) asm volatile("s_waitcnt vmcnt(" #n ")" ::: "memory")
#define PG8_WAIT_L(n) asm volatile("s_waitcnt lgkmcnt(" #n ")" ::: "memory")
#define PG8_BAR __builtin_amdgcn_s_barrier()
#define PG8_SCHED __builtin_amdgcn_sched_barrier(0)
    Unit cur, nxt; int ui = 0;
    if (!S.next(0, cur)) return;
    int tag0 = -1, tag1 = -1, tag2 = -1, tag3 = -1; LAS float* rstab = (LAS float*)(lds + STAGE_BYTES);
    if constexpr (Epi::RSTD) {
        { Unit t_; for (int i = 0; S.next(i, t_); ++i) { const int pm = t_.pm; if (pm == tag0 || pm == tag1 || pm == tag2 || pm == tag3) continue;
                if (tag0 < 0) tag0 = pm; else if (tag1 < 0) tag1 = pm; else if (tag2 < 0) tag2 = pm; else tag3 = pm; } }
#pragma unroll
        for (int sl = 0; sl < 2; ++sl) { const int slot = (tid >> 8) + 2 * sl; const int pm = slot == 0 ? tag0 : slot == 1 ? tag1 : slot == 2 ? tag2 : tag3;
            if (pm >= 0) { const f32x4* p = (const f32x4*)(E.SS + ((size_t)pm * 256 + (tid & 255)) * 16); const f32x4 a = p[0], b = p[1], c = p[2], d = p[3]; const f32x4 t = (a + b) + (c + d);
                rstab[slot * 256 + (tid & 255)] = rsqrtf(((t[0] + t[1]) + (t[2] + t[3])) * (1.0f / 1024.0f) + 1e-6f); } }
        __syncthreads();
    }
    f32x4 acc[2][2][4][2];
#pragma unroll
    for (int a = 0; a < 2; ++a)
#pragma unroll
        for (int b = 0; b < 2; ++b)
#pragma unroll
            for (int m = 0; m < 4; ++m)
#pragma unroll
                for (int n = 0; n < 2; ++n) acc[a][b][m][n] = (f32x4){0.f, 0.f, 0.f, 0.f};
    bf16x8 At[4][2], B0[2][2], B1[2][2];
    const char* cA = (const char*)g.A + (size_t)cur.bz * g.strideA * 2 + (size_t)cur.pm * tstepA;
    const char* cB = (const char*)g.Bt + (size_t)cur.bz * g.strideB * 2 + (size_t)cur.pn * tstepB;
    PG8_STAGE(PG8_SB(0, 0), cB, voffB); PG8_STAGE(PG8_SB(0, 1), cB + hstepB, voffB); PG8_STAGE(PG8_SA(0, 0), cA, voffA); PG8_STAGE(PG8_SA(0, 1), cA + hstepA, voffA);
    if (wr == 1) PG8_BAR;
    PG8_WAIT_V(2); PG8_BAR;
    PG8_STAGE(PG8_SB(1, 0), cB + kstep, voffB); PG8_STAGE(PG8_SA(1, 0), cA + kstep, voffA); PG8_STAGE(PG8_SB(1, 1), cB + hstepB + kstep, voffB);
    PG8_WAIT_V(6); PG8_BAR;
    for (;;) {
        const bool has_next = S.next(ui + 1, nxt);
        const char* nA = has_next ? (const char*)g.A + (size_t)nxt.bz * g.strideA * 2 + (size_t)nxt.pm * tstepA : cA;
        const char* nB = has_next ? (const char*)g.Bt + (size_t)nxt.bz * g.strideB * 2 + (size_t)nxt.pn * tstepB : cB;
        for (int t = 0; t < nt; t += 2) {
            const bool last = (t == nt - 2);
            const char* a1 = cA + (size_t)(t + 1) * kstep;
            const char* a2 = last ? nA : cA + (size_t)(t + 2) * kstep; const char* b2 = last ? nB : cB + (size_t)(t + 2) * kstep;
            const char* a3 = a2 + kstep; const char* b3 = b2 + kstep;
            PG8_LDB(B0, 0, 0); PG8_LDB(B1, 0, 1); PG8_SCHED; PG8_LDA(At, 0, 0); PG8_STAGE(PG8_SA(1, 1), a1 + hstepA, voffA);
            PG8_WAIT_V(8); PG8_WAIT_L(0); PG8_BAR; PG8_MMA(0, 0, At, B0); PG8_MMA(0, 1, At, B1); PG8_BAR; PG8_SCHED;
            PG8_LDA(At, 0, 1); PG8_STAGE(PG8_SB(0, 0), b2, voffB); PG8_STAGE(PG8_SB(0, 1), b2 + hstepB, voffB); PG8_STAGE(PG8_SA(0, 0), a2, voffA);
            PG8_WAIT_V(8); PG8_WAIT_L(0); PG8_BAR; PG8_MMA(1, 0, At, B0); PG8_MMA(1, 1, At, B1); PG8_BAR; PG8_SCHED;
            PG8_LDB(B0, 1, 0); PG8_LDB(B1, 1, 1); PG8_SCHED; PG8_LDA(At, 1, 0); PG8_STAGE(PG8_SA(0, 1), a2 + hstepA, voffA);
            PG8_WAIT_V(8); PG8_WAIT_L(0); PG8_BAR; PG8_MMA(0, 0, At, B0); PG8_MMA(0, 1, At, B1); PG8_BAR; PG8_SCHED;
            PG8_LDA(At, 1, 1); PG8_STAGE(PG8_SB(1, 0), b3, voffB); PG8_STAGE(PG8_SB(1, 1), b3 + hstepB, voffB); PG8_STAGE(PG8_SA(1, 0), a3, voffA);
            PG8_WAIT_V(8); PG8_WAIT_L(0); PG8_BAR; PG8_MMA(1, 0, At, B0); PG8_MMA(1, 1, At, B1); PG8_BAR; PG8_SCHED;
        }
        if (wr == 0) PG8_BAR;
        E(acc, cur, wr, wc, fr, fq, rstab + (cur.pm == tag1 ? 256 : cur.pm == tag2 ? 512 : cur.pm == tag3 ? 768 : 0));
        if (!has_next) break;
#pragma unroll
        for (int a = 0; a < 2; ++a)
#pragma unroll
            for (int b = 0; b < 2; ++b)
#pragma unroll
                for (int m = 0; m < 4; ++m)
#pragma unroll
                    for (int n = 0; n < 2; ++n) acc[a][b][m][n] = (f32x4){0.f, 0.f, 0.f, 0.f};
        cur = nxt; cA = nA; cB = nB; ++ui;
        if (wr == 1) PG8_BAR;
    }
    PG8_WAIT_V(0);
    PG8_BAR;
#undef PG8_SA
#undef PG8_SB
#undef PG8_STAGE
#undef PG8_LDA
#undef PG8_LDB
#undef PG8_MMA
#undef PG8_WAIT_V
#undef PG8_WAIT_L
#undef PG8_BAR
#undef PG8_SCHED
}
}
using pg8::Unit;
typedef const f32x4 (&AccRef)[2][2][4][2];

struct EpiSwiGLU {
    static constexpr bool PERM = true, RSTD = true;
    bf16_t* O; const float* SS;
    __device__ __forceinline__ void operator()(AccRef acc, const Unit& u, int wr, int wc, int fr, int fq, const LAS float* rsl) const {
        const int row0 = u.pm * 256 + wr * 64 + fr, col0 = u.pn * 128 + wc * 32 + 8 * fq;
#pragma unroll
        for (int ai = 0; ai < 2; ++ai)
#pragma unroll
            for (int m = 0; m < 4; ++m) { bf16_t* rowp = O + (size_t)(row0 + ai * 128 + m * 16) * 2816 + col0; uint4 w; const float rs = rsl[ai * 128 + wr * 64 + m * 16 + fr];
                { const f32x4 gt = rs * acc[ai][0][m][0], up = rs * acc[ai][1][m][0]; w.x = pack2(silu_f(gt[0]) * up[0], silu_f(gt[1]) * up[1]); w.y = pack2(silu_f(gt[2]) * up[2], silu_f(gt[3]) * up[3]); }
                { const f32x4 gt = rs * acc[ai][0][m][1], up = rs * acc[ai][1][m][1]; w.z = pack2(silu_f(gt[0]) * up[0], silu_f(gt[1]) * up[1]); w.w = pack2(silu_f(gt[2]) * up[2], silu_f(gt[3]) * up[3]); }
                *(uint4*)rowp = w; }
    }
};
template <bool STATS> struct EpiResid {
    static constexpr bool PERM = true, RSTD = false;
    const float* Xin; float* X; bf16_t* XB; float* SS; float alpha;
    __device__ __forceinline__ void operator()(AccRef acc, const Unit& u, int wr, int wc, int fr, int fq, const LAS float* rsl) const {
        const int row0 = u.pm * 256 + wr * 64 + fr, col0 = u.pn * 256 + wc * 32 + 8 * fq;
#pragma unroll
        for (int ai = 0; ai < 2; ++ai)
#pragma unroll
            for (int m = 0; m < 4; ++m) { const size_t ro = (size_t)(row0 + ai * 128 + m * 16) * 1024 + col0; float sq = 0.f;
#pragma unroll
                for (int bj = 0; bj < 2; ++bj) { const size_t o = ro + bj * 128; const f32x4 x0 = *(const f32x4*)(Xin + o), x1 = *(const f32x4*)(Xin + o + 4);
                    const f32x4 y0 = x0 + alpha * acc[ai][bj][m][0], y1 = x1 + alpha * acc[ai][bj][m][1]; *(f32x4*)(X + o) = y0; *(f32x4*)(X + o + 4) = y1;
                    if (STATS) { uint4 w; w.x = pack2(y0[0], y0[1]); w.y = pack2(y0[2], y0[3]); w.z = pack2(y1[0], y1[1]); w.w = pack2(y1[2], y1[3]); *(uint4*)(XB + o) = w;
                        sq += y0[0] * y0[0] + y0[1] * y0[1] + y0[2] * y0[2] + y0[3] * y0[3] + y1[0] * y1[0] + y1[1] * y1[1] + y1[2] * y1[2] + y1[3] * y1[3]; } }
                if (STATS) { sq += __shfl_xor(sq, 16); sq += __shfl_xor(sq, 32); if (fq == 0) SS[(size_t)(row0 + ai * 128 + m * 16) * 16 + u.pn * 4 + wc] = sq; } }
    }
};
struct EpiBf16 {
    static constexpr bool PERM = true, RSTD = true;
    bf16_t* O; int ldc; const float* SS;
    __device__ __forceinline__ void operator()(AccRef acc, const Unit& u, int wr, int wc, int fr, int fq, const LAS float* rsl) const {
        const int row0 = u.pm * 256 + wr * 64 + fr, col0 = u.pn * 256 + wc * 32 + 8 * fq;
#pragma unroll
        for (int ai = 0; ai < 2; ++ai)
#pragma unroll
            for (int m = 0; m < 4; ++m) { bf16_t* rowp = O + (size_t)(row0 + ai * 128 + m * 16) * ldc + col0; const float rs = rsl[ai * 128 + wr * 64 + m * 16 + fr];
#pragma unroll
                for (int bj = 0; bj < 2; ++bj) { const f32x4 v0 = rs * acc[ai][bj][m][0], v1 = rs * acc[ai][bj][m][1]; uint4 w; w.x = pack2(v0[0], v0[1]); w.y = pack2(v0[2], v0[3]); w.z = pack2(v1[0], v1[1]); w.w = pack2(v1[2], v1[3]);
                    *(uint4*)(rowp + bj * 128) = w; } }
    }
};
struct EpiWin0 {
    static constexpr bool PERM = true, RSTD = true;
    bf16_t* AS5; bf16_t* PQ; const float* SS;
    __device__ __forceinline__ void operator()(AccRef acc, const Unit& u, int wr, int wc, int fr, int fq, const LAS float* rsl) const {
        const int row0 = u.pm * 256 + wr * 64 + fr, col0 = u.pn * 256 + wc * 32 + 8 * fq;
#pragma unroll
        for (int ai = 0; ai < 2; ++ai)
#pragma unroll
            for (int m = 0; m < 4; ++m) { const int r = row0 + ai * 128 + m * 16; const float rs = rsl[ai * 128 + wr * 64 + m * 16 + fr];
#pragma unroll
                for (int bj = 0; bj < 2; ++bj) { const int c = col0 + bj * 128; const f32x4 v0 = rs * acc[ai][bj][m][0], v1 = rs * acc[ai][bj][m][1];
                    uint4 w; w.x = pack2(v0[0], v0[1]); w.y = pack2(v0[2], v0[3]); w.z = pack2(v1[0], v1[1]); w.w = pack2(v1[2], v1[3]);
                    if (u.pn < 2) *(uint4*)(AS5 + ((size_t)((c >> 4) * 1024 + (r >> 6))) * 1280 + (r & 63) * 16 + (c & 15)) = w;
                    else *(uint4*)(PQ + (size_t)r * 1792 + (c - 512)) = w; } }
    }
};
struct EpiGLU {
    static constexpr bool PERM = true, RSTD = false;
    const bf16_t* GY; bf16_t* MIX;
    __device__ __forceinline__ void operator()(AccRef acc, const Unit& u, int wr, int wc, int fr, int fq, const LAS float* rsl) const {
        const int row0 = u.pm * 256 + wr * 64 + fr, col0 = u.pn * 256 + wc * 32 + 8 * fq;
#pragma unroll
        for (int ai = 0; ai < 2; ++ai)
#pragma unroll
            for (int m = 0; m < 4; ++m) { const int r = row0 + ai * 128 + m * 16;
#pragma unroll
                for (int bj = 0; bj < 2; ++bj) { const int c = col0 + bj * 128; const f32x4 v0 = acc[ai][bj][m][0], v1 = acc[ai][bj][m][1];
                    const uint4 gy = *(const uint4*)(GY + (size_t)r * 512 + c); uint4 w;
                    w.x = pack2(bflo(gy.x) * fast_sigmoid(v0[0]), bfhi(gy.x) * fast_sigmoid(v0[1])); w.y = pack2(bflo(gy.y) * fast_sigmoid(v0[2]), bfhi(gy.y) * fast_sigmoid(v0[3]));
                    w.z = pack2(bflo(gy.z) * fast_sigmoid(v1[0]), bfhi(gy.z) * fast_sigmoid(v1[1])); w.w = pack2(bflo(gy.w) * fast_sigmoid(v1[2]), bfhi(gy.w) * fast_sigmoid(v1[3]));
                    *(uint4*)(MIX + (size_t)r * 1024 + c) = w; } }
    }
};
struct EpiS5E {
    static constexpr bool PERM = false, RSTD = false;
    float* E;
    __device__ __forceinline__ void operator()(AccRef acc, const Unit& u, int wr, int wc, int fr, int fq, const LAS float* rsl) const {
        const int row0 = u.pm * 256 + wr * 64 + fr, col0 = wc * 32 + 4 * fq;
#pragma unroll
        for (int ai = 0; ai < 2; ++ai)
#pragma unroll
            for (int m = 0; m < 4; ++m) { float* rowp = E + ((size_t)u.bz * 1024 + row0 + ai * 128 + m * 16) * 256 + col0;
#pragma unroll
                for (int bj = 0; bj < 2; ++bj)
#pragma unroll
                    for (int n = 0; n < 2; ++n) *(f32x4*)(rowp + bj * 128 + n * 16) = acc[ai][bj][m][n]; }
    }
};
struct EpiS5Y {
    static constexpr bool PERM = true, RSTD = false;
    bf16_t* GY;
    __device__ __forceinline__ void operator()(AccRef acc, const Unit& u, int wr, int wc, int fr, int fq, const LAS float* rsl) const {
        const int row0 = u.pm * 256 + wr * 64 + fr, col0 = u.pn * 256 + wc * 32 + 8 * fq;
#pragma unroll
        for (int ai = 0; ai < 2; ++ai)
#pragma unroll
            for (int m = 0; m < 4; ++m) { const int bc = row0 + ai * 128 + m * 16;
#pragma unroll
                for (int bj = 0; bj < 2; ++bj) { const int c = col0 + bj * 128; const f32x4 v0 = acc[ai][bj][m][0], v1 = acc[ai][bj][m][1]; uint4 w;
                    w.x = pack2(gelu_tanh(v0[0]), gelu_tanh(v0[1])); w.y = pack2(gelu_tanh(v0[2]), gelu_tanh(v0[3])); w.z = pack2(gelu_tanh(v1[0]), gelu_tanh(v1[1])); w.w = pack2(gelu_tanh(v1[2]), gelu_tanh(v1[3]));
                    *(uint4*)(GY + ((size_t)bc * 64 + (c >> 4)) * 512 + u.bz * 16 + (c & 15)) = w; } }
    }
};

__device__ void transpose_job(const float* __restrict__ src, int K, int Nsrc, bf16_t* __restrict__ dst, int Ndst, int mode, LAS float* tile, int b0, int nb, const float* __restrict__ gain) {
    const int tid = otid();
    const int ntk = K >> 8, nt = (Ndst >> 6) * ntk;
    for (int t = obid() - b0; t < nt; t += nb) {
        const int tn = t / ntk, tk = t % ntk, n0 = tn * 64, k0 = tk * 256;
        int ns0 = n0;
        if (mode == 1) { const int tt = n0 >> 8, j = n0 & 255; ns0 = (j < 128) ? (tt * 128 + j) : (2816 + tt * 128 + (j - 128)); }
        const int r = tid >> 4, c4 = (tid & 15) * 4;
        float4 v[8];
#pragma unroll
        for (int rr = 0; rr < 8; ++rr) { v[rr] = make_float4(0.f, 0.f, 0.f, 0.f);
            if (ns0 + c4 + 3 < Nsrc) v[rr] = *(const float4*)(src + (size_t)(k0 + r + rr * 32) * Nsrc + ns0 + c4);
            if (gain) { const float gk = gain[k0 + r + rr * 32]; v[rr].x *= gk; v[rr].y *= gk; v[rr].z *= gk; v[rr].w *= gk; } }
#pragma unroll
        for (int rr = 0; rr < 8; ++rr) { const int kk = r + rr * 32; LAS float* tp = tile + (kk >> 6) * (64 * 65) + (kk & 63) * 65 + c4;
            tp[0] = v[rr].x; tp[1] = v[rr].y; tp[2] = v[rr].z; tp[3] = v[rr].w; }
        __syncthreads();
        const int n = tid >> 3, kq = (tid & 7) * 8;
#pragma unroll
        for (int kt = 0; kt < 4; ++kt) { const LAS float* tp = tile + kt * (64 * 65); uint4 w;
            w.x = pack2(tp[(kq + 0) * 65 + n], tp[(kq + 1) * 65 + n]); w.y = pack2(tp[(kq + 2) * 65 + n], tp[(kq + 3) * 65 + n]);
            w.z = pack2(tp[(kq + 4) * 65 + n], tp[(kq + 5) * 65 + n]); w.w = pack2(tp[(kq + 6) * 65 + n], tp[(kq + 7) * 65 + n]);
            *(uint4*)(dst + (size_t)(n0 + n) * K + k0 + kt * 64 + kq) = w; }
        __syncthreads();
    }
}

__device__ void s5_pre(CP P, int g, int dir, int part, LAS unsigned char* lds) {
    LAS f32x2* pw = (LAS f32x2*)lds;
    LAS f32x2* Bb = pw + 65 * 64;
    LAS f32x2* Cc = Bb + 64 * 16;
    const int tid = otid();
    float* Ktab = (float*)(P->ws + OFF_KTAB); float* AT = (float*)(P->ws + OFF_S5P);
    bf16_t* KG = (bf16_t*)(P->ws + OFF_KG); bf16_t* H = (bf16_t*)(P->ws + OFF_H);
    if (tid < 64) { const int n = tid, gi = (dir * 32 + g) * 64 + n;
        const double lr = fmin((double)P->in[9][gi], -1e-4), li = (double)P->in[10][gi], dt = (double)expf(P->in[15][dir * 32 + g]);
        const double em1 = (double)expm1f((float)(lr * dt)), mag = 1.0 + em1;
        double rev = li * dt * 0.15915494309189535; rev -= rint(rev); const float th = (float)(rev * 6.283185307179586), thh = 0.5f * th;
        const double sn_ = (double)sinf(th), shalf = (double)sinf(thh), cm1 = -2.0 * shalf * shalf;
        const double ar = mag * (1.0 + cm1), ai = mag * sn_, arm1 = em1 + cm1 + em1 * cm1, den = lr * lr + li * li;
        const double cr = (arm1 * lr + ai * li) / den, ci = (ai * lr - arm1 * li) / den;
#pragma unroll 1
        for (int p = 0; p < 16; ++p) { const double br = (double)P->in[11][gi * 16 + p], bi = (double)P->in[12][gi * 16 + p];
            Bb[n * 16 + p] = mkf2((float)(cr * br - ci * bi), (float)(cr * bi + ci * br)); }
        double xr = 1.0, xi = 0.0;
#pragma unroll 1
        for (int d = 0; d <= 64; ++d) { pw[d * 64 + n] = mkf2((float)xr, (float)xi); const double t0 = xr * ar - xi * ai; xi = xr * ai + xi * ar; xr = t0; }
        const f32x2 a64 = pw[64 * 64 + n];
        if (part == 0) { AT[((g * 2 + dir) * 64 + n) * 2 + 0] = a64.x; AT[((g * 2 + dir) * 64 + n) * 2 + 1] = a64.y; } }
#pragma unroll 1
    for (int idx = tid; idx < 16 * 64; idx += NTHR) { const int p = idx >> 6, n = idx & 63; const int ci_ = ((dir * 32 + g) * 16 + p) * 64 + n;
        Cc[idx] = mkf2(P->in[13][ci_], P->in[14][ci_]); }
    __syncthreads();
    { const int dq = tid >> 8, p = (tid >> 4) & 15, pp = tid & 15;
#pragma unroll 1
        for (int dd = 0; dd < 16; ++dd) { const int d = part * 32 + dq * 16 + dd; float acc = 0.f;
#pragma unroll 4
            for (int n = 0; n < 64; ++n) { const f32x2 w = pw[d * 64 + n], bb = Bb[n * 16 + pp], c = Cc[p * 64 + n];
                const float zr = w.x * bb.x - w.y * bb.y, zi = w.x * bb.y + w.y * bb.x; acc += c.x * zr - c.y * zi; }
            Ktab[((size_t)((g * 2 + dir) * 64 + d)) * 256 + p * 16 + pp] = acc; } }
#pragma unroll 1
    for (int idx = tid; idx < 512 * 64; idx += NTHR) { const int row = part * 512 + (idx >> 6), n = idx & 63, t = row >> 4, p = row & 15, d = dir == 0 ? t + 1 : 64 - t;
        const f32x2 w = pw[d * 64 + n], c = Cc[p * 64 + n]; const float gr = c.x * w.x - c.y * w.y, gi = c.x * w.y + c.y * w.x;
        *(unsigned*)(KG + ((size_t)(g * 1024 + row)) * 1280 + 1024 + dir * 128 + n * 2) = pack2(gr, -gi); }
#pragma unroll 1
    for (int idx = tid; idx < 32 * 64 * 8; idx += NTHR) { const int pp2 = (idx & 7) * 2, s = (idx >> 3) & 63, n = part * 32 + (idx >> 9), d = dir == 0 ? 63 - s : s;
        const f32x2 w = pw[d * 64 + n], b0 = Bb[n * 16 + pp2], b1 = Bb[n * 16 + pp2 + 1];
        const float hr0 = w.x * b0.x - w.y * b0.y, hi0 = w.x * b0.y + w.y * b0.x, hr1 = w.x * b1.x - w.y * b1.y, hi1 = w.x * b1.y + w.y * b1.x;
        const size_t row0 = (size_t)g * 256 + dir * 128 + n * 2;
        *(unsigned*)(H + row0 * 1024 + s * 16 + pp2) = pack2(hr0, hr1); *(unsigned*)(H + (row0 + 1) * 1024 + s * 16 + pp2) = pack2(hi0, hi1); }
    __syncthreads();
}

template <bool FINAL> __device__ void phase_norm(const float* __restrict__ x, const float* __restrict__ g, bf16_t* __restrict__ xb, float* __restrict__ ss_out, float* __restrict__ outf, int b0, int nb, int rbeg, int rend);
__device__ void phase_prologue(CP P, LAS unsigned char* lds) {
    const int tid = otid(), bq = obid();
    if (bq < 128) { if (EN(20)) s5_pre(P, bq >> 2, (bq >> 1) & 1, bq & 1, lds);
        phase_norm<false>(P->in[0], nullptr, (bf16_t*)(P->ws + OFF_XN), (float*)(P->ws + OFF_SSQ), nullptr, 0, 128, 0, 40960); return; }
    const int b0 = 128, nb = (int)gridDim.x - 128;
    if (EN(21)) { float* cs = (float*)(P->ws + OFF_ROPE); float* sn = cs + 8192 * 64;
        for (int idx = (bq - b0) * NTHR + tid; idx < 8192 * 64; idx += nb * NTHR) { const int pos = idx >> 6, f = idx & 63;
            const float inv = expf(-9.210340371976184f * (float)f * (1.0f / 64.0f)); const float ang = (float)pos * inv;
            cs[idx] = cosf(ang); sn[idx] = sinf(ang); } }
    phase_norm<false>(P->in[0], nullptr, (bf16_t*)(P->ws + OFF_XN), (float*)(P->ws + OFF_SSQ), nullptr, b0, nb, 40960, 65536);
    LAS float* tile = (LAS float*)lds;
    if (EN(22)) for (int l = 0; l < 2; ++l) {
        transpose_job(P->in[2] + (size_t)l * 1024 * 5632, 1024, 5632, (bf16_t*)(P->ws + OFF_W1 + (size_t)(2 * l) * SZ_W1), 5632, 1, tile, b0, nb, P->in[1] + l * 1024);
        transpose_job(P->in[6] + (size_t)l * 1024 * 5632, 1024, 5632, (bf16_t*)(P->ws + OFF_W1 + (size_t)(2 * l + 1) * SZ_W1), 5632, 1, tile, b0, nb, P->in[5] + l * 1024);
        transpose_job(P->in[3] + (size_t)l * 2816 * 1024, 2816, 1024, (bf16_t*)(P->ws + OFF_W2 + (size_t)(2 * l) * SZ_W2), 1024, 0, tile, b0, nb, nullptr);
        transpose_job(P->in[7] + (size_t)l * 2816 * 1024, 2816, 1024, (bf16_t*)(P->ws + OFF_W2 + (size_t)(2 * l + 1) * SZ_W2), 1024, 0, tile, b0, nb, nullptr);
    }
    if (EN(22)) transpose_job(P->in[8], 1024, 2080, (bf16_t*)(P->ws + OFF_WIN0), 2304, 0, tile, b0, nb, P->in[4]);
    if (EN(22)) transpose_job(P->in[17], 512, 512, (bf16_t*)(P->ws + OFF_WGLU), 512, 0, tile, b0, nb, nullptr);
    if (EN(22)) transpose_job(P->in[21], 1024, 1024, (bf16_t*)(P->ws + OFF_WOUT0), 1024, 0, tile, b0, nb, nullptr);
    if (EN(22)) transpose_job(P->in[22], 1024, 6144, (bf16_t*)(P->ws + OFF_WIN1), 6144, 0, tile, b0, nb, P->in[4] + 1024);
    if (EN(22)) transpose_job(P->in[24], 2048, 1024, (bf16_t*)(P->ws + OFF_WOUT1), 1024, 0, tile, b0, nb, nullptr);
}

__device__ void phase_kmat(CP P) {
    const float* Ktab = (const float*)(P->ws + OFF_KTAB); bf16_t* KG = (bf16_t*)(P->ws + OFF_KG); const float* dsk = P->in[16];
    for (int idx = obid() * NTHR + otid(); idx < 32 * 1024 * 512; idx += gridDim.x * NTHR) {
        const int kp = idx & 511, row = (idx >> 9) & 1023, g = idx >> 19, t = row >> 4, p = row & 15, k = kp * 2, s = k >> 4, pp = k & 15;
        float v0 = 0.f, v1 = 0.f;
        if (s <= t) { const float* b = Ktab + ((size_t)((g * 2 + 0) * 64 + (t - s))) * 256 + p * 16 + pp; v0 += b[0]; v1 += b[1]; }
        if (s >= t) { const float* b = Ktab + ((size_t)((g * 2 + 1) * 64 + (s - t))) * 256 + p * 16 + pp; v0 += b[0]; v1 += b[1]; }
        if (s == t) { const float dv = dsk[g * 16 + p]; if (pp == p) v0 += dv; if (pp + 1 == p) v1 += dv; }
        *(unsigned*)(KG + ((size_t)(g * 1024 + row)) * 1280 + k) = pack2(v0, v1);
    }
}

template <bool FINAL>
__device__ void phase_norm(const float* __restrict__ x, const float* __restrict__ g, bf16_t* __restrict__ xb, float* __restrict__ ss_out, float* __restrict__ outf, int b0, int nb, int rbeg, int rend) {
    const int tid_ = otid(), lane = tid_ & 63, wid = tid_ >> 6; const int bq = obid() - b0;
    if (bq < 0) return;
    f32x4 gv[4];
#pragma unroll
    for (int i = 0; i < 4; ++i) gv[i] = FINAL ? *(const f32x4*)(g + (lane + 64 * i) * 4) : (f32x4){1.f, 1.f, 1.f, 1.f};
    for (int row0 = rbeg + bq * 8 + wid; row0 < rend; row0 += nb * 16) {
        const int row1 = row0 + nb * 8; const bool has1 = row1 < rend;
        const float* xr0 = x + (size_t)row0 * 1024; const float* xr1 = x + (size_t)(has1 ? row1 : row0) * 1024; f32x4 v[4], u[4]; float ss = 0.f, st = 0.f;
#pragma unroll
        for (int i = 0; i < 4; ++i) { v[i] = *(const f32x4*)(xr0 + (lane + 64 * i) * 4); u[i] = *(const f32x4*)(xr1 + (lane + 64 * i) * 4); }
#pragma unroll
        for (int i = 0; i < 4; ++i) { ss += v[i][0] * v[i][0] + v[i][1] * v[i][1] + v[i][2] * v[i][2] + v[i][3] * v[i][3]; st += u[i][0] * u[i][0] + u[i][1] * u[i][1] + u[i][2] * u[i][2] + u[i][3] * u[i][3]; }
#pragma unroll
        for (int o = 32; o > 0; o >>= 1) { ss += __shfl_xor(ss, o); st += __shfl_xor(st, o); }
#pragma unroll
        for (int rr = 0; rr < 2; ++rr) { if (rr == 1 && !has1) break; const int row = rr ? row1 : row0; const float sv = rr ? st : ss;
            if (FINAL) { const float rstd = rsqrtf(sv * (1.0f / 1024.0f) + 1e-6f);
#pragma unroll
                for (int i = 0; i < 4; ++i) *(f32x4*)(outf + (size_t)row * 1024 + (lane + 64 * i) * 4) = (rr ? u[i] : v[i]) * rstd * gv[i]; }
            else { if (lane < 16) ss_out[(size_t)row * 16 + lane] = lane == 0 ? sv : 0.f;
#pragma unroll
                for (int i = 0; i < 4; ++i) { const f32x4 y = rr ? u[i] : v[i]; uint2 w; w.x = pack2(y[0], y[1]); w.y = pack2(y[2], y[3]); *(uint2*)(xb + (size_t)row * 1024 + (lane + 64 * i) * 4) = w; } } }
    }
}

__device__ __forceinline__ f32x4 mma16(const LAS bf16_t* As, int lda, const LAS bf16_t* Bs, int ldb, int K, f32x4 acc, int lane) {
    const int r = lane & 15, q = lane >> 4;
#pragma unroll
    for (int k = 0; k < K; k += 32) { const bf16x8 a = *(const LAS bf16x8*)(As + r * lda + k + q * 8); const bf16x8 b = *(const LAS bf16x8*)(Bs + r * ldb + k + q * 8);
        acc = __builtin_amdgcn_mfma_f32_16x16x32_bf16(b, a, acc, 0, 0, 0); }
    return acc;
}


typedef short s16x4 __attribute__((ext_vector_type(4)));
__device__ __forceinline__ bf16x8 frag_tr(const LAS bf16_t* T, int ld, int lane) {
    const int g = lane >> 4, qq = (lane & 15) >> 2, p = lane & 3;
    LAS bf16_t* a = (LAS bf16_t*)T + (8 * g + qq) * ld + 4 * p;
    const s16x4 lo = __builtin_amdgcn_ds_read_tr16_b64_v4i16((LAS s16x4*)a);
    const s16x4 hi = __builtin_amdgcn_ds_read_tr16_b64_v4i16((LAS s16x4*)(a + 4 * ld));
    return (bf16x8){lo[0], lo[1], lo[2], lo[3], hi[0], hi[1], hi[2], hi[3]};
}

__device__ __forceinline__ void lds_barrier() { asm volatile("s_waitcnt lgkmcnt(0)" ::: "memory"); __builtin_amdgcn_s_barrier(); asm volatile("" ::: "memory"); }

__device__ void phase_s5_scan(CP P) {
    const float* E = (const float*)(P->ws + OFF_E); const float* AT = (const float*)(P->ws + OFF_S5P); bf16_t* AS5 = (bf16_t*)(P->ws + OFF_AS5);
    const int tid_ = otid(); if (tid_ >= 128) return;
    for (int idx = obid() * 128 + tid_; idx < 32 * 8 * 2 * 64; idx += gridDim.x * 128) {
        const int n = idx & 63, dir = (idx >> 6) & 1, b = (idx >> 7) & 7, g = idx >> 10;
        const float ar = AT[((g * 2 + dir) * 64 + n) * 2], ai = AT[((g * 2 + dir) * 64 + n) * 2 + 1];
        float xr = 0.f, xi = 0.f;
#pragma unroll 16
        for (int cc = 0; cc < 128; ++cc) { const int c = dir == 0 ? cc : 127 - cc; const size_t bc = (size_t)g * 1024 + b * 128 + c;
            *(unsigned*)(AS5 + bc * 1280 + 1024 + dir * 128 + n * 2) = pack2(xr, xi);
            const float2 e = *(const float2*)(E + bc * 256 + dir * 128 + n * 2);
            const float t0 = ar * xr - ai * xi + e.x; xi = ar * xi + ai * xr + e.y; xr = t0; }
    }
}

__device__ __forceinline__ void gla_gates(CP P, const bf16_t* PQ, int m0, int h, LAS unsigned char* lds) {
    LAS float* gl = (LAS float*)lds; LAS float* tot = (LAS float*)(lds + 8192); LAS float* G = (LAS float*)(lds + 17408);
    const int tid = otid();
    const int dir = tid >> 8, d = tid & 63, tq = (tid >> 6) & 3;
    { const int idx = tid * 4, t = idx >> 5, r = idx & 31; const uint2 raw = *(const uint2*)(PQ + (size_t)(m0 + t) * 1792 + 1536 + r);
        *(LAS f32x4*)(gl + idx) = (f32x4){bflo(raw.x), bfhi(raw.x), bflo(raw.y), bfhi(raw.y)}; }
    float w[16];
#pragma unroll
    for (int r = 0; r < 16; ++r) w[r] = P->in[18][(dir * 16 + r) * 256 + h * 64 + d];
    const float b = P->in[19][dir * 256 + h * 64 + d];
    lds_barrier();
    float c[16];
#pragma unroll
    for (int i = 0; i < 16; ++i) { const int t = tq * 16 + i; float z = b;
#pragma unroll
        for (int r4 = 0; r4 < 4; ++r4) { const f32x4 g4 = *(const LAS f32x4*)(gl + t * 32 + dir * 16 + r4 * 4);
            z += g4[0] * w[r4 * 4] + g4[1] * w[r4 * 4 + 1] + g4[2] * w[r4 * 4 + 2] + g4[3] * w[r4 * 4 + 3]; }
        c[i] = (fminf(z, 0.f) - __logf(1.0f + __expf(-fabsf(z)))) * (1.0f / 16.0f); }
    if (dir == 0) {
#pragma unroll
        for (int i = 1; i < 16; ++i) c[i] += c[i - 1];
        tot[(dir * 4 + tq) * 64 + d] = c[15]; }
    else {
#pragma unroll
        for (int i = 14; i >= 0; --i) c[i] += c[i + 1];
        tot[(dir * 4 + tq) * 64 + d] = c[0]; }
    lds_barrier();
    float off = 0.f;
#pragma unroll
    for (int q = 0; q < 4; ++q) { const float tv = tot[(dir * 4 + q) * 64 + d]; off += ((dir == 0) ? (q < tq) : (q > tq)) ? tv : 0.f; }
#pragma unroll
    for (int i = 0; i < 16; ++i) G[(dir * 64 + tq * 16 + i) * 64 + d] = c[i] + off;
    lds_barrier();
}

__device__ void gla_a_unit(CP P, int unit, LAS unsigned char* lds) {
    const int c = unit & 127, h = (unit >> 7) & 3, b = unit >> 9, m0 = b * 8192 + c * 64;
    const bf16_t* PQ = (const bf16_t*)(P->ws + OFF_PQ); bf16_t* GST = (bf16_t*)(P->ws + OFF_GST); float* GDEC = (float*)(P->ws + OFF_GDEC);
    const int tid = otid(), lane = tid & 63, wid = tid >> 6;
    const int t = tid >> 3, d8 = (tid & 7) * 8, v16 = (tid & 7) * 16;
    const uint4 kraw = *(const uint4*)(PQ + (size_t)(m0 + t) * 1792 + 256 + h * 64 + d8);
    const uint4 vr0 = *(const uint4*)(PQ + (size_t)(m0 + t) * 1792 + 512 + h * 128 + v16), vr1 = *(const uint4*)(PQ + (size_t)(m0 + t) * 1792 + 512 + h * 128 + v16 + 8);
    gla_gates(P, PQ, m0, h, lds);
    LAS float* G = (LAS float*)(lds + 17408);
    LAS bf16_t* kA = (LAS bf16_t*)(lds + 50176);
    LAS bf16_t* Vs = (LAS bf16_t*)(lds + 67584);
    { const unsigned rw[4] = {kraw.x, kraw.y, kraw.z, kraw.w}; float ef[8], eb[8];
#pragma unroll
        for (int q = 0; q < 2; ++q) { const f32x4 lf = *(const LAS f32x4*)(G + 63 * 64 + d8 + q * 4), cf = *(const LAS f32x4*)(G + t * 64 + d8 + q * 4);
            const f32x4 lb = *(const LAS f32x4*)(G + 64 * 64 + d8 + q * 4), cb = *(const LAS f32x4*)(G + (64 + t) * 64 + d8 + q * 4);
#pragma unroll
            for (int j = 0; j < 4; ++j) { ef[q * 4 + j] = __expf(lf[j] - cf[j]); eb[q * 4 + j] = __expf(lb[j] - cb[j]); } }
        unsigned of[4], ob[4];
#pragma unroll
        for (int i = 0; i < 4; ++i) { const float k0 = bflo(rw[i]), k1 = bfhi(rw[i]); of[i] = pack2(k0 * ef[2 * i], k1 * ef[2 * i + 1]); ob[i] = pack2(k0 * eb[2 * i], k1 * eb[2 * i + 1]); }
        *(LAS u32x4*)(kA + t * 136 + d8) = mk4(of[0], of[1], of[2], of[3]); *(LAS u32x4*)(kA + t * 136 + 64 + d8) = mk4(ob[0], ob[1], ob[2], ob[3]);
        *(LAS u32x4*)(Vs + t * 136 + v16) = mk4(vr0.x, vr0.y, vr0.z, vr0.w); *(LAS u32x4*)(Vs + t * 136 + v16 + 8) = mk4(vr1.x, vr1.y, vr1.z, vr1.w); }
    if (tid < 128) { const int dir = tid >> 6, d = tid & 63; const float last = dir == 0 ? G[63 * 64 + d] : G[64 * 64 + d];
        GDEC[((size_t)(((b * 4 + h) * 2 + dir) * 128 + c)) * 64 + d] = __expf(last); }
    lds_barrier();
    { f32x4 acc[8];
#pragma unroll
        for (int nt = 0; nt < 8; ++nt) acc[nt] = (f32x4){0.f, 0.f, 0.f, 0.f};
#pragma unroll
        for (int ks = 0; ks < 2; ++ks) { const bf16x8 af = frag_tr(kA + ks * 32 * 136 + wid * 16, 136, lane);
#pragma unroll
            for (int nt = 0; nt < 8; ++nt) { const bf16x8 bfr = frag_tr(Vs + ks * 32 * 136 + nt * 16, 136, lane); acc[nt] = __builtin_amdgcn_mfma_f32_16x16x32_bf16(bfr, af, acc[nt], 0, 0, 0); } }
        const int row = wid * 16 + (lane & 15), dir = row >> 6, d = row & 63; bf16_t* out = GST + ((size_t)(((b * 4 + h) * 2 + dir) * 128 + c)) * 8192 + d * 128 + 4 * (lane >> 4);
#pragma unroll
        for (int nt = 0; nt < 8; ++nt) { uint2 w; w.x = pack2(acc[nt][0], acc[nt][1]); w.y = pack2(acc[nt][2], acc[nt][3]); *(uint2*)(out + nt * 16) = w; } }
    lds_barrier();
}

__device__ void phase_gla_b(CP P) {
    bf16_t* GST = (bf16_t*)(P->ws + OFF_GST); const float* GDEC = (const float*)(P->ws + OFF_GDEC);
    for (int idx = obid() * NTHR + otid(); idx < 64 * 1024; idx += gridDim.x * NTHR) {
        const int bhd = idx >> 10, e = (idx & 1023) * 8, d = e >> 7, dir = bhd & 1;
        f32x4 S0 = (f32x4){0.f, 0.f, 0.f, 0.f}, S1 = S0;
#pragma unroll 8
        for (int cc = 0; cc < 128; ++cc) { const int c = dir == 0 ? cc : 127 - cc; bf16_t* p = GST + ((size_t)(bhd * 128 + c)) * 8192 + e;
            const uint4 t = *(const uint4*)p; const float dec = GDEC[((size_t)(bhd * 128 + c)) * 64 + d];
            uint4 o; o.x = pack2(S0[0], S0[1]); o.y = pack2(S0[2], S0[3]); o.z = pack2(S1[0], S1[1]); o.w = pack2(S1[2], S1[3]); *(uint4*)p = o;
            S0 = dec * S0 + (f32x4){bflo(t.x), bfhi(t.x), bflo(t.y), bfhi(t.y)}; S1 = dec * S1 + (f32x4){bflo(t.z), bfhi(t.z), bflo(t.w), bfhi(t.w)}; }
    }
}

__device__ void gla_c_unit(CP P, int unit, LAS unsigned char* lds) {
    const int c = unit & 127, h = (unit >> 7) & 3, b = unit >> 9, m0 = b * 8192 + c * 64;
    const bf16_t* PQ = (const bf16_t*)(P->ws + OFF_PQ); const bf16_t* GST = (const bf16_t*)(P->ws + OFF_GST); bf16_t* MIX = (bf16_t*)(P->ws + OFF_XN);
    const int tid = otid(), lane = tid & 63, wid = tid >> 6;
    const int t = tid >> 3, d8 = (tid & 7) * 8, v16 = (tid & 7) * 16;
    const uint4 rq = *(const uint4*)(PQ + (size_t)(m0 + t) * 1792 + h * 64 + d8), rk = *(const uint4*)(PQ + (size_t)(m0 + t) * 1792 + 256 + h * 64 + d8);
    const uint4 vr0 = *(const uint4*)(PQ + (size_t)(m0 + t) * 1792 + 512 + h * 128 + v16), vr1 = *(const uint4*)(PQ + (size_t)(m0 + t) * 1792 + 512 + h * 128 + v16 + 8);
    const uint4 ogr0 = *(const uint4*)(PQ + (size_t)(m0 + t) * 1792 + 1024 + h * 128 + v16), ogr1 = *(const uint4*)(PQ + (size_t)(m0 + t) * 1792 + 1024 + h * 128 + v16 + 8);
    uint4 sr[4];
#pragma unroll
    for (int i = 0; i < 4; ++i) { const int idx = tid + i * NTHR, v8 = (idx & 15) * 8, d = (idx >> 4) & 63, dir = idx >> 10;
        sr[i] = *(const uint4*)(GST + ((size_t)(((b * 4 + h) * 2 + dir) * 128 + c)) * 8192 + d * 128 + v8); }
    gla_gates(P, PQ, m0, h, lds);
    LAS float* G = (LAS float*)(lds + 17408);
    LAS bf16_t* Ps = (LAS bf16_t*)lds;
    LAS bf16_t* qf = (LAS bf16_t*)(lds + 51200);
    LAS bf16_t* kf = qf + 64 * 72; LAS bf16_t* qb = kf + 64 * 72; LAS bf16_t* kb = qb + 64 * 72;
    LAS bf16_t* Vs = (LAS bf16_t*)(lds + 88064);
    LAS bf16_t* Ss = (LAS bf16_t*)(lds + 105472);
    { const unsigned qw[4] = {rq.x, rq.y, rq.z, rq.w}, kw[4] = {rk.x, rk.y, rk.z, rk.w};
        unsigned oqf[4], okf[4], oqb[4], okb[4]; float cf[8], cb[8];
#pragma unroll
        for (int q = 0; q < 2; ++q) { const f32x4 a = *(const LAS f32x4*)(G + t * 64 + d8 + q * 4), bb = *(const LAS f32x4*)(G + (64 + t) * 64 + d8 + q * 4);
#pragma unroll
            for (int j = 0; j < 4; ++j) { cf[q * 4 + j] = a[j]; cb[q * 4 + j] = bb[j]; } }
#pragma unroll
        for (int i = 0; i < 4; ++i) { const float cf0 = cf[2 * i], cf1 = cf[2 * i + 1], cb0 = cb[2 * i], cb1 = cb[2 * i + 1];
            const float q0 = bflo(qw[i]) * 0.125f, q1 = bfhi(qw[i]) * 0.125f, k0 = bflo(kw[i]), k1 = bfhi(kw[i]);
            oqf[i] = pack2(q0 * __expf(cf0), q1 * __expf(cf1)); okf[i] = pack2(k0 * __expf(-cf0), k1 * __expf(-cf1));
            oqb[i] = pack2(q0 * __expf(cb0), q1 * __expf(cb1)); okb[i] = pack2(k0 * __expf(-cb0), k1 * __expf(-cb1)); }
        *(LAS u32x4*)(qf + t * 72 + d8) = mk4(oqf[0], oqf[1], oqf[2], oqf[3]); *(LAS u32x4*)(kf + t * 72 + d8) = mk4(okf[0], okf[1], okf[2], okf[3]);
        *(LAS u32x4*)(qb + t * 72 + d8) = mk4(oqb[0], oqb[1], oqb[2], oqb[3]); *(LAS u32x4*)(kb + t * 72 + d8) = mk4(okb[0], okb[1], okb[2], okb[3]);
        *(LAS u32x4*)(Vs + t * 136 + v16) = mk4(vr0.x, vr0.y, vr0.z, vr0.w); *(LAS u32x4*)(Vs + t * 136 + v16 + 8) = mk4(vr1.x, vr1.y, vr1.z, vr1.w); }
#pragma unroll
    for (int i = 0; i < 4; ++i) { const int idx = tid + i * NTHR, v8 = (idx & 15) * 8, d = (idx >> 4) & 63, dir = idx >> 10;
        *(LAS u32x4*)(Ss + (dir * 64 + d) * 136 + v8) = mk4(sr[i].x, sr[i].y, sr[i].z, sr[i].w); }
    lds_barrier();
#pragma unroll
    for (int tl = 0; tl < 2; ++tl) { const int tile = wid * 2 + tl, mi = tile >> 2, ni = tile & 3; f32x4 pf = (f32x4){0.f, 0.f, 0.f, 0.f}, pb = pf;
        pf = mma16(qf + mi * 16 * 72, 72, kf + ni * 16 * 72, 72, 64, pf, lane); pb = mma16(qb + mi * 16 * 72, 72, kb + ni * 16 * 72, 72, 64, pb, lane);
        const int i = mi * 16 + (lane & 15), j0 = ni * 16 + 4 * (lane >> 4); float pv[4];
#pragma unroll
        for (int jj = 0; jj < 4; ++jj) pv[jj] = (j0 + jj <= i) ? pf[jj] : pb[jj];
        *(LAS u32x2*)(Ps + i * 72 + j0) = mk2(pack2(pv[0], pv[1]), pack2(pv[2], pv[3])); }
    lds_barrier();
    { const int mi = wid & 3, nb = (wid >> 2) * 4; LAS float* ost = G; f32x4 acc[4];
#pragma unroll
        for (int nt = 0; nt < 4; ++nt) acc[nt] = (f32x4){0.f, 0.f, 0.f, 0.f};
#pragma unroll
        for (int ks = 0; ks < 2; ++ks) {
            const bf16x8 ap = *(const LAS bf16x8*)(Ps + (mi * 16 + (lane & 15)) * 72 + ks * 32 + (lane >> 4) * 8);
            const bf16x8 af = *(const LAS bf16x8*)(qf + (mi * 16 + (lane & 15)) * 72 + ks * 32 + (lane >> 4) * 8);
            const bf16x8 ab = *(const LAS bf16x8*)(qb + (mi * 16 + (lane & 15)) * 72 + ks * 32 + (lane >> 4) * 8);
#pragma unroll
            for (int nt = 0; nt < 4; ++nt) { const int ni = nb + nt;
                acc[nt] = __builtin_amdgcn_mfma_f32_16x16x32_bf16(frag_tr(Vs + ks * 32 * 136 + ni * 16, 136, lane), ap, acc[nt], 0, 0, 0);
                acc[nt] = __builtin_amdgcn_mfma_f32_16x16x32_bf16(frag_tr(Ss + ks * 32 * 136 + ni * 16, 136, lane), af, acc[nt], 0, 0, 0);
                acc[nt] = __builtin_amdgcn_mfma_f32_16x16x32_bf16(frag_tr(Ss + (64 + ks * 32) * 136 + ni * 16, 136, lane), ab, acc[nt], 0, 0, 0); } }
#pragma unroll
        for (int nt = 0; nt < 4; ++nt) *(LAS f32x4*)(ost + (mi * 16 + (lane & 15)) * 132 + (nb + nt) * 16 + 4 * (lane >> 4)) = acc[nt]; }
    lds_barrier();
    { LAS float* ost = G; float o[16]; float ss = 0.f;
#pragma unroll
        for (int i = 0; i < 4; ++i) { const f32x4 v = *(const LAS f32x4*)(ost + t * 132 + v16 + i * 4); o[4 * i] = v[0]; o[4 * i + 1] = v[1]; o[4 * i + 2] = v[2]; o[4 * i + 3] = v[3]; ss += v[0] * v[0] + v[1] * v[1] + v[2] * v[2] + v[3] * v[3]; }
        ss += __shfl_xor(ss, 1); ss += __shfl_xor(ss, 2); ss += __shfl_xor(ss, 4);
        const float rstd = rsqrtf(ss * (1.0f / 128.0f) + 1e-6f);
        const float* gn = P->in[20] + h * 128 + v16;
        bf16_t* op = MIX + (size_t)(m0 + t) * 1024 + 512 + h * 128 + v16;
#pragma unroll
        for (int hh = 0; hh < 2; ++hh) { const uint4 raw = hh ? ogr1 : ogr0; const unsigned rw[4] = {raw.x, raw.y, raw.z, raw.w}; unsigned ow[4];
#pragma unroll
            for (int i = 0; i < 4; ++i) { const int e = hh * 8 + 2 * i; const float g0 = bflo(rw[i]), g1 = bfhi(rw[i]);
                ow[i] = pack2(o[e] * rstd * gn[e] * silu_f(g0), o[e + 1] * rstd * gn[e + 1] * silu_f(g1)); }
            *(uint4*)(op + hh * 8) = make_uint4(ow[0], ow[1], ow[2], ow[3]); } }
    lds_barrier();
}

__device__ __forceinline__ float ret_lg(int h) {
    float v = -0.0317486983145803f;
    v = h == 1 ? -0.015748356968139168f : v; v = h == 2 ? -0.007843177461025893f : v; v = h == 3 ? -0.003913899321136329f : v; v = h == 4 ? -0.0019550348358033506f : v;
    v = h == 5 ? -0.0009770396478266127f : v; v = h == 6 ? -0.0004884004981088745f : v; v = h == 7 ? -0.0002441704321739145f : v; return v;
}

struct KRaw { uint4 a, b; f32x4 c0, c1, s0, s1; };
__device__ __forceinline__ KRaw rot_load(const bf16_t* rowp, const float* cs, const float* sn, int dq) {
    KRaw k; k.a = *(const uint4*)(rowp + dq); k.b = *(const uint4*)(rowp + 64 + dq);
    k.c0 = *(const f32x4*)(cs + dq); k.c1 = *(const f32x4*)(cs + dq + 4); k.s0 = *(const f32x4*)(sn + dq); k.s1 = *(const f32x4*)(sn + dq + 4); return k;
}
__device__ __forceinline__ void rot_apply(const KRaw& k, float (&r1)[8], float (&r2)[8]) {
    const unsigned aw[4] = {k.a.x, k.a.y, k.a.z, k.a.w}, bw[4] = {k.b.x, k.b.y, k.b.z, k.b.w};
#pragma unroll
    for (int i = 0; i < 8; ++i) { const float t1 = (i & 1) ? bfhi(aw[i >> 1]) : bflo(aw[i >> 1]), t2 = (i & 1) ? bfhi(bw[i >> 1]) : bflo(bw[i >> 1]);
        const float cv = i < 4 ? k.c0[i & 3] : k.c1[i & 3], sv = i < 4 ? k.s0[i & 3] : k.s1[i & 3]; r1[i] = t1 * cv - t2 * sv; r2[i] = t1 * sv + t2 * cv; }
}
__device__ __forceinline__ void load_rot(const bf16_t* rowp, const float* cs, const float* sn, int dq, float (&r1)[8], float (&r2)[8]) { const KRaw k = rot_load(rowp, cs, sn, dq); rot_apply(k, r1, r2); }

__device__ void ret_a_unit(CP P, int hf, int unit, LAS unsigned char* lds) {
    const int vh = (unit >> 3) & 1, ur = (unit & 7) | ((unit >> 4) << 3), sc = ur & 31, h = (ur >> 5) & 7, bl = ur >> 8;
    const bf16_t* PR = (const bf16_t*)(P->ws + OFF_PROJ1); bf16_t* RST = (bf16_t*)(P->ws + OFF_RST);
    const float* cs = (const float*)(P->ws + OFF_ROPE); const float* sn = cs + 8192 * 64;
    const int tid = otid(), lane = tid & 63, wid = tid >> 6;
    const size_t r0 = (size_t)bl * 8192 + sc * 256;
    const float lgf = ret_lg(h), lgb = ret_lg(7 - h);
    LAS bf16_t* kf = (LAS bf16_t*)lds;
    LAS bf16_t* kb = (LAS bf16_t*)(lds + 17408);
    LAS bf16_t* Vs = (LAS bf16_t*)(lds + 34816);
    f32x4 acc[4][4];
#pragma unroll
    for (int a = 0; a < 4; ++a)
#pragma unroll
        for (int n = 0; n < 4; ++n) acc[a][n] = (f32x4){0.f, 0.f, 0.f, 0.f};
    const int mb = (wid >> 1) * 4, nb = (wid & 1) * 4;
    const LAS bf16_t* kA = (mb >= 8) ? kb : kf; const int dt0 = (mb & 7) * 16;
    const int pj = tid >> 3, pdq = (tid & 7) * 8, pv16 = (tid & 7) * 16;
    const bf16_t* kbase = PR + (r0 + pj) * 6144 + 1024 + h * 128; const bf16_t* vbase = PR + (r0 + pj) * 6144 + 2048 + h * 256 + vh * 128 + pv16;
    KRaw kr = rot_load(kbase, cs + (sc * 256 + pj) * 64, sn + (sc * 256 + pj) * 64, pdq);
    uint4 vr0 = *(const uint4*)(vbase), vr1 = *(const uint4*)(vbase + 8);
    for (int jb = 0; jb < 4; ++jb) {
        { const int j = pj, dq = pdq, J = jb * 64 + j; float r1[8], r2[8];
            rot_apply(kr, r1, r2);
            const float sf = 0.08838834764831845f * __expf((float)(255 - J) * lgf), sb = 0.08838834764831845f * __expf((float)J * lgb);
            *(LAS u32x4*)(kf + j * 136 + dq) = mk4(pack2(r1[0] * sf, r1[1] * sf), pack2(r1[2] * sf, r1[3] * sf), pack2(r1[4] * sf, r1[5] * sf), pack2(r1[6] * sf, r1[7] * sf));
            *(LAS u32x4*)(kf + j * 136 + 64 + dq) = mk4(pack2(r2[0] * sf, r2[1] * sf), pack2(r2[2] * sf, r2[3] * sf), pack2(r2[4] * sf, r2[5] * sf), pack2(r2[6] * sf, r2[7] * sf));
            *(LAS u32x4*)(kb + j * 136 + dq) = mk4(pack2(r1[0] * sb, r1[1] * sb), pack2(r1[2] * sb, r1[3] * sb), pack2(r1[4] * sb, r1[5] * sb), pack2(r1[6] * sb, r1[7] * sb));
            *(LAS u32x4*)(kb + j * 136 + 64 + dq) = mk4(pack2(r2[0] * sb, r2[1] * sb), pack2(r2[2] * sb, r2[3] * sb), pack2(r2[4] * sb, r2[5] * sb), pack2(r2[6] * sb, r2[7] * sb));
            *(LAS u32x4*)(Vs + j * 136 + pv16) = mk4(vr0.x, vr0.y, vr0.z, vr0.w); *(LAS u32x4*)(Vs + j * 136 + pv16 + 8) = mk4(vr1.x, vr1.y, vr1.z, vr1.w); }
        lds_barrier();
        if (jb < 3) { const int J = (jb + 1) * 64 + pj; kr = rot_load(kbase + (size_t)(jb + 1) * 64 * 6144, cs + (sc * 256 + J) * 64, sn + (sc * 256 + J) * 64, pdq);
            vr0 = *(const uint4*)(vbase + (size_t)(jb + 1) * 64 * 6144); vr1 = *(const uint4*)(vbase + (size_t)(jb + 1) * 64 * 6144 + 8); }
#pragma unroll
        for (int ks = 0; ks < 2; ++ks) { bf16x8 af[4], bfr[4];
#pragma unroll
            for (int a = 0; a < 4; ++a) af[a] = frag_tr(kA + ks * 32 * 136 + dt0 + a * 16, 136, lane);
#pragma unroll
            for (int n = 0; n < 4; ++n) bfr[n] = frag_tr(Vs + ks * 32 * 136 + (nb + n) * 16, 136, lane);
#pragma unroll
            for (int a = 0; a < 4; ++a)
#pragma unroll
                for (int n = 0; n < 4; ++n) acc[a][n] = __builtin_amdgcn_mfma_f32_16x16x32_bf16(bfr[n], af[a], acc[a][n], 0, 0, 0); }
        lds_barrier();
    }
#pragma unroll
    for (int a = 0; a < 4; ++a) { const int row = (mb + a) * 16 + (lane & 15), dir = row >> 7, d = row & 127;
        bf16_t* out = RST + ((size_t)(((bl * 8 + h) * 2 + dir) * 32 + sc)) * 32768 + d * 256 + vh * 128 + 4 * (lane >> 4);
#pragma unroll
        for (int n = 0; n < 4; ++n) { uint2 w; w.x = pack2(acc[a][n][0], acc[a][n][1]); w.y = pack2(acc[a][n][2], acc[a][n][3]); *(uint2*)(out + (nb + n) * 16) = w; } }
}

__device__ void phase_ret_b(CP P) {
    bf16_t* RST = (bf16_t*)(P->ws + OFF_RST);
    for (int idx = obid() * NTHR + otid(); idx < 64 * 4096; idx += gridDim.x * NTHR) {
        const int bhd = idx >> 12, e = (idx & 4095) * 8, dir = bhd & 1, h = (bhd >> 1) & 7;
        const float dec = __expf(256.0f * ret_lg(dir == 0 ? h : 7 - h));
        f32x4 S0 = (f32x4){0.f, 0.f, 0.f, 0.f}, S1 = S0;
#pragma unroll 8
        for (int cc = 0; cc < 32; ++cc) { const int c = dir == 0 ? cc : 31 - cc; bf16_t* p = RST + ((size_t)(bhd * 32 + c)) * 32768 + e;
            const uint4 t = *(const uint4*)p; uint4 o; o.x = pack2(S0[0], S0[1]); o.y = pack2(S0[2], S0[3]); o.z = pack2(S1[0], S1[1]); o.w = pack2(S1[2], S1[3]); *(uint4*)p = o;
            S0 = dec * S0 + (f32x4){bflo(t.x), bfhi(t.x), bflo(t.y), bfhi(t.y)}; S1 = dec * S1 + (f32x4){bflo(t.z), bfhi(t.z), bflo(t.w), bfhi(t.w)}; }
    }
}

__device__ void ret_c_unit(CP P, int hf, int unit, LAS unsigned char* lds) {
    const int rh = (unit >> 3) & 1, ur = (unit & 7) | ((unit >> 4) << 3), sc = ur & 31, h = (ur >> 5) & 7, bl = ur >> 8;
    const bf16_t* PR = (const bf16_t*)(P->ws + OFF_PROJ1); const bf16_t* RST = (const bf16_t*)(P->ws + OFF_RST);
    const float* cs = (const float*)(P->ws + OFF_ROPE); const float* sn = cs + 8192 * 64;
    const int tid = otid(), lane = tid & 63, wid = tid >> 6;
    const size_t r0 = (size_t)bl * 8192 + sc * 256;
    const float lgf = ret_lg(h), lgb = ret_lg(7 - h);
    LAS bf16_t* qs = (LAS bf16_t*)lds;
    LAS bf16_t* ks = (LAS bf16_t*)(lds + 34816);
    LAS bf16_t* Ps = (LAS bf16_t*)(lds + 52224);
    LAS bf16_t* Vs = (LAS bf16_t*)(lds + 70656);
    LAS float* red = (LAS float*)(lds + 104448);
    LAS bf16_t* qx = ks;
#pragma unroll
    for (int rep = 0; rep < 2; ++rep) { const int i = (tid >> 3) + rep * 64, dq = (tid & 7) * 8, I = rh * 128 + i, pos = sc * 256 + I; float r1[8], r2[8];
        load_rot(PR + (r0 + I) * 6144 + h * 128, cs + pos * 64, sn + pos * 64, dq, r1, r2);
        *(LAS u32x4*)(qs + i * 136 + dq) = mk4(pack2(r1[0], r1[1]), pack2(r1[2], r1[3]), pack2(r1[4], r1[5]), pack2(r1[6], r1[7]));
        *(LAS u32x4*)(qs + i * 136 + 64 + dq) = mk4(pack2(r2[0], r2[1]), pack2(r2[2], r2[3]), pack2(r2[4], r2[5]), pack2(r2[6], r2[7])); }
    f32x4 acc[2][8];
#pragma unroll
    for (int r = 0; r < 2; ++r)
#pragma unroll
        for (int n = 0; n < 8; ++n) acc[r][n] = (f32x4){0.f, 0.f, 0.f, 0.f};
    const int mi2 = (wid & 3) * 2, nb = (wid >> 2) * 8;
    const int pj = tid >> 3, pdq = (tid & 7) * 8, pv32 = (tid & 7) * 32;
    const bf16_t* kbase = PR + (r0 + pj) * 6144 + 1024 + h * 128; const bf16_t* vbase = PR + (r0 + pj) * 6144 + 2048 + h * 256 + pv32;
    KRaw kr = rot_load(kbase, cs + (sc * 256 + pj) * 64, sn + (sc * 256 + pj) * 64, pdq);
    uint4 vr[4];
#pragma unroll
    for (int hh = 0; hh < 4; ++hh) vr[hh] = *(const uint4*)(vbase + hh * 8);
    uint4 st[4];
    const bf16_t* sbase = RST + ((size_t)((bl * 8 + h) * 2) * 32 + sc) * 32768;
    for (int kb = 0; kb < 4; ++kb) {
        { const int j = pj, dq = pdq; float r1[8], r2[8];
            rot_apply(kr, r1, r2);
            const float s = 0.08838834764831845f;
            *(LAS u32x4*)(ks + j * 136 + dq) = mk4(pack2(r1[0] * s, r1[1] * s), pack2(r1[2] * s, r1[3] * s), pack2(r1[4] * s, r1[5] * s), pack2(r1[6] * s, r1[7] * s));
            *(LAS u32x4*)(ks + j * 136 + 64 + dq) = mk4(pack2(r2[0] * s, r2[1] * s), pack2(r2[2] * s, r2[3] * s), pack2(r2[4] * s, r2[5] * s), pack2(r2[6] * s, r2[7] * s));
#pragma unroll
            for (int hh = 0; hh < 4; ++hh) *(LAS u32x4*)(Vs + j * 264 + pv32 + hh * 8) = mk4(vr[hh].x, vr[hh].y, vr[hh].z, vr[hh].w); }
        lds_barrier();
        if (kb < 3) { const int J = (kb + 1) * 64 + pj; kr = rot_load(kbase + (size_t)(kb + 1) * 64 * 6144, cs + (sc * 256 + J) * 64, sn + (sc * 256 + J) * 64, pdq);
#pragma unroll
            for (int hh = 0; hh < 4; ++hh) vr[hh] = *(const uint4*)(vbase + (size_t)(kb + 1) * 64 * 6144 + hh * 8); }
        else {
#pragma unroll
            for (int i = 0; i < 4; ++i) { const int idx = tid + i * NTHR, v8 = (idx & 31) * 8, dd = idx >> 5; st[i] = *(const uint4*)(sbase + dd * 256 + v8); } }
#pragma unroll
        for (int tr = 0; tr < 2; ++tr)
#pragma unroll
            for (int tc = 0; tc < 2; ++tc) { const int ti = mi2 + tr, tj = (wid >> 2) * 2 + tc; f32x4 s = (f32x4){0.f, 0.f, 0.f, 0.f};
                s = mma16(qs + ti * 16 * 136, 136, ks + tj * 16 * 136, 136, 128, s, lane);
                const int i = ti * 16 + (lane & 15), j0 = tj * 16 + 4 * (lane >> 4), I = rh * 128 + i; float pv[4];
#pragma unroll
                for (int jj = 0; jj < 4; ++jj) { const int df = I - (kb * 64 + j0 + jj); const float dm = df >= 0 ? __expf((float)df * lgf) : __expf((float)(-df) * lgb); pv[jj] = s[jj] * dm; }
                *(LAS u32x2*)(Ps + i * 72 + j0) = mk2(pack2(pv[0], pv[1]), pack2(pv[2], pv[3])); }
        lds_barrier();
#pragma unroll
        for (int k2 = 0; k2 < 2; ++k2) { bf16x8 af[2], bfr[8];
#pragma unroll
            for (int r = 0; r < 2; ++r) af[r] = *(const LAS bf16x8*)(Ps + ((mi2 + r) * 16 + (lane & 15)) * 72 + k2 * 32 + (lane >> 4) * 8);
#pragma unroll
            for (int n = 0; n < 8; ++n) bfr[n] = frag_tr(Vs + k2 * 32 * 264 + (nb + n) * 16, 264, lane);
#pragma unroll
            for (int r = 0; r < 2; ++r)
#pragma unroll
                for (int n = 0; n < 8; ++n) acc[r][n] = __builtin_amdgcn_mfma_f32_16x16x32_bf16(bfr[n], af[r], acc[r][n], 0, 0, 0); }
        lds_barrier();
    }
    uint2 ogr[2][8];
#pragma unroll
    for (int r = 0; r < 2; ++r) { const bf16_t* ogp = PR + (r0 + rh * 128 + (mi2 + r) * 16 + (lane & 15)) * 6144 + 4096 + h * 256 + 4 * (lane >> 4);
#pragma unroll
        for (int n = 0; n < 8; ++n) ogr[r][n] = *(const uint2*)(ogp + (nb + n) * 16); }
    for (int sl = 0; sl < 4; ++sl) { const int dir = sl >> 1, dh = sl & 1;
        if (dh == 0) { const int i = tid >> 2, c32 = (tid & 3) * 32, I = rh * 128 + i; const float xs = dir == 0 ? __expf((float)(I + 1) * lgf) : __expf((float)(256 - I) * lgb);
#pragma unroll
            for (int hh = 0; hh < 4; ++hh) { const u32x4 w = *(const LAS u32x4*)(qs + i * 136 + c32 + hh * 8);
                *(LAS u32x4*)(qx + i * 136 + c32 + hh * 8) = mk4(pack2(bflo(w[0]) * xs, bfhi(w[0]) * xs), pack2(bflo(w[1]) * xs, bfhi(w[1]) * xs), pack2(bflo(w[2]) * xs, bfhi(w[2]) * xs), pack2(bflo(w[3]) * xs, bfhi(w[3]) * xs)); } }
#pragma unroll
        for (int i = 0; i < 4; ++i) { const int idx = tid + i * NTHR, v8 = (idx & 31) * 8, dd = idx >> 5; *(LAS u32x4*)(Vs + dd * 264 + v8) = mk4(st[i].x, st[i].y, st[i].z, st[i].w); }
        lds_barrier();
        if (sl < 3) { const int nd = (sl + 1) >> 1, nh = (sl + 1) & 1; const bf16_t* sp = sbase + (size_t)nd * 32 * 32768 + (size_t)nh * 64 * 256;
#pragma unroll
            for (int i = 0; i < 4; ++i) { const int idx = tid + i * NTHR, v8 = (idx & 31) * 8, dd = idx >> 5; st[i] = *(const uint4*)(sp + dd * 256 + v8); } }
#pragma unroll
        for (int k2 = 0; k2 < 2; ++k2) { bf16x8 af[2], bfr[8];
#pragma unroll
            for (int r = 0; r < 2; ++r) af[r] = *(const LAS bf16x8*)(qx + ((mi2 + r) * 16 + (lane & 15)) * 136 + dh * 64 + k2 * 32 + (lane >> 4) * 8);
#pragma unroll
            for (int n = 0; n < 8; ++n) bfr[n] = frag_tr(Vs + k2 * 32 * 264 + (nb + n) * 16, 264, lane);
#pragma unroll
            for (int r = 0; r < 2; ++r)
#pragma unroll
                for (int n = 0; n < 8; ++n) acc[r][n] = __builtin_amdgcn_mfma_f32_16x16x32_bf16(bfr[n], af[r], acc[r][n], 0, 0, 0); }
        lds_barrier();
    }
    { float ss[2];
#pragma unroll
        for (int r = 0; r < 2; ++r) { ss[r] = 0.f;
#pragma unroll
            for (int n = 0; n < 8; ++n) ss[r] += acc[r][n][0] * acc[r][n][0] + acc[r][n][1] * acc[r][n][1] + acc[r][n][2] * acc[r][n][2] + acc[r][n][3] * acc[r][n][3];
            ss[r] += __shfl_xor(ss[r], 16); ss[r] += __shfl_xor(ss[r], 32);
            if ((lane >> 4) == 0) red[((mi2 + r) * 16 + (lane & 15)) * 2 + (wid >> 2)] = ss[r]; }
        lds_barrier();
#pragma unroll
        for (int r = 0; r < 2; ++r) { const int i = (mi2 + r) * 16 + (lane & 15);
            const float rstd = rsqrtf((red[i * 2] + red[i * 2 + 1]) * (1.0f / 256.0f) + 1e-6f);
            const float* gn = P->in[23] + h * 256 + 4 * (lane >> 4);
            bf16_t* op = (bf16_t*)(P->ws + OFF_OBUF) + (r0 + rh * 128 + i) * 2048 + h * 256 + 4 * (lane >> 4);
#pragma unroll
            for (int n = 0; n < 8; ++n) { const int v = (nb + n) * 16; const uint2 og = ogr[r][n]; const f32x4 g4 = *(const f32x4*)(gn + v);
                uint2 w; w.x = pack2(acc[r][n][0] * rstd * g4[0] * silu_f(bflo(og.x)), acc[r][n][1] * rstd * g4[1] * silu_f(bfhi(og.x)));
                w.y = pack2(acc[r][n][2] * rstd * g4[2] * silu_f(bflo(og.y)), acc[r][n][3] * rstd * g4[3] * silu_f(bfhi(og.y)));
                *(uint2*)(op + v) = w; } } }
    lds_barrier();
}

__device__ __forceinline__ void grid_barrier(unsigned* cnt, unsigned target) {
    asm volatile("s_waitcnt vmcnt(0)" ::: "memory");
    __syncthreads();
    if (threadIdx.x == 0) {
        __builtin_amdgcn_fence(__ATOMIC_RELEASE, "agent");
        asm volatile("s_waitcnt vmcnt(0)" ::: "memory");
        (void)__hip_atomic_fetch_add(cnt, 1u, __ATOMIC_RELAXED, __HIP_MEMORY_SCOPE_AGENT);
        unsigned spins = 0;
        while (__hip_atomic_load(cnt, __ATOMIC_RELAXED, __HIP_MEMORY_SCOPE_AGENT) < target) { __builtin_amdgcn_s_sleep(2); if (++spins > (1u << 24)) break; }
        __builtin_amdgcn_fence(__ATOMIC_ACQUIRE, "agent");
        asm volatile("s_waitcnt vmcnt(0)" ::: "memory");
    }
    __syncthreads();
}

__global__ void __launch_bounds__(NTHR, 2) mega(Params Pval, int ph0, int ph1) {
    extern __shared__ __attribute__((aligned(16))) unsigned char lds_raw[];
    LAS unsigned char* lds = (LAS unsigned char*)lds_raw;
    unsigned nbar = 0;
    for (int ph = ph0; ph < ph1; ++ph) {
        CP P = (CP)__builtin_amdgcn_kernarg_segment_ptr(); asm volatile("" : "+s"(P));
        unsigned char* ws = P->ws;
        bf16_t* XN = (bf16_t*)(ws + OFF_XN); bf16_t* ACT = (bf16_t*)(ws + OFF_ACT); float* X = P->out;
        if (ph == 1 || ph == 4 || ph == 11 || ph == 14 || ph == 17 || ph == 28) continue;
        const int reps = (((unsigned long long)(PROBE_MASK) >> ph) & 1ull) ? 2 : 1;
        for (int rep = 0; rep < reps; ++rep) {
        float* SSQ = (float*)(ws + OFF_SSQ); bf16_t* XB2 = (bf16_t*)(ws + OFF_XB2);
        int ffn = -1, sub = 0;
        if (ph >= 2 && ph <= 3) { ffn = 0; sub = ph - 1; } else if (ph >= 12 && ph <= 13) { ffn = 1; sub = ph - 11; }
        else if (ph >= 15 && ph <= 16) { ffn = 2; sub = ph - 14; } else if (ph >= 29 && ph <= 30) { ffn = 3; sub = ph - 28; }
        if (ph == 0) { if (EN(0)) phase_prologue(P, lds); }
        else if (ffn >= 0) {
            const float* xin = (ffn == 0) ? P->in[0] : X;
            const float* ssin = SSQ + (size_t)(ffn == 0 ? 0 : ffn == 1 ? 2 : ffn == 2 ? 3 : 5) * SSN;
            if (sub == 1) { if (EN(2)) { if (ffn == 0) phase_kmat(P);
                pg8::Gemm g{ffn == 1 ? XB2 : XN, (const bf16_t*)(ws + OFF_W1 + (size_t)ffn * SZ_W1), 1024, 1024, 1024, 256, 22, 1, 0, 0}; EpiSwiGLU e{ACT, ssin}; pg8::gemm_phase(lds, g, e); } }
            else { if (EN(3)) { pg8::Gemm g{ACT, (const bf16_t*)(ws + OFF_W2 + (size_t)ffn * SZ_W2), 2816, 2816, 2816, 256, 4, 1, 0, 0};
                float* ssout = SSQ + (size_t)(ffn == 0 ? 1 : ffn == 1 ? 3 : 4) * SSN;
                if (ffn == 3) { EpiResid<false> e{xin, X, nullptr, nullptr, 0.5f}; pg8::gemm_phase(lds, g, e); }
                else { EpiResid<true> e{xin, X, XN, ssout, 0.5f}; pg8::gemm_phase(lds, g, e); } } }
        }
        else if (ph == 5) { if (EN(4)) { pg8::Gemm g{XN, (const bf16_t*)(ws + OFF_WIN0), 1024, 1024, 1024, 256, 9, 1, 0, 0}; EpiWin0 e{(bf16_t*)(ws + OFF_AS5), (bf16_t*)(ws + OFF_PQ), SSQ + SSN}; pg8::gemm_phase(lds, g, e); } }
        else if (ph == 6) { if (EN(5)) {
            if (EN(16)) { pg8::Gemm g{(const bf16_t*)(ws + OFF_AS5), (const bf16_t*)(ws + OFF_H), 1280, 1024, 1024, 4, 1, 32, (size_t)1024 * 1280, (size_t)256 * 1024}; EpiS5E e{(float*)(ws + OFF_E)}; pg8::gemm_phase(lds, g, e); }
            __syncthreads();
            if (EN(17)) for (int u = obid(); u < 4096; u += gridDim.x) gla_a_unit(P, u, lds);
        } }
        else if (ph == 7) { if (EN(6)) { phase_s5_scan(P); phase_gla_b(P); } }
        else if (ph == 8) { if (EN(7)) {
            if (EN(18)) { pg8::Gemm g{(const bf16_t*)(ws + OFF_AS5), (const bf16_t*)(ws + OFF_KG), 1280, 1280, 1280, 4, 4, 32, (size_t)1024 * 1280, (size_t)1024 * 1280}; EpiS5Y e{(bf16_t*)(ws + OFF_GY)}; pg8::gemm_phase(lds, g, e); }
            __syncthreads();
            if (EN(19)) for (int u = obid(); u < 4096; u += gridDim.x) gla_c_unit(P, u, lds);
        } }
        else if (ph == 9) { if (EN(8)) { pg8::Gemm g{(const bf16_t*)(ws + OFF_GY), (const bf16_t*)(ws + OFF_WGLU), 512, 512, 512, 256, 2, 1, 0, 0}; EpiGLU e{(const bf16_t*)(ws + OFF_GY), XN}; pg8::gemm_phase(lds, g, e); } }
        else if (ph == 10) { if (EN(9)) { pg8::Gemm g{XN, (const bf16_t*)(ws + OFF_WOUT0), 1024, 1024, 1024, 256, 4, 1, 0, 0}; EpiResid<true> e{X, X, XB2, SSQ + 2 * SSN, 1.0f}; pg8::gemm_phase(lds, g, e); } }
        else if (ph >= 18 && ph <= 27) {
            const int hf = (ph - 18) / 5, s = (ph - 18) % 5;
            if (s == 0) { if (EN(10)) { pg8::Gemm g{XN + (size_t)hf * 32768 * 1024, (const bf16_t*)(ws + OFF_WIN1), 1024, 1024, 1024, 128, 24, 1, 0, 0}; EpiBf16 e{(bf16_t*)(ws + OFF_PROJ1), 6144, SSQ + 4 * SSN + (size_t)hf * 32768 * 16}; pg8::gemm_phase(lds, g, e); } }
            else if (s == 1) { if (EN(11)) for (int u = obid(); u < 2048; u += gridDim.x) ret_a_unit(P, hf, u, lds); }
            else if (s == 2) { if (EN(12)) phase_ret_b(P); }
            else if (s == 3) { if (EN(13)) for (int u = obid(); u < 2048; u += gridDim.x) ret_c_unit(P, hf, u, lds); }
            else { if (EN(14)) { pg8::Gemm g{(const bf16_t*)(ws + OFF_OBUF), (const bf16_t*)(ws + OFF_WOUT1), 2048, 2048, 2048, 128, 4, 1, 0, 0};
                float* Xh = X + (size_t)hf * 32768 * 1024; EpiResid<true> e{Xh, Xh, XN + (size_t)hf * 32768 * 1024, SSQ + 5 * SSN + (size_t)hf * 32768 * 16, 1.0f}; pg8::gemm_phase(lds, g, e); } }
        }
        else if (ph == 31) { if (EN(15)) phase_norm<true>(X, P->in[25], nullptr, nullptr, X, 0, (int)gridDim.x, 0, 65536); }
        if (rep + 1 < reps) __syncthreads();
        }
        if (ph + 1 < ph1) { if (ph == 0) cg::this_grid().sync();
            else { ++nbar; grid_barrier((unsigned*)(P->ws + OFF_BAR), nbar * gridDim.x); } }
    }
}

extern "C" void kernel_launch(void* const* d_in, const int* in_sizes, int n_in, void* d_out, int out_size, void* d_ws, size_t ws_size, hipStream_t stream) {
    static int inited = 0;
    if (!inited) { (void)hipFuncSetAttribute((const void*)mega, hipFuncAttributeMaxDynamicSharedMemorySize, LDS_BYTES); inited = 1; }
    Params p{};
    for (int i = 0; i < 26; ++i) p.in[i] = (const float*)d_in[i];
    p.out = (float*)d_out; p.ws = (unsigned char*)d_ws;
    if (ws_size < OFF_R + 770 * MiB) fprintf(stderr, "kernel_launch: workspace too small (%zu)\n", ws_size);
    const int grid = 256;
#if ONE_LAUNCH
    (void)hipMemsetAsync((unsigned char*)d_ws + OFF_BAR, 0, 256, stream);
    int ph0 = 0, ph1 = NPHASE; void* args[] = {&p, &ph0, &ph1};
    hipError_t e = hipLaunchCooperativeKernel((const void*)mega, dim3(grid), dim3(NTHR), args, LDS_BYTES, stream);
    if (e != hipSuccess) fprintf(stderr, "cooperative launch failed: %s\n", hipGetErrorString(e));
#else
    for (int ph = 0; ph < NPHASE; ++ph) hipLaunchKernelGGL(mega, dim3(grid), dim3(NTHR), LDS_BYTES, stream, p, ph, ph + 1);
#endif
}
```

```cpp
#include <hip/hip_runtime.h>
#include <hip/hip_cooperative_groups.h>
#include <cstdio>
#include <cstdint>
namespace cg = cooperative_groups;

#ifndef ONE_LAUNCH
#define ONE_LAUNCH 1
#endif

#ifndef PHASE_MASK
#define PHASE_MASK 0xffffffffffull
#endif
#define EN(n) (((PHASE_MASK) >> (n)) & 1ull)
#ifndef PROBE_MASK
#define PROBE_MASK 0ull
#endif
#define LAS __attribute__((address_space(3)))
typedef unsigned short bf16_t;
typedef short bf16x8 __attribute__((ext_vector_type(8)));
typedef float f32x4 __attribute__((ext_vector_type(4)));
typedef float f32x2 __attribute__((ext_vector_type(2)));
typedef unsigned u32x2 __attribute__((ext_vector_type(2)));
typedef unsigned u32x4 __attribute__((ext_vector_type(4)));
__device__ __forceinline__ u32x4 mk4(unsigned a, unsigned b, unsigned c, unsigned d) { return (u32x4){a, b, c, d}; }
__device__ __forceinline__ u32x2 mk2(unsigned a, unsigned b) { return (u32x2){a, b}; }
__device__ __forceinline__ f32x2 mkf2(float a, float b) { return (f32x2){a, b}; }

constexpr int NTHR = 512;
constexpr int LDS_BYTES = 147456;
constexpr int NPHASE = 32;

struct Params { const float* in[26]; float* out; unsigned char* ws; };
typedef const __attribute__((address_space(4))) Params* CP;

constexpr size_t MiB = 1ull << 20;
constexpr size_t OFF_W1 = 0, SZ_W1 = 11 * MiB;
constexpr size_t OFF_W2 = 44 * MiB, SZ_W2 = 5 * MiB + MiB / 2;
constexpr size_t OFF_WIN0 = 66 * MiB;
constexpr size_t OFF_WGLU = 70 * MiB + MiB / 2;
constexpr size_t OFF_WOUT0 = 71 * MiB;
constexpr size_t OFF_WIN1 = 73 * MiB;
constexpr size_t OFF_WOUT1 = 85 * MiB;
constexpr size_t OFF_ROPE = 89 * MiB;
constexpr size_t OFF_KTAB = 93 * MiB;
constexpr size_t OFF_S5P = 97 * MiB;
constexpr size_t OFF_XN = 98 * MiB;
constexpr size_t OFF_R = 226 * MiB;
constexpr size_t OFF_ACT = OFF_R;
constexpr size_t OFF_PQ = OFF_R;
constexpr size_t OFF_AS5 = OFF_R + 224 * MiB;
constexpr size_t OFF_E = OFF_R + 304 * MiB;
constexpr size_t OFF_KG = OFF_R + 352 * MiB;
constexpr size_t OFF_H = OFF_R + 432 * MiB;
constexpr size_t OFF_GST = OFF_R + 448 * MiB;
constexpr size_t OFF_GDEC = OFF_R + 704 * MiB;
constexpr size_t OFF_GY = OFF_R + 706 * MiB;
constexpr size_t OFF_PROJ1 = OFF_R;
constexpr size_t OFF_RST = OFF_R + 384 * MiB;
constexpr size_t OFF_SSQ = 998 * MiB;
constexpr int SSN = 65536 * 16;
constexpr size_t OFF_XB2 = OFF_R + 448 * MiB;
constexpr size_t OFF_BAR = 1023 * MiB;
constexpr size_t OFF_OBUF = OFF_R + 640 * MiB;

__device__ __forceinline__ int otid() { int t = threadIdx.x; asm volatile("" : "+v"(t)); return t; }
__device__ __forceinline__ int obid() { int t = blockIdx.x; asm volatile("" : "+s"(t)); return t; }
__device__ __forceinline__ bf16_t f2bf(float f) { unsigned u = __float_as_uint(f); u += 0x7FFFu + ((u >> 16) & 1u); return (bf16_t)(u >> 16); }
__device__ __forceinline__ float bf2f(unsigned b) { return __uint_as_float(b << 16); }
typedef __bf16 bf16x2_t __attribute__((ext_vector_type(2)));
typedef float f32x2_t __attribute__((ext_vector_type(2)));
__device__ __forceinline__ unsigned pack2(float lo, float hi) { const f32x2_t v = {lo, hi}; const bf16x2_t b = __builtin_convertvector(v, bf16x2_t); return __builtin_bit_cast(unsigned, b); }
__device__ __forceinline__ float bflo(unsigned w) { return __uint_as_float(w << 16); }
__device__ __forceinline__ float bfhi(unsigned w) { return __uint_as_float(w & 0xffff0000u); }
__device__ __forceinline__ float fast_sigmoid(float x) { return __builtin_amdgcn_rcpf(1.0f + __expf(-x)); }
__device__ __forceinline__ float silu_f(float x) { return x * fast_sigmoid(x); }
__device__ __forceinline__ float gelu_tanh(float x) { const float u = 0.7978845608028654f * (x + 0.044715f * x * x * x); return x * fast_sigmoid(2.0f * u); }

namespace pg8 {
constexpr int BM = 256, BK = 64, HALF = 128, HTB = HALF * BK * 2, STAGE_BYTES = 8 * HTB, NXCD = 8, WGM = 8;
__device__ __forceinline__ int lds_byte(int r, int c) { const int st = (r >> 4) * 2 + (c >> 5), rr = r & 15, cc = c & 31, ob = rr * 64 + cc * 2; return st * 1024 + (ob ^ (((ob >> 9) & 1) << 5)); }
__device__ __forceinline__ void stage_rc(int b, int& R, int& C) { const int st = b / 1024, sb = b % 1024, swz = sb ^ (((sb >> 9) & 1) << 5); R = (st >> 1) * 16 + swz / 64; C = (st & 1) * 32 + (swz % 64) / 2; }

__device__ __forceinline__ int perm32(int rho) { const int n = rho >> 4, i = rho & 15; return 8 * (i >> 2) + 4 * n + (i & 3); }
struct Unit { int pm, pn, bz; };
struct Gemm { const bf16_t* A; const bf16_t* Bt; int lda, ldb, K, nM, nN, nB; size_t strideA, strideB; };

struct Sched {
    int nM, nN, nwg, total, G, c;
    __device__ void init(int nM_, int nN_, int nB_, int G_, int c_) { nM = nM_; nN = nN_; nwg = nM * nN; total = nwg * nB_; G = G_; c = c_; }
    __device__ bool next(int i, Unit& u) const {
        const long L = (long)i * G + c; if (L >= total) return false;
        u.bz = (int)(L / nwg); int wgid = (int)(L % nwg);
        { const int q = nwg / NXCD, r = nwg % NXCD, xcd = wgid % NXCD, off = wgid / NXCD; wgid = (xcd < r ? xcd * (q + 1) : r * (q + 1) + (xcd - r) * q) + off; }
        const int nig = WGM * nN, gid = wgid / nig, fm = gid * WGM, gsz = (nM - fm) < WGM ? (nM - fm) : WGM;
        u.pm = fm + ((wgid % nig) % gsz); u.pn = (wgid % nig) / gsz; return true;
    }
};

template <class Epi>
__device__ __forceinline__ void gemm_phase(LAS unsigned char* lds, const Gemm g, const Epi& E) {
    const int tid = otid(), wid = __builtin_amdgcn_readfirstlane(tid >> 6), lane = tid & 63, wr = wid >> 2, wc = wid & 3, fr = lane & 15, fq = lane >> 4;
    const int nt = g.K / BK;
    Sched S; S.init(g.nM, g.nN, g.nB, (int)gridDim.x, obid());
    unsigned voffA[2], voffB[2];
#pragma unroll
    for (int i = 0; i < 2; ++i) { int R, C; stage_rc(tid * 16 + i * 8192, R, C); const int Rb = Epi::PERM ? ((R & ~31) + perm32(R & 31)) : R;
        voffA[i] = (unsigned)(R * g.lda + C) * 2u; voffB[i] = (unsigned)(Rb * g.ldb + C) * 2u; }
    const size_t kstep = (size_t)(BK * 2);
    const size_t hstepA = (size_t)HALF * g.lda * 2, hstepB = (size_t)HALF * g.ldb * 2;
    const size_t tstepA = 2 * hstepA, tstepB = 2 * hstepB;
    const unsigned ldsw = (unsigned)wid * 1024u;
    const int aoff = lds_byte(wr * 64 + fr, fq * 8), boff = lds_byte(wc * 32 + fr, fq * 8);
#define PG8_SA(b, h) (((b) * 2 + (h)) * HTB)
#define PG8_SB(b, h) ((4 + (b) * 2 + (h)) * HTB)
#define PG8_STAGE(bufoff, gbase, voff) do { _Pragma("unroll") for (int _i = 0; _i < 2; ++_i) \
        __builtin_amdgcn_global_load_lds((const unsigned*)((const char*)(gbase) + (voff)[_i]), (LAS unsigned*)(lds + (bufoff) + ldsw + _i * 8192), 16, 0, 0); } while (0)
#define PG8_LDA(dst, b, h) do { _Pragma("unroll") for (int m = 0; m < 4; ++m) _Pragma("unroll") for (int k = 0; k < 2; ++k) dst[m][k] = *(const LAS bf16x8*)(lds + PG8_SA(b, h) + aoff + m * 2048 + k * 1024); } while (0)
#define PG8_LDB(dst, b, h) do { _Pragma("unroll") for (int n = 0; n < 2; ++n) _Pragma("unroll") for (int k = 0; k < 2; ++k) dst[n][k] = *(const LAS bf16x8*)(lds + PG8_SB(b, h) + boff + n * 2048 + k * 1024); } while (0)
#define PG8_MMA(ai, bj, At, Bt) do { __builtin_amdgcn_s_setprio(1); _Pragma("unroll") for (int m = 0; m < 4; ++m) _Pragma("unroll") for (int n = 0; n < 2; ++n) _Pragma("unroll") for (int k = 0; k < 2; ++k) \
        acc[ai][bj][m][n] = __builtin_amdgcn_mfma_f32_16x16x32_bf16(Bt[n][k], At[m][k], acc[ai][bj][m][n], 0, 0, 0); __builtin_amdgcn_s_setprio(0); } while (0)
#define PG8_WAIT_V(n) asm volatile("s_waitcnt vmcnt(" #n ")" ::: "memory")
#define PG8_WAIT_L(n) asm volatile("s_waitcnt lgkmcnt(" #n ")" ::: "memory")
#define PG8_BAR __builtin_amdgcn_s_barrier()
#define PG8_SCHED __builtin_amdgcn_sched_barrier(0)
    Unit cur, nxt; int ui = 0;
    if (!S.next(0, cur)) return;
    int tag0 = -1, tag1 = -1, tag2 = -1, tag3 = -1; LAS float* rstab = (LAS float*)(lds + STAGE_BYTES);
    if constexpr (Epi::RSTD) {
        { Unit t_; for (int i = 0; S.next(i, t_); ++i) { const int pm = t_.pm; if (pm == tag0 || pm == tag1 || pm == tag2 || pm == tag3) continue;
                if (tag0 < 0) tag0 = pm; else if (tag1 < 0) tag1 = pm; else if (tag2 < 0) tag2 = pm; else tag3 = pm; } }
#pragma unroll
        for (int sl = 0; sl < 2; ++sl) { const int slot = (tid >> 8) + 2 * sl; const int pm = slot == 0 ? tag0 : slot == 1 ? tag1 : slot == 2 ? tag2 : tag3;
            if (pm >= 0) { const f32x4* p = (const f32x4*)(E.SS + ((size_t)pm * 256 + (tid & 255)) * 16); const f32x4 a = p[0], b = p[1], c = p[2], d = p[3]; const f32x4 t = (a + b) + (c + d);
                rstab[slot * 256 + (tid & 255)] = rsqrtf(((t[0] + t[1]) + (t[2] + t[3])) * (1.0f / 1024.0f) + 1e-6f); } }
        __syncthreads();
    }
    f32x4 acc[2][2][4][2];
#pragma unroll
    for (int a = 0; a < 2; ++a)
#pragma unroll
        for (int b = 0; b < 2; ++b)
#pragma unroll
            for (int m = 0; m < 4; ++m)
#pragma unroll
                for (int n = 0; n < 2; ++n) acc[a][b][m][n] = (f32x4){0.f, 0.f, 0.f, 0.f};
    bf16x8 At[4][2], B0[2][2], B1[2][2];
    const char* cA = (const char*)g.A + (size_t)cur.bz * g.strideA * 2 + (size_t)cur.pm * tstepA;
    const char* cB = (const char*)g.Bt + (size_t)cur.bz * g.strideB * 2 + (size_t)cur.pn * tstepB;
    PG8_STAGE(PG8_SB(0, 0), cB, voffB); PG8_STAGE(PG8_SB(0, 1), cB + hstepB, voffB); PG8_STAGE(PG8_SA(0, 0), cA, voffA); PG8_STAGE(PG8_SA(0, 1), cA + hstepA, voffA);
    if (wr == 1) PG8_BAR;
    PG8_WAIT_V(2); PG8_BAR;
    PG8_STAGE(PG8_SB(1, 0), cB + kstep, voffB); PG8_STAGE(PG8_SA(1, 0), cA + kstep, voffA); PG8_STAGE(PG8_SB(1, 1), cB + hstepB + kstep, voffB);
    PG8_WAIT_V(6); PG8_BAR;
    for (;;) {
        const bool has_next = S.next(ui + 1, nxt);
        const char* nA = has_next ? (const char*)g.A + (size_t)nxt.bz * g.strideA * 2 + (size_t)nxt.pm * tstepA : cA;
        const char* nB = has_next ? (const char*)g.Bt + (size_t)nxt.bz * g.strideB * 2 + (size_t)nxt.pn * tstepB : cB;
        for (int t = 0; t < nt; t += 2) {
            const bool last = (t == nt - 2);
            const char* a1 = cA + (size_t)(t + 1) * kstep;
            const char* a2 = last ? nA : cA + (size_t)(t + 2) * kstep; const char* b2 = last ? nB : cB + (size_t)(t + 2) * kstep;
            const char* a3 = a2 + kstep; const char* b3 = b2 + kstep;
            PG8_LDB(B0, 0, 0); PG8_LDB(B1, 0, 1); PG8_SCHED; PG8_LDA(At, 0, 0); PG8_STAGE(PG8_SA(1, 1), a1 + hstepA, voffA);
            PG8_WAIT_V(8); PG8_WAIT_L(0); PG8_BAR; PG8_MMA(0, 0, At, B0); PG8_MMA(0, 1, At, B1); PG8_BAR; PG8_SCHED;
            PG8_LDA(At, 0, 1); PG8_STAGE(PG8_SB(0, 0), b2, voffB); PG8_STAGE(PG8_SB(0, 1), b2 + hstepB, voffB); PG8_STAGE(PG8_SA(0, 0), a2, voffA);
            PG8_WAIT_V(8); PG8_WAIT_L(0); PG8_BAR; PG8_MMA(1, 0, At, B0); PG8_MMA(1, 1, At, B1); PG8_BAR; PG8_SCHED;
            PG8_LDB(B0, 1, 0); PG8_LDB(B1, 1, 1); PG8_SCHED; PG8_LDA(At, 1, 0); PG8_STAGE(PG8_SA(0, 1), a2 + hstepA, voffA);
            PG8_WAIT_V(8); PG8_WAIT_L(0); PG8_BAR; PG8_MMA(0, 0, At, B0); PG8_MMA(0, 1, At, B1); PG8_BAR; PG8_SCHED;
            PG8_LDA(At, 1, 1); PG8_STAGE(PG8_SB(1, 0), b3, voffB); PG8_STAGE(PG8_SB(1, 1), b3 + hstepB, voffB); PG8_STAGE(PG8_SA(1, 0), a3, voffA);
            PG8_WAIT_V(8); PG8_WAIT_L(0); PG8_BAR; PG8_MMA(1, 0, At, B0); PG8_MMA(1, 1, At, B1); PG8_BAR; PG8_SCHED;
        }
        if (wr == 0) PG8_BAR;
        E(acc, cur, wr, wc, fr, fq, rstab + (cur.pm == tag1 ? 256 : cur.pm == tag2 ? 512 : cur.pm == tag3 ? 768 : 0));
        if (!has_next) break;
#pragma unroll
        for (int a = 0; a < 2; ++a)
#pragma unroll
            for (int b = 0; b < 2; ++b)
#pragma unroll
                for (int m = 0; m < 4; ++m)
#pragma unroll
                    for (int n = 0; n < 2; ++n) acc[a][b][m][n] = (f32x4){0.f, 0.f, 0.f, 0.f};
        cur = nxt; cA = nA; cB = nB; ++ui;
        if (wr == 1) PG8_BAR;
    }
    PG8_WAIT_V(0);
    PG8_BAR;
#undef PG8_SA
#undef PG8_SB
#undef PG8_STAGE
#undef PG8_LDA
#undef PG8_LDB
#undef PG8_MMA
#undef PG8_WAIT_V
#undef PG8_WAIT_L
#undef PG8_BAR
#undef PG8_SCHED
}
}
using pg8::Unit;
typedef const f32x4 (&AccRef)[2][2][4][2];

struct EpiSwiGLU {
    static constexpr bool PERM = true, RSTD = true;
    bf16_t* O; const float* SS;
    __device__ __forceinline__ void operator()(AccRef acc, const Unit& u, int wr, int wc, int fr, int fq, const LAS float* rsl) const {
        const int row0 = u.pm * 256 + wr * 64 + fr, col0 = u.pn * 128 + wc * 32 + 8 * fq;
#pragma unroll
        for (int ai = 0; ai < 2; ++ai)
#pragma unroll
            for (int m = 0; m < 4; ++m) { bf16_t* rowp = O + (size_t)(row0 + ai * 128 + m * 16) * 2816 + col0; uint4 w; const float rs = rsl[ai * 128 + wr * 64 + m * 16 + fr];
                { const f32x4 gt = rs * acc[ai][0][m][0], up = rs * acc[ai][1][m][0]; w.x = pack2(silu_f(gt[0]) * up[0], silu_f(gt[1]) * up[1]); w.y = pack2(silu_f(gt[2]) * up[2], silu_f(gt[3]) * up[3]); }
                { const f32x4 gt = rs * acc[ai][0][m][1], up = rs * acc[ai][1][m][1]; w.z = pack2(silu_f(gt[0]) * up[0], silu_f(gt[1]) * up[1]); w.w = pack2(silu_f(gt[2]) * up[2], silu_f(gt[3]) * up[3]); }
                *(uint4*)rowp = w; }
    }
};
template <bool STATS> struct EpiResid {
    static constexpr bool PERM = true, RSTD = false;
    const float* Xin; float* X; bf16_t* XB; float* SS; float alpha;
    __device__ __forceinline__ void operator()(AccRef acc, const Unit& u, int wr, int wc, int fr, int fq, const LAS float* rsl) const {
        const int row0 = u.pm * 256 + wr * 64 + fr, col0 = u.pn * 256 + wc * 32 + 8 * fq;
#pragma unroll
        for (int ai = 0; ai < 2; ++ai)
#pragma unroll
            for (int m = 0; m < 4; ++m) { const size_t ro = (size_t)(row0 + ai * 128 + m * 16) * 1024 + col0; float sq = 0.f;
#pragma unroll
                for (int bj = 0; bj < 2; ++bj) { const size_t o = ro + bj * 128; const f32x4 x0 = *(const f32x4*)(Xin + o), x1 = *(const f32x4*)(Xin + o + 4);
                    const f32x4 y0 = x0 + alpha * acc[ai][bj][m][0], y1 = x1 + alpha * acc[ai][bj][m][1]; *(f32x4*)(X + o) = y0; *(f32x4*)(X + o + 4) = y1;
                    if (STATS) { uint4 w; w.x = pack2(y0[0], y0[1]); w.y = pack2(y0[2], y0[3]); w.z = pack2(y1[0], y1[1]); w.w = pack2(y1[2], y1[3]); *(uint4*)(XB + o) = w;
                        sq += y0[0] * y0[0] + y0[1] * y0[1] + y0[2] * y0[2] + y0[3] * y0[3] + y1[0] * y1[0] + y1[1] * y1[1] + y1[2] * y1[2] + y1[3] * y1[3]; } }
                if (STATS) { sq += __shfl_xor(sq, 16); sq += __shfl_xor(sq, 32); if (fq == 0) SS[(size_t)(row0 + ai * 128 + m * 16) * 16 + u.pn * 4 + wc] = sq; } }
    }
};
struct EpiBf16 {
    static constexpr bool PERM = true, RSTD = true;
    bf16_t* O; int ldc; const float* SS;
    __device__ __forceinline__ void operator()(AccRef acc, const Unit& u, int wr, int wc, int fr, int fq, const LAS float* rsl) const {
        const int row0 = u.pm * 256 + wr * 64 + fr, col0 = u.pn * 256 + wc * 32 + 8 * fq;
#pragma unroll
        for (int ai = 0; ai < 2; ++ai)
#pragma unroll
            for (int m = 0; m < 4; ++m) { bf16_t* rowp = O + (size_t)(row0 + ai * 128 + m * 16) * ldc + col0; const float rs = rsl[ai * 128 + wr * 64 + m * 16 + fr];
#pragma unroll
                for (int bj = 0; bj < 2; ++bj) { const f32x4 v0 = rs * acc[ai][bj][m][0], v1 = rs * acc[ai][bj][m][1]; uint4 w; w.x = pack2(v0[0], v0[1]); w.y = pack2(v0[2], v0[3]); w.z = pack2(v1[0], v1[1]); w.w = pack2(v1[2], v1[3]);
                    *(uint4*)(rowp + bj * 128) = w; } }
    }
};
struct EpiRetIn {
    static constexpr bool PERM = true, RSTD = true;
    bf16_t* O; int ldc; const float* SS; const float* cs; const float* sn; int rowbase;
    __device__ __forceinline__ void operator()(AccRef acc, const Unit& u, int wr, int wc, int fr, int fq, const LAS float* rsl) const {
        const int row0 = u.pm * 256 + wr * 64 + fr, col0 = u.pn * 256 + wc * 32 + 8 * fq, f = 16 * wc + 4 * fq;
#pragma unroll
        for (int ai = 0; ai < 2; ++ai)
#pragma unroll
            for (int m = 0; m < 4; ++m) { const int r = row0 + ai * 128 + m * 16; bf16_t* rowp = O + (size_t)r * ldc + col0; const float rs = rsl[ai * 128 + wr * 64 + m * 16 + fr];
                f32x4 c4 = (f32x4){1.f, 1.f, 1.f, 1.f}, s4 = (f32x4){0.f, 0.f, 0.f, 0.f};
                if (u.pn < 8) { const int pos = (rowbase + r) & 8191; c4 = *(const f32x4*)(cs + pos * 64 + f); s4 = *(const f32x4*)(sn + pos * 64 + f);
                    if (u.pn >= 4) { c4 *= 0.08838834764831845f; s4 *= 0.08838834764831845f; } }
#pragma unroll
                for (int bj = 0; bj < 2; ++bj) { const f32x4 t1 = rs * acc[ai][bj][m][0], t2 = rs * acc[ai][bj][m][1]; const f32x4 v0 = t1 * c4 - t2 * s4, v1 = t1 * s4 + t2 * c4;
                    uint4 w; w.x = pack2(v0[0], v0[1]); w.y = pack2(v0[2], v0[3]); w.z = pack2(v1[0], v1[1]); w.w = pack2(v1[2], v1[3]);
                    *(uint4*)(rowp + bj * 128) = w; } }
    }
};
struct EpiWin0 {
    static constexpr bool PERM = true, RSTD = true;
    bf16_t* AS5; bf16_t* PQ; const float* SS;
    __device__ __forceinline__ void operator()(AccRef acc, const Unit& u, int wr, int wc, int fr, int fq, const LAS float* rsl) const {
        const int row0 = u.pm * 256 + wr * 64 + fr, col0 = u.pn * 256 + wc * 32 + 8 * fq;
#pragma unroll
        for (int ai = 0; ai < 2; ++ai)
#pragma unroll
            for (int m = 0; m < 4; ++m) { const int r = row0 + ai * 128 + m * 16; const float rs = rsl[ai * 128 + wr * 64 + m * 16 + fr];
#pragma unroll
                for (int bj = 0; bj < 2; ++bj) { const int c = col0 + bj * 128; const f32x4 v0 = rs * acc[ai][bj][m][0], v1 = rs * acc[ai][bj][m][1];
                    uint4 w; w.x = pack2(v0[0], v0[1]); w.y = pack2(v0[2], v0[3]); w.z = pack2(v1[0], v1[1]); w.w = pack2(v1[2], v1[3]);
                    if (u.pn < 2) *(uint4*)(AS5 + ((size_t)((c >> 4) * 1024 + (r >> 6))) * 1280 + (r & 63) * 16 + (c & 15)) = w;
                    else *(uint4*)(PQ + (size_t)r * 1792 + (c - 512)) = w; } }
    }
};
struct EpiGLU {
    static constexpr bool PERM = true, RSTD = false;
    const bf16_t* GY; bf16_t* MIX;
    __device__ __forceinline__ void operator()(AccRef acc, const Unit& u, int wr, int wc, int fr, int fq, const LAS float* rsl) const {
        const int row0 = u.pm * 256 + wr * 64 + fr, col0 = u.pn * 256 + wc * 32 + 8 * fq;
#pragma unroll
        for (int ai = 0; ai < 2; ++ai)
#pragma unroll
            for (int m = 0; m < 4; ++m) { const int r = row0 + ai * 128 + m * 16;
#pragma unroll
                for (int bj = 0; bj < 2; ++bj) { const int c = col0 + bj * 128; const f32x4 v0 = acc[ai][bj][m][0], v1 = acc[ai][bj][m][1];
                    const uint4 gy = *(const uint4*)(GY + (size_t)r * 512 + c); uint4 w;
                    w.x = pack2(bflo(gy.x) * fast_sigmoid(v0[0]), bfhi(gy.x) * fast_sigmoid(v0[1])); w.y = pack2(bflo(gy.y) * fast_sigmoid(v0[2]), bfhi(gy.y) * fast_sigmoid(v0[3]));
                    w.z = pack2(bflo(gy.z) * fast_sigmoid(v1[0]), bfhi(gy.z) * fast_sigmoid(v1[1])); w.w = pack2(bflo(gy.w) * fast_sigmoid(v1[2]), bfhi(gy.w) * fast_sigmoid(v1[3]));
                    *(uint4*)(MIX + (size_t)r * 1024 + c) = w; } }
    }
};
struct EpiS5E {
    static constexpr bool PERM = false, RSTD = false;
    float* E;
    __device__ __forceinline__ void operator()(AccRef acc, const Unit& u, int wr, int wc, int fr, int fq, const LAS float* rsl) const {
        const int row0 = u.pm * 256 + wr * 64 + fr, col0 = wc * 32 + 4 * fq;
#pragma unroll
        for (int ai = 0; ai < 2; ++ai)
#pragma unroll
            for (int m = 0; m < 4; ++m) { float* rowp = E + ((size_t)u.bz * 1024 + row0 + ai * 128 + m * 16) * 256 + col0;
#pragma unroll
                for (int bj = 0; bj < 2; ++bj)
#pragma unroll
                    for (int n = 0; n < 2; ++n) *(f32x4*)(rowp + bj * 128 + n * 16) = acc[ai][bj][m][n]; }
    }
};
struct EpiS5Y {
    static constexpr bool PERM = true, RSTD = false;
    bf16_t* GY;
    __device__ __forceinline__ void operator()(AccRef acc, const Unit& u, int wr, int wc, int fr, int fq, const LAS float* rsl) const {
        const int row0 = u.pm * 256 + wr * 64 + fr, col0 = u.pn * 256 + wc * 32 + 8 * fq;
#pragma unroll
        for (int ai = 0; ai < 2; ++ai)
#pragma unroll
            for (int m = 0; m < 4; ++m) { const int bc = row0 + ai * 128 + m * 16;
#pragma unroll
                for (int bj = 0; bj < 2; ++bj) { const int c = col0 + bj * 128; const f32x4 v0 = acc[ai][bj][m][0], v1 = acc[ai][bj][m][1]; uint4 w;
                    w.x = pack2(gelu_tanh(v0[0]), gelu_tanh(v0[1])); w.y = pack2(gelu_tanh(v0[2]), gelu_tanh(v0[3])); w.z = pack2(gelu_tanh(v1[0]), gelu_tanh(v1[1])); w.w = pack2(gelu_tanh(v1[2]), gelu_tanh(v1[3]));
                    *(uint4*)(GY + ((size_t)bc * 64 + (c >> 4)) * 512 + u.bz * 16 + (c & 15)) = w; } }
    }
};

__device__ void transpose_job(const float* __restrict__ src, int K, int Nsrc, bf16_t* __restrict__ dst, int Ndst, int mode, LAS float* tile, int b0, int nb, const float* __restrict__ gain) {
    const int tid = otid();
    const int ntk = K >> 8, nt = (Ndst >> 6) * ntk;
    for (int t = obid() - b0; t < nt; t += nb) {
        const int tn = t / ntk, tk = t % ntk, n0 = tn * 64, k0 = tk * 256;
        int ns0 = n0;
        if (mode == 1) { const int tt = n0 >> 8, j = n0 & 255; ns0 = (j < 128) ? (tt * 128 + j) : (2816 + tt * 128 + (j - 128)); }
        const int r = tid >> 4; int c4 = (tid & 15) * 4;
        const int c4d = c4;
        if (mode == 2 && n0 < 2048) { const int s_ = (n0 + c4) & 127;
            c4 = ((n0 + c4) & ~127) + 64 * ((s_ >> 2) & 1) + 16 * (s_ >> 5) + 4 * ((s_ >> 3) & 3) - n0; }
        float4 v[8];
#pragma unroll
        for (int rr = 0; rr < 8; ++rr) { v[rr] = make_float4(0.f, 0.f, 0.f, 0.f);
            if (ns0 + c4 + 3 < Nsrc) v[rr] = *(const float4*)(src + (size_t)(k0 + r + rr * 32) * Nsrc + ns0 + c4);
            if (gain) { const float gk = gain[k0 + r + rr * 32]; v[rr].x *= gk; v[rr].y *= gk; v[rr].z *= gk; v[rr].w *= gk; } }
#pragma unroll
        for (int rr = 0; rr < 8; ++rr) { const int kk = r + rr * 32; LAS float* tp = tile + (kk >> 6) * (64 * 65) + (kk & 63) * 65 + c4d;
            tp[0] = v[rr].x; tp[1] = v[rr].y; tp[2] = v[rr].z; tp[3] = v[rr].w; }
        __syncthreads();
        const int n = tid >> 3, kq = (tid & 7) * 8;
#pragma unroll
        for (int kt = 0; kt < 4; ++kt) { const LAS float* tp = tile + kt * (64 * 65); uint4 w;
            w.x = pack2(tp[(kq + 0) * 65 + n], tp[(kq + 1) * 65 + n]); w.y = pack2(tp[(kq + 2) * 65 + n], tp[(kq + 3) * 65 + n]);
            w.z = pack2(tp[(kq + 4) * 65 + n], tp[(kq + 5) * 65 + n]); w.w = pack2(tp[(kq + 6) * 65 + n], tp[(kq + 7) * 65 + n]);
            *(uint4*)(dst + (size_t)(n0 + n) * K + k0 + kt * 64 + kq) = w; }
        __syncthreads();
    }
}

__device__ void s5_pre(CP P, int g, int dir, int part, LAS unsigned char* lds) {
    LAS f32x2* pw = (LAS f32x2*)lds;
    LAS f32x2* Bb = pw + 65 * 64;
    LAS f32x2* Cc = Bb + 64 * 16;
    const int tid = otid();
    float* Ktab = (float*)(P->ws + OFF_KTAB); float* AT = (float*)(P->ws + OFF_S5P);
    bf16_t* KG = (bf16_t*)(P->ws + OFF_KG); bf16_t* H = (bf16_t*)(P->ws + OFF_H);
    if (tid < 64) { const int n = tid, gi = (dir * 32 + g) * 64 + n;
        const double lr = fmin((double)P->in[9][gi], -1e-4), li = (double)P->in[10][gi], dt = (double)expf(P->in[15][dir * 32 + g]);
        const double em1 = (double)expm1f((float)(lr * dt)), mag = 1.0 + em1;
        double rev = li * dt * 0.15915494309189535; rev -= rint(rev); const float th = (float)(rev * 6.283185307179586), thh = 0.5f * th;
        const double sn_ = (double)sinf(th), shalf = (double)sinf(thh), cm1 = -2.0 * shalf * shalf;
        const double ar = mag * (1.0 + cm1), ai = mag * sn_, arm1 = em1 + cm1 + em1 * cm1, den = lr * lr + li * li;
        const double cr = (arm1 * lr + ai * li) / den, ci = (ai * lr - arm1 * li) / den;
#pragma unroll 1
        for (int p = 0; p < 16; ++p) { const double br = (double)P->in[11][gi * 16 + p], bi = (double)P->in[12][gi * 16 + p];
            Bb[n * 16 + p] = mkf2((float)(cr * br - ci * bi), (float)(cr * bi + ci * br)); }
        double xr = 1.0, xi = 0.0;
#pragma unroll 1
        for (int d = 0; d <= 64; ++d) { pw[d * 64 + n] = mkf2((float)xr, (float)xi); const double t0 = xr * ar - xi * ai; xi = xr * ai + xi * ar; xr = t0; }
        const f32x2 a64 = pw[64 * 64 + n];
        if (part == 0) { AT[((g * 2 + dir) * 64 + n) * 2 + 0] = a64.x; AT[((g * 2 + dir) * 64 + n) * 2 + 1] = a64.y; } }
#pragma unroll 1
    for (int idx = tid; idx < 16 * 64; idx += NTHR) { const int p = idx >> 6, n = idx & 63; const int ci_ = ((dir * 32 + g) * 16 + p) * 64 + n;
        Cc[idx] = mkf2(P->in[13][ci_], P->in[14][ci_]); }
    __syncthreads();
    { const int dq = tid >> 8, p = (tid >> 4) & 15, pp = tid & 15;
#pragma unroll 1
        for (int dd = 0; dd < 16; ++dd) { const int d = part * 32 + dq * 16 + dd; float acc = 0.f;
#pragma unroll 4
            for (int n = 0; n < 64; ++n) { const f32x2 w = pw[d * 64 + n], bb = Bb[n * 16 + pp], c = Cc[p * 64 + n];
                const float zr = w.x * bb.x - w.y * bb.y, zi = w.x * bb.y + w.y * bb.x; acc += c.x * zr - c.y * zi; }
            Ktab[((size_t)((g * 2 + dir) * 64 + d)) * 256 + p * 16 + pp] = acc; } }
#pragma unroll 1
    for (int idx = tid; idx < 512 * 64; idx += NTHR) { const int row = part * 512 + (idx >> 6), n = idx & 63, t = row >> 4, p = row & 15, d = dir == 0 ? t + 1 : 64 - t;
        const f32x2 w = pw[d * 64 + n], c = Cc[p * 64 + n]; const float gr = c.x * w.x - c.y * w.y, gi = c.x * w.y + c.y * w.x;
        *(unsigned*)(KG + ((size_t)(g * 1024 + row)) * 1280 + 1024 + dir * 128 + n * 2) = pack2(gr, -gi); }
#pragma unroll 1
    for (int idx = tid; idx < 32 * 64 * 8; idx += NTHR) { const int pp2 = (idx & 7) * 2, s = (idx >> 3) & 63, n = part * 32 + (idx >> 9), d = dir == 0 ? 63 - s : s;
        const f32x2 w = pw[d * 64 + n], b0 = Bb[n * 16 + pp2], b1 = Bb[n * 16 + pp2 + 1];
        const float hr0 = w.x * b0.x - w.y * b0.y, hi0 = w.x * b0.y + w.y * b0.x, hr1 = w.x * b1.x - w.y * b1.y, hi1 = w.x * b1.y + w.y * b1.x;
        const size_t row0 = (size_t)g * 256 + dir * 128 + n * 2;
        *(unsigned*)(H + row0 * 1024 + s * 16 + pp2) = pack2(hr0, hr1); *(unsigned*)(H + (row0 + 1) * 1024 + s * 16 + pp2) = pack2(hi0, hi1); }
    __syncthreads();
}

template <bool FINAL> __device__ void phase_norm(const float* __restrict__ x, const float* __restrict__ g, bf16_t* __restrict__ xb, float* __restrict__ ss_out, float* __restrict__ outf, int b0, int nb, int rbeg, int rend);
__device__ void phase_prologue(CP P, LAS unsigned char* lds) {
    const int tid = otid(), bq = obid();
    if (bq < 128) { if (EN(20)) s5_pre(P, bq >> 2, (bq >> 1) & 1, bq & 1, lds);
        phase_norm<false>(P->in[0], nullptr, (bf16_t*)(P->ws + OFF_XN), (float*)(P->ws + OFF_SSQ), nullptr, 0, 128, 0, 40960); return; }
    const int b0 = 128, nb = (int)gridDim.x - 128;
    if (EN(21)) { float* cs = (float*)(P->ws + OFF_ROPE); float* sn = cs + 8192 * 64;
        for (int idx = (bq - b0) * NTHR + tid; idx < 8192 * 64; idx += nb * NTHR) { const int pos = idx >> 6, f = idx & 63;
            const float inv = expf(-9.210340371976184f * (float)f * (1.0f / 64.0f)); const float ang = (float)pos * inv;
            cs[idx] = cosf(ang); sn[idx] = sinf(ang); } }
    phase_norm<false>(P->in[0], nullptr, (bf16_t*)(P->ws + OFF_XN), (float*)(P->ws + OFF_SSQ), nullptr, b0, nb, 40960, 65536);
    LAS float* tile = (LAS float*)lds;
    if (EN(22)) for (int l = 0; l < 2; ++l) {
        transpose_job(P->in[2] + (size_t)l * 1024 * 5632, 1024, 5632, (bf16_t*)(P->ws + OFF_W1 + (size_t)(2 * l) * SZ_W1), 5632, 1, tile, b0, nb, P->in[1] + l * 1024);
        transpose_job(P->in[6] + (size_t)l * 1024 * 5632, 1024, 5632, (bf16_t*)(P->ws + OFF_W1 + (size_t)(2 * l + 1) * SZ_W1), 5632, 1, tile, b0, nb, P->in[5] + l * 1024);
        transpose_job(P->in[3] + (size_t)l * 2816 * 1024, 2816, 1024, (bf16_t*)(P->ws + OFF_W2 + (size_t)(2 * l) * SZ_W2), 1024, 0, tile, b0, nb, nullptr);
        transpose_job(P->in[7] + (size_t)l * 2816 * 1024, 2816, 1024, (bf16_t*)(P->ws + OFF_W2 + (size_t)(2 * l + 1) * SZ_W2), 1024, 0, tile, b0, nb, nullptr);
    }
    if (EN(22)) transpose_job(P->in[8], 1024, 2080, (bf16_t*)(P->ws + OFF_WIN0), 2304, 0, tile, b0, nb, P->in[4]);
    if (EN(22)) transpose_job(P->in[17], 512, 512, (bf16_t*)(P->ws + OFF_WGLU), 512, 0, tile, b0, nb, nullptr);
    if (EN(22)) transpose_job(P->in[21], 1024, 1024, (bf16_t*)(P->ws + OFF_WOUT0), 1024, 0, tile, b0, nb, nullptr);
    if (EN(22)) transpose_job(P->in[22], 1024, 6144, (bf16_t*)(P->ws + OFF_WIN1), 6144, 2, tile, b0, nb, P->in[4] + 1024);
    if (EN(22)) transpose_job(P->in[24], 2048, 1024, (bf16_t*)(P->ws + OFF_WOUT1), 1024, 0, tile, b0, nb, nullptr);
}

__device__ void phase_kmat(CP P) {
    const float* Ktab = (const float*)(P->ws + OFF_KTAB); bf16_t* KG = (bf16_t*)(P->ws + OFF_KG); const float* dsk = P->in[16];
    for (int idx = obid() * NTHR + otid(); idx < 32 * 1024 * 512; idx += gridDim.x * NTHR) {
        const int kp = idx & 511, row = (idx >> 9) & 1023, g = idx >> 19, t = row >> 4, p = row & 15, k = kp * 2, s = k >> 4, pp = k & 15;
        float v0 = 0.f, v1 = 0.f;
        if (s <= t) { const float* b = Ktab + ((size_t)((g * 2 + 0) * 64 + (t - s))) * 256 + p * 16 + pp; v0 += b[0]; v1 += b[1]; }
        if (s >= t) { const float* b = Ktab + ((size_t)((g * 2 + 1) * 64 + (s - t))) * 256 + p * 16 + pp; v0 += b[0]; v1 += b[1]; }
        if (s == t) { const float dv = dsk[g * 16 + p]; if (pp == p) v0 += dv; if (pp + 1 == p) v1 += dv; }
        *(unsigned*)(KG + ((size_t)(g * 1024 + row)) * 1280 + k) = pack2(v0, v1);
    }
}

template <bool FINAL>
__device__ void phase_norm(const float* __restrict__ x, const float* __restrict__ g, bf16_t* __restrict__ xb, float* __restrict__ ss_out, float* __restrict__ outf, int b0, int nb, int rbeg, int rend) {
    const int tid_ = otid(), lane = tid_ & 63, wid = tid_ >> 6; const int bq = obid() - b0;
    if (bq < 0) return;
    f32x4 gv[4];
#pragma unroll
    for (int i = 0; i < 4; ++i) gv[i] = FINAL ? *(const f32x4*)(g + (lane + 64 * i) * 4) : (f32x4){1.f, 1.f, 1.f, 1.f};
    for (int row0 = rbeg + bq * 8 + wid; row0 < rend; row0 += nb * 16) {
        const int row1 = row0 + nb * 8; const bool has1 = row1 < rend;
        const float* xr0 = x + (size_t)row0 * 1024; const float* xr1 = x + (size_t)(has1 ? row1 : row0) * 1024; f32x4 v[4], u[4]; float ss = 0.f, st = 0.f;
#pragma unroll
        for (int i = 0; i < 4; ++i) { v[i] = *(const f32x4*)(xr0 + (lane + 64 * i) * 4); u[i] = *(const f32x4*)(xr1 + (lane + 64 * i) * 4); }
#pragma unroll
        for (int i = 0; i < 4; ++i) { ss += v[i][0] * v[i][0] + v[i][1] * v[i][1] + v[i][2] * v[i][2] + v[i][3] * v[i][3]; st += u[i][0] * u[i][0] + u[i][1] * u[i][1] + u[i][2] * u[i][2] + u[i][3] * u[i][3]; }
#pragma unroll
        for (int o = 32; o > 0; o >>= 1) { ss += __shfl_xor(ss, o); st += __shfl_xor(st, o); }
#pragma unroll
        for (int rr = 0; rr < 2; ++rr) { if (rr == 1 && !has1) break; const int row = rr ? row1 : row0; const float sv = rr ? st : ss;
            if (FINAL) { const float rstd = rsqrtf(sv * (1.0f / 1024.0f) + 1e-6f);
#pragma unroll
                for (int i = 0; i < 4; ++i) *(f32x4*)(outf + (size_t)row * 1024 + (lane + 64 * i) * 4) = (rr ? u[i] : v[i]) * rstd * gv[i]; }
            else { if (lane < 16) ss_out[(size_t)row * 16 + lane] = lane == 0 ? sv : 0.f;
#pragma unroll
                for (int i = 0; i < 4; ++i) { const f32x4 y = rr ? u[i] : v[i]; uint2 w; w.x = pack2(y[0], y[1]); w.y = pack2(y[2], y[3]); *(uint2*)(xb + (size_t)row * 1024 + (lane + 64 * i) * 4) = w; } } }
    }
}

__device__ __forceinline__ f32x4 mma16(const LAS bf16_t* As, int lda, const LAS bf16_t* Bs, int ldb, int K, f32x4 acc, int lane) {
    const int r = lane & 15, q = lane >> 4;
#pragma unroll
    for (int k = 0; k < K; k += 32) { const bf16x8 a = *(const LAS bf16x8*)(As + r * lda + k + q * 8); const bf16x8 b = *(const LAS bf16x8*)(Bs + r * ldb + k + q * 8);
        acc = __builtin_amdgcn_mfma_f32_16x16x32_bf16(b, a, acc, 0, 0, 0); }
    return acc;
}


typedef short s16x4 __attribute__((ext_vector_type(4)));
__device__ __forceinline__ bf16x8 frag_tr(const LAS bf16_t* T, int ld, int lane) {
    const int g = lane >> 4, qq = (lane & 15) >> 2, p = lane & 3;
    LAS bf16_t* a = (LAS bf16_t*)T + (8 * g + qq) * ld + 4 * p;
    const s16x4 lo = __builtin_amdgcn_ds_read_tr16_b64_v4i16((LAS s16x4*)a);
    const s16x4 hi = __builtin_amdgcn_ds_read_tr16_b64_v4i16((LAS s16x4*)(a + 4 * ld));
    return (bf16x8){lo[0], lo[1], lo[2], lo[3], hi[0], hi[1], hi[2], hi[3]};
}

__device__ __forceinline__ void lds_barrier() { asm volatile("s_waitcnt lgkmcnt(0)" ::: "memory"); __builtin_amdgcn_s_barrier(); asm volatile("" ::: "memory"); }

__device__ void phase_s5_scan(CP P) {
    const float* E = (const float*)(P->ws + OFF_E); const float* AT = (const float*)(P->ws + OFF_S5P); bf16_t* AS5 = (bf16_t*)(P->ws + OFF_AS5);
    const int tid_ = otid(); if (tid_ >= 128) return;
    for (int idx = obid() * 128 + tid_; idx < 32 * 8 * 2 * 64; idx += gridDim.x * 128) {
        const int n = idx & 63, dir = (idx >> 6) & 1, b = (idx >> 7) & 7, g = idx >> 10;
        const float ar = AT[((g * 2 + dir) * 64 + n) * 2], ai = AT[((g * 2 + dir) * 64 + n) * 2 + 1];
        float xr = 0.f, xi = 0.f;
#pragma unroll 16
        for (int cc = 0; cc < 128; ++cc) { const int c = dir == 0 ? cc : 127 - cc; const size_t bc = (size_t)g * 1024 + b * 128 + c;
            *(unsigned*)(AS5 + bc * 1280 + 1024 + dir * 128 + n * 2) = pack2(xr, xi);
            const float2 e = *(const float2*)(E + bc * 256 + dir * 128 + n * 2);
            const float t0 = ar * xr - ai * xi + e.x; xi = ar * xi + ai * xr + e.y; xr = t0; }
    }
}

__device__ __forceinline__ void gla_gates(CP P, const bf16_t* PQ, int m0, int h, LAS unsigned char* lds) {
    LAS float* gl = (LAS float*)lds; LAS float* tot = (LAS float*)(lds + 8192); LAS float* G = (LAS float*)(lds + 17408);
    const int tid = otid();
    const int dir = tid >> 8, d = tid & 63, tq = (tid >> 6) & 3;
    { const int idx = tid * 4, t = idx >> 5, r = idx & 31; const uint2 raw = *(const uint2*)(PQ + (size_t)(m0 + t) * 1792 + 1536 + r);
        *(LAS f32x4*)(gl + idx) = (f32x4){bflo(raw.x), bfhi(raw.x), bflo(raw.y), bfhi(raw.y)}; }
    float w[16];
#pragma unroll
    for (int r = 0; r < 16; ++r) w[r] = P->in[18][(dir * 16 + r) * 256 + h * 64 + d];
    const float b = P->in[19][dir * 256 + h * 64 + d];
    lds_barrier();
    float c[16];
#pragma unroll
    for (int i = 0; i < 16; ++i) { const int t = tq * 16 + i; float z = b;
#pragma unroll
        for (int r4 = 0; r4 < 4; ++r4) { const f32x4 g4 = *(const LAS f32x4*)(gl + t * 32 + dir * 16 + r4 * 4);
            z += g4[0] * w[r4 * 4] + g4[1] * w[r4 * 4 + 1] + g4[2] * w[r4 * 4 + 2] + g4[3] * w[r4 * 4 + 3]; }
        c[i] = (fminf(z, 0.f) - __logf(1.0f + __expf(-fabsf(z)))) * (1.0f / 16.0f); }
    if (dir == 0) {
#pragma unroll
        for (int i = 1; i < 16; ++i) c[i] += c[i - 1];
        tot[(dir * 4 + tq) * 64 + d] = c[15]; }
    else {
#pragma unroll
        for (int i = 14; i >= 0; --i) c[i] += c[i + 1];
        tot[(dir * 4 + tq) * 64 + d] = c[0]; }
    lds_barrier();
    float off = 0.f;
#pragma unroll
    for (int q = 0; q < 4; ++q) { const float tv = tot[(dir * 4 + q) * 64 + d]; off += ((dir == 0) ? (q < tq) : (q > tq)) ? tv : 0.f; }
#pragma unroll
    for (int i = 0; i < 16; ++i) G[(dir * 64 + tq * 16 + i) * 64 + d] = c[i] + off;
    lds_barrier();
}

__device__ void gla_a_unit(CP P, int unit, LAS unsigned char* lds) {
    const int c = unit & 127, h = (unit >> 7) & 3, b = unit >> 9, m0 = b * 8192 + c * 64;
    const bf16_t* PQ = (const bf16_t*)(P->ws + OFF_PQ); bf16_t* GST = (bf16_t*)(P->ws + OFF_GST); float* GDEC = (float*)(P->ws + OFF_GDEC);
    const int tid = otid(), lane = tid & 63, wid = tid >> 6;
    const int t = tid >> 3, d8 = (tid & 7) * 8, v16 = (tid & 7) * 16;
    const uint4 kraw = *(const uint4*)(PQ + (size_t)(m0 + t) * 1792 + 256 + h * 64 + d8);
    const uint4 vr0 = *(const uint4*)(PQ + (size_t)(m0 + t) * 1792 + 512 + h * 128 + v16), vr1 = *(const uint4*)(PQ + (size_t)(m0 + t) * 1792 + 512 + h * 128 + v16 + 8);
    gla_gates(P, PQ, m0, h, lds);
    LAS float* G = (LAS float*)(lds + 17408);
    LAS bf16_t* kA = (LAS bf16_t*)(lds + 50176);
    LAS bf16_t* Vs = (LAS bf16_t*)(lds + 67584);
    { const unsigned rw[4] = {kraw.x, kraw.y, kraw.z, kraw.w}; float ef[8], eb[8];
#pragma unroll
        for (int q = 0; q < 2; ++q) { const f32x4 lf = *(const LAS f32x4*)(G + 63 * 64 + d8 + q * 4), cf = *(const LAS f32x4*)(G + t * 64 + d8 + q * 4);
            const f32x4 lb = *(const LAS f32x4*)(G + 64 * 64 + d8 + q * 4), cb = *(const LAS f32x4*)(G + (64 + t) * 64 + d8 + q * 4);
#pragma unroll
            for (int j = 0; j < 4; ++j) { ef[q * 4 + j] = __expf(lf[j] - cf[j]); eb[q * 4 + j] = __expf(lb[j] - cb[j]); } }
        unsigned of[4], ob[4];
#pragma unroll
        for (int i = 0; i < 4; ++i) { const float k0 = bflo(rw[i]), k1 = bfhi(rw[i]); of[i] = pack2(k0 * ef[2 * i], k1 * ef[2 * i + 1]); ob[i] = pack2(k0 * eb[2 * i], k1 * eb[2 * i + 1]); }
        *(LAS u32x4*)(kA + t * 136 + d8) = mk4(of[0], of[1], of[2], of[3]); *(LAS u32x4*)(kA + t * 136 + 64 + d8) = mk4(ob[0], ob[1], ob[2], ob[3]);
        *(LAS u32x4*)(Vs + t * 136 + v16) = mk4(vr0.x, vr0.y, vr0.z, vr0.w); *(LAS u32x4*)(Vs + t * 136 + v16 + 8) = mk4(vr1.x, vr1.y, vr1.z, vr1.w); }
    if (tid < 128) { const int dir = tid >> 6, d = tid & 63; const float last = dir == 0 ? G[63 * 64 + d] : G[64 * 64 + d];
        GDEC[((size_t)(((b * 4 + h) * 2 + dir) * 128 + c)) * 64 + d] = __expf(last); }
    lds_barrier();
    { f32x4 acc[8];
#pragma unroll
        for (int nt = 0; nt < 8; ++nt) acc[nt] = (f32x4){0.f, 0.f, 0.f, 0.f};
#pragma unroll
        for (int ks = 0; ks < 2; ++ks) { const bf16x8 af = frag_tr(kA + ks * 32 * 136 + wid * 16, 136, lane);
#pragma unroll
            for (int nt = 0; nt < 8; ++nt) { const bf16x8 bfr = frag_tr(Vs + ks * 32 * 136 + nt * 16, 136, lane); acc[nt] = __builtin_amdgcn_mfma_f32_16x16x32_bf16(bfr, af, acc[nt], 0, 0, 0); } }
        const int row = wid * 16 + (lane & 15), dir = row >> 6, d = row & 63; bf16_t* out = GST + ((size_t)(((b * 4 + h) * 2 + dir) * 128 + c)) * 8192 + d * 128 + 4 * (lane >> 4);
#pragma unroll
        for (int nt = 0; nt < 8; ++nt) { uint2 w; w.x = pack2(acc[nt][0], acc[nt][1]); w.y = pack2(acc[nt][2], acc[nt][3]); *(uint2*)(out + nt * 16) = w; } }
    lds_barrier();
}

__device__ void phase_gla_b(CP P) {
    bf16_t* GST = (bf16_t*)(P->ws + OFF_GST); const float* GDEC = (const float*)(P->ws + OFF_GDEC);
    for (int idx = obid() * NTHR + otid(); idx < 64 * 1024; idx += gridDim.x * NTHR) {
        const int bhd = idx >> 10, e = (idx & 1023) * 8, d = e >> 7, dir = bhd & 1;
        f32x4 S0 = (f32x4){0.f, 0.f, 0.f, 0.f}, S1 = S0;
#pragma unroll 8
        for (int cc = 0; cc < 128; ++cc) { const int c = dir == 0 ? cc : 127 - cc; bf16_t* p = GST + ((size_t)(bhd * 128 + c)) * 8192 + e;
            const uint4 t = *(const uint4*)p; const float dec = GDEC[((size_t)(bhd * 128 + c)) * 64 + d];
            uint4 o; o.x = pack2(S0[0], S0[1]); o.y = pack2(S0[2], S0[3]); o.z = pack2(S1[0], S1[1]); o.w = pack2(S1[2], S1[3]); *(uint4*)p = o;
            S0 = dec * S0 + (f32x4){bflo(t.x), bfhi(t.x), bflo(t.y), bfhi(t.y)}; S1 = dec * S1 + (f32x4){bflo(t.z), bfhi(t.z), bflo(t.w), bfhi(t.w)}; }
    }
}

__device__ void gla_c_unit(CP P, int unit, LAS unsigned char* lds) {
    const int c = unit & 127, h = (unit >> 7) & 3, b = unit >> 9, m0 = b * 8192 + c * 64;
    const bf16_t* PQ = (const bf16_t*)(P->ws + OFF_PQ); const bf16_t* GST = (const bf16_t*)(P->ws + OFF_GST); bf16_t* MIX = (bf16_t*)(P->ws + OFF_XN);
    const int tid = otid(), lane = tid & 63, wid = tid >> 6;
    const int t = tid >> 3, d8 = (tid & 7) * 8, v16 = (tid & 7) * 16;
    const uint4 rq = *(const uint4*)(PQ + (size_t)(m0 + t) * 1792 + h * 64 + d8), rk = *(const uint4*)(PQ + (size_t)(m0 + t) * 1792 + 256 + h * 64 + d8);
    const uint4 vr0 = *(const uint4*)(PQ + (size_t)(m0 + t) * 1792 + 512 + h * 128 + v16), vr1 = *(const uint4*)(PQ + (size_t)(m0 + t) * 1792 + 512 + h * 128 + v16 + 8);
    const uint4 ogr0 = *(const uint4*)(PQ + (size_t)(m0 + t) * 1792 + 1024 + h * 128 + v16), ogr1 = *(const uint4*)(PQ + (size_t)(m0 + t) * 1792 + 1024 + h * 128 + v16 + 8);
    uint4 sr[4];
#pragma unroll
    for (int i = 0; i < 4; ++i) { const int idx = tid + i * NTHR, v8 = (idx & 15) * 8, d = (idx >> 4) & 63, dir = idx >> 10;
        sr[i] = *(const uint4*)(GST + ((size_t)(((b * 4 + h) * 2 + dir) * 128 + c)) * 8192 + d * 128 + v8); }
    gla_gates(P, PQ, m0, h, lds);
    LAS float* G = (LAS float*)(lds + 17408);
    LAS bf16_t* Ps = (LAS bf16_t*)lds;
    LAS bf16_t* qf = (LAS bf16_t*)(lds + 51200);
    LAS bf16_t* kf = qf + 64 * 72; LAS bf16_t* qb = kf + 64 * 72; LAS bf16_t* kb = qb + 64 * 72;
    LAS bf16_t* Vs = (LAS bf16_t*)(lds + 88064);
    LAS bf16_t* Ss = (LAS bf16_t*)(lds + 105472);
    { const unsigned qw[4] = {rq.x, rq.y, rq.z, rq.w}, kw[4] = {rk.x, rk.y, rk.z, rk.w};
        unsigned oqf[4], okf[4], oqb[4], okb[4]; float cf[8], cb[8];
#pragma unroll
        for (int q = 0; q < 2; ++q) { const f32x4 a = *(const LAS f32x4*)(G + t * 64 + d8 + q * 4), bb = *(const LAS f32x4*)(G + (64 + t) * 64 + d8 + q * 4);
#pragma unroll
            for (int j = 0; j < 4; ++j) { cf[q * 4 + j] = a[j]; cb[q * 4 + j] = bb[j]; } }
#pragma unroll
        for (int i = 0; i < 4; ++i) { const float cf0 = cf[2 * i], cf1 = cf[2 * i + 1], cb0 = cb[2 * i], cb1 = cb[2 * i + 1];
            const float q0 = bflo(qw[i]) * 0.125f, q1 = bfhi(qw[i]) * 0.125f, k0 = bflo(kw[i]), k1 = bfhi(kw[i]);
            oqf[i] = pack2(q0 * __expf(cf0), q1 * __expf(cf1)); okf[i] = pack2(k0 * __expf(-cf0), k1 * __expf(-cf1));
            oqb[i] = pack2(q0 * __expf(cb0), q1 * __expf(cb1)); okb[i] = pack2(k0 * __expf(-cb0), k1 * __expf(-cb1)); }
        *(LAS u32x4*)(qf + t * 72 + d8) = mk4(oqf[0], oqf[1], oqf[2], oqf[3]); *(LAS u32x4*)(kf + t * 72 + d8) = mk4(okf[0], okf[1], okf[2], okf[3]);
        *(LAS u32x4*)(qb + t * 72 + d8) = mk4(oqb[0], oqb[1], oqb[2], oqb[3]); *(LAS u32x4*)(kb + t * 72 + d8) = mk4(okb[0], okb[1], okb[2], okb[3]);
        *(LAS u32x4*)(Vs + t * 136 + v16) = mk4(vr0.x, vr0.y, vr0.z, vr0.w); *(LAS u32x4*)(Vs + t * 136 + v16 + 8) = mk4(vr1.x, vr1.y, vr1.z, vr1.w); }
#pragma unroll
    for (int i = 0; i < 4; ++i) { const int idx = tid + i * NTHR, v8 = (idx & 15) * 8, d = (idx >> 4) & 63, dir = idx >> 10;
        *(LAS u32x4*)(Ss + (dir * 64 + d) * 136 + v8) = mk4(sr[i].x, sr[i].y, sr[i].z, sr[i].w); }
    lds_barrier();
#pragma unroll
    for (int tl = 0; tl < 2; ++tl) { const int tile = wid * 2 + tl, mi = tile >> 2, ni = tile & 3; f32x4 pf = (f32x4){0.f, 0.f, 0.f, 0.f}, pb = pf;
        pf = mma16(qf + mi * 16 * 72, 72, kf + ni * 16 * 72, 72, 64, pf, lane); pb = mma16(qb + mi * 16 * 72, 72, kb + ni * 16 * 72, 72, 64, pb, lane);
        const int i = mi * 16 + (lane & 15), j0 = ni * 16 + 4 * (lane >> 4); float pv[4];
#pragma unroll
        for (int jj = 0; jj < 4; ++jj) pv[jj] = (j0 + jj <= i) ? pf[jj] : pb[jj];
        *(LAS u32x2*)(Ps + i * 72 + j0) = mk2(pack2(pv[0], pv[1]), pack2(pv[2], pv[3])); }
    lds_barrier();
    { const int mi = wid & 3, nb = (wid >> 2) * 4; LAS float* ost = G; f32x4 acc[4];
#pragma unroll
        for (int nt = 0; nt < 4; ++nt) acc[nt] = (f32x4){0.f, 0.f, 0.f, 0.f};
#pragma unroll
        for (int ks = 0; ks < 2; ++ks) {
            const bf16x8 ap = *(const LAS bf16x8*)(Ps + (mi * 16 + (lane & 15)) * 72 + ks * 32 + (lane >> 4) * 8);
            const bf16x8 af = *(const LAS bf16x8*)(qf + (mi * 16 + (lane & 15)) * 72 + ks * 32 + (lane >> 4) * 8);
            const bf16x8 ab = *(const LAS bf16x8*)(qb + (mi * 16 + (lane & 15)) * 72 + ks * 32 + (lane >> 4) * 8);
#pragma unroll
            for (int nt = 0; nt < 4; ++nt) { const int ni = nb + nt;
                acc[nt] = __builtin_amdgcn_mfma_f32_16x16x32_bf16(frag_tr(Vs + ks * 32 * 136 + ni * 16, 136, lane), ap, acc[nt], 0, 0, 0);
                acc[nt] = __builtin_amdgcn_mfma_f32_16x16x32_bf16(frag_tr(Ss + ks * 32 * 136 + ni * 16, 136, lane), af, acc[nt], 0, 0, 0);
                acc[nt] = __builtin_amdgcn_mfma_f32_16x16x32_bf16(frag_tr(Ss + (64 + ks * 32) * 136 + ni * 16, 136, lane), ab, acc[nt], 0, 0, 0); } }
#pragma unroll
        for (int nt = 0; nt < 4; ++nt) *(LAS f32x4*)(ost + (mi * 16 + (lane & 15)) * 132 + (nb + nt) * 16 + 4 * (lane >> 4)) = acc[nt]; }
    lds_barrier();
    { LAS float* ost = G; float o[16]; float ss = 0.f;
#pragma unroll
        for (int i = 0; i < 4; ++i) { const f32x4 v = *(const LAS f32x4*)(ost + t * 132 + v16 + i * 4); o[4 * i] = v[0]; o[4 * i + 1] = v[1]; o[4 * i + 2] = v[2]; o[4 * i + 3] = v[3]; ss += v[0] * v[0] + v[1] * v[1] + v[2] * v[2] + v[3] * v[3]; }
        ss += __shfl_xor(ss, 1); ss += __shfl_xor(ss, 2); ss += __shfl_xor(ss, 4);
        const float rstd = rsqrtf(ss * (1.0f / 128.0f) + 1e-6f);
        const float* gn = P->in[20] + h * 128 + v16;
        bf16_t* op = MIX + (size_t)(m0 + t) * 1024 + 512 + h * 128 + v16;
#pragma unroll
        for (int hh = 0; hh < 2; ++hh) { const uint4 raw = hh ? ogr1 : ogr0; const unsigned rw[4] = {raw.x, raw.y, raw.z, raw.w}; unsigned ow[4];
#pragma unroll
            for (int i = 0; i < 4; ++i) { const int e = hh * 8 + 2 * i; const float g0 = bflo(rw[i]), g1 = bfhi(rw[i]);
                ow[i] = pack2(o[e] * rstd * gn[e] * silu_f(g0), o[e + 1] * rstd * gn[e + 1] * silu_f(g1)); }
            *(uint4*)(op + hh * 8) = make_uint4(ow[0], ow[1], ow[2], ow[3]); } }
    lds_barrier();
}

__device__ __forceinline__ float ret_lg(int h) {
    float v = -0.0317486983145803f;
    v = h == 1 ? -0.015748356968139168f : v; v = h == 2 ? -0.007843177461025893f : v; v = h == 3 ? -0.003913899321136329f : v; v = h == 4 ? -0.0019550348358033506f : v;
    v = h == 5 ? -0.0009770396478266127f : v; v = h == 6 ? -0.0004884004981088745f : v; v = h == 7 ? -0.0002441704321739145f : v; return v;
}

struct KRaw { uint4 a, b; };
__device__ __forceinline__ KRaw rot_load(const bf16_t* rowp, const float*, const float*, int dq) { KRaw k; k.a = *(const uint4*)(rowp + dq); k.b = *(const uint4*)(rowp + 64 + dq); return k; }
__device__ __forceinline__ void rot_apply(const KRaw& k, float (&r1)[8], float (&r2)[8]) {
    const unsigned aw[4] = {k.a.x, k.a.y, k.a.z, k.a.w}, bw[4] = {k.b.x, k.b.y, k.b.z, k.b.w};
#pragma unroll
    for (int i = 0; i < 8; ++i) { r1[i] = (i & 1) ? bfhi(aw[i >> 1]) : bflo(aw[i >> 1]); r2[i] = (i & 1) ? bfhi(bw[i >> 1]) : bflo(bw[i >> 1]); }
}

__device__ void ret_a_unit(CP P, int hf, int unit, LAS unsigned char* lds) {
    const int vh = (unit >> 3) & 1, ur = (unit & 7) | ((unit >> 4) << 3), sc = ur & 31, h = (ur >> 5) & 7, bl = ur >> 8;
    const bf16_t* PR = (const bf16_t*)(P->ws + OFF_PROJ1); bf16_t* RST = (bf16_t*)(P->ws + OFF_RST);
    const float* cs = (const float*)(P->ws + OFF_ROPE); const float* sn = cs + 8192 * 64;
    const int tid = otid(), lane = tid & 63, wid = tid >> 6;
    const size_t r0 = (size_t)bl * 8192 + sc * 256;
    const float lgf = ret_lg(h), lgb = ret_lg(7 - h);
    LAS bf16_t* kf = (LAS bf16_t*)lds;
    LAS bf16_t* kb = (LAS bf16_t*)(lds + 17408);
    LAS bf16_t* Vs = (LAS bf16_t*)(lds + 34816);
    f32x4 acc[4][4];
#pragma unroll
    for (int a = 0; a < 4; ++a)
#pragma unroll
        for (int n = 0; n < 4; ++n) acc[a][n] = (f32x4){0.f, 0.f, 0.f, 0.f};
    const int mb = (wid >> 1) * 4, nb = (wid & 1) * 4;
    const LAS bf16_t* kA = (mb >= 8) ? kb : kf; const int dt0 = (mb & 7) * 16;
    const int pj = tid >> 3, pdq = (tid & 7) * 8, pv16 = (tid & 7) * 16;
    const bf16_t* kbase = PR + (r0 + pj) * 6144 + 1024 + h * 128; const bf16_t* vbase = PR + (r0 + pj) * 6144 + 2048 + h * 256 + vh * 128 + pv16;
    KRaw kr = rot_load(kbase, cs + (sc * 256 + pj) * 64, sn + (sc * 256 + pj) * 64, pdq);
    uint4 vr0 = *(const uint4*)(vbase), vr1 = *(const uint4*)(vbase + 8);
    for (int jb = 0; jb < 4; ++jb) {
        { const int j = pj, dq = pdq, J = jb * 64 + j; float r1[8], r2[8];
            rot_apply(kr, r1, r2);
            const float sf = __expf((float)(255 - J) * lgf), sb = __expf((float)J * lgb);
            *(LAS u32x4*)(kf + j * 136 + dq) = mk4(pack2(r1[0] * sf, r1[1] * sf), pack2(r1[2] * sf, r1[3] * sf), pack2(r1[4] * sf, r1[5] * sf), pack2(r1[6] * sf, r1[7] * sf));
            *(LAS u32x4*)(kf + j * 136 + 64 + dq) = mk4(pack2(r2[0] * sf, r2[1] * sf), pack2(r2[2] * sf, r2[3] * sf), pack2(r2[4] * sf, r2[5] * sf), pack2(r2[6] * sf, r2[7] * sf));
            *(LAS u32x4*)(kb + j * 136 + dq) = mk4(pack2(r1[0] * sb, r1[1] * sb), pack2(r1[2] * sb, r1[3] * sb), pack2(r1[4] * sb, r1[5] * sb), pack2(r1[6] * sb, r1[7] * sb));
            *(LAS u32x4*)(kb + j * 136 + 64 + dq) = mk4(pack2(r2[0] * sb, r2[1] * sb), pack2(r2[2] * sb, r2[3] * sb), pack2(r2[4] * sb, r2[5] * sb), pack2(r2[6] * sb, r2[7] * sb));
            *(LAS u32x4*)(Vs + j * 136 + pv16) = mk4(vr0.x, vr0.y, vr0.z, vr0.w); *(LAS u32x4*)(Vs + j * 136 + pv16 + 8) = mk4(vr1.x, vr1.y, vr1.z, vr1.w); }
        lds_barrier();
        if (jb < 3) { const int J = (jb + 1) * 64 + pj; kr = rot_load(kbase + (size_t)(jb + 1) * 64 * 6144, cs + (sc * 256 + J) * 64, sn + (sc * 256 + J) * 64, pdq);
            vr0 = *(const uint4*)(vbase + (size_t)(jb + 1) * 64 * 6144); vr1 = *(const uint4*)(vbase + (size_t)(jb + 1) * 64 * 6144 + 8); }
#pragma unroll
        for (int ks = 0; ks < 2; ++ks) { bf16x8 af[4], bfr[4];
#pragma unroll
            for (int a = 0; a < 4; ++a) af[a] = frag_tr(kA + ks * 32 * 136 + dt0 + a * 16, 136, lane);
#pragma unroll
            for (int n = 0; n < 4; ++n) bfr[n] = frag_tr(Vs + ks * 32 * 136 + (nb + n) * 16, 136, lane);
#pragma unroll
            for (int a = 0; a < 4; ++a)
#pragma unroll
                for (int n = 0; n < 4; ++n) acc[a][n] = __builtin_amdgcn_mfma_f32_16x16x32_bf16(bfr[n], af[a], acc[a][n], 0, 0, 0); }
        lds_barrier();
    }
#pragma unroll
    for (int a = 0; a < 4; ++a) { const int row = (mb + a) * 16 + (lane & 15), dir = row >> 7, d = row & 127;
        bf16_t* out = RST + ((size_t)(((bl * 8 + h) * 2 + dir) * 32 + sc)) * 32768 + d * 256 + vh * 128 + 4 * (lane >> 4);
#pragma unroll
        for (int n = 0; n < 4; ++n) { uint2 w; w.x = pack2(acc[a][n][0], acc[a][n][1]); w.y = pack2(acc[a][n][2], acc[a][n][3]); *(uint2*)(out + (nb + n) * 16) = w; } }
}

__device__ void phase_ret_b(CP P) {
    bf16_t* RST = (bf16_t*)(P->ws + OFF_RST);
    for (int idx = obid() * NTHR + otid(); idx < 64 * 4096; idx += gridDim.x * NTHR) {
        const int bhd = idx >> 12, e = (idx & 4095) * 8, dir = bhd & 1, h = (bhd >> 1) & 7;
        const float dec = __expf(256.0f * ret_lg(dir == 0 ? h : 7 - h));
        f32x4 S0 = (f32x4){0.f, 0.f, 0.f, 0.f}, S1 = S0;
#pragma unroll 8
        for (int cc = 0; cc < 32; ++cc) { const int c = dir == 0 ? cc : 31 - cc; bf16_t* p = RST + ((size_t)(bhd * 32 + c)) * 32768 + e;
            const uint4 t = *(const uint4*)p; uint4 o; o.x = pack2(S0[0], S0[1]); o.y = pack2(S0[2], S0[3]); o.z = pack2(S1[0], S1[1]); o.w = pack2(S1[2], S1[3]); *(uint4*)p = o;
            S0 = dec * S0 + (f32x4){bflo(t.x), bfhi(t.x), bflo(t.y), bfhi(t.y)}; S1 = dec * S1 + (f32x4){bflo(t.z), bfhi(t.z), bflo(t.w), bfhi(t.w)}; }
    }
}

__device__ void ret_c_unit(CP P, int hf, int unit, LAS unsigned char* lds) {
    const int rh = (unit >> 3) & 1, ur = (unit & 7) | ((unit >> 4) << 3), sc = ur & 31, h = (ur >> 5) & 7, bl = ur >> 8;
    const bf16_t* PR = (const bf16_t*)(P->ws + OFF_PROJ1); const bf16_t* RST = (const bf16_t*)(P->ws + OFF_RST);
    const float* cs = (const float*)(P->ws + OFF_ROPE); const float* sn = cs + 8192 * 64;
    const int tid = otid(), lane = tid & 63, wid = tid >> 6;
    const size_t r0 = (size_t)bl * 8192 + sc * 256;
    const float lgf = ret_lg(h), lgb = ret_lg(7 - h);
    LAS bf16_t* qs = (LAS bf16_t*)lds;
    LAS bf16_t* ks = (LAS bf16_t*)(lds + 34816);
    LAS bf16_t* Ps = (LAS bf16_t*)(lds + 52224);
    LAS bf16_t* Vs = (LAS bf16_t*)(lds + 70656);
    LAS float* red = (LAS float*)(lds + 104448);
    LAS bf16_t* qx = ks;
#pragma unroll
    for (int rep = 0; rep < 2; ++rep) { const int i = (tid >> 3) + rep * 64, dq = (tid & 7) * 8, I = rh * 128 + i;
        const KRaw q_ = rot_load(PR + (r0 + I) * 6144 + h * 128, nullptr, nullptr, dq);
        *(LAS u32x4*)(qs + i * 136 + dq) = mk4(q_.a.x, q_.a.y, q_.a.z, q_.a.w); *(LAS u32x4*)(qs + i * 136 + 64 + dq) = mk4(q_.b.x, q_.b.y, q_.b.z, q_.b.w); }
    f32x4 acc[2][8];
#pragma unroll
    for (int r = 0; r < 2; ++r)
#pragma unroll
        for (int n = 0; n < 8; ++n) acc[r][n] = (f32x4){0.f, 0.f, 0.f, 0.f};
    const int mi2 = (wid & 3) * 2, nb = (wid >> 2) * 8;
    const int pj = tid >> 3, pdq = (tid & 7) * 8, pv32 = (tid & 7) * 32;
    const bf16_t* kbase = PR + (r0 + pj) * 6144 + 1024 + h * 128; const bf16_t* vbase = PR + (r0 + pj) * 6144 + 2048 + h * 256 + pv32;
    KRaw kr = rot_load(kbase, cs + (sc * 256 + pj) * 64, sn + (sc * 256 + pj) * 64, pdq);
    uint4 vr[4];
#pragma unroll
    for (int hh = 0; hh < 4; ++hh) vr[hh] = *(const uint4*)(vbase + hh * 8);
    uint4 st[4];
    const bf16_t* sbase = RST + ((size_t)((bl * 8 + h) * 2) * 32 + sc) * 32768;
    for (int kb = 0; kb < 4; ++kb) {
        { const int j = pj, dq = pdq;
            *(LAS u32x4*)(ks + j * 136 + dq) = mk4(kr.a.x, kr.a.y, kr.a.z, kr.a.w); *(LAS u32x4*)(ks + j * 136 + 64 + dq) = mk4(kr.b.x, kr.b.y, kr.b.z, kr.b.w);
#pragma unroll
            for (int hh = 0; hh < 4; ++hh) *(LAS u32x4*)(Vs + j * 264 + pv32 + hh * 8) = mk4(vr[hh].x, vr[hh].y, vr[hh].z, vr[hh].w); }
        lds_barrier();
        if (kb < 3) { const int J = (kb + 1) * 64 + pj; kr = rot_load(kbase + (size_t)(kb + 1) * 64 * 6144, cs + (sc * 256 + J) * 64, sn + (sc * 256 + J) * 64, pdq);
#pragma unroll
            for (int hh = 0; hh < 4; ++hh) vr[hh] = *(const uint4*)(vbase + (size_t)(kb + 1) * 64 * 6144 + hh * 8); }
        else {
#pragma unroll
            for (int i = 0; i < 4; ++i) { const int idx = tid + i * NTHR, v8 = (idx & 31) * 8, dd = idx >> 5; st[i] = *(const uint4*)(sbase + dd * 256 + v8); } }
#pragma unroll
        for (int tr = 0; tr < 2; ++tr)
#pragma unroll
            for (int tc = 0; tc < 2; ++tc) { const int ti = mi2 + tr, tj = (wid >> 2) * 2 + tc; f32x4 s = (f32x4){0.f, 0.f, 0.f, 0.f};
                s = mma16(qs + ti * 16 * 136, 136, ks + tj * 16 * 136, 136, 128, s, lane);
                const int i = ti * 16 + (lane & 15), j0 = tj * 16 + 4 * (lane >> 4), I = rh * 128 + i; float pv[4];
#pragma unroll
                for (int jj = 0; jj < 4; ++jj) { const int df = I - (kb * 64 + j0 + jj); const float dm = df >= 0 ? __expf((float)df * lgf) : __expf((float)(-df) * lgb); pv[jj] = s[jj] * dm; }
                *(LAS u32x2*)(Ps + i * 72 + j0) = mk2(pack2(pv[0], pv[1]), pack2(pv[2], pv[3])); }
        lds_barrier();
#pragma unroll
        for (int k2 = 0; k2 < 2; ++k2) { bf16x8 af[2], bfr[8];
#pragma unroll
            for (int r = 0; r < 2; ++r) af[r] = *(const LAS bf16x8*)(Ps + ((mi2 + r) * 16 + (lane & 15)) * 72 + k2 * 32 + (lane >> 4) * 8);
#pragma unroll
            for (int n = 0; n < 8; ++n) bfr[n] = frag_tr(Vs + k2 * 32 * 264 + (nb + n) * 16, 264, lane);
#pragma unroll
            for (int r = 0; r < 2; ++r)
#pragma unroll
                for (int n = 0; n < 8; ++n) acc[r][n] = __builtin_amdgcn_mfma_f32_16x16x32_bf16(bfr[n], af[r], acc[r][n], 0, 0, 0); }
        lds_barrier();
    }
    uint2 ogr[2][8];
#pragma unroll
    for (int r = 0; r < 2; ++r) { const bf16_t* ogp = PR + (r0 + rh * 128 + (mi2 + r) * 16 + (lane & 15)) * 6144 + 4096 + h * 256 + 4 * (lane >> 4);
#pragma unroll
        for (int n = 0; n < 8; ++n) ogr[r][n] = *(const uint2*)(ogp + (nb + n) * 16); }
    for (int sl = 0; sl < 4; ++sl) { const int dir = sl >> 1, dh = sl & 1;
        if (dh == 0) { const int i = tid >> 2, c32 = (tid & 3) * 32, I = rh * 128 + i; const float xs = dir == 0 ? __expf((float)(I + 1) * lgf) : __expf((float)(256 - I) * lgb);
#pragma unroll
            for (int hh = 0; hh < 4; ++hh) { const u32x4 w = *(const LAS u32x4*)(qs + i * 136 + c32 + hh * 8);
                *(LAS u32x4*)(qx + i * 136 + c32 + hh * 8) = mk4(pack2(bflo(w[0]) * xs, bfhi(w[0]) * xs), pack2(bflo(w[1]) * xs, bfhi(w[1]) * xs), pack2(bflo(w[2]) * xs, bfhi(w[2]) * xs), pack2(bflo(w[3]) * xs, bfhi(w[3]) * xs)); } }
#pragma unroll
        for (int i = 0; i < 4; ++i) { const int idx = tid + i * NTHR, v8 = (idx & 31) * 8, dd = idx >> 5; *(LAS u32x4*)(Vs + dd * 264 + v8) = mk4(st[i].x, st[i].y, st[i].z, st[i].w); }
        lds_barrier();
        if (sl < 3) { const int nd = (sl + 1) >> 1, nh = (sl + 1) & 1; const bf16_t* sp = sbase + (size_t)nd * 32 * 32768 + (size_t)nh * 64 * 256;
#pragma unroll
            for (int i = 0; i < 4; ++i) { const int idx = tid + i * NTHR, v8 = (idx & 31) * 8, dd = idx >> 5; st[i] = *(const uint4*)(sp + dd * 256 + v8); } }
#pragma unroll
        for (int k2 = 0; k2 < 2; ++k2) { bf16x8 af[2], bfr[8];
#pragma unroll
            for (int r = 0; r < 2; ++r) af[r] = *(const LAS bf16x8*)(qx + ((mi2 + r) * 16 + (lane & 15)) * 136 + dh * 64 + k2 * 32 + (lane >> 4) * 8);
#pragma unroll
            for (int n = 0; n < 8; ++n) bfr[n] = frag_tr(Vs + k2 * 32 * 264 + (nb + n) * 16, 264, lane);
#pragma unroll
            for (int r = 0; r < 2; ++r)
#pragma unroll
                for (int n = 0; n < 8; ++n) acc[r][n] = __builtin_amdgcn_mfma_f32_16x16x32_bf16(bfr[n], af[r], acc[r][n], 0, 0, 0); }
        lds_barrier();
    }
    { float ss[2];
#pragma unroll
        for (int r = 0; r < 2; ++r) { ss[r] = 0.f;
#pragma unroll
            for (int n = 0; n < 8; ++n) ss[r] += acc[r][n][0] * acc[r][n][0] + acc[r][n][1] * acc[r][n][1] + acc[r][n][2] * acc[r][n][2] + acc[r][n][3] * acc[r][n][3];
            ss[r] += __shfl_xor(ss[r], 16); ss[r] += __shfl_xor(ss[r], 32);
            if ((lane >> 4) == 0) red[((mi2 + r) * 16 + (lane & 15)) * 2 + (wid >> 2)] = ss[r]; }
        lds_barrier();
#pragma unroll
        for (int r = 0; r < 2; ++r) { const int i = (mi2 + r) * 16 + (lane & 15);
            const float rstd = rsqrtf((red[i * 2] + red[i * 2 + 1]) * (1.0f / 256.0f) + 1e-6f);
            const float* gn = P->in[23] + h * 256 + 4 * (lane >> 4);
            bf16_t* op = (bf16_t*)(P->ws + OFF_OBUF) + (r0 + rh * 128 + i) * 2048 + h * 256 + 4 * (lane >> 4);
#pragma unroll
            for (int n = 0; n < 8; ++n) { const int v = (nb + n) * 16; const uint2 og = ogr[r][n]; const f32x4 g4 = *(const f32x4*)(gn + v);
                uint2 w; w.x = pack2(acc[r][n][0] * rstd * g4[0] * silu_f(bflo(og.x)), acc[r][n][1] * rstd * g4[1] * silu_f(bfhi(og.x)));
                w.y = pack2(acc[r][n][2] * rstd * g4[2] * silu_f(bflo(og.y)), acc[r][n][3] * rstd * g4[3] * silu_f(bfhi(og.y)));
                *(uint2*)(op + v) = w; } } }
    lds_barrier();
}

__device__ __forceinline__ void grid_barrier(unsigned* cnt, unsigned target) {
    asm volatile("s_waitcnt vmcnt(0)" ::: "memory");
    __syncthreads();
    if (threadIdx.x == 0) {
        __builtin_amdgcn_fence(__ATOMIC_RELEASE, "agent");
        asm volatile("s_waitcnt vmcnt(0)" ::: "memory");
        (void)__hip_atomic_fetch_add(cnt, 1u, __ATOMIC_RELAXED, __HIP_MEMORY_SCOPE_AGENT);
        unsigned spins = 0;
        while (__hip_atomic_load(cnt, __ATOMIC_RELAXED, __HIP_MEMORY_SCOPE_AGENT) < target) { __builtin_amdgcn_s_sleep(2); if (++spins > (1u << 24)) break; }
        __builtin_amdgcn_fence(__ATOMIC_ACQUIRE, "agent");
        asm volatile("s_waitcnt vmcnt(0)" ::: "memory");
    }
    __syncthreads();
}

__global__ void __launch_bounds__(NTHR, 2) mega(Params Pval, int ph0, int ph1) {
    extern __shared__ __attribute__((aligned(16))) unsigned char lds_raw[];
    LAS unsigned char* lds = (LAS unsigned char*)lds_raw;
    unsigned nbar = 0;
    for (int ph = ph0; ph < ph1; ++ph) {
        CP P = (CP)__builtin_amdgcn_kernarg_segment_ptr(); asm volatile("" : "+s"(P));
        unsigned char* ws = P->ws;
        bf16_t* XN = (bf16_t*)(ws + OFF_XN); bf16_t* ACT = (bf16_t*)(ws + OFF_ACT); float* X = P->out;
        if (ph == 1 || ph == 4 || ph == 11 || ph == 14 || ph == 17 || ph == 28) continue;
        const int reps = (((unsigned long long)(PROBE_MASK) >> ph) & 1ull) ? 2 : 1;
        for (int rep = 0; rep < reps; ++rep) {
        float* SSQ = (float*)(ws + OFF_SSQ); bf16_t* XB2 = (bf16_t*)(ws + OFF_XB2);
        int ffn = -1, sub = 0;
        if (ph >= 2 && ph <= 3) { ffn = 0; sub = ph - 1; } else if (ph >= 12 && ph <= 13) { ffn = 1; sub = ph - 11; }
        else if (ph >= 15 && ph <= 16) { ffn = 2; sub = ph - 14; } else if (ph >= 29 && ph <= 30) { ffn = 3; sub = ph - 28; }
        if (ph == 0) { if (EN(0)) phase_prologue(P, lds); }
        else if (ffn >= 0) {
            const float* xin = (ffn == 0) ? P->in[0] : X;
            const float* ssin = SSQ + (size_t)(ffn == 0 ? 0 : ffn == 1 ? 2 : ffn == 2 ? 3 : 5) * SSN;
            if (sub == 1) { if (EN(2)) { if (ffn == 0) phase_kmat(P);
                pg8::Gemm g{ffn == 1 ? XB2 : XN, (const bf16_t*)(ws + OFF_W1 + (size_t)ffn * SZ_W1), 1024, 1024, 1024, 256, 22, 1, 0, 0}; EpiSwiGLU e{ACT, ssin}; pg8::gemm_phase(lds, g, e); } }
            else { if (EN(3)) { pg8::Gemm g{ACT, (const bf16_t*)(ws + OFF_W2 + (size_t)ffn * SZ_W2), 2816, 2816, 2816, 256, 4, 1, 0, 0};
                float* ssout = SSQ + (size_t)(ffn == 0 ? 1 : ffn == 1 ? 3 : 4) * SSN;
                if (ffn == 3) { EpiResid<false> e{xin, X, nullptr, nullptr, 0.5f}; pg8::gemm_phase(lds, g, e); }
                else { EpiResid<true> e{xin, X, XN, ssout, 0.5f}; pg8::gemm_phase(lds, g, e); } } }
        }
        else if (ph == 5) { if (EN(4)) { pg8::Gemm g{XN, (const bf16_t*)(ws + OFF_WIN0), 1024, 1024, 1024, 256, 9, 1, 0, 0}; EpiWin0 e{(bf16_t*)(ws + OFF_AS5), (bf16_t*)(ws + OFF_PQ), SSQ + SSN}; pg8::gemm_phase(lds, g, e); } }
        else if (ph == 6) { if (EN(5)) {
            if (EN(16)) { pg8::Gemm g{(const bf16_t*)(ws + OFF_AS5), (const bf16_t*)(ws + OFF_H), 1280, 1024, 1024, 4, 1, 32, (size_t)1024 * 1280, (size_t)256 * 1024}; EpiS5E e{(float*)(ws + OFF_E)}; pg8::gemm_phase(lds, g, e); }
            __syncthreads();
            if (EN(17)) for (int u = obid(); u < 4096; u += gridDim.x) gla_a_unit(P, u, lds);
        } }
        else if (ph == 7) { if (EN(6)) { phase_s5_scan(P); phase_gla_b(P); } }
        else if (ph == 8) { if (EN(7)) {
            if (EN(18)) { pg8::Gemm g{(const bf16_t*)(ws + OFF_AS5), (const bf16_t*)(ws + OFF_KG), 1280, 1280, 1280, 4, 4, 32, (size_t)1024 * 1280, (size_t)1024 * 1280}; EpiS5Y e{(bf16_t*)(ws + OFF_GY)}; pg8::gemm_phase(lds, g, e); }
            __syncthreads();
            if (EN(19)) for (int u = obid(); u < 4096; u += gridDim.x) gla_c_unit(P, u, lds);
        } }
        else if (ph == 9) { if (EN(8)) { pg8::Gemm g{(const bf16_t*)(ws + OFF_GY), (const bf16_t*)(ws + OFF_WGLU), 512, 512, 512, 256, 2, 1, 0, 0}; EpiGLU e{(const bf16_t*)(ws + OFF_GY), XN}; pg8::gemm_phase(lds, g, e); } }
        else if (ph == 10) { if (EN(9)) { pg8::Gemm g{XN, (const bf16_t*)(ws + OFF_WOUT0), 1024, 1024, 1024, 256, 4, 1, 0, 0}; EpiResid<true> e{X, X, XB2, SSQ + 2 * SSN, 1.0f}; pg8::gemm_phase(lds, g, e); } }
        else if (ph >= 18 && ph <= 27) {
            const int hf = (ph - 18) / 5, s = (ph - 18) % 5;
            if (s == 0) { if (EN(10)) { pg8::Gemm g{XN + (size_t)hf * 32768 * 1024, (const bf16_t*)(ws + OFF_WIN1), 1024, 1024, 1024, 128, 24, 1, 0, 0}; EpiRetIn e{(bf16_t*)(ws + OFF_PROJ1), 6144, SSQ + 4 * SSN + (size_t)hf * 32768 * 16, (const float*)(ws + OFF_ROPE), (const float*)(ws + OFF_ROPE) + 8192 * 64, hf * 32768}; pg8::gemm_phase(lds, g, e); } }
            else if (s == 1) { if (EN(11)) for (int u = obid(); u < 2048; u += gridDim.x) ret_a_unit(P, hf, u, lds); }
            else if (s == 2) { if (EN(12)) phase_ret_b(P); }
            else if (s == 3) { if (EN(13)) for (int u = obid(); u < 2048; u += gridDim.x) ret_c_unit(P, hf, u, lds); }
            else { if (EN(14)) { pg8::Gemm g{(const bf16_t*)(ws + OFF_OBUF), (const bf16_t*)(ws + OFF_WOUT1), 2048, 2048, 2048, 128, 4, 1, 0, 0};
                float* Xh = X + (size_t)hf * 32768 * 1024; EpiResid<true> e{Xh, Xh, XN + (size_t)hf * 32768 * 1024, SSQ + 5 * SSN + (size_t)hf * 32768 * 16, 1.0f}; pg8::gemm_phase(lds, g, e); } }
        }
        else if (ph == 31) { if (EN(15)) phase_norm<true>(X, P->in[25], nullptr, nullptr, X, 0, (int)gridDim.x, 0, 65536); }
        if (rep + 1 < reps) __syncthreads();
        }
        if (ph + 1 < ph1) { if (ph == 0) cg::this_grid().sync();
            else { ++nbar; grid_barrier((unsigned*)(P->ws + OFF_BAR), nbar * gridDim.x); } }
    }
}

extern "C" void kernel_launch(void* const* d_in, const int* in_sizes, int n_in, void* d_out, int out_size, void* d_ws, size_t ws_size, hipStream_t stream) {
    static int inited = 0;
    if (!inited) { (void)hipFuncSetAttribute((const void*)mega, hipFuncAttributeMaxDynamicSharedMemorySize, LDS_BYTES); inited = 1; }
    Params p{};
    for (int i = 0; i < 26; ++i) p.in[i] = (const float*)d_in[i];
    p.out = (float*)d_out; p.ws = (unsigned char*)d_ws;
    if (ws_size < OFF_R + 770 * MiB) fprintf(stderr, "kernel_launch: workspace too small (%zu)\n", ws_size);
    const int grid = 256;
#if ONE_LAUNCH
    (void)hipMemsetAsync((unsigned char*)d_ws + OFF_BAR, 0, 256, stream);
    int ph0 = 0, ph1 = NPHASE; void* args[] = {&p, &ph0, &ph1};
    hipError_t e = hipLaunchCooperativeKernel((const void*)mega, dim3(grid), dim3(NTHR), args, LDS_BYTES, stream);
    if (e != hipSuccess) fprintf(stderr, "cooperative launch failed: %s\n", hipGetErrorString(e));
#else
    for (int ph = 0; ph < NPHASE; ++ph) hipLaunchKernelGGL(mega, dim3(grid), dim3(NTHR), LDS_BYTES, stream, p, ph, ph + 1);
#endif
}
```

```cpp
#include <hip/hip_runtime.h>
#include <hip/hip_cooperative_groups.h>
#include <cstdio>
#include <cstdint>
namespace cg = cooperative_groups;

#ifndef ONE_LAUNCH
#define ONE_LAUNCH 1
#endif

#ifndef PHASE_MASK
#define PHASE_MASK 0xffffffffffull
#endif
#define EN(n) (((PHASE_MASK) >> (n)) & 1ull)
#ifndef PROBE_MASK
#define PROBE_MASK 0ull
#endif
#define LAS __attribute__((address_space(3)))
typedef unsigned short bf16_t;
typedef short bf16x8 __attribute__((ext_vector_type(8)));
typedef float f32x4 __attribute__((ext_vector_type(4)));
typedef float f32x2 __attribute__((ext_vector_type(2)));
typedef unsigned u32x2 __attribute__((ext_vector_type(2)));
typedef unsigned u32x4 __attribute__((ext_vector_type(4)));
__device__ __forceinline__ u32x4 mk4(unsigned a, unsigned b, unsigned c, unsigned d) { return (u32x4){a, b, c, d}; }
__device__ __forceinline__ u32x2 mk2(unsigned a, unsigned b) { return (u32x2){a, b}; }
__device__ __forceinline__ f32x2 mkf2(float a, float b) { return (f32x2){a, b}; }

constexpr int NTHR = 512;
constexpr int LDS_BYTES = 147456;
constexpr int NPHASE = 32;

struct Params { const float* in[26]; float* out; unsigned char* ws; };
typedef const __attribute__((address_space(4))) Params* CP;

constexpr size_t MiB = 1ull << 20;
constexpr size_t OFF_W1 = 0, SZ_W1 = 11 * MiB;
constexpr size_t OFF_W2 = 44 * MiB, SZ_W2 = 5 * MiB + MiB / 2;
constexpr size_t OFF_WIN0 = 66 * MiB;
constexpr size_t OFF_WGLU = 70 * MiB + MiB / 2;
constexpr size_t OFF_WOUT0 = 71 * MiB;
constexpr size_t OFF_WIN1 = 73 * MiB;
constexpr size_t OFF_WOUT1 = 85 * MiB;
constexpr size_t OFF_ROPE = 89 * MiB;
constexpr size_t OFF_KTAB = 93 * MiB;
constexpr size_t OFF_S5P = 97 * MiB;
constexpr size_t OFF_XN = 98 * MiB;
constexpr size_t OFF_R = 226 * MiB;
constexpr size_t OFF_ACT = OFF_R;
constexpr size_t OFF_PQ = OFF_R;
constexpr size_t OFF_AS5 = OFF_R + 224 * MiB;
constexpr size_t OFF_E = OFF_R + 304 * MiB;
constexpr size_t OFF_KG = OFF_R + 352 * MiB;
constexpr size_t OFF_H = OFF_R + 432 * MiB;
constexpr size_t OFF_GST = OFF_R + 448 * MiB;
constexpr size_t OFF_GDEC = OFF_R + 704 * MiB;
constexpr size_t OFF_GY = OFF_R + 706 * MiB;
constexpr size_t OFF_PROJ1 = OFF_R;
constexpr size_t OFF_RST = OFF_R + 384 * MiB;
constexpr size_t OFF_SSQ = 998 * MiB;
constexpr int SSN = 65536 * 16;
constexpr size_t OFF_XB2 = OFF_R + 448 * MiB;
constexpr size_t OFF_BAR = 1023 * MiB;
constexpr size_t OFF_OBUF = OFF_R + 640 * MiB;

__device__ __forceinline__ int otid() { int t = threadIdx.x; asm volatile("" : "+v"(t)); return t; }
__device__ __forceinline__ int obid() { int t = blockIdx.x; asm volatile("" : "+s"(t)); return t; }
__device__ __forceinline__ bf16_t f2bf(float f) { unsigned u = __float_as_uint(f); u += 0x7FFFu + ((u >> 16) & 1u); return (bf16_t)(u >> 16); }
__device__ __forceinline__ float bf2f(unsigned b) { return __uint_as_float(b << 16); }
typedef __bf16 bf16x2_t __attribute__((ext_vector_type(2)));
typedef float f32x2_t __attribute__((ext_vector_type(2)));
__device__ __forceinline__ unsigned pack2(float lo, float hi) { const f32x2_t v = {lo, hi}; const bf16x2_t b = __builtin_convertvector(v, bf16x2_t); return __builtin_bit_cast(unsigned, b); }
__device__ __forceinline__ float bflo(unsigned w) { return __uint_as_float(w << 16); }
__device__ __forceinline__ float bfhi(unsigned w) { return __uint_as_float(w & 0xffff0000u); }
__device__ __forceinline__ float fast_sigmoid(float x) { return __builtin_amdgcn_rcpf(1.0f + __expf(-x)); }
__device__ __forceinline__ float silu_f(float x) { return x * fast_sigmoid(x); }
__device__ __forceinline__ float gelu_tanh(float x) { const float u = 0.7978845608028654f * (x + 0.044715f * x * x * x); return x * fast_sigmoid(2.0f * u); }

namespace pg8 {
constexpr int BM = 256, BK = 64, HALF = 128, HTB = HALF * BK * 2, STAGE_BYTES = 8 * HTB, NXCD = 8, WGM = 8;
__device__ __forceinline__ int lds_byte(int r, int c) { const int st = (r >> 4) * 2 + (c >> 5), rr = r & 15, cc = c & 31, ob = rr * 64 + cc * 2; return st * 1024 + (ob ^ (((ob >> 9) & 1) << 5)); }
__device__ __forceinline__ void stage_rc(int b, int& R, int& C) { const int st = b / 1024, sb = b % 1024, swz = sb ^ (((sb >> 9) & 1) << 5); R = (st >> 1) * 16 + swz / 64; C = (st & 1) * 32 + (swz % 64) / 2; }

__device__ __forceinline__ int perm32(int rho) { const int n = rho >> 4, i = rho & 15; return 8 * (i >> 2) + 4 * n + (i & 3); }
struct Unit { int pm, pn, bz; };
struct Gemm { const bf16_t* A; const bf16_t* Bt; int lda, ldb, K, nM, nN, nB; size_t strideA, strideB; };

struct Sched {
    int nM, nN, nwg, total, G, c;
    __device__ void init(int nM_, int nN_, int nB_, int G_, int c_) { nM = nM_; nN = nN_; nwg = nM * nN; total = nwg * nB_; G = G_; c = c_; }
    __device__ bool next(int i, Unit& u) const {
        const long L = (long)i * G + c; if (L >= total) return false;
        u.bz = (int)(L / nwg); int wgid = (int)(L % nwg);
        { const int q = nwg / NXCD, r = nwg % NXCD, xcd = wgid % NXCD, off = wgid / NXCD; wgid = (xcd < r ? xcd * (q + 1) : r * (q + 1) + (xcd - r) * q) + off; }
        const int nig = WGM * nN, gid = wgid / nig, fm = gid * WGM, gsz = (nM - fm) < WGM ? (nM - fm) : WGM;
        u.pm = fm + ((wgid % nig) % gsz); u.pn = (wgid % nig) / gsz; return true;
    }
};

template <class Epi>
__device__ __forceinline__ void gemm_phase(LAS unsigned char* lds, const Gemm g, const Epi& E) {
    const int tid = otid(), wid = __builtin_amdgcn_readfirstlane(tid >> 6), lane = tid & 63, wr = wid >> 2, wc = wid & 3, fr = lane & 15, fq = lane >> 4;
    const int nt = g.K / BK;
    Sched S; S.init(g.nM, g.nN, g.nB, (int)gridDim.x, obid());
    unsigned voffA[2], voffB[2];
#pragma unroll
    for (int i = 0; i < 2; ++i) { int R, C; stage_rc(tid * 16 + i * 8192, R, C); const int Rb = Epi::PERM ? ((R & ~31) + perm32(R & 31)) : R;
        voffA[i] = (unsigned)(R * g.lda + C) * 2u; voffB[i] = (unsigned)(Rb * g.ldb + C) * 2u; }
    const size_t kstep = (size_t)(BK * 2);
    const size_t hstepA = (size_t)HALF * g.lda * 2, hstepB = (size_t)HALF * g.ldb * 2;
    const size_t tstepA = 2 * hstepA, tstepB = 2 * hstepB;
    const unsigned ldsw = (unsigned)wid * 1024u;
    const int aoff = lds_byte(wr * 64 + fr, fq * 8), boff = lds_byte(wc * 32 + fr, fq * 8);
#define PG8_SA(b, h) (((b) * 2 + (h)) * HTB)
#define PG8_SB(b, h) ((4 + (b) * 2 + (h)) * HTB)
#define PG8_STAGE(bufoff, gbase, voff) do { _Pragma("unroll") for (int _i = 0; _i < 2; ++_i) \
        __builtin_amdgcn_global_load_lds((const unsigned*)((const char*)(gbase) + (voff)[_i]), (LAS unsigned*)(lds + (bufoff) + ldsw + _i * 8192), 16, 0, 0); } while (0)
#define PG8_LDA(dst, b, h) do { _Pragma("unroll") for (int m = 0; m < 4; ++m) _Pragma("unroll") for (int k = 0; k < 2; ++k) dst[m][k] = *(const LAS bf16x8*)(lds + PG8_SA(b, h) + aoff + m * 2048 + k * 1024); } while (0)
#define PG8_LDB(dst, b, h) do { _Pragma("unroll") for (int n = 0; n < 2; ++n) _Pragma("unroll") for (int k = 0; k < 2; ++k) dst[n][k] = *(const LAS bf16x8*)(lds + PG8_SB(b, h) + boff + n * 2048 + k * 1024); } while (0)
#define PG8_MMA(ai, bj, At, Bt) do { __builtin_amdgcn_s_setprio(1); _Pragma("unroll") for (int m = 0; m < 4; ++m) _Pragma("unroll") for (int n = 0; n < 2; ++n) _Pragma("unroll") for (int k = 0; k < 2; ++k) \
        acc[ai][bj][m][n] = __builtin_amdgcn_mfma_f32_16x16x32_bf16(Bt[n][k], At[m][k], acc[ai][bj][m][n], 0, 0, 0); __builtin_amdgcn_s_setprio(0); } while (0)
#define PG8_WAIT_V(n) asm volatile("s_waitcnt vmcnt(" #n ")" ::: "memory")
#define PG8_WAIT_L(n) asm volatile("s_waitcnt lgkmcnt(" #n ")" ::: "memory")
#define PG8_BAR __builtin_amdgcn_s_barrier()
#define PG8_SCHED __builtin_amdgcn_sched_barrier(0)
    Unit cur, nxt; int ui = 0;
    if (!S.next(0, cur)) return;
    int tag0 = -1, tag1 = -1, tag2 = -1, tag3 = -1; LAS float* rstab = (LAS float*)(lds + STAGE_BYTES);
    if constexpr (Epi::RSTD) {
        { Unit t_; for (int i = 0; S.next(i, t_); ++i) { const int pm = t_.pm; if (pm == tag0 || pm == tag1 || pm == tag2 || pm == tag3) continue;
                if (tag0 < 0) tag0 = pm; else if (tag1 < 0) tag1 = pm; else if (tag2 < 0) tag2 = pm; else tag3 = pm; } }
#pragma unroll
        for (int sl = 0; sl < 2; ++sl) { const int slot = (tid >> 8) + 2 * sl; const int pm = slot == 0 ? tag0 : slot == 1 ? tag1 : slot == 2 ? tag2 : tag3;
            if (pm >= 0) { const f32x4* p = (const f32x4*)(E.SS + ((size_t)pm * 256 + (tid & 255)) * 16); const f32x4 a = p[0], b = p[1], c = p[2], d = p[3]; const f32x4 t = (a + b) + (c + d);
                rstab[slot * 256 + (tid & 255)] = rsqrtf(((t[0] + t[1]) + (t[2] + t[3])) * (1.0f / 1024.0f) + 1e-6f); } }
        __syncthreads();
    }
    f32x4 acc[2][2][4][2];
#pragma unroll
    for (int a = 0; a < 2; ++a)
#pragma unroll
        for (int b = 0; b < 2; ++b)
#pragma unroll
            for (int m = 0; m < 4; ++m)
#pragma unroll
                for (int n = 0; n < 2; ++n) acc[a][b][m][n] = (f32x4){0.f, 0.f, 0.f, 0.f};
    bf16x8 At[4][2], B0[2][2], B1[2][2];
    const char* cA = (const char*)g.A + (size_t)cur.bz * g.strideA * 2 + (size_t)cur.pm * tstepA;
    const char* cB = (const char*)g.Bt + (size_t)cur.bz * g.strideB * 2 + (size_t)cur.pn * tstepB;
    PG8_STAGE(PG8_SB(0, 0), cB, voffB); PG8_STAGE(PG8_SB(0, 1), cB + hstepB, voffB); PG8_STAGE(PG8_SA(0, 0), cA, voffA); PG8_STAGE(PG8_SA(0, 1), cA + hstepA, voffA);
    if (wr == 1) PG8_BAR;
    PG8_WAIT_V(2); PG8_BAR;
    PG8_STAGE(PG8_SB(1, 0), cB + kstep, voffB); PG8_STAGE(PG8_SA(1, 0), cA + kstep, voffA); PG8_STAGE(PG8_SB(1, 1), cB + hstepB + kstep, voffB);
    PG8_WAIT_V(6); PG8_BAR;
    for (;;) {
        const bool has_next = S.next(ui + 1, nxt);
        const char* nA = has_next ? (const char*)g.A + (size_t)nxt.bz * g.strideA * 2 + (size_t)nxt.pm * tstepA : cA;
        const char* nB = has_next ? (const char*)g.Bt + (size_t)nxt.bz * g.strideB * 2 + (size_t)nxt.pn * tstepB : cB;
        for (int t = 0; t < nt; t += 2) {
            const bool last = (t == nt - 2);
            const char* a1 = cA + (size_t)(t + 1) * kstep;
            const char* a2 = last ? nA : cA + (size_t)(t + 2) * kstep; const char* b2 = last ? nB : cB + (size_t)(t + 2) * kstep;
            const char* a3 = a2 + kstep; const char* b3 = b2 + kstep;
            PG8_LDB(B0, 0, 0); PG8_LDB(B1, 0, 1); PG8_SCHED; PG8_LDA(At, 0, 0); PG8_STAGE(PG8_SA(1, 1), a1 + hstepA, voffA);
            PG8_WAIT_V(8); PG8_WAIT_L(0); PG8_BAR; PG8_MMA(0, 0, At, B0); PG8_MMA(0, 1, At, B1); PG8_BAR; PG8_SCHED;
            PG8_LDA(At, 0, 1); PG8_STAGE(PG8_SB(0, 0), b2, voffB); PG8_STAGE(PG8_SB(0, 1), b2 + hstepB, voffB); PG8_STAGE(PG8_SA(0, 0), a2, voffA);
            PG8_WAIT_V(8); PG8_WAIT_L(0); PG8_BAR; PG8_MMA(1, 0, At, B0); PG8_MMA(1, 1, At, B1); PG8_BAR; PG8_SCHED;
            PG8_LDB(B0, 1, 0); PG8_LDB(B1, 1, 1); PG8_SCHED; PG8_LDA(At, 1, 0); PG8_STAGE(PG8_SA(0, 1), a2 + hstepA, voffA);
            PG8_WAIT_V(8); PG8_WAIT_L(0); PG8_BAR; PG8_MMA(0, 0, At, B0); PG8_MMA(0, 1, At, B1); PG8_BAR; PG8_SCHED;
            PG8_LDA(At, 1, 1); PG8_STAGE(PG8_SB(1, 0), b3, voffB); PG8_STAGE(PG8_SB(1, 1), b3 + hstepB, voffB); PG8_STAGE(PG8_SA(1, 0), a3, voffA);
            PG8_WAIT_V(8); PG8_WAIT_L(0); PG8_BAR; PG8_MMA(1, 0, At, B0); PG8_MMA(1, 1, At, B1); PG8_BAR; PG8_SCHED;
        }
        if (wr == 0) PG8_BAR;
        E(acc, cur, wr, wc, fr, fq, rstab + (cur.pm == tag1 ? 256 : cur.pm == tag2 ? 512 : cur.pm == tag3 ? 768 : 0));
        if (!has_next) break;
#pragma unroll
        for (int a = 0; a < 2; ++a)
#pragma unroll
            for (int b = 0; b < 2; ++b)
#pragma unroll
                for (int m = 0; m < 4; ++m)
#pragma unroll
                    for (int n = 0; n < 2; ++n) acc[a][b][m][n] = (f32x4){0.f, 0.f, 0.f, 0.f};
        cur = nxt; cA = nA; cB = nB; ++ui;
        if (wr == 1) PG8_BAR;
    }
    PG8_WAIT_V(0);
    PG8_BAR;
#undef PG8_SA
#undef PG8_SB
#undef PG8_STAGE
#undef PG8_LDA
#undef PG8_LDB
#undef PG8_MMA
#undef PG8_WAIT_V
#undef PG8_WAIT_L
#undef PG8_BAR
#undef PG8_SCHED
}
}
using pg8::Unit;
typedef const f32x4 (&AccRef)[2][2][4][2];

struct EpiSwiGLU {
    static constexpr bool PERM = true, RSTD = true;
    bf16_t* O; const float* SS;
    __device__ __forceinline__ void operator()(AccRef acc, const Unit& u, int wr, int wc, int fr, int fq, const LAS float* rsl) const {
        const int row0 = u.pm * 256 + wr * 64 + fr, col0 = u.pn * 128 + wc * 32 + 8 * fq;
#pragma unroll
        for (int ai = 0; ai < 2; ++ai)
#pragma unroll
            for (int m = 0; m < 4; ++m) { bf16_t* rowp = O + (size_t)(row0 + ai * 128 + m * 16) * 2816 + col0; uint4 w; const float rs = rsl[ai * 128 + wr * 64 + m * 16 + fr];
                { const f32x4 gt = rs * acc[ai][0][m][0], up = rs * acc[ai][1][m][0]; w.x = pack2(silu_f(gt[0]) * up[0], silu_f(gt[1]) * up[1]); w.y = pack2(silu_f(gt[2]) * up[2], silu_f(gt[3]) * up[3]); }
                { const f32x4 gt = rs * acc[ai][0][m][1], up = rs * acc[ai][1][m][1]; w.z = pack2(silu_f(gt[0]) * up[0], silu_f(gt[1]) * up[1]); w.w = pack2(silu_f(gt[2]) * up[2], silu_f(gt[3]) * up[3]); }
                *(uint4*)rowp = w; }
    }
};
template <bool STATS> struct EpiResid {
    static constexpr bool PERM = true, RSTD = false;
    const float* Xin; float* X; bf16_t* XB; float* SS; float alpha;
    __device__ __forceinline__ void operator()(AccRef acc, const Unit& u, int wr, int wc, int fr, int fq, const LAS float* rsl) const {
        const int row0 = u.pm * 256 + wr * 64 + fr, col0 = u.pn * 256 + wc * 32 + 8 * fq;
#pragma unroll
        for (int ai = 0; ai < 2; ++ai)
#pragma unroll
            for (int m = 0; m < 4; ++m) { const size_t ro = (size_t)(row0 + ai * 128 + m * 16) * 1024 + col0; float sq = 0.f;
#pragma unroll
                for (int bj = 0; bj < 2; ++bj) { const size_t o = ro + bj * 128; const f32x4 x0 = *(const f32x4*)(Xin + o), x1 = *(const f32x4*)(Xin + o + 4);
                    const f32x4 y0 = x0 + alpha * acc[ai][bj][m][0], y1 = x1 + alpha * acc[ai][bj][m][1]; *(f32x4*)(X + o) = y0; *(f32x4*)(X + o + 4) = y1;
                    if (STATS) { uint4 w; w.x = pack2(y0[0], y0[1]); w.y = pack2(y0[2], y0[3]); w.z = pack2(y1[0], y1[1]); w.w = pack2(y1[2], y1[3]); *(uint4*)(XB + o) = w;
                        sq += y0[0] * y0[0] + y0[1] * y0[1] + y0[2] * y0[2] + y0[3] * y0[3] + y1[0] * y1[0] + y1[1] * y1[1] + y1[2] * y1[2] + y1[3] * y1[3]; } }
                if (STATS) { sq += __shfl_xor(sq, 16); sq += __shfl_xor(sq, 32); if (fq == 0) SS[(size_t)(row0 + ai * 128 + m * 16) * 16 + u.pn * 4 + wc] = sq; } }
    }
};
struct EpiBf16 {
    static constexpr bool PERM = true, RSTD = true;
    bf16_t* O; int ldc; const float* SS;
    __device__ __forceinline__ void operator()(AccRef acc, const Unit& u, int wr, int wc, int fr, int fq, const LAS float* rsl) const {
        const int row0 = u.pm * 256 + wr * 64 + fr, col0 = u.pn * 256 + wc * 32 + 8 * fq;
#pragma unroll
        for (int ai = 0; ai < 2; ++ai)
#pragma unroll
            for (int m = 0; m < 4; ++m) { bf16_t* rowp = O + (size_t)(row0 + ai * 128 + m * 16) * ldc + col0; const float rs = rsl[ai * 128 + wr * 64 + m * 16 + fr];
#pragma unroll
                for (int bj = 0; bj < 2; ++bj) { const f32x4 v0 = rs * acc[ai][bj][m][0], v1 = rs * acc[ai][bj][m][1]; uint4 w; w.x = pack2(v0[0], v0[1]); w.y = pack2(v0[2], v0[3]); w.z = pack2(v1[0], v1[1]); w.w = pack2(v1[2], v1[3]);
                    *(uint4*)(rowp + bj * 128) = w; } }
    }
};
struct EpiRetIn {
    static constexpr bool PERM = true, RSTD = true;
    bf16_t* O; int ldc; const float* SS; const float* cs; const float* sn; int rowbase;
    __device__ __forceinline__ void operator()(AccRef acc, const Unit& u, int wr, int wc, int fr, int fq, const LAS float* rsl) const {
        const int row0 = u.pm * 256 + wr * 64 + fr, col0 = u.pn * 256 + wc * 32 + 8 * fq, f = 16 * wc + 4 * fq;
#pragma unroll
        for (int ai = 0; ai < 2; ++ai)
#pragma unroll
            for (int m = 0; m < 4; ++m) { const int r = row0 + ai * 128 + m * 16; bf16_t* rowp = O + (size_t)r * ldc + col0; const float rs = rsl[ai * 128 + wr * 64 + m * 16 + fr];
                f32x4 c4 = (f32x4){1.f, 1.f, 1.f, 1.f}, s4 = (f32x4){0.f, 0.f, 0.f, 0.f};
                if (u.pn < 8) { const int pos = (rowbase + r) & 8191; c4 = *(const f32x4*)(cs + pos * 64 + f); s4 = *(const f32x4*)(sn + pos * 64 + f);
                    if (u.pn >= 4) { c4 *= 0.08838834764831845f; s4 *= 0.08838834764831845f; } }
#pragma unroll
                for (int bj = 0; bj < 2; ++bj) { const f32x4 t1 = rs * acc[ai][bj][m][0], t2 = rs * acc[ai][bj][m][1]; const f32x4 v0 = t1 * c4 - t2 * s4, v1 = t1 * s4 + t2 * c4;
                    uint4 w; w.x = pack2(v0[0], v0[1]); w.y = pack2(v0[2], v0[3]); w.z = pack2(v1[0], v1[1]); w.w = pack2(v1[2], v1[3]);
                    *(uint4*)(rowp + bj * 128) = w; } }
    }
};
struct EpiWin0 {
    static constexpr bool PERM = true, RSTD = true;
    bf16_t* AS5; bf16_t* PQ; const float* SS;
    __device__ __forceinline__ void operator()(AccRef acc, const Unit& u, int wr, int wc, int fr, int fq, const LAS float* rsl) const {
        const int row0 = u.pm * 256 + wr * 64 + fr, col0 = u.pn * 256 + wc * 32 + 8 * fq;
#pragma unroll
        for (int ai = 0; ai < 2; ++ai)
#pragma unroll
            for (int m = 0; m < 4; ++m) { const int r = row0 + ai * 128 + m * 16; const float rs = rsl[ai * 128 + wr * 64 + m * 16 + fr];
#pragma unroll
                for (int bj = 0; bj < 2; ++bj) { const int c = col0 + bj * 128; const f32x4 v0 = rs * acc[ai][bj][m][0], v1 = rs * acc[ai][bj][m][1];
                    uint4 w; w.x = pack2(v0[0], v0[1]); w.y = pack2(v0[2], v0[3]); w.z = pack2(v1[0], v1[1]); w.w = pack2(v1[2], v1[3]);
                    if (u.pn < 2) *(uint4*)(AS5 + ((size_t)((c >> 4) * 1024 + (r >> 6))) * 1280 + (r & 63) * 16 + (c & 15)) = w;
                    else *(uint4*)(PQ + (size_t)r * 1792 + (c - 512)) = w; } }
    }
};
struct EpiGLU {
    static constexpr bool PERM = true, RSTD = false;
    const bf16_t* GY; bf16_t* MIX;
    __device__ __forceinline__ void operator()(AccRef acc, const Unit& u, int wr, int wc, int fr, int fq, const LAS float* rsl) const {
        const int row0 = u.pm * 256 + wr * 64 + fr, col0 = u.pn * 256 + wc * 32 + 8 * fq;
#pragma unroll
        for (int ai = 0; ai < 2; ++ai)
#pragma unroll
            for (int m = 0; m < 4; ++m) { const int r = row0 + ai * 128 + m * 16;
#pragma unroll
                for (int bj = 0; bj < 2; ++bj) { const int c = col0 + bj * 128; const f32x4 v0 = acc[ai][bj][m][0], v1 = acc[ai][bj][m][1];
                    const uint4 gy = *(const uint4*)(GY + (size_t)r * 512 + c); uint4 w;
                    w.x = pack2(bflo(gy.x) * fast_sigmoid(v0[0]), bfhi(gy.x) * fast_sigmoid(v0[1])); w.y = pack2(bflo(gy.y) * fast_sigmoid(v0[2]), bfhi(gy.y) * fast_sigmoid(v0[3]));
                    w.z = pack2(bflo(gy.z) * fast_sigmoid(v1[0]), bfhi(gy.z) * fast_sigmoid(v1[1])); w.w = pack2(bflo(gy.w) * fast_sigmoid(v1[2]), bfhi(gy.w) * fast_sigmoid(v1[3]));
                    *(uint4*)(MIX + (size_t)r * 1024 + c) = w; } }
    }
};
struct EpiS5E {
    static constexpr bool PERM = false, RSTD = false;
    float* E;
    __device__ __forceinline__ void operator()(AccRef acc, const Unit& u, int wr, int wc, int fr, int fq, const LAS float* rsl) const {
        const int row0 = u.pm * 256 + wr * 64 + fr, col0 = wc * 32 + 4 * fq;
#pragma unroll
        for (int ai = 0; ai < 2; ++ai)
#pragma unroll
            for (int m = 0; m < 4; ++m) { float* rowp = E + ((size_t)u.bz * 1024 + row0 + ai * 128 + m * 16) * 256 + col0;
#pragma unroll
                for (int bj = 0; bj < 2; ++bj)
#pragma unroll
                    for (int n = 0; n < 2; ++n) *(f32x4*)(rowp + bj * 128 + n * 16) = acc[ai][bj][m][n]; }
    }
};
struct EpiS5Y {
    static constexpr bool PERM = true, RSTD = false;
    bf16_t* GY;
    __device__ __forceinline__ void operator()(AccRef acc, const Unit& u, int wr, int wc, int fr, int fq, const LAS float* rsl) const {
        const int row0 = u.pm * 256 + wr * 64 + fr, col0 = u.pn * 256 + wc * 32 + 8 * fq;
#pragma unroll
        for (int ai = 0; ai < 2; ++ai)
#pragma unroll
            for (int m = 0; m < 4; ++m) { const int bc = row0 + ai * 128 + m * 16;
#pragma unroll
                for (int bj = 0; bj < 2; ++bj) { const int c = col0 + bj * 128; const f32x4 v0 = acc[ai][bj][m][0], v1 = acc[ai][bj][m][1]; uint4 w;
                    w.x = pack2(gelu_tanh(v0[0]), gelu_tanh(v0[1])); w.y = pack2(gelu_tanh(v0[2]), gelu_tanh(v0[3])); w.z = pack2(gelu_tanh(v1[0]), gelu_tanh(v1[1])); w.w = pack2(gelu_tanh(v1[2]), gelu_tanh(v1[3]));
                    *(uint4*)(GY + ((size_t)bc * 64 + (c >> 4)) * 512 + u.bz * 16 + (c & 15)) = w; } }
    }
};

__device__ void transpose_job(const float* __restrict__ src, int K, int Nsrc, bf16_t* __restrict__ dst, int Ndst, int mode, LAS float* tile, int b0, int nb, const float* __restrict__ gain) {
    const int tid = otid();
    const int ntk = K >> 8, nt = (Ndst >> 6) * ntk;
    for (int t = obid() - b0; t < nt; t += nb) {
        const int tn = t / ntk, tk = t % ntk, n0 = tn * 64, k0 = tk * 256;
        int ns0 = n0;
        if (mode == 1) { const int tt = n0 >> 8, j = n0 & 255; ns0 = (j < 128) ? (tt * 128 + j) : (2816 + tt * 128 + (j - 128)); }
        const int r = tid >> 4; int c4 = (tid & 15) * 4;
        const int c4d = c4;
        if (mode == 2 && n0 < 2048) { const int s_ = (n0 + c4) & 127;
            c4 = ((n0 + c4) & ~127) + 64 * ((s_ >> 2) & 1) + 16 * (s_ >> 5) + 4 * ((s_ >> 3) & 3) - n0; }
        float4 v[8];
#pragma unroll
        for (int rr = 0; rr < 8; ++rr) { v[rr] = make_float4(0.f, 0.f, 0.f, 0.f);
            if (ns0 + c4 + 3 < Nsrc) v[rr] = *(const float4*)(src + (size_t)(k0 + r + rr * 32) * Nsrc + ns0 + c4);
            if (gain) { const float gk = gain[k0 + r + rr * 32]; v[rr].x *= gk; v[rr].y *= gk; v[rr].z *= gk; v[rr].w *= gk; } }
#pragma unroll
        for (int rr = 0; rr < 8; ++rr) { const int kk = r + rr * 32; LAS float* tp = tile + (kk >> 6) * (64 * 65) + (kk & 63) * 65 + c4d;
            tp[0] = v[rr].x; tp[1] = v[rr].y; tp[2] = v[rr].z; tp[3] = v[rr].w; }
        __syncthreads();
        const int n = tid >> 3, kq = (tid & 7) * 8;
#pragma unroll
        for (int kt = 0; kt < 4; ++kt) { const LAS float* tp = tile + kt * (64 * 65); uint4 w;
            w.x = pack2(tp[(kq + 0) * 65 + n], tp[(kq + 1) * 65 + n]); w.y = pack2(tp[(kq + 2) * 65 + n], tp[(kq + 3) * 65 + n]);
            w.z = pack2(tp[(kq + 4) * 65 + n], tp[(kq + 5) * 65 + n]); w.w = pack2(tp[(kq + 6) * 65 + n], tp[(kq + 7) * 65 + n]);
            *(uint4*)(dst + (size_t)(n0 + n) * K + k0 + kt * 64 + kq) = w; }
        __syncthreads();
    }
}

__device__ void s5_pre(CP P, int g, int dir, int part, LAS unsigned char* lds) {
    LAS f32x2* pw = (LAS f32x2*)lds;
    LAS f32x2* Bb = pw + 65 * 64;
    LAS f32x2* Cc = Bb + 64 * 16;
    const int tid = otid();
    float* Ktab = (float*)(P->ws + OFF_KTAB); float* AT = (float*)(P->ws + OFF_S5P);
    bf16_t* KG = (bf16_t*)(P->ws + OFF_KG); bf16_t* H = (bf16_t*)(P->ws + OFF_H);
    if (tid < 64) { const int n = tid, gi = (dir * 32 + g) * 64 + n;
        const double lr = fmin((double)P->in[9][gi], -1e-4), li = (double)P->in[10][gi], dt = (double)expf(P->in[15][dir * 32 + g]);
        const double em1 = (double)expm1f((float)(lr * dt)), mag = 1.0 + em1;
        double rev = li * dt * 0.15915494309189535; rev -= rint(rev); const float th = (float)(rev * 6.283185307179586), thh = 0.5f * th;
        const double sn_ = (double)sinf(th), shalf = (double)sinf(thh), cm1 = -2.0 * shalf * shalf;
        const double ar = mag * (1.0 + cm1), ai = mag * sn_, arm1 = em1 + cm1 + em1 * cm1, den = lr * lr + li * li;
        const double cr = (arm1 * lr + ai * li) / den, ci = (ai * lr - arm1 * li) / den;
#pragma unroll 1
        for (int p = 0; p < 16; ++p) { const double br = (double)P->in[11][gi * 16 + p], bi = (double)P->in[12][gi * 16 + p];
            Bb[n * 16 + p] = mkf2((float)(cr * br - ci * bi), (float)(cr * bi + ci * br)); }
        double xr = 1.0, xi = 0.0;
#pragma unroll 1
        for (int d = 0; d <= 64; ++d) { pw[d * 64 + n] = mkf2((float)xr, (float)xi); const double t0 = xr * ar - xi * ai; xi = xr * ai + xi * ar; xr = t0; }
        const f32x2 a64 = pw[64 * 64 + n];
        if (part == 0) { AT[((g * 2 + dir) * 64 + n) * 2 + 0] = a64.x; AT[((g * 2 + dir) * 64 + n) * 2 + 1] = a64.y; } }
#pragma unroll 1
    for (int idx = tid; idx < 16 * 64; idx += NTHR) { const int p = idx >> 6, n = idx & 63; const int ci_ = ((dir * 32 + g) * 16 + p) * 64 + n;
        Cc[idx] = mkf2(P->in[13][ci_], P->in[14][ci_]); }
    __syncthreads();
    { const int dq = tid >> 8, p = (tid >> 4) & 15, pp = tid & 15;
#pragma unroll 1
        for (int dd = 0; dd < 16; ++dd) { const int d = part * 32 + dq * 16 + dd; float acc = 0.f;
#pragma unroll 4
            for (int n = 0; n < 64; ++n) { const f32x2 w = pw[d * 64 + n], bb = Bb[n * 16 + pp], c = Cc[p * 64 + n];
                const float zr = w.x * bb.x - w.y * bb.y, zi = w.x * bb.y + w.y * bb.x; acc += c.x * zr - c.y * zi; }
            Ktab[((size_t)((g * 2 + dir) * 64 + d)) * 256 + p * 16 + pp] = acc; } }
#pragma unroll 1
    for (int idx = tid; idx < 512 * 64; idx += NTHR) { const int row = part * 512 + (idx >> 6), n = idx & 63, t = row >> 4, p = row & 15, d = dir == 0 ? t + 1 : 64 - t;
        const f32x2 w = pw[d * 64 + n], c = Cc[p * 64 + n]; const float gr = c.x * w.x - c.y * w.y, gi = c.x * w.y + c.y * w.x;
        *(unsigned*)(KG + ((size_t)(g * 1024 + row)) * 1280 + 1024 + dir * 128 + n * 2) = pack2(gr, -gi); }
#pragma unroll 1
    for (int idx = tid; idx < 32 * 64 * 8; idx += NTHR) { const int pp2 = (idx & 7) * 2, s = (idx >> 3) & 63, n = part * 32 + (idx >> 9), d = dir == 0 ? 63 - s : s;
        const f32x2 w = pw[d * 64 + n], b0 = Bb[n * 16 + pp2], b1 = Bb[n * 16 + pp2 + 1];
        const float hr0 = w.x * b0.x - w.y * b0.y, hi0 = w.x * b0.y + w.y * b0.x, hr1 = w.x * b1.x - w.y * b1.y, hi1 = w.x * b1.y + w.y * b1.x;
        const size_t row0 = (size_t)g * 256 + dir * 128 + n * 2;
        *(unsigned*)(H + row0 * 1024 + s * 16 + pp2) = pack2(hr0, hr1); *(unsigned*)(H + (row0 + 1) * 1024 + s * 16 + pp2) = pack2(hi0, hi1); }
    __syncthreads();
}

template <bool FINAL> __device__ void phase_norm(const float* __restrict__ x, const float* __restrict__ g, bf16_t* __restrict__ xb, float* __restrict__ ss_out, float* __restrict__ outf, int b0, int nb, int rbeg, int rend);
__device__ void phase_prologue(CP P, LAS unsigned char* lds) {
    const int tid = otid(), bq = obid();
    if (bq < 128) { if (EN(20)) s5_pre(P, bq >> 2, (bq >> 1) & 1, bq & 1, lds);
        phase_norm<false>(P->in[0], nullptr, (bf16_t*)(P->ws + OFF_XN), (float*)(P->ws + OFF_SSQ), nullptr, 0, 128, 0, 40960); return; }
    const int b0 = 128, nb = (int)gridDim.x - 128;
    if (EN(21)) { float* cs = (float*)(P->ws + OFF_ROPE); float* sn = cs + 8192 * 64;
        for (int idx = (bq - b0) * NTHR + tid; idx < 8192 * 64; idx += nb * NTHR) { const int pos = idx >> 6, f = idx & 63;
            const float inv = expf(-9.210340371976184f * (float)f * (1.0f / 64.0f)); const float ang = (float)pos * inv;
            cs[idx] = cosf(ang); sn[idx] = sinf(ang); } }
    phase_norm<false>(P->in[0], nullptr, (bf16_t*)(P->ws + OFF_XN), (float*)(P->ws + OFF_SSQ), nullptr, b0, nb, 40960, 65536);
    LAS float* tile = (LAS float*)lds;
    if (EN(22)) for (int l = 0; l < 2; ++l) {
        transpose_job(P->in[2] + (size_t)l * 1024 * 5632, 1024, 5632, (bf16_t*)(P->ws + OFF_W1 + (size_t)(2 * l) * SZ_W1), 5632, 1, tile, b0, nb, P->in[1] + l * 1024);
        transpose_job(P->in[6] + (size_t)l * 1024 * 5632, 1024, 5632, (bf16_t*)(P->ws + OFF_W1 + (size_t)(2 * l + 1) * SZ_W1), 5632, 1, tile, b0, nb, P->in[5] + l * 1024);
        transpose_job(P->in[3] + (size_t)l * 2816 * 1024, 2816, 1024, (bf16_t*)(P->ws + OFF_W2 + (size_t)(2 * l) * SZ_W2), 1024, 0, tile, b0, nb, nullptr);
        transpose_job(P->in[7] + (size_t)l * 2816 * 1024, 2816, 1024, (bf16_t*)(P->ws + OFF_W2 + (size_t)(2 * l + 1) * SZ_W2), 1024, 0, tile, b0, nb, nullptr);
    }
    if (EN(22)) transpose_job(P->in[8], 1024, 2080, (bf16_t*)(P->ws + OFF_WIN0), 2304, 0, tile, b0, nb, P->in[4]);
    if (EN(22)) transpose_job(P->in[17], 512, 512, (bf16_t*)(P->ws + OFF_WGLU), 512, 0, tile, b0, nb, nullptr);
    if (EN(22)) transpose_job(P->in[21], 1024, 1024, (bf16_t*)(P->ws + OFF_WOUT0), 1024, 0, tile, b0, nb, nullptr);
    if (EN(22)) transpose_job(P->in[22], 1024, 6144, (bf16_t*)(P->ws + OFF_WIN1), 6144, 2, tile, b0, nb, P->in[4] + 1024);
    if (EN(22)) transpose_job(P->in[24], 2048, 1024, (bf16_t*)(P->ws + OFF_WOUT1), 1024, 0, tile, b0, nb, nullptr);
}

__device__ void phase_kmat(CP P) {
    const float* Ktab = (const float*)(P->ws + OFF_KTAB); bf16_t* KG = (bf16_t*)(P->ws + OFF_KG); const float* dsk = P->in[16];
    for (int idx = obid() * NTHR + otid(); idx < 32 * 1024 * 512; idx += gridDim.x * NTHR) {
        const int kp = idx & 511, row = (idx >> 9) & 1023, g = idx >> 19, t = row >> 4, p = row & 15, k = kp * 2, s = k >> 4, pp = k & 15;
        float v0 = 0.f, v1 = 0.f;
        if (s <= t) { const float* b = Ktab + ((size_t)((g * 2 + 0) * 64 + (t - s))) * 256 + p * 16 + pp; v0 += b[0]; v1 += b[1]; }
        if (s >= t) { const float* b = Ktab + ((size_t)((g * 2 + 1) * 64 + (s - t))) * 256 + p * 16 + pp; v0 += b[0]; v1 += b[1]; }
        if (s == t) { const float dv = dsk[g * 16 + p]; if (pp == p) v0 += dv; if (pp + 1 == p) v1 += dv; }
        *(unsigned*)(KG + ((size_t)(g * 1024 + row)) * 1280 + k) = pack2(v0, v1);
    }
}

template <bool FINAL>
__device__ void phase_norm(const float* __restrict__ x, const float* __restrict__ g, bf16_t* __restrict__ xb, float* __restrict__ ss_out, float* __restrict__ outf, int b0, int nb, int rbeg, int rend) {
    const int tid_ = otid(), lane = tid_ & 63, wid = tid_ >> 6; const int bq = obid() - b0;
    if (bq < 0) return;
    f32x4 gv[4];
#pragma unroll
    for (int i = 0; i < 4; ++i) gv[i] = FINAL ? *(const f32x4*)(g + (lane + 64 * i) * 4) : (f32x4){1.f, 1.f, 1.f, 1.f};
    for (int row0 = rbeg + bq * 8 + wid; row0 < rend; row0 += nb * 16) {
        const int row1 = row0 + nb * 8; const bool has1 = row1 < rend;
        const float* xr0 = x + (size_t)row0 * 1024; const float* xr1 = x + (size_t)(has1 ? row1 : row0) * 1024; f32x4 v[4], u[4]; float ss = 0.f, st = 0.f;
#pragma unroll
        for (int i = 0; i < 4; ++i) { v[i] = *(const f32x4*)(xr0 + (lane + 64 * i) * 4); u[i] = *(const f32x4*)(xr1 + (lane + 64 * i) * 4); }
#pragma unroll
        for (int i = 0; i < 4; ++i) { ss += v[i][0] * v[i][0] + v[i][1] * v[i][1] + v[i][2] * v[i][2] + v[i][3] * v[i][3]; st += u[i][0] * u[i][0] + u[i][1] * u[i][1] + u[i][2] * u[i][2] + u[i][3] * u[i][3]; }
#pragma unroll
        for (int o = 32; o > 0; o >>= 1) { ss += __shfl_xor(ss, o); st += __shfl_xor(st, o); }
#pragma unroll
        for (int rr = 0; rr < 2; ++rr) { if (rr == 1 && !has1) break; const int row = rr ? row1 : row0; const float sv = rr ? st : ss;
            if (FINAL) { const float rstd = rsqrtf(sv * (1.0f / 1024.0f) + 1e-6f);
#pragma unroll
                for (int i = 0; i < 4; ++i) *(f32x4*)(outf + (size_t)row * 1024 + (lane + 64 * i) * 4) = (rr ? u[i] : v[i]) * rstd * gv[i]; }
            else { if (lane < 16) ss_out[(size_t)row * 16 + lane] = lane == 0 ? sv : 0.f;
#pragma unroll
                for (int i = 0; i < 4; ++i) { const f32x4 y = rr ? u[i] : v[i]; uint2 w; w.x = pack2(y[0], y[1]); w.y = pack2(y[2], y[3]); *(uint2*)(xb + (size_t)row * 1024 + (lane + 64 * i) * 4) = w; } } }
    }
}

__device__ __forceinline__ f32x4 mma16(const LAS bf16_t* As, int lda, const LAS bf16_t* Bs, int ldb, int K, f32x4 acc, int lane) {
    const int r = lane & 15, q = lane >> 4;
#pragma unroll
    for (int k = 0; k < K; k += 32) { const bf16x8 a = *(const LAS bf16x8*)(As + r * lda + k + q * 8); const bf16x8 b = *(const LAS bf16x8*)(Bs + r * ldb + k + q * 8);
        acc = __builtin_amdgcn_mfma_f32_16x16x32_bf16(b, a, acc, 0, 0, 0); }
    return acc;
}


typedef short s16x4 __attribute__((ext_vector_type(4)));
__device__ __forceinline__ bf16x8 frag_tr(const LAS bf16_t* T, int ld, int lane) {
    const int g = lane >> 4, qq = (lane & 15) >> 2, p = lane & 3;
    LAS bf16_t* a = (LAS bf16_t*)T + (8 * g + qq) * ld + 4 * p;
    const s16x4 lo = __builtin_amdgcn_ds_read_tr16_b64_v4i16((LAS s16x4*)a);
    const s16x4 hi = __builtin_amdgcn_ds_read_tr16_b64_v4i16((LAS s16x4*)(a + 4 * ld));
    return (bf16x8){lo[0], lo[1], lo[2], lo[3], hi[0], hi[1], hi[2], hi[3]};
}

__device__ __forceinline__ void lds_barrier() { asm volatile("s_waitcnt lgkmcnt(0)" ::: "memory"); __builtin_amdgcn_s_barrier(); asm volatile("" ::: "memory"); }

__device__ void phase_s5_scan(CP P) {
    const float* E = (const float*)(P->ws + OFF_E); const float* AT = (const float*)(P->ws + OFF_S5P); bf16_t* AS5 = (bf16_t*)(P->ws + OFF_AS5);
    const int tid_ = otid(); if (tid_ >= 128) return;
    for (int idx = obid() * 128 + tid_; idx < 32 * 8 * 2 * 64; idx += gridDim.x * 128) {
        const int n = idx & 63, dir = (idx >> 6) & 1, b = (idx >> 7) & 7, g = idx >> 10;
        const float ar = AT[((g * 2 + dir) * 64 + n) * 2], ai = AT[((g * 2 + dir) * 64 + n) * 2 + 1];
        float xr = 0.f, xi = 0.f;
#pragma unroll 16
        for (int cc = 0; cc < 128; ++cc) { const int c = dir == 0 ? cc : 127 - cc; const size_t bc = (size_t)g * 1024 + b * 128 + c;
            *(unsigned*)(AS5 + bc * 1280 + 1024 + dir * 128 + n * 2) = pack2(xr, xi);
            const float2 e = *(const float2*)(E + bc * 256 + dir * 128 + n * 2);
            const float t0 = ar * xr - ai * xi + e.x; xi = ar * xi + ai * xr + e.y; xr = t0; }
    }
}

__device__ __forceinline__ void gla_gates(CP P, const bf16_t* PQ, int m0, int h, LAS unsigned char* lds) {
    LAS float* gl = (LAS float*)lds; LAS float* tot = (LAS float*)(lds + 8192); LAS float* G = (LAS float*)(lds + 17408);
    const int tid = otid();
    const int dir = tid >> 8, d = tid & 63, tq = (tid >> 6) & 3;
    { const int idx = tid * 4, t = idx >> 5, r = idx & 31; const uint2 raw = *(const uint2*)(PQ + (size_t)(m0 + t) * 1792 + 1536 + r);
        *(LAS f32x4*)(gl + idx) = (f32x4){bflo(raw.x), bfhi(raw.x), bflo(raw.y), bfhi(raw.y)}; }
    float w[16];
#pragma unroll
    for (int r = 0; r < 16; ++r) w[r] = P->in[18][(dir * 16 + r) * 256 + h * 64 + d];
    const float b = P->in[19][dir * 256 + h * 64 + d];
    lds_barrier();
    float c[16];
#pragma unroll
    for (int i = 0; i < 16; ++i) { const int t = tq * 16 + i; float z = b;
#pragma unroll
        for (int r4 = 0; r4 < 4; ++r4) { const f32x4 g4 = *(const LAS f32x4*)(gl + t * 32 + dir * 16 + r4 * 4);
            z += g4[0] * w[r4 * 4] + g4[1] * w[r4 * 4 + 1] + g4[2] * w[r4 * 4 + 2] + g4[3] * w[r4 * 4 + 3]; }
        c[i] = (fminf(z, 0.f) - __logf(1.0f + __expf(-fabsf(z)))) * (1.0f / 16.0f); }
    if (dir == 0) {
#pragma unroll
        for (int i = 1; i < 16; ++i) c[i] += c[i - 1];
        tot[(dir * 4 + tq) * 64 + d] = c[15]; }
    else {
#pragma unroll
        for (int i = 14; i >= 0; --i) c[i] += c[i + 1];
        tot[(dir * 4 + tq) * 64 + d] = c[0]; }
    lds_barrier();
    float off = 0.f;
#pragma unroll
    for (int q = 0; q < 4; ++q) { const float tv = tot[(dir * 4 + q) * 64 + d]; off += ((dir == 0) ? (q < tq) : (q > tq)) ? tv : 0.f; }
#pragma unroll
    for (int i = 0; i < 16; ++i) G[(dir * 64 + tq * 16 + i) * 64 + d] = c[i] + off;
    lds_barrier();
}

__device__ void gla_a_unit(CP P, int unit, LAS unsigned char* lds) {
    const int c = unit & 127, h = (unit >> 7) & 3, b = unit >> 9, m0 = b * 8192 + c * 64;
    const bf16_t* PQ = (const bf16_t*)(P->ws + OFF_PQ); bf16_t* GST = (bf16_t*)(P->ws + OFF_GST); float* GDEC = (float*)(P->ws + OFF_GDEC);
    const int tid = otid(), lane = tid & 63, wid = tid >> 6;
    const int t = tid >> 3, d8 = (tid & 7) * 8, v16 = (tid & 7) * 16;
    const uint4 kraw = *(const uint4*)(PQ + (size_t)(m0 + t) * 1792 + 256 + h * 64 + d8);
    const uint4 vr0 = *(const uint4*)(PQ + (size_t)(m0 + t) * 1792 + 512 + h * 128 + v16), vr1 = *(const uint4*)(PQ + (size_t)(m0 + t) * 1792 + 512 + h * 128 + v16 + 8);
    gla_gates(P, PQ, m0, h, lds);
    LAS float* G = (LAS float*)(lds + 17408);
    LAS bf16_t* kA = (LAS bf16_t*)(lds + 50176);
    LAS bf16_t* Vs = (LAS bf16_t*)(lds + 67584);
    { const unsigned rw[4] = {kraw.x, kraw.y, kraw.z, kraw.w}; float ef[8], eb[8];
#pragma unroll
        for (int q = 0; q < 2; ++q) { const f32x4 lf = *(const LAS f32x4*)(G + 63 * 64 + d8 + q * 4), cf = *(const LAS f32x4*)(G + t * 64 + d8 + q * 4);
            const f32x4 lb = *(const LAS f32x4*)(G + 64 * 64 + d8 + q * 4), cb = *(const LAS f32x4*)(G + (64 + t) * 64 + d8 + q * 4);
#pragma unroll
            for (int j = 0; j < 4; ++j) { ef[q * 4 + j] = __expf(lf[j] - cf[j]); eb[q * 4 + j] = __expf(lb[j] - cb[j]); } }
        unsigned of[4], ob[4];
#pragma unroll
        for (int i = 0; i < 4; ++i) { const float k0 = bflo(rw[i]), k1 = bfhi(rw[i]); of[i] = pack2(k0 * ef[2 * i], k1 * ef[2 * i + 1]); ob[i] = pack2(k0 * eb[2 * i], k1 * eb[2 * i + 1]); }
        *(LAS u32x4*)(kA + t * 136 + d8) = mk4(of[0], of[1], of[2], of[3]); *(LAS u32x4*)(kA + t * 136 + 64 + d8) = mk4(ob[0], ob[1], ob[2], ob[3]);
        *(LAS u32x4*)(Vs + t * 136 + v16) = mk4(vr0.x, vr0.y, vr0.z, vr0.w); *(LAS u32x4*)(Vs + t * 136 + v16 + 8) = mk4(vr1.x, vr1.y, vr1.z, vr1.w); }
    if (tid < 128) { const int dir = tid >> 6, d = tid & 63; const float last = dir == 0 ? G[63 * 64 + d] : G[64 * 64 + d];
        GDEC[((size_t)(((b * 4 + h) * 2 + dir) * 128 + c)) * 64 + d] = __expf(last); }
    lds_barrier();
    { f32x4 acc[8];
#pragma unroll
        for (int nt = 0; nt < 8; ++nt) acc[nt] = (f32x4){0.f, 0.f, 0.f, 0.f};
#pragma unroll
        for (int ks = 0; ks < 2; ++ks) { const bf16x8 af = frag_tr(kA + ks * 32 * 136 + wid * 16, 136, lane);
#pragma unroll
            for (int nt = 0; nt < 8; ++nt) { const bf16x8 bfr = frag_tr(Vs + ks * 32 * 136 + nt * 16, 136, lane); acc[nt] = __builtin_amdgcn_mfma_f32_16x16x32_bf16(bfr, af, acc[nt], 0, 0, 0); } }
        const int row = wid * 16 + (lane & 15), dir = row >> 6, d = row & 63; bf16_t* out = GST + ((size_t)(((b * 4 + h) * 2 + dir) * 128 + c)) * 8192 + d * 128 + 4 * (lane >> 4);
#pragma unroll
        for (int nt = 0; nt < 8; ++nt) { uint2 w; w.x = pack2(acc[nt][0], acc[nt][1]); w.y = pack2(acc[nt][2], acc[nt][3]); *(uint2*)(out + nt * 16) = w; } }
    lds_barrier();
}

__device__ void phase_gla_b(CP P) {
    bf16_t* GST = (bf16_t*)(P->ws + OFF_GST); const float* GDEC = (const float*)(P->ws + OFF_GDEC);
    for (int idx = obid() * NTHR + otid(); idx < 64 * 1024; idx += gridDim.x * NTHR) {
        const int bhd = idx >> 10, e = (idx & 1023) * 8, d = e >> 7, dir = bhd & 1;
        f32x4 S0 = (f32x4){0.f, 0.f, 0.f, 0.f}, S1 = S0;
#pragma unroll 8
        for (int cc = 0; cc < 128; ++cc) { const int c = dir == 0 ? cc : 127 - cc; bf16_t* p = GST + ((size_t)(bhd * 128 + c)) * 8192 + e;
            const uint4 t = *(const uint4*)p; const float dec = GDEC[((size_t)(bhd * 128 + c)) * 64 + d];
            uint4 o; o.x = pack2(S0[0], S0[1]); o.y = pack2(S0[2], S0[3]); o.z = pack2(S1[0], S1[1]); o.w = pack2(S1[2], S1[3]); *(uint4*)p = o;
            S0 = dec * S0 + (f32x4){bflo(t.x), bfhi(t.x), bflo(t.y), bfhi(t.y)}; S1 = dec * S1 + (f32x4){bflo(t.z), bfhi(t.z), bflo(t.w), bfhi(t.w)}; }
    }
}

__device__ void gla_c_unit(CP P, int unit, LAS unsigned char* lds) {
    const int c = unit & 127, h = (unit >> 7) & 3, b = unit >> 9, m0 = b * 8192 + c * 64;
    const bf16_t* PQ = (const bf16_t*)(P->ws + OFF_PQ); const bf16_t* GST = (const bf16_t*)(P->ws + OFF_GST); bf16_t* MIX = (bf16_t*)(P->ws + OFF_XN);
    const int tid = otid(), lane = tid & 63, wid = tid >> 6;
    const int t = tid >> 3, d8 = (tid & 7) * 8, v16 = (tid & 7) * 16;
    const uint4 rq = *(const uint4*)(PQ + (size_t)(m0 + t) * 1792 + h * 64 + d8), rk = *(const uint4*)(PQ + (size_t)(m0 + t) * 1792 + 256 + h * 64 + d8);
    const uint4 vr0 = *(const uint4*)(PQ + (size_t)(m0 + t) * 1792 + 512 + h * 128 + v16), vr1 = *(const uint4*)(PQ + (size_t)(m0 + t) * 1792 + 512 + h * 128 + v16 + 8);
    const uint4 ogr0 = *(const uint4*)(PQ + (size_t)(m0 + t) * 1792 + 1024 + h * 128 + v16), ogr1 = *(const uint4*)(PQ + (size_t)(m0 + t) * 1792 + 1024 + h * 128 + v16 + 8);
    uint4 sr[4];
#pragma unroll
    for (int i = 0; i < 4; ++i) { const int idx = tid + i * NTHR, v8 = (idx & 15) * 8, d = (idx >> 4) & 63, dir = idx >> 10;
        sr[i] = *(const uint4*)(GST + ((size_t)(((b * 4 + h) * 2 + dir) * 128 + c)) * 8192 + d * 128 + v8); }
    gla_gates(P, PQ, m0, h, lds);
    LAS float* G = (LAS float*)(lds + 17408);
    LAS bf16_t* Ps = (LAS bf16_t*)lds;
    LAS bf16_t* qf = (LAS bf16_t*)(lds + 51200);
    LAS bf16_t* kf = qf + 64 * 72; LAS bf16_t* qb = kf + 64 * 72; LAS bf16_t* kb = qb + 64 * 72;
    LAS bf16_t* Vs = (LAS bf16_t*)(lds + 88064);
    LAS bf16_t* Ss = (LAS bf16_t*)(lds + 105472);
    { const unsigned qw[4] = {rq.x, rq.y, rq.z, rq.w}, kw[4] = {rk.x, rk.y, rk.z, rk.w};
        unsigned oqf[4], okf[4], oqb[4], okb[4]; float cf[8], cb[8];
#pragma unroll
        for (int q = 0; q < 2; ++q) { const f32x4 a = *(const LAS f32x4*)(G + t * 64 + d8 + q * 4), bb = *(const LAS f32x4*)(G + (64 + t) * 64 + d8 + q * 4);
#pragma unroll
            for (int j = 0; j < 4; ++j) { cf[q * 4 + j] = a[j]; cb[q * 4 + j] = bb[j]; } }
#pragma unroll
        for (int i = 0; i < 4; ++i) { const float cf0 = cf[2 * i], cf1 = cf[2 * i + 1], cb0 = cb[2 * i], cb1 = cb[2 * i + 1];
            const float q0 = bflo(qw[i]) * 0.125f, q1 = bfhi(qw[i]) * 0.125f, k0 = bflo(kw[i]), k1 = bfhi(kw[i]);
            oqf[i] = pack2(q0 * __expf(cf0), q1 * __expf(cf1)); okf[i] = pack2(k0 * __expf(-cf0), k1 * __expf(-cf1));
            oqb[i] = pack2(q0 * __expf(cb0), q1 * __expf(cb1)); okb[i] = pack2(k0 * __expf(-cb0), k1 * __expf(-cb1)); }
        *(LAS u32x4*)(qf + t * 72 + d8) = mk4(oqf[0], oqf[1], oqf[2], oqf[3]); *(LAS u32x4*)(kf + t * 72 + d8) = mk4(okf[0], okf[1], okf[2], okf[3]);
        *(LAS u32x4*)(qb + t * 72 + d8) = mk4(oqb[0], oqb[1], oqb[2], oqb[3]); *(LAS u32x4*)(kb + t * 72 + d8) = mk4(okb[0], okb[1], okb[2], okb[3]);
        *(LAS u32x4*)(Vs + t * 136 + v16) = mk4(vr0.x, vr0.y, vr0.z, vr0.w); *(LAS u32x4*)(Vs + t * 136 + v16 + 8) = mk4(vr1.x, vr1.y, vr1.z, vr1.w); }
#pragma unroll
    for (int i = 0; i < 4; ++i) { const int idx = tid + i * NTHR, v8 = (idx & 15) * 8, d = (idx >> 4) & 63, dir = idx >> 10;
        *(LAS u32x4*)(Ss + (dir * 64 + d) * 136 + v8) = mk4(sr[i].x, sr[i].y, sr[i].z, sr[i].w); }
    lds_barrier();
#pragma unroll
    for (int tl = 0; tl < 2; ++tl) { const int tile = wid * 2 + tl, mi = tile >> 2, ni = tile & 3; f32x4 pf = (f32x4){0.f, 0.f, 0.f, 0.f}, pb = pf;
        pf = mma16(qf + mi * 16 * 72, 72, kf + ni * 16 * 72, 72, 64, pf, lane); pb = mma16(qb + mi * 16 * 72, 72, kb + ni * 16 * 72, 72, 64, pb, lane);
        const int i = mi * 16 + (lane & 15), j0 = ni * 16 + 4 * (lane >> 4); float pv[4];
#pragma unroll
        for (int jj = 0; jj < 4; ++jj) pv[jj] = (j0 + jj <= i) ? pf[jj] : pb[jj];
        *(LAS u32x2*)(Ps + i * 72 + j0) = mk2(pack2(pv[0], pv[1]), pack2(pv[2], pv[3])); }
    lds_barrier();
    { const int mi = wid & 3, nb = (wid >> 2) * 4; LAS float* ost = G; f32x4 acc[4];
#pragma unroll
        for (int nt = 0; nt < 4; ++nt) acc[nt] = (f32x4){0.f, 0.f, 0.f, 0.f};
#pragma unroll
        for (int ks = 0; ks < 2; ++ks) {
            const bf16x8 ap = *(const LAS bf16x8*)(Ps + (mi * 16 + (lane & 15)) * 72 + ks * 32 + (lane >> 4) * 8);
            const bf16x8 af = *(const LAS bf16x8*)(qf + (mi * 16 + (lane & 15)) * 72 + ks * 32 + (lane >> 4) * 8);
            const bf16x8 ab = *(const LAS bf16x8*)(qb + (mi * 16 + (lane & 15)) * 72 + ks * 32 + (lane >> 4) * 8);
#pragma unroll
            for (int nt = 0; nt < 4; ++nt) { const int ni = nb + nt;
                acc[nt] = __builtin_amdgcn_mfma_f32_16x16x32_bf16(frag_tr(Vs + ks * 32 * 136 + ni * 16, 136, lane), ap, acc[nt], 0, 0, 0);
                acc[nt] = __builtin_amdgcn_mfma_f32_16x16x32_bf16(frag_tr(Ss + ks * 32 * 136 + ni * 16, 136, lane), af, acc[nt], 0, 0, 0);
                acc[nt] = __builtin_amdgcn_mfma_f32_16x16x32_bf16(frag_tr(Ss + (64 + ks * 32) * 136 + ni * 16, 136, lane), ab, acc[nt], 0, 0, 0); } }
#pragma unroll
        for (int nt = 0; nt < 4; ++nt) *(LAS f32x4*)(ost + (mi * 16 + (lane & 15)) * 132 + (nb + nt) * 16 + 4 * (lane >> 4)) = acc[nt]; }
    lds_barrier();
    { LAS float* ost = G; float o[16]; float ss = 0.f;
#pragma unroll
        for (int i = 0; i < 4; ++i) { const f32x4 v = *(const LAS f32x4*)(ost + t * 132 + v16 + i * 4); o[4 * i] = v[0]; o[4 * i + 1] = v[1]; o[4 * i + 2] = v[2]; o[4 * i + 3] = v[3]; ss += v[0] * v[0] + v[1] * v[1] + v[2] * v[2] + v[3] * v[3]; }
        ss += __shfl_xor(ss, 1); ss += __shfl_xor(ss, 2); ss += __shfl_xor(ss, 4);
        const float rstd = rsqrtf(ss * (1.0f / 128.0f) + 1e-6f);
        const float* gn = P->in[20] + h * 128 + v16;
        bf16_t* op = MIX + (size_t)(m0 + t) * 1024 + 512 + h * 128 + v16;
#pragma unroll
        for (int hh = 0; hh < 2; ++hh) { const uint4 raw = hh ? ogr1 : ogr0; const unsigned rw[4] = {raw.x, raw.y, raw.z, raw.w}; unsigned ow[4];
#pragma unroll
            for (int i = 0; i < 4; ++i) { const int e = hh * 8 + 2 * i; const float g0 = bflo(rw[i]), g1 = bfhi(rw[i]);
                ow[i] = pack2(o[e] * rstd * gn[e] * silu_f(g0), o[e + 1] * rstd * gn[e + 1] * silu_f(g1)); }
            *(uint4*)(op + hh * 8) = make_uint4(ow[0], ow[1], ow[2], ow[3]); } }
    lds_barrier();
}

__device__ __forceinline__ float ret_lg(int h) {
    float v = -0.0317486983145803f;
    v = h == 1 ? -0.015748356968139168f : v; v = h == 2 ? -0.007843177461025893f : v; v = h == 3 ? -0.003913899321136329f : v; v = h == 4 ? -0.0019550348358033506f : v;
    v = h == 5 ? -0.0009770396478266127f : v; v = h == 6 ? -0.0004884004981088745f : v; v = h == 7 ? -0.0002441704321739145f : v; return v;
}

struct KRaw { uint4 a, b; };
__device__ __forceinline__ KRaw rot_load(const bf16_t* rowp, const float*, const float*, int dq) { KRaw k; k.a = *(const uint4*)(rowp + dq); k.b = *(const uint4*)(rowp + 64 + dq); return k; }
__device__ __forceinline__ void rot_apply(const KRaw& k, float (&r1)[8], float (&r2)[8]) {
    const unsigned aw[4] = {k.a.x, k.a.y, k.a.z, k.a.w}, bw[4] = {k.b.x, k.b.y, k.b.z, k.b.w};
#pragma unroll
    for (int i = 0; i < 8; ++i) { r1[i] = (i & 1) ? bfhi(aw[i >> 1]) : bflo(aw[i >> 1]); r2[i] = (i & 1) ? bfhi(bw[i >> 1]) : bflo(bw[i >> 1]); }
}

__device__ void ret_a_unit(CP P, int hf, int unit, LAS unsigned char* lds) {
    const int sc = unit & 31, h = (unit >> 5) & 7, bl = unit >> 8;
    const bf16_t* PR = (const bf16_t*)(P->ws + OFF_PROJ1); bf16_t* RST = (bf16_t*)(P->ws + OFF_RST);
    const int tid = otid(), lane = tid & 63, wid = tid >> 6;
    const size_t r0 = (size_t)bl * 8192 + sc * 256;
    const float lgf = ret_lg(h), lgb = ret_lg(7 - h);
    LAS bf16_t* kf = (LAS bf16_t*)lds;
    LAS bf16_t* kb = (LAS bf16_t*)(lds + 17408);
    LAS bf16_t* Vs = (LAS bf16_t*)(lds + 34816);
    f32x4 acc[4][8];
#pragma unroll
    for (int a = 0; a < 4; ++a)
#pragma unroll
        for (int n = 0; n < 8; ++n) acc[a][n] = (f32x4){0.f, 0.f, 0.f, 0.f};
    const int mb = (wid >> 1) * 4, nb = (wid & 1) * 8;
    const LAS bf16_t* kA = (mb >= 8) ? kb : kf; const int dt0 = (mb & 7) * 16;
    const int pj = tid >> 3, pdq = (tid & 7) * 8, pv32 = (tid & 7) * 32;
    const bf16_t* kbase = PR + (r0 + pj) * 6144 + 1024 + h * 128; const bf16_t* vbase = PR + (r0 + pj) * 6144 + 2048 + h * 256 + pv32;
    KRaw kr = rot_load(kbase, nullptr, nullptr, pdq);
    uint4 vr[4];
#pragma unroll
    for (int hh = 0; hh < 4; ++hh) vr[hh] = *(const uint4*)(vbase + hh * 8);
    for (int jb = 0; jb < 4; ++jb) {
        { const int j = pj, dq = pdq, J = jb * 64 + j; float r1[8], r2[8];
            rot_apply(kr, r1, r2);
            const float sf = __expf((float)(255 - J) * lgf), sb = __expf((float)J * lgb);
            *(LAS u32x4*)(kf + j * 136 + dq) = mk4(pack2(r1[0] * sf, r1[1] * sf), pack2(r1[2] * sf, r1[3] * sf), pack2(r1[4] * sf, r1[5] * sf), pack2(r1[6] * sf, r1[7] * sf));
            *(LAS u32x4*)(kf + j * 136 + 64 + dq) = mk4(pack2(r2[0] * sf, r2[1] * sf), pack2(r2[2] * sf, r2[3] * sf), pack2(r2[4] * sf, r2[5] * sf), pack2(r2[6] * sf, r2[7] * sf));
            *(LAS u32x4*)(kb + j * 136 + dq) = mk4(pack2(r1[0] * sb, r1[1] * sb), pack2(r1[2] * sb, r1[3] * sb), pack2(r1[4] * sb, r1[5] * sb), pack2(r1[6] * sb, r1[7] * sb));
            *(LAS u32x4*)(kb + j * 136 + 64 + dq) = mk4(pack2(r2[0] * sb, r2[1] * sb), pack2(r2[2] * sb, r2[3] * sb), pack2(r2[4] * sb, r2[5] * sb), pack2(r2[6] * sb, r2[7] * sb));
#pragma unroll
            for (int hh = 0; hh < 4; ++hh) *(LAS u32x4*)(Vs + j * 264 + pv32 + hh * 8) = mk4(vr[hh].x, vr[hh].y, vr[hh].z, vr[hh].w); }
        lds_barrier();
        if (jb < 3) { kr = rot_load(kbase + (size_t)(jb + 1) * 64 * 6144, nullptr, nullptr, pdq);
#pragma unroll
            for (int hh = 0; hh < 4; ++hh) vr[hh] = *(const uint4*)(vbase + (size_t)(jb + 1) * 64 * 6144 + hh * 8); }
#pragma unroll
        for (int ks = 0; ks < 2; ++ks) { bf16x8 af[4];
#pragma unroll
            for (int a = 0; a < 4; ++a) af[a] = frag_tr(kA + ks * 32 * 136 + dt0 + a * 16, 136, lane);
#pragma unroll
            for (int n = 0; n < 8; ++n) { const bf16x8 bfr = frag_tr(Vs + ks * 32 * 264 + (nb + n) * 16, 264, lane);
#pragma unroll
                for (int a = 0; a < 4; ++a) acc[a][n] = __builtin_amdgcn_mfma_f32_16x16x32_bf16(bfr, af[a], acc[a][n], 0, 0, 0); } }
        lds_barrier();
    }
#pragma unroll
    for (int a = 0; a < 4; ++a) { const int row = (mb + a) * 16 + (lane & 15), dir = row >> 7, d = row & 127;
        bf16_t* out = RST + ((size_t)(((bl * 8 + h) * 2 + dir) * 32 + sc)) * 32768 + d * 256 + 4 * (lane >> 4);
#pragma unroll
        for (int n = 0; n < 8; ++n) { uint2 w; w.x = pack2(acc[a][n][0], acc[a][n][1]); w.y = pack2(acc[a][n][2], acc[a][n][3]); *(uint2*)(out + (nb + n) * 16) = w; } }
}

__device__ void phase_ret_b(CP P) {
    bf16_t* RST = (bf16_t*)(P->ws + OFF_RST);
    for (int idx = obid() * NTHR + otid(); idx < 64 * 4096; idx += gridDim.x * NTHR) {
        const int bhd = idx >> 12, e = (idx & 4095) * 8, dir = bhd & 1, h = (bhd >> 1) & 7;
        const float dec = __expf(256.0f * ret_lg(dir == 0 ? h : 7 - h));
        f32x4 S0 = (f32x4){0.f, 0.f, 0.f, 0.f}, S1 = S0;
#pragma unroll 8
        for (int cc = 0; cc < 32; ++cc) { const int c = dir == 0 ? cc : 31 - cc; bf16_t* p = RST + ((size_t)(bhd * 32 + c)) * 32768 + e;
            const uint4 t = *(const uint4*)p; uint4 o; o.x = pack2(S0[0], S0[1]); o.y = pack2(S0[2], S0[3]); o.z = pack2(S1[0], S1[1]); o.w = pack2(S1[2], S1[3]); *(uint4*)p = o;
            S0 = dec * S0 + (f32x4){bflo(t.x), bfhi(t.x), bflo(t.y), bfhi(t.y)}; S1 = dec * S1 + (f32x4){bflo(t.z), bfhi(t.z), bflo(t.w), bfhi(t.w)}; }
    }
}

__device__ void ret_c_unit(CP P, int hf, int unit, LAS unsigned char* lds) {
    const int rh = (unit >> 3) & 1, ur = (unit & 7) | ((unit >> 4) << 3), sc = ur & 31, h = (ur >> 5) & 7, bl = ur >> 8;
    const bf16_t* PR = (const bf16_t*)(P->ws + OFF_PROJ1); const bf16_t* RST = (const bf16_t*)(P->ws + OFF_RST);
    const float* cs = (const float*)(P->ws + OFF_ROPE); const float* sn = cs + 8192 * 64;
    const int tid = otid(), lane = tid & 63, wid = tid >> 6;
    const size_t r0 = (size_t)bl * 8192 + sc * 256;
    const float lgf = ret_lg(h), lgb = ret_lg(7 - h);
    LAS bf16_t* qs = (LAS bf16_t*)lds;
    LAS bf16_t* ks = (LAS bf16_t*)(lds + 34816);
    LAS bf16_t* Ps = (LAS bf16_t*)(lds + 52224);
    LAS bf16_t* Vs = (LAS bf16_t*)(lds + 70656);
    LAS float* red = (LAS float*)(lds + 104448);
    LAS bf16_t* qx = ks;
#pragma unroll
    for (int rep = 0; rep < 2; ++rep) { const int i = (tid >> 3) + rep * 64, dq = (tid & 7) * 8, I = rh * 128 + i;
        const KRaw q_ = rot_load(PR + (r0 + I) * 6144 + h * 128, nullptr, nullptr, dq);
        *(LAS u32x4*)(qs + i * 136 + dq) = mk4(q_.a.x, q_.a.y, q_.a.z, q_.a.w); *(LAS u32x4*)(qs + i * 136 + 64 + dq) = mk4(q_.b.x, q_.b.y, q_.b.z, q_.b.w); }
    f32x4 acc[2][8];
#pragma unroll
    for (int r = 0; r < 2; ++r)
#pragma unroll
        for (int n = 0; n < 8; ++n) acc[r][n] = (f32x4){0.f, 0.f, 0.f, 0.f};
    const int mi2 = (wid & 3) * 2, nb = (wid >> 2) * 8;
    const int pj = tid >> 3, pdq = (tid & 7) * 8, pv32 = (tid & 7) * 32;
    const bf16_t* kbase = PR + (r0 + pj) * 6144 + 1024 + h * 128; const bf16_t* vbase = PR + (r0 + pj) * 6144 + 2048 + h * 256 + pv32;
    KRaw kr = rot_load(kbase, cs + (sc * 256 + pj) * 64, sn + (sc * 256 + pj) * 64, pdq);
    uint4 vr[4];
#pragma unroll
    for (int hh = 0; hh < 4; ++hh) vr[hh] = *(const uint4*)(vbase + hh * 8);
    uint4 st[4];
    const bf16_t* sbase = RST + ((size_t)((bl * 8 + h) * 2) * 32 + sc) * 32768;
    for (int kb = 0; kb < 4; ++kb) {
        { const int j = pj, dq = pdq;
            *(LAS u32x4*)(ks + j * 136 + dq) = mk4(kr.a.x, kr.a.y, kr.a.z, kr.a.w); *(LAS u32x4*)(ks + j * 136 + 64 + dq) = mk4(kr.b.x, kr.b.y, kr.b.z, kr.b.w);
#pragma unroll
            for (int hh = 0; hh < 4; ++hh) *(LAS u32x4*)(Vs + j * 264 + pv32 + hh * 8) = mk4(vr[hh].x, vr[hh].y, vr[hh].z, vr[hh].w); }
        lds_barrier();
        if (kb < 3) { const int J = (kb + 1) * 64 + pj; kr = rot_load(kbase + (size_t)(kb + 1) * 64 * 6144, cs + (sc * 256 + J) * 64, sn + (sc * 256 + J) * 64, pdq);
#pragma unroll
            for (int hh = 0; hh < 4; ++hh) vr[hh] = *(const uint4*)(vbase + (size_t)(kb + 1) * 64 * 6144 + hh * 8); }
        else {
#pragma unroll
            for (int i = 0; i < 4; ++i) { const int idx = tid + i * NTHR, v8 = (idx & 31) * 8, dd = idx >> 5; st[i] = *(const uint4*)(sbase + dd * 256 + v8); } }
#pragma unroll
        for (int tr = 0; tr < 2; ++tr)
#pragma unroll
            for (int tc = 0; tc < 2; ++tc) { const int ti = mi2 + tr, tj = (wid >> 2) * 2 + tc; f32x4 s = (f32x4){0.f, 0.f, 0.f, 0.f};
                s = mma16(qs + ti * 16 * 136, 136, ks + tj * 16 * 136, 136, 128, s, lane);
                const int i = ti * 16 + (lane & 15), j0 = tj * 16 + 4 * (lane >> 4), I = rh * 128 + i; float pv[4];
#pragma unroll
                for (int jj = 0; jj < 4; ++jj) { const int df = I - (kb * 64 + j0 + jj); const float dm = df >= 0 ? __expf((float)df * lgf) : __expf((float)(-df) * lgb); pv[jj] = s[jj] * dm; }
                *(LAS u32x2*)(Ps + i * 72 + j0) = mk2(pack2(pv[0], pv[1]), pack2(pv[2], pv[3])); }
        lds_barrier();
#pragma unroll
        for (int k2 = 0; k2 < 2; ++k2) { bf16x8 af[2], bfr[8];
#pragma unroll
            for (int r = 0; r < 2; ++r) af[r] = *(const LAS bf16x8*)(Ps + ((mi2 + r) * 16 + (lane & 15)) * 72 + k2 * 32 + (lane >> 4) * 8);
#pragma unroll
            for (int n = 0; n < 8; ++n) bfr[n] = frag_tr(Vs + k2 * 32 * 264 + (nb + n) * 16, 264, lane);
#pragma unroll
            for (int r = 0; r < 2; ++r)
#pragma unroll
                for (int n = 0; n < 8; ++n) acc[r][n] = __builtin_amdgcn_mfma_f32_16x16x32_bf16(bfr[n], af[r], acc[r][n], 0, 0, 0); }
        lds_barrier();
    }
    uint2 ogr[2][8];
#pragma unroll
    for (int r = 0; r < 2; ++r) { const bf16_t* ogp = PR + (r0 + rh * 128 + (mi2 + r) * 16 + (lane & 15)) * 6144 + 4096 + h * 256 + 4 * (lane >> 4);
#pragma unroll
        for (int n = 0; n < 8; ++n) ogr[r][n] = *(const uint2*)(ogp + (nb + n) * 16); }
    for (int sl = 0; sl < 4; ++sl) { const int dir = sl >> 1, dh = sl & 1;
        if (dh == 0) { const int i = tid >> 2, c32 = (tid & 3) * 32, I = rh * 128 + i; const float xs = dir == 0 ? __expf((float)(I + 1) * lgf) : __expf((float)(256 - I) * lgb);
#pragma unroll
            for (int hh = 0; hh < 4; ++hh) { const u32x4 w = *(const LAS u32x4*)(qs + i * 136 + c32 + hh * 8);
                *(LAS u32x4*)(qx + i * 136 + c32 + hh * 8) = mk4(pack2(bflo(w[0]) * xs, bfhi(w[0]) * xs), pack2(bflo(w[1]) * xs, bfhi(w[1]) * xs), pack2(bflo(w[2]) * xs, bfhi(w[2]) * xs), pack2(bflo(w[3]) * xs, bfhi(w[3]) * xs)); } }
#pragma unroll
        for (int i = 0; i < 4; ++i) { const int idx = tid + i * NTHR, v8 = (idx & 31) * 8, dd = idx >> 5; *(LAS u32x4*)(Vs + dd * 264 + v8) = mk4(st[i].x, st[i].y, st[i].z, st[i].w); }
        lds_barrier();
        if (sl < 3) { const int nd = (sl + 1) >> 1, nh = (sl + 1) & 1; const bf16_t* sp = sbase + (size_t)nd * 32 * 32768 + (size_t)nh * 64 * 256;
#pragma unroll
            for (int i = 0; i < 4; ++i) { const int idx = tid + i * NTHR, v8 = (idx & 31) * 8, dd = idx >> 5; st[i] = *(const uint4*)(sp + dd * 256 + v8); } }
#pragma unroll
        for (int k2 = 0; k2 < 2; ++k2) { bf16x8 af[2], bfr[8];
#pragma unroll
            for (int r = 0; r < 2; ++r) af[r] = *(const LAS bf16x8*)(qx + ((mi2 + r) * 16 + (lane & 15)) * 136 + dh * 64 + k2 * 32 + (lane >> 4) * 8);
#pragma unroll
            for (int n = 0; n < 8; ++n) bfr[n] = frag_tr(Vs + k2 * 32 * 264 + (nb + n) * 16, 264, lane);
#pragma unroll
            for (int r = 0; r < 2; ++r)
#pragma unroll
                for (int n = 0; n < 8; ++n) acc[r][n] = __builtin_amdgcn_mfma_f32_16x16x32_bf16(bfr[n], af[r], acc[r][n], 0, 0, 0); }
        lds_barrier();
    }
    { float ss[2];
#pragma unroll
        for (int r = 0; r < 2; ++r) { ss[r] = 0.f;
#pragma unroll
            for (int n = 0; n < 8; ++n) ss[r] += acc[r][n][0] * acc[r][n][0] + acc[r][n][1] * acc[r][n][1] + acc[r][n][2] * acc[r][n][2] + acc[r][n][3] * acc[r][n][3];
            ss[r] += __shfl_xor(ss[r], 16); ss[r] += __shfl_xor(ss[r], 32);
            if ((lane >> 4) == 0) red[((mi2 + r) * 16 + (lane & 15)) * 2 + (wid >> 2)] = ss[r]; }
        lds_barrier();
#pragma unroll
        for (int r = 0; r < 2; ++r) { const int i = (mi2 + r) * 16 + (lane & 15);
            const float rstd = rsqrtf((red[i * 2] + red[i * 2 + 1]) * (1.0f / 256.0f) + 1e-6f);
            const float* gn = P->in[23] + h * 256 + 4 * (lane >> 4);
            bf16_t* op = (bf16_t*)(P->ws + OFF_OBUF) + (r0 + rh * 128 + i) * 2048 + h * 256 + 4 * (lane >> 4);
#pragma unroll
            for (int n = 0; n < 8; ++n) { const int v = (nb + n) * 16; const uint2 og = ogr[r][n]; const f32x4 g4 = *(const f32x4*)(gn + v);
                uint2 w; w.x = pack2(acc[r][n][0] * rstd * g4[0] * silu_f(bflo(og.x)), acc[r][n][1] * rstd * g4[1] * silu_f(bfhi(og.x)));
                w.y = pack2(acc[r][n][2] * rstd * g4[2] * silu_f(bflo(og.y)), acc[r][n][3] * rstd * g4[3] * silu_f(bfhi(og.y)));
                *(uint2*)(op + v) = w; } } }
    lds_barrier();
}

__device__ __forceinline__ void grid_barrier(unsigned* cnt, unsigned target) {
    asm volatile("s_waitcnt vmcnt(0)" ::: "memory");
    __syncthreads();
    if (threadIdx.x == 0) {
        __builtin_amdgcn_fence(__ATOMIC_RELEASE, "agent");
        asm volatile("s_waitcnt vmcnt(0)" ::: "memory");
        (void)__hip_atomic_fetch_add(cnt, 1u, __ATOMIC_RELAXED, __HIP_MEMORY_SCOPE_AGENT);
        unsigned spins = 0;
        while (__hip_atomic_load(cnt, __ATOMIC_RELAXED, __HIP_MEMORY_SCOPE_AGENT) < target) { __builtin_amdgcn_s_sleep(2); if (++spins > (1u << 24)) break; }
        __builtin_amdgcn_fence(__ATOMIC_ACQUIRE, "agent");
        asm volatile("s_waitcnt vmcnt(0)" ::: "memory");
    }
    __syncthreads();
}

__global__ void __launch_bounds__(NTHR, 2) mega(Params Pval, int ph0, int ph1) {
    extern __shared__ __attribute__((aligned(16))) unsigned char lds_raw[];
    LAS unsigned char* lds = (LAS unsigned char*)lds_raw;
    unsigned nbar = 0;
    for (int ph = ph0; ph < ph1; ++ph) {
        CP P = (CP)__builtin_amdgcn_kernarg_segment_ptr(); asm volatile("" : "+s"(P));
        unsigned char* ws = P->ws;
        bf16_t* XN = (bf16_t*)(ws + OFF_XN); bf16_t* ACT = (bf16_t*)(ws + OFF_ACT); float* X = P->out;
        if (ph == 1 || ph == 4 || ph == 11 || ph == 14 || ph == 17 || ph == 28) continue;
        const int reps = (((unsigned long long)(PROBE_MASK) >> ph) & 1ull) ? 2 : 1;
        for (int rep = 0; rep < reps; ++rep) {
        float* SSQ = (float*)(ws + OFF_SSQ); bf16_t* XB2 = (bf16_t*)(ws + OFF_XB2);
        int ffn = -1, sub = 0;
        if (ph >= 2 && ph <= 3) { ffn = 0; sub = ph - 1; } else if (ph >= 12 && ph <= 13) { ffn = 1; sub = ph - 11; }
        else if (ph >= 15 && ph <= 16) { ffn = 2; sub = ph - 14; } else if (ph >= 29 && ph <= 30) { ffn = 3; sub = ph - 28; }
        if (ph == 0) { if (EN(0)) phase_prologue(P, lds); }
        else if (ffn >= 0) {
            const float* xin = (ffn == 0) ? P->in[0] : X;
            const float* ssin = SSQ + (size_t)(ffn == 0 ? 0 : ffn == 1 ? 2 : ffn == 2 ? 3 : 5) * SSN;
            if (sub == 1) { if (EN(2)) { if (ffn == 0) phase_kmat(P);
                pg8::Gemm g{ffn == 1 ? XB2 : XN, (const bf16_t*)(ws + OFF_W1 + (size_t)ffn * SZ_W1), 1024, 1024, 1024, 256, 22, 1, 0, 0}; EpiSwiGLU e{ACT, ssin}; pg8::gemm_phase(lds, g, e); } }
            else { if (EN(3)) { pg8::Gemm g{ACT, (const bf16_t*)(ws + OFF_W2 + (size_t)ffn * SZ_W2), 2816, 2816, 2816, 256, 4, 1, 0, 0};
                float* ssout = SSQ + (size_t)(ffn == 0 ? 1 : ffn == 1 ? 3 : 4) * SSN;
                if (ffn == 3) { EpiResid<false> e{xin, X, nullptr, nullptr, 0.5f}; pg8::gemm_phase(lds, g, e); }
                else { EpiResid<true> e{xin, X, XN, ssout, 0.5f}; pg8::gemm_phase(lds, g, e); } } }
        }
        else if (ph == 5) { if (EN(4)) { pg8::Gemm g{XN, (const bf16_t*)(ws + OFF_WIN0), 1024, 1024, 1024, 256, 9, 1, 0, 0}; EpiWin0 e{(bf16_t*)(ws + OFF_AS5), (bf16_t*)(ws + OFF_PQ), SSQ + SSN}; pg8::gemm_phase(lds, g, e); } }
        else if (ph == 6) { if (EN(5)) {
            if (EN(16)) { pg8::Gemm g{(const bf16_t*)(ws + OFF_AS5), (const bf16_t*)(ws + OFF_H), 1280, 1024, 1024, 4, 1, 32, (size_t)1024 * 1280, (size_t)256 * 1024}; EpiS5E e{(float*)(ws + OFF_E)}; pg8::gemm_phase(lds, g, e); }
            __syncthreads();
            if (EN(17)) for (int u = obid(); u < 4096; u += gridDim.x) gla_a_unit(P, u, lds);
        } }
        else if (ph == 7) { if (EN(6)) { phase_s5_scan(P); phase_gla_b(P); } }
        else if (ph == 8) { if (EN(7)) {
            if (EN(18)) { pg8::Gemm g{(const bf16_t*)(ws + OFF_AS5), (const bf16_t*)(ws + OFF_KG), 1280, 1280, 1280, 4, 4, 32, (size_t)1024 * 1280, (size_t)1024 * 1280}; EpiS5Y e{(bf16_t*)(ws + OFF_GY)}; pg8::gemm_phase(lds, g, e); }
            __syncthreads();
            if (EN(19)) for (int u = obid(); u < 4096; u += gridDim.x) gla_c_unit(P, u, lds);
        } }
        else if (ph == 9) { if (EN(8)) { pg8::Gemm g{(const bf16_t*)(ws + OFF_GY), (const bf16_t*)(ws + OFF_WGLU), 512, 512, 512, 256, 2, 1, 0, 0}; EpiGLU e{(const bf16_t*)(ws + OFF_GY), XN}; pg8::gemm_phase(lds, g, e); } }
        else if (ph == 10) { if (EN(9)) { pg8::Gemm g{XN, (const bf16_t*)(ws + OFF_WOUT0), 1024, 1024, 1024, 256, 4, 1, 0, 0}; EpiResid<true> e{X, X, XB2, SSQ + 2 * SSN, 1.0f}; pg8::gemm_phase(lds, g, e); } }
        else if (ph >= 18 && ph <= 27) {
            const int hf = (ph - 18) / 5, s = (ph - 18) % 5;
            if (s == 0) { if (EN(10)) { pg8::Gemm g{XN + (size_t)hf * 32768 * 1024, (const bf16_t*)(ws + OFF_WIN1), 1024, 1024, 1024, 128, 24, 1, 0, 0}; EpiRetIn e{(bf16_t*)(ws + OFF_PROJ1), 6144, SSQ + 4 * SSN + (size_t)hf * 32768 * 16, (const float*)(ws + OFF_ROPE), (const float*)(ws + OFF_ROPE) + 8192 * 64, hf * 32768}; pg8::gemm_phase(lds, g, e); } }
            else if (s == 1) { if (EN(11)) for (int u = obid(); u < 1024; u += gridDim.x) ret_a_unit(P, hf, u, lds); }
            else if (s == 2) { if (EN(12)) phase_ret_b(P); }
            else if (s == 3) { if (EN(13)) for (int u = obid(); u < 2048; u += gridDim.x) ret_c_unit(P, hf, u, lds); }
            else { if (EN(14)) { pg8::Gemm g{(const bf16_t*)(ws + OFF_OBUF), (const bf16_t*)(ws + OFF_WOUT1), 2048, 2048, 2048, 128, 4, 1, 0, 0};
                float* Xh = X + (size_t)hf * 32768 * 1024; EpiResid<true> e{Xh, Xh, XN + (size_t)hf * 32768 * 1024, SSQ + 5 * SSN + (size_t)hf * 32768 * 16, 1.0f}; pg8::gemm_phase(lds, g, e); } }
        }
        else if (ph == 31) { if (EN(15)) phase_norm<true>(X, P->in[25], nullptr, nullptr, X, 0, (int)gridDim.x, 0, 65536); }
        if (rep + 1 < reps) __syncthreads();
        }
        if (ph + 1 < ph1) { if (ph == 0) cg::this_grid().sync();
            else { ++nbar; grid_barrier((unsigned*)(P->ws + OFF_BAR), nbar * gridDim.x); } }
    }
}

extern "C" void kernel_launch(void* const* d_in, const int* in_sizes, int n_in, void* d_out, int out_size, void* d_ws, size_t ws_size, hipStream_t stream) {
    static int inited = 0;
    if (!inited) { (void)hipFuncSetAttribute((const void*)mega, hipFuncAttributeMaxDynamicSharedMemorySize, LDS_BYTES); inited = 1; }
    Params p{};
    for (int i = 0; i < 26; ++i) p.in[i] = (const float*)d_in[i];
    p.out = (float*)d_out; p.ws = (unsigned char*)d_ws;
    if (ws_size < OFF_R + 770 * MiB) fprintf(stderr, "kernel_launch: workspace too small (%zu)\n", ws_size);
    const int grid = 256;
#if ONE_LAUNCH
    (void)hipMemsetAsync((unsigned char*)d_ws + OFF_BAR, 0, 256, stream);
    int ph0 = 0, ph1 = NPHASE; void* args[] = {&p, &ph0, &ph1};
    hipError_t e = hipLaunchCooperativeKernel((const void*)mega, dim3(grid), dim3(NTHR), args, LDS_BYTES, stream);
    if (e != hipSuccess) fprintf(stderr, "cooperative launch failed: %s\n", hipGetErrorString(e));
#else
    for (int ph = 0; ph < NPHASE; ++ph) hipLaunchKernelGGL(mega, dim3(grid), dim3(NTHR), LDS_BYTES, stream, p, ph, ph + 1);
#endif
}
```

```cpp
#include <hip/hip_runtime.h>
#include <hip/hip_cooperative_groups.h>
#include <cstdio>
#include <cstdint>
namespace cg = cooperative_groups;

#ifndef ONE_LAUNCH
#define ONE_LAUNCH 1
#endif

#ifndef PHASE_MASK
#define PHASE_MASK 0xffffffffffull
#endif
#define EN(n) (((PHASE_MASK) >> (n)) & 1ull)
#ifndef PROBE_MASK
#define PROBE_MASK 0ull
#endif
#define LAS __attribute__((address_space(3)))
typedef unsigned short bf16_t;
typedef short bf16x8 __attribute__((ext_vector_type(8)));
typedef float f32x4 __attribute__((ext_vector_type(4)));
typedef float f32x2 __attribute__((ext_vector_type(2)));
typedef unsigned u32x2 __attribute__((ext_vector_type(2)));
typedef unsigned u32x4 __attribute__((ext_vector_type(4)));
__device__ __forceinline__ u32x4 mk4(unsigned a, unsigned b, unsigned c, unsigned d) { return (u32x4){a, b, c, d}; }
__device__ __forceinline__ u32x2 mk2(unsigned a, unsigned b) { return (u32x2){a, b}; }
__device__ __forceinline__ f32x2 mkf2(float a, float b) { return (f32x2){a, b}; }

constexpr int NTHR = 512;
constexpr int LDS_BYTES = 147456;
constexpr int NPHASE = 32;

struct Params { const float* in[26]; float* out; unsigned char* ws; };
typedef const __attribute__((address_space(4))) Params* CP;

constexpr size_t MiB = 1ull << 20;
constexpr size_t OFF_W1 = 0, SZ_W1 = 11 * MiB;
constexpr size_t OFF_W2 = 44 * MiB, SZ_W2 = 5 * MiB + MiB / 2;
constexpr size_t OFF_WIN0 = 66 * MiB;
constexpr size_t OFF_WGLU = 70 * MiB + MiB / 2;
constexpr size_t OFF_WOUT0 = 71 * MiB;
constexpr size_t OFF_WIN1 = 73 * MiB;
constexpr size_t OFF_WOUT1 = 85 * MiB;
constexpr size_t OFF_ROPE = 89 * MiB;
constexpr size_t OFF_KTAB = 93 * MiB;
constexpr size_t OFF_S5P = 97 * MiB;
constexpr size_t OFF_XN = 98 * MiB;
constexpr size_t OFF_R = 226 * MiB;
constexpr size_t OFF_ACT = OFF_R;
constexpr size_t OFF_PQ = OFF_R;
constexpr size_t OFF_AS5 = OFF_R + 224 * MiB;
constexpr size_t OFF_E = OFF_R + 304 * MiB;
constexpr size_t OFF_KG = OFF_R + 352 * MiB;
constexpr size_t OFF_H = OFF_R + 432 * MiB;
constexpr size_t OFF_GST = OFF_R + 448 * MiB;
constexpr size_t OFF_GDEC = OFF_R + 704 * MiB;
constexpr size_t OFF_GY = OFF_R + 706 * MiB;
constexpr size_t OFF_PROJ1 = OFF_R;
constexpr size_t OFF_RST = OFF_R + 384 * MiB;
constexpr size_t OFF_SSQ = 998 * MiB;
constexpr int SSN = 65536 * 16;
constexpr size_t OFF_XB2 = OFF_R + 448 * MiB;
constexpr size_t OFF_BAR = 1023 * MiB;
constexpr size_t OFF_OBUF = OFF_R + 640 * MiB;

__device__ __forceinline__ int otid() { int t = threadIdx.x; asm volatile("" : "+v"(t)); return t; }
__device__ __forceinline__ int obid() { int t = blockIdx.x; asm volatile("" : "+s"(t)); return t; }
__device__ __forceinline__ bf16_t f2bf(float f) { unsigned u = __float_as_uint(f); u += 0x7FFFu + ((u >> 16) & 1u); return (bf16_t)(u >> 16); }
__device__ __forceinline__ float bf2f(unsigned b) { return __uint_as_float(b << 16); }
typedef __bf16 bf16x2_t __attribute__((ext_vector_type(2)));
typedef float f32x2_t __attribute__((ext_vector_type(2)));
__device__ __forceinline__ unsigned pack2(float lo, float hi) { const f32x2_t v = {lo, hi}; const bf16x2_t b = __builtin_convertvector(v, bf16x2_t); return __builtin_bit_cast(unsigned, b); }
__device__ __forceinline__ float bflo(unsigned w) { return __uint_as_float(w << 16); }
__device__ __forceinline__ float bfhi(unsigned w) { return __uint_as_float(w & 0xffff0000u); }
__device__ __forceinline__ float fast_sigmoid(float x) { return __builtin_amdgcn_rcpf(1.0f + __expf(-x)); }
__device__ __forceinline__ float silu_f(float x) { return x * fast_sigmoid(x); }
__device__ __forceinline__ float gelu_tanh(float x) { const float u = 0.7978845608028654f * (x + 0.044715f * x * x * x); return x * fast_sigmoid(2.0f * u); }

namespace pg8 {
constexpr int BM = 256, BK = 64, HALF = 128, HTB = HALF * BK * 2, STAGE_BYTES = 8 * HTB, NXCD = 8, WGM = 8;
__device__ __forceinline__ int lds_byte(int r, int c) { const int st = (r >> 4) * 2 + (c >> 5), rr = r & 15, cc = c & 31, ob = rr * 64 + cc * 2; return st * 1024 + (ob ^ (((ob >> 9) & 1) << 5)); }
__device__ __forceinline__ void stage_rc(int b, int& R, int& C) { const int st = b / 1024, sb = b % 1024, swz = sb ^ (((sb >> 9) & 1) << 5); R = (st >> 1) * 16 + swz / 64; C = (st & 1) * 32 + (swz % 64) / 2; }

__device__ __forceinline__ int perm32(int rho) { const int n = rho >> 4, i = rho & 15; return 8 * (i >> 2) + 4 * n + (i & 3); }
struct Unit { int pm, pn, bz; };
struct Gemm { const bf16_t* A; const bf16_t* Bt; int lda, ldb, K, nM, nN, nB; size_t strideA, strideB; };

struct Sched {
    int nM, nN, nwg, total, G, c;
    __device__ void init(int nM_, int nN_, int nB_, int G_, int c_) { nM = nM_; nN = nN_; nwg = nM * nN; total = nwg * nB_; G = G_; c = c_; }
    __device__ bool next(int i, Unit& u) const {
        const long L = (long)i * G + c; if (L >= total) return false;
        u.bz = (int)(L / nwg); int wgid = (int)(L % nwg);
        { const int q = nwg / NXCD, r = nwg % NXCD, xcd = wgid % NXCD, off = wgid / NXCD; wgid = (xcd < r ? xcd * (q + 1) : r * (q + 1) + (xcd - r) * q) + off; }
        const int nig = WGM * nN, gid = wgid / nig, fm = gid * WGM, gsz = (nM - fm) < WGM ? (nM - fm) : WGM;
        u.pm = fm + ((wgid % nig) % gsz); u.pn = (wgid % nig) / gsz; return true;
    }
};

template <class Epi>
__device__ __forceinline__ void gemm_phase(LAS unsigned char* lds, const Gemm g, const Epi& E) {
    const int tid = otid(), wid = __builtin_amdgcn_readfirstlane(tid >> 6), lane = tid & 63, wr = wid >> 2, wc = wid & 3, fr = lane & 15, fq = lane >> 4;
    const int nt = g.K / BK;
    Sched S; S.init(g.nM, g.nN, g.nB, (int)gridDim.x, obid());
    unsigned voffA[2], voffB[2];
#pragma unroll
    for (int i = 0; i < 2; ++i) { int R, C; stage_rc(tid * 16 + i * 8192, R, C); const int Rb = Epi::PERM ? ((R & ~31) + perm32(R & 31)) : R;
        voffA[i] = (unsigned)(R * g.lda + C) * 2u; voffB[i] = (unsigned)(Rb * g.ldb + C) * 2u; }
    const size_t kstep = (size_t)(BK * 2);
    const size_t hstepA = (size_t)HALF * g.lda * 2, hstepB = (size_t)HALF * g.ldb * 2;
    const size_t tstepA = 2 * hstepA, tstepB = 2 * hstepB;
    const unsigned ldsw = (unsigned)wid * 1024u;
    const int aoff = lds_byte(wr * 64 + fr, fq * 8), boff = lds_byte(wc * 32 + fr, fq * 8);
#define PG8_SA(b, h) (((b) * 2 + (h)) * HTB)
#define PG8_SB(b, h) ((4 + (b) * 2 + (h)) * HTB)
#define PG8_STAGE(bufoff, gbase, voff) do { _Pragma("unroll") for (int _i = 0; _i < 2; ++_i) \
        __builtin_amdgcn_global_load_lds((const unsigned*)((const char*)(gbase) + (voff)[_i]), (LAS unsigned*)(lds + (bufoff) + ldsw + _i * 8192), 16, 0, 0); } while (0)
#define PG8_LDA(dst, b, h) do { _Pragma("unroll") for (int m = 0; m < 4; ++m) _Pragma("unroll") for (int k = 0; k < 2; ++k) dst[m][k] = *(const LAS bf16x8*)(lds + PG8_SA(b, h) + aoff + m * 2048 + k * 1024); } while (0)
#define PG8_LDB(dst, b, h) do { _Pragma("unroll") for (int n = 0; n < 2; ++n) _Pragma("unroll") for (int k = 0; k < 2; ++k) dst[n][k] = *(const LAS bf16x8*)(lds + PG8_SB(b, h) + boff + n * 2048 + k * 1024); } while (0)
#define PG8_MMA(ai, bj, At, Bt) do { __builtin_amdgcn_s_setprio(1); _Pragma("unroll") for (int m = 0; m < 4; ++m) _Pragma("unroll") for (int n = 0; n < 2; ++n) _Pragma("unroll") for (int k = 0; k < 2; ++k) \
        acc[ai][bj][m][n] = __builtin_amdgcn_mfma_f32_16x16x32_bf16(Bt[n][k], At[m][k], acc[ai][bj][m][n], 0, 0, 0); __builtin_amdgcn_s_setprio(0); } while (0)
#define PG8_WAIT_V(n) asm volatile("s_waitcnt vmcnt(" #n ")" ::: "memory")
#define PG8_WAIT_L(n) asm volatile("s_waitcnt lgkmcnt(" #n ")" ::: "memory")
#define PG8_BAR __builtin_amdgcn_s_barrier()
#define PG8_SCHED __builtin_amdgcn_sched_barrier(0)
    Unit cur, nxt; int ui = 0;
    if (!S.next(0, cur)) return;
    int tag0 = -1, tag1 = -1, tag2 = -1, tag3 = -1; LAS float* rstab = (LAS float*)(lds + STAGE_BYTES);
    if constexpr (Epi::RSTD) {
        { Unit t_; for (int i = 0; S.next(i, t_); ++i) { const int pm = t_.pm; if (pm == tag0 || pm == tag1 || pm == tag2 || pm == tag3) continue;
                if (tag0 < 0) tag0 = pm; else if (tag1 < 0) tag1 = pm; else if (tag2 < 0) tag2 = pm; else tag3 = pm; } }
#pragma unroll
        for (int sl = 0; sl < 2; ++sl) { const int slot = (tid >> 8) + 2 * sl; const int pm = slot == 0 ? tag0 : slot == 1 ? tag1 : slot == 2 ? tag2 : tag3;
            if (pm >= 0) { const f32x4* p = (const f32x4*)(E.SS + ((size_t)pm * 256 + (tid & 255)) * 16); const f32x4 a = p[0], b = p[1], c = p[2], d = p[3]; const f32x4 t = (a + b) + (c + d);
                rstab[slot * 256 + (tid & 255)] = rsqrtf(((t[0] + t[1]) + (t[2] + t[3])) * (1.0f / 1024.0f) + 1e-6f); } }
        __syncthreads();
    }
    f32x4 acc[2][2][4][2];
#pragma unroll
    for (int a = 0; a < 2; ++a)
#pragma unroll
        for (int b = 0; b < 2; ++b)
#pragma unroll
            for (int m = 0; m < 4; ++m)
#pragma unroll
                for (int n = 0; n < 2; ++n) acc[a][b][m][n] = (f32x4){0.f, 0.f, 0.f, 0.f};
    bf16x8 At[4][2], B0[2][2], B1[2][2];
    const char* cA = (const char*)g.A + (size_t)cur.bz * g.strideA * 2 + (size_t)cur.pm * tstepA;
    const char* cB = (const char*)g.Bt + (size_t)cur.bz * g.strideB * 2 + (size_t)cur.pn * tstepB;
    PG8_STAGE(PG8_SB(0, 0), cB, voffB); PG8_STAGE(PG8_SB(0, 1), cB + hstepB, voffB); PG8_STAGE(PG8_SA(0, 0), cA, voffA); PG8_STAGE(PG8_SA(0, 1), cA + hstepA, voffA);
    if (wr == 1) PG8_BAR;
    PG8_WAIT_V(2); PG8_BAR;
    PG8_STAGE(PG8_SB(1, 0), cB + kstep, voffB); PG8_STAGE(PG8_SA(1, 0), cA + kstep, voffA); PG8_STAGE(PG8_SB(1, 1), cB + hstepB + kstep, voffB);
    PG8_WAIT_V(6); PG8_BAR;
    for (;;) {
        const bool has_next = S.next(ui + 1, nxt);
        const char* nA = has_next ? (const char*)g.A + (size_t)nxt.bz * g.strideA * 2 + (size_t)nxt.pm * tstepA : cA;
        const char* nB = has_next ? (const char*)g.Bt + (size_t)nxt.bz * g.strideB * 2 + (size_t)nxt.pn * tstepB : cB;
        for (int t = 0; t < nt; t += 2) {
            const bool last = (t == nt - 2);
            const char* a1 = cA + (size_t)(t + 1) * kstep;
            const char* a2 = last ? nA : cA + (size_t)(t + 2) * kstep; const char* b2 = last ? nB : cB + (size_t)(t + 2) * kstep;
            const char* a3 = a2 + kstep; const char* b3 = b2 + kstep;
            PG8_LDB(B0, 0, 0); PG8_LDB(B1, 0, 1); PG8_SCHED; PG8_LDA(At, 0, 0); PG8_STAGE(PG8_SA(1, 1), a1 + hstepA, voffA);
            PG8_WAIT_V(8); PG8_WAIT_L(0); PG8_BAR; PG8_MMA(0, 0, At, B0); PG8_MMA(0, 1, At, B1); PG8_BAR; PG8_SCHED;
            PG8_LDA(At, 0, 1); PG8_STAGE(PG8_SB(0, 0), b2, voffB); PG8_STAGE(PG8_SB(0, 1), b2 + hstepB, voffB); PG8_STAGE(PG8_SA(0, 0), a2, voffA);
            PG8_WAIT_V(8); PG8_WAIT_L(0); PG8_BAR; PG8_MMA(1, 0, At, B0); PG8_MMA(1, 1, At, B1); PG8_BAR; PG8_SCHED;
            PG8_LDB(B0, 1, 0); PG8_LDB(B1, 1, 1); PG8_SCHED; PG8_LDA(At, 1, 0); PG8_STAGE(PG8_SA(0, 1), a2 + hstepA, voffA);
            PG8_WAIT_V(8); PG8_WAIT_L(0); PG8_BAR; PG8_MMA(0, 0, At, B0); PG8_MMA(0, 1, At, B1); PG8_BAR; PG8_SCHED;
            PG8_LDA(At, 1, 1); PG8_STAGE(PG8_SB(1, 0), b3, voffB); PG8_STAGE(PG8_SB(1, 1), b3 + hstepB, voffB); PG8_STAGE(PG8_SA(1, 0), a3, voffA);
            PG8_WAIT_V(8); PG8_WAIT_L(0); PG8_BAR; PG8_MMA(1, 0, At, B0); PG8_MMA(1, 1, At, B1); PG8_BAR; PG8_SCHED;
        }
        if (wr == 0) PG8_BAR;
        E(acc, cur, wr, wc, fr, fq, rstab + (cur.pm == tag1 ? 256 : cur.pm == tag2 ? 512 : cur.pm == tag3 ? 768 : 0));
        if (!has_next) break;
#pragma unroll
        for (int a = 0; a < 2; ++a)
#pragma unroll
            for (int b = 0; b < 2; ++b)
#pragma unroll
                for (int m = 0; m < 4; ++m)
#pragma unroll
                    for (int n = 0; n < 2; ++n) acc[a][b][m][n] = (f32x4){0.f, 0.f, 0.f, 0.f};
        cur = nxt; cA = nA; cB = nB; ++ui;
        if (wr == 1) PG8_BAR;
    }
    PG8_WAIT_V(0);
    PG8_BAR;
#undef PG8_SA
#undef PG8_SB
#undef PG8_STAGE
#undef PG8_LDA
#undef PG8_LDB
#undef PG8_MMA
#undef PG8_WAIT_V
#undef PG8_WAIT_L
#undef PG8_BAR
#undef PG8_SCHED
}
}
using pg8::Unit;
typedef const f32x4 (&AccRef)[2][2][4][2];

struct EpiSwiGLU {
    static constexpr bool PERM = true, RSTD = true;
    bf16_t* O; const float* SS;
    __device__ __forceinline__ void operator()(AccRef acc, const Unit& u, int wr, int wc, int fr, int fq, const LAS float* rsl) const {
        const int row0 = u.pm * 256 + wr * 64 + fr, col0 = u.pn * 128 + wc * 32 + 8 * fq;
#pragma unroll
        for (int ai = 0; ai < 2; ++ai)
#pragma unroll
            for (int m = 0; m < 4; ++m) { bf16_t* rowp = O + (size_t)(row0 + ai * 128 + m * 16) * 2816 + col0; uint4 w; const float rs = rsl[ai * 128 + wr * 64 + m * 16 + fr];
                { const f32x4 gt = rs * acc[ai][0][m][0], up = rs * acc[ai][1][m][0]; w.x = pack2(silu_f(gt[0]) * up[0], silu_f(gt[1]) * up[1]); w.y = pack2(silu_f(gt[2]) * up[2], silu_f(gt[3]) * up[3]); }
                { const f32x4 gt = rs * acc[ai][0][m][1], up = rs * acc[ai][1][m][1]; w.z = pack2(silu_f(gt[0]) * up[0], silu_f(gt[1]) * up[1]); w.w = pack2(silu_f(gt[2]) * up[2], silu_f(gt[3]) * up[3]); }
                *(uint4*)rowp = w; }
    }
};
template <bool STATS> struct EpiResid {
    static constexpr bool PERM = true, RSTD = false;
    const float* Xin; float* X; bf16_t* XB; float* SS; float alpha;
    __device__ __forceinline__ void operator()(AccRef acc, const Unit& u, int wr, int wc, int fr, int fq, const LAS float* rsl) const {
        const int row0 = u.pm * 256 + wr * 64 + fr, col0 = u.pn * 256 + wc * 32 + 8 * fq;
#pragma unroll
        for (int ai = 0; ai < 2; ++ai)
#pragma unroll
            for (int mp = 0; mp < 2; ++mp) {
                f32x4 xo[2][2][2];
#pragma unroll
                for (int mm = 0; mm < 2; ++mm)
#pragma unroll
                    for (int bj = 0; bj < 2; ++bj) { const size_t o = (size_t)(row0 + ai * 128 + (mp * 2 + mm) * 16) * 1024 + col0 + bj * 128; xo[mm][bj][0] = *(const f32x4*)(Xin + o); xo[mm][bj][1] = *(const f32x4*)(Xin + o + 4); }
#pragma unroll
                for (int mm = 0; mm < 2; ++mm) { const int m = mp * 2 + mm; const size_t ro = (size_t)(row0 + ai * 128 + m * 16) * 1024 + col0; float sq = 0.f;
#pragma unroll
                    for (int bj = 0; bj < 2; ++bj) { const size_t o = ro + bj * 128;
                        const f32x4 y0 = xo[mm][bj][0] + alpha * acc[ai][bj][m][0], y1 = xo[mm][bj][1] + alpha * acc[ai][bj][m][1]; *(f32x4*)(X + o) = y0; *(f32x4*)(X + o + 4) = y1;
                        if (STATS) { uint4 w; w.x = pack2(y0[0], y0[1]); w.y = pack2(y0[2], y0[3]); w.z = pack2(y1[0], y1[1]); w.w = pack2(y1[2], y1[3]); *(uint4*)(XB + o) = w;
                            sq += y0[0] * y0[0] + y0[1] * y0[1] + y0[2] * y0[2] + y0[3] * y0[3] + y1[0] * y1[0] + y1[1] * y1[1] + y1[2] * y1[2] + y1[3] * y1[3]; } }
                    if (STATS) { sq += __shfl_xor(sq, 16); sq += __shfl_xor(sq, 32); if (fq == 0) SS[(size_t)(row0 + ai * 128 + m * 16) * 16 + u.pn * 4 + wc] = sq; } } }
    }
};
struct EpiBf16 {
    static constexpr bool PERM = true, RSTD = true;
    bf16_t* O; int ldc; const float* SS;
    __device__ __forceinline__ void operator()(AccRef acc, const Unit& u, int wr, int wc, int fr, int fq, const LAS float* rsl) const {
        const int row0 = u.pm * 256 + wr * 64 + fr, col0 = u.pn * 256 + wc * 32 + 8 * fq;
#pragma unroll
        for (int ai = 0; ai < 2; ++ai)
#pragma unroll
            for (int m = 0; m < 4; ++m) { bf16_t* rowp = O + (size_t)(row0 + ai * 128 + m * 16) * ldc + col0; const float rs = rsl[ai * 128 + wr * 64 + m * 16 + fr];
#pragma unroll
                for (int bj = 0; bj < 2; ++bj) { const f32x4 v0 = rs * acc[ai][bj][m][0], v1 = rs * acc[ai][bj][m][1]; uint4 w; w.x = pack2(v0[0], v0[1]); w.y = pack2(v0[2], v0[3]); w.z = pack2(v1[0], v1[1]); w.w = pack2(v1[2], v1[3]);
                    *(uint4*)(rowp + bj * 128) = w; } }
    }
};
struct EpiRetIn {
    static constexpr bool PERM = true, RSTD = true;
    bf16_t* O; int ldc; const float* SS; const float* cs; const float* sn; int rowbase;
    __device__ __forceinline__ void operator()(AccRef acc, const Unit& u, int wr, int wc, int fr, int fq, const LAS float* rsl) const {
        const int row0 = u.pm * 256 + wr * 64 + fr, col0 = u.pn * 256 + wc * 32 + 8 * fq, f = 16 * wc + 4 * fq;
#pragma unroll
        for (int ai = 0; ai < 2; ++ai)
#pragma unroll
            for (int m = 0; m < 4; ++m) { const int r = row0 + ai * 128 + m * 16; bf16_t* rowp = O + (size_t)r * ldc + col0; const float rs = rsl[ai * 128 + wr * 64 + m * 16 + fr];
                f32x4 c4 = (f32x4){1.f, 1.f, 1.f, 1.f}, s4 = (f32x4){0.f, 0.f, 0.f, 0.f};
                if (u.pn < 8) { const int pos = (rowbase + r) & 8191; c4 = *(const f32x4*)(cs + pos * 64 + f); s4 = *(const f32x4*)(sn + pos * 64 + f);
                    if (u.pn >= 4) { c4 *= 0.08838834764831845f; s4 *= 0.08838834764831845f; } }
#pragma unroll
                for (int bj = 0; bj < 2; ++bj) { const f32x4 t1 = rs * acc[ai][bj][m][0], t2 = rs * acc[ai][bj][m][1]; const f32x4 v0 = t1 * c4 - t2 * s4, v1 = t1 * s4 + t2 * c4;
                    uint4 w; w.x = pack2(v0[0], v0[1]); w.y = pack2(v0[2], v0[3]); w.z = pack2(v1[0], v1[1]); w.w = pack2(v1[2], v1[3]);
                    *(uint4*)(rowp + bj * 128) = w; } }
    }
};
struct EpiWin0 {
    static constexpr bool PERM = true, RSTD = true;
    bf16_t* AS5; bf16_t* PQ; const float* SS;
    __device__ __forceinline__ void operator()(AccRef acc, const Unit& u, int wr, int wc, int fr, int fq, const LAS float* rsl) const {
        const int row0 = u.pm * 256 + wr * 64 + fr, col0 = u.pn * 256 + wc * 32 + 8 * fq;
#pragma unroll
        for (int ai = 0; ai < 2; ++ai)
#pragma unroll
            for (int m = 0; m < 4; ++m) { const int r = row0 + ai * 128 + m * 16; const float rs = rsl[ai * 128 + wr * 64 + m * 16 + fr];
#pragma unroll
                for (int bj = 0; bj < 2; ++bj) { const int c = col0 + bj * 128; const f32x4 v0 = rs * acc[ai][bj][m][0], v1 = rs * acc[ai][bj][m][1];
                    uint4 w; w.x = pack2(v0[0], v0[1]); w.y = pack2(v0[2], v0[3]); w.z = pack2(v1[0], v1[1]); w.w = pack2(v1[2], v1[3]);
                    if (u.pn < 2) *(uint4*)(AS5 + ((size_t)((c >> 4) * 1024 + (r >> 6))) * 1280 + (r & 63) * 16 + (c & 15)) = w;
                    else *(uint4*)(PQ + (size_t)r * 1792 + (c - 512)) = w; } }
    }
};
struct EpiGLU {
    static constexpr bool PERM = true, RSTD = false;
    const bf16_t* GY; bf16_t* MIX;
    __device__ __forceinline__ void operator()(AccRef acc, const Unit& u, int wr, int wc, int fr, int fq, const LAS float* rsl) const {
        const int row0 = u.pm * 256 + wr * 64 + fr, col0 = u.pn * 256 + wc * 32 + 8 * fq;
#pragma unroll
        for (int ai = 0; ai < 2; ++ai)
#pragma unroll
            for (int m = 0; m < 4; ++m) { const int r = row0 + ai * 128 + m * 16;
#pragma unroll
                for (int bj = 0; bj < 2; ++bj) { const int c = col0 + bj * 128; const f32x4 v0 = acc[ai][bj][m][0], v1 = acc[ai][bj][m][1];
                    const uint4 gy = *(const uint4*)(GY + (size_t)r * 512 + c); uint4 w;
                    w.x = pack2(bflo(gy.x) * fast_sigmoid(v0[0]), bfhi(gy.x) * fast_sigmoid(v0[1])); w.y = pack2(bflo(gy.y) * fast_sigmoid(v0[2]), bfhi(gy.y) * fast_sigmoid(v0[3]));
                    w.z = pack2(bflo(gy.z) * fast_sigmoid(v1[0]), bfhi(gy.z) * fast_sigmoid(v1[1])); w.w = pack2(bflo(gy.w) * fast_sigmoid(v1[2]), bfhi(gy.w) * fast_sigmoid(v1[3]));
                    *(uint4*)(MIX + (size_t)r * 1024 + c) = w; } }
    }
};
struct EpiS5E {
    static constexpr bool PERM = false, RSTD = false;
    float* E;
    __device__ __forceinline__ void operator()(AccRef acc, const Unit& u, int wr, int wc, int fr, int fq, const LAS float* rsl) const {
        const int row0 = u.pm * 256 + wr * 64 + fr, col0 = wc * 32 + 4 * fq;
#pragma unroll
        for (int ai = 0; ai < 2; ++ai)
#pragma unroll
            for (int m = 0; m < 4; ++m) { float* rowp = E + ((size_t)u.bz * 1024 + row0 + ai * 128 + m * 16) * 256 + col0;
#pragma unroll
                for (int bj = 0; bj < 2; ++bj)
#pragma unroll
                    for (int n = 0; n < 2; ++n) *(f32x4*)(rowp + bj * 128 + n * 16) = acc[ai][bj][m][n]; }
    }
};
struct EpiS5Y {
    static constexpr bool PERM = true, RSTD = false;
    bf16_t* GY;
    __device__ __forceinline__ void operator()(AccRef acc, const Unit& u, int wr, int wc, int fr, int fq, const LAS float* rsl) const {
        const int row0 = u.pm * 256 + wr * 64 + fr, col0 = u.pn * 256 + wc * 32 + 8 * fq;
#pragma unroll
        for (int ai = 0; ai < 2; ++ai)
#pragma unroll
            for (int m = 0; m < 4; ++m) { const int bc = row0 + ai * 128 + m * 16;
#pragma unroll
                for (int bj = 0; bj < 2; ++bj) { const int c = col0 + bj * 128; const f32x4 v0 = acc[ai][bj][m][0], v1 = acc[ai][bj][m][1]; uint4 w;
                    w.x = pack2(gelu_tanh(v0[0]), gelu_tanh(v0[1])); w.y = pack2(gelu_tanh(v0[2]), gelu_tanh(v0[3])); w.z = pack2(gelu_tanh(v1[0]), gelu_tanh(v1[1])); w.w = pack2(gelu_tanh(v1[2]), gelu_tanh(v1[3]));
                    *(uint4*)(GY + ((size_t)bc * 64 + (c >> 4)) * 512 + u.bz * 16 + (c & 15)) = w; } }
    }
};

__device__ void transpose_job(const float* __restrict__ src, int K, int Nsrc, bf16_t* __restrict__ dst, int Ndst, int mode, LAS float* tile, int b0, int nb, const float* __restrict__ gain) {
    const int tid = otid();
    const int ntk = K >> 8, nt = (Ndst >> 6) * ntk;
    for (int t = obid() - b0; t < nt; t += nb) {
        const int tn = t / ntk, tk = t % ntk, n0 = tn * 64, k0 = tk * 256;
        int ns0 = n0;
        if (mode == 1) { const int tt = n0 >> 8, j = n0 & 255; ns0 = (j < 128) ? (tt * 128 + j) : (2816 + tt * 128 + (j - 128)); }
        const int r = tid >> 4; int c4 = (tid & 15) * 4;
        const int c4d = c4;
        if (mode == 2 && n0 < 2048) { const int s_ = (n0 + c4) & 127;
            c4 = ((n0 + c4) & ~127) + 64 * ((s_ >> 2) & 1) + 16 * (s_ >> 5) + 4 * ((s_ >> 3) & 3) - n0; }
        float4 v[8];
#pragma unroll
        for (int rr = 0; rr < 8; ++rr) { v[rr] = make_float4(0.f, 0.f, 0.f, 0.f);
            if (ns0 + c4 + 3 < Nsrc) v[rr] = *(const float4*)(src + (size_t)(k0 + r + rr * 32) * Nsrc + ns0 + c4);
            if (gain) { const float gk = gain[k0 + r + rr * 32]; v[rr].x *= gk; v[rr].y *= gk; v[rr].z *= gk; v[rr].w *= gk; } }
#pragma unroll
        for (int rr = 0; rr < 8; ++rr) { const int kk = r + rr * 32; LAS float* tp = tile + (kk >> 6) * (64 * 65) + (kk & 63) * 65 + c4d;
            tp[0] = v[rr].x; tp[1] = v[rr].y; tp[2] = v[rr].z; tp[3] = v[rr].w; }
        __syncthreads();
        const int n = tid >> 3, kq = (tid & 7) * 8;
#pragma unroll
        for (int kt = 0; kt < 4; ++kt) { const LAS float* tp = tile + kt * (64 * 65); uint4 w;
            w.x = pack2(tp[(kq + 0) * 65 + n], tp[(kq + 1) * 65 + n]); w.y = pack2(tp[(kq + 2) * 65 + n], tp[(kq + 3) * 65 + n]);
            w.z = pack2(tp[(kq + 4) * 65 + n], tp[(kq + 5) * 65 + n]); w.w = pack2(tp[(kq + 6) * 65 + n], tp[(kq + 7) * 65 + n]);
            *(uint4*)(dst + (size_t)(n0 + n) * K + k0 + kt * 64 + kq) = w; }
        __syncthreads();
    }
}

__device__ void s5_pre(CP P, int g, int dir, int part, LAS unsigned char* lds) {
    LAS f32x2* pw = (LAS f32x2*)lds;
    LAS f32x2* Bb = pw + 65 * 64;
    LAS f32x2* Cc = Bb + 64 * 16;
    const int tid = otid();
    float* Ktab = (float*)(P->ws + OFF_KTAB); float* AT = (float*)(P->ws + OFF_S5P);
    bf16_t* KG = (bf16_t*)(P->ws + OFF_KG); bf16_t* H = (bf16_t*)(P->ws + OFF_H);
    if (tid < 64) { const int n = tid, gi = (dir * 32 + g) * 64 + n;
        const double lr = fmin((double)P->in[9][gi], -1e-4), li = (double)P->in[10][gi], dt = (double)expf(P->in[15][dir * 32 + g]);
        const double em1 = (double)expm1f((float)(lr * dt)), mag = 1.0 + em1;
        double rev = li * dt * 0.15915494309189535; rev -= rint(rev); const float th = (float)(rev * 6.283185307179586), thh = 0.5f * th;
        const double sn_ = (double)sinf(th), shalf = (double)sinf(thh), cm1 = -2.0 * shalf * shalf;
        const double ar = mag * (1.0 + cm1), ai = mag * sn_, arm1 = em1 + cm1 + em1 * cm1, den = lr * lr + li * li;
        const double cr = (arm1 * lr + ai * li) / den, ci = (ai * lr - arm1 * li) / den;
#pragma unroll 1
        for (int p = 0; p < 16; ++p) { const double br = (double)P->in[11][gi * 16 + p], bi = (double)P->in[12][gi * 16 + p];
            Bb[n * 16 + p] = mkf2((float)(cr * br - ci * bi), (float)(cr * bi + ci * br)); }
        double xr = 1.0, xi = 0.0;
#pragma unroll 1
        for (int d = 0; d <= 64; ++d) { pw[d * 64 + n] = mkf2((float)xr, (float)xi); const double t0 = xr * ar - xi * ai; xi = xr * ai + xi * ar; xr = t0; }
        const f32x2 a64 = pw[64 * 64 + n];
        if (part == 0) { AT[((g * 2 + dir) * 64 + n) * 2 + 0] = a64.x; AT[((g * 2 + dir) * 64 + n) * 2 + 1] = a64.y; } }
#pragma unroll 1
    for (int idx = tid; idx < 16 * 64; idx += NTHR) { const int p = idx >> 6, n = idx & 63; const int ci_ = ((dir * 32 + g) * 16 + p) * 64 + n;
        Cc[idx] = mkf2(P->in[13][ci_], P->in[14][ci_]); }
    __syncthreads();
    { const int dq = tid >> 8, p = (tid >> 4) & 15, pp = tid & 15;
#pragma unroll 1
        for (int dd = 0; dd < 16; ++dd) { const int d = part * 32 + dq * 16 + dd; float acc = 0.f;
#pragma unroll 4
            for (int n = 0; n < 64; ++n) { const f32x2 w = pw[d * 64 + n], bb = Bb[n * 16 + pp], c = Cc[p * 64 + n];
                const float zr = w.x * bb.x - w.y * bb.y, zi = w.x * bb.y + w.y * bb.x; acc += c.x * zr - c.y * zi; }
            Ktab[((size_t)((g * 2 + dir) * 64 + d)) * 256 + p * 16 + pp] = acc; } }
#pragma unroll 1
    for (int idx = tid; idx < 512 * 64; idx += NTHR) { const int row = part * 512 + (idx >> 6), n = idx & 63, t = row >> 4, p = row & 15, d = dir == 0 ? t + 1 : 64 - t;
        const f32x2 w = pw[d * 64 + n], c = Cc[p * 64 + n]; const float gr = c.x * w.x - c.y * w.y, gi = c.x * w.y + c.y * w.x;
        *(unsigned*)(KG + ((size_t)(g * 1024 + row)) * 1280 + 1024 + dir * 128 + n * 2) = pack2(gr, -gi); }
#pragma unroll 1
    for (int idx = tid; idx < 32 * 64 * 8; idx += NTHR) { const int pp2 = (idx & 7) * 2, s = (idx >> 3) & 63, n = part * 32 + (idx >> 9), d = dir == 0 ? 63 - s : s;
        const f32x2 w = pw[d * 64 + n], b0 = Bb[n * 16 + pp2], b1 = Bb[n * 16 + pp2 + 1];
        const float hr0 = w.x * b0.x - w.y * b0.y, hi0 = w.x * b0.y + w.y * b0.x, hr1 = w.x * b1.x - w.y * b1.y, hi1 = w.x * b1.y + w.y * b1.x;
        const size_t row0 = (size_t)g * 256 + dir * 128 + n * 2;
        *(unsigned*)(H + row0 * 1024 + s * 16 + pp2) = pack2(hr0, hr1); *(unsigned*)(H + (row0 + 1) * 1024 + s * 16 + pp2) = pack2(hi0, hi1); }
    __syncthreads();
}

template <bool FINAL> __device__ void phase_norm(const float* __restrict__ x, const float* __restrict__ g, bf16_t* __restrict__ xb, float* __restrict__ ss_out, float* __restrict__ outf, int b0, int nb, int rbeg, int rend);
__device__ void phase_prologue(CP P, LAS unsigned char* lds) {
    const int tid = otid(), bq = obid();
    if (bq < 128) { if (EN(20)) s5_pre(P, bq >> 2, (bq >> 1) & 1, bq & 1, lds);
        phase_norm<false>(P->in[0], nullptr, (bf16_t*)(P->ws + OFF_XN), (float*)(P->ws + OFF_SSQ), nullptr, 0, 128, 0, 40960); return; }
    const int b0 = 128, nb = (int)gridDim.x - 128;
    if (EN(21)) { float* cs = (float*)(P->ws + OFF_ROPE); float* sn = cs + 8192 * 64;
        for (int idx = (bq - b0) * NTHR + tid; idx < 8192 * 64; idx += nb * NTHR) { const int pos = idx >> 6, f = idx & 63;
            const float inv = expf(-9.210340371976184f * (float)f * (1.0f / 64.0f)); const float ang = (float)pos * inv;
            cs[idx] = cosf(ang); sn[idx] = sinf(ang); } }
    phase_norm<false>(P->in[0], nullptr, (bf16_t*)(P->ws + OFF_XN), (float*)(P->ws + OFF_SSQ), nullptr, b0, nb, 40960, 65536);
    LAS float* tile = (LAS float*)lds;
    if (EN(22)) for (int l = 0; l < 2; ++l) {
        transpose_job(P->in[2] + (size_t)l * 1024 * 5632, 1024, 5632, (bf16_t*)(P->ws + OFF_W1 + (size_t)(2 * l) * SZ_W1), 5632, 1, tile, b0, nb, P->in[1] + l * 1024);
        transpose_job(P->in[6] + (size_t)l * 1024 * 5632, 1024, 5632, (bf16_t*)(P->ws + OFF_W1 + (size_t)(2 * l + 1) * SZ_W1), 5632, 1, tile, b0, nb, P->in[5] + l * 1024);
        transpose_job(P->in[3] + (size_t)l * 2816 * 1024, 2816, 1024, (bf16_t*)(P->ws + OFF_W2 + (size_t)(2 * l) * SZ_W2), 1024, 0, tile, b0, nb, nullptr);
        transpose_job(P->in[7] + (size_t)l * 2816 * 1024, 2816, 1024, (bf16_t*)(P->ws + OFF_W2 + (size_t)(2 * l + 1) * SZ_W2), 1024, 0, tile, b0, nb, nullptr);
    }
    if (EN(22)) transpose_job(P->in[8], 1024, 2080, (bf16_t*)(P->ws + OFF_WIN0), 2304, 0, tile, b0, nb, P->in[4]);
    if (EN(22)) transpose_job(P->in[17], 512, 512, (bf16_t*)(P->ws + OFF_WGLU), 512, 0, tile, b0, nb, nullptr);
    if (EN(22)) transpose_job(P->in[21], 1024, 1024, (bf16_t*)(P->ws + OFF_WOUT0), 1024, 0, tile, b0, nb, nullptr);
    if (EN(22)) transpose_job(P->in[22], 1024, 6144, (bf16_t*)(P->ws + OFF_WIN1), 6144, 2, tile, b0, nb, P->in[4] + 1024);
    if (EN(22)) transpose_job(P->in[24], 2048, 1024, (bf16_t*)(P->ws + OFF_WOUT1), 1024, 0, tile, b0, nb, nullptr);
}

__device__ void phase_kmat(CP P) {
    const float* Ktab = (const float*)(P->ws + OFF_KTAB); bf16_t* KG = (bf16_t*)(P->ws + OFF_KG); const float* dsk = P->in[16];
    for (int idx = obid() * NTHR + otid(); idx < 32 * 1024 * 512; idx += gridDim.x * NTHR) {
        const int kp = idx & 511, row = (idx >> 9) & 1023, g = idx >> 19, t = row >> 4, p = row & 15, k = kp * 2, s = k >> 4, pp = k & 15;
        float v0 = 0.f, v1 = 0.f;
        if (s <= t) { const float* b = Ktab + ((size_t)((g * 2 + 0) * 64 + (t - s))) * 256 + p * 16 + pp; v0 += b[0]; v1 += b[1]; }
        if (s >= t) { const float* b = Ktab + ((size_t)((g * 2 + 1) * 64 + (s - t))) * 256 + p * 16 + pp; v0 += b[0]; v1 += b[1]; }
        if (s == t) { const float dv = dsk[g * 16 + p]; if (pp == p) v0 += dv; if (pp + 1 == p) v1 += dv; }
        *(unsigned*)(KG + ((size_t)(g * 1024 + row)) * 1280 + k) = pack2(v0, v1);
    }
}

template <bool FINAL>
__device__ void phase_norm(const float* __restrict__ x, const float* __restrict__ g, bf16_t* __restrict__ xb, float* __restrict__ ss_out, float* __restrict__ outf, int b0, int nb, int rbeg, int rend) {
    const int tid_ = otid(), lane = tid_ & 63, wid = tid_ >> 6; const int bq = obid() - b0;
    if (bq < 0) return;
    f32x4 gv[4];
#pragma unroll
    for (int i = 0; i < 4; ++i) gv[i] = FINAL ? *(const f32x4*)(g + (lane + 64 * i) * 4) : (f32x4){1.f, 1.f, 1.f, 1.f};
    for (int row0 = rbeg + bq * 8 + wid; row0 < rend; row0 += nb * 16) {
        const int row1 = row0 + nb * 8; const bool has1 = row1 < rend;
        const float* xr0 = x + (size_t)row0 * 1024; const float* xr1 = x + (size_t)(has1 ? row1 : row0) * 1024; f32x4 v[4], u[4]; float ss = 0.f, st = 0.f;
#pragma unroll
        for (int i = 0; i < 4; ++i) { v[i] = *(const f32x4*)(xr0 + (lane + 64 * i) * 4); u[i] = *(const f32x4*)(xr1 + (lane + 64 * i) * 4); }
#pragma unroll
        for (int i = 0; i < 4; ++i) { ss += v[i][0] * v[i][0] + v[i][1] * v[i][1] + v[i][2] * v[i][2] + v[i][3] * v[i][3]; st += u[i][0] * u[i][0] + u[i][1] * u[i][1] + u[i][2] * u[i][2] + u[i][3] * u[i][3]; }
#pragma unroll
        for (int o = 32; o > 0; o >>= 1) { ss += __shfl_xor(ss, o); st += __shfl_xor(st, o); }
#pragma unroll
        for (int rr = 0; rr < 2; ++rr) { if (rr == 1 && !has1) break; const int row = rr ? row1 : row0; const float sv = rr ? st : ss;
            if (FINAL) { const float rstd = rsqrtf(sv * (1.0f / 1024.0f) + 1e-6f);
#pragma unroll
                for (int i = 0; i < 4; ++i) *(f32x4*)(outf + (size_t)row * 1024 + (lane + 64 * i) * 4) = (rr ? u[i] : v[i]) * rstd * gv[i]; }
            else { if (lane < 16) ss_out[(size_t)row * 16 + lane] = lane == 0 ? sv : 0.f;
#pragma unroll
                for (int i = 0; i < 4; ++i) { const f32x4 y = rr ? u[i] : v[i]; uint2 w; w.x = pack2(y[0], y[1]); w.y = pack2(y[2], y[3]); *(uint2*)(xb + (size_t)row * 1024 + (lane + 64 * i) * 4) = w; } } }
    }
}

__device__ __forceinline__ f32x4 mma16(const LAS bf16_t* As, int lda, const LAS bf16_t* Bs, int ldb, int K, f32x4 acc, int lane) {
    const int r = lane & 15, q = lane >> 4;
#pragma unroll
    for (int k = 0; k < K; k += 32) { const bf16x8 a = *(const LAS bf16x8*)(As + r * lda + k + q * 8); const bf16x8 b = *(const LAS bf16x8*)(Bs + r * ldb + k + q * 8);
        acc = __builtin_amdgcn_mfma_f32_16x16x32_bf16(b, a, acc, 0, 0, 0); }
    return acc;
}


typedef short s16x4 __attribute__((ext_vector_type(4)));
__device__ __forceinline__ bf16x8 frag_tr(const LAS bf16_t* T, int ld, int lane) {
    const int g = lane >> 4, qq = (lane & 15) >> 2, p = lane & 3;
    LAS bf16_t* a = (LAS bf16_t*)T + (8 * g + qq) * ld + 4 * p;
    const s16x4 lo = __builtin_amdgcn_ds_read_tr16_b64_v4i16((LAS s16x4*)a);
    const s16x4 hi = __builtin_amdgcn_ds_read_tr16_b64_v4i16((LAS s16x4*)(a + 4 * ld));
    return (bf16x8){lo[0], lo[1], lo[2], lo[3], hi[0], hi[1], hi[2], hi[3]};
}

__device__ __forceinline__ void lds_barrier() { asm volatile("s_waitcnt lgkmcnt(0)" ::: "memory"); __builtin_amdgcn_s_barrier(); asm volatile("" ::: "memory"); }

__device__ void phase_s5_scan(CP P) {
    const float* E = (const float*)(P->ws + OFF_E); const float* AT = (const float*)(P->ws + OFF_S5P); bf16_t* AS5 = (bf16_t*)(P->ws + OFF_AS5);
    const int tid_ = otid(); if (tid_ >= 128) return;
    for (int idx = obid() * 128 + tid_; idx < 32 * 8 * 2 * 64; idx += gridDim.x * 128) {
        const int n = idx & 63, dir = (idx >> 6) & 1, b = (idx >> 7) & 7, g = idx >> 10;
        const float ar = AT[((g * 2 + dir) * 64 + n) * 2], ai = AT[((g * 2 + dir) * 64 + n) * 2 + 1];
        float xr = 0.f, xi = 0.f;
#pragma unroll 16
        for (int cc = 0; cc < 128; ++cc) { const int c = dir == 0 ? cc : 127 - cc; const size_t bc = (size_t)g * 1024 + b * 128 + c;
            *(unsigned*)(AS5 + bc * 1280 + 1024 + dir * 128 + n * 2) = pack2(xr, xi);
            const float2 e = *(const float2*)(E + bc * 256 + dir * 128 + n * 2);
            const float t0 = ar * xr - ai * xi + e.x; xi = ar * xi + ai * xr + e.y; xr = t0; }
    }
}

__device__ __forceinline__ void gla_gates(CP P, const bf16_t* PQ, int m0, int h, LAS unsigned char* lds) {
    LAS float* gl = (LAS float*)lds; LAS float* tot = (LAS float*)(lds + 8192); LAS float* G = (LAS float*)(lds + 17408);
    const int tid = otid();
    const int dir = tid >> 8, d = tid & 63, tq = (tid >> 6) & 3;
    { const int idx = tid * 4, t = idx >> 5, r = idx & 31; const uint2 raw = *(const uint2*)(PQ + (size_t)(m0 + t) * 1792 + 1536 + r);
        *(LAS f32x4*)(gl + idx) = (f32x4){bflo(raw.x), bfhi(raw.x), bflo(raw.y), bfhi(raw.y)}; }
    float w[16];
#pragma unroll
    for (int r = 0; r < 16; ++r) w[r] = P->in[18][(dir * 16 + r) * 256 + h * 64 + d];
    const float b = P->in[19][dir * 256 + h * 64 + d];
    lds_barrier();
    float c[16];
#pragma unroll
    for (int i = 0; i < 16; ++i) { const int t = tq * 16 + i; float z = b;
#pragma unroll
        for (int r4 = 0; r4 < 4; ++r4) { const f32x4 g4 = *(const LAS f32x4*)(gl + t * 32 + dir * 16 + r4 * 4);
            z += g4[0] * w[r4 * 4] + g4[1] * w[r4 * 4 + 1] + g4[2] * w[r4 * 4 + 2] + g4[3] * w[r4 * 4 + 3]; }
        c[i] = (fminf(z, 0.f) - __logf(1.0f + __expf(-fabsf(z)))) * (1.0f / 16.0f); }
    if (dir == 0) {
#pragma unroll
        for (int i = 1; i < 16; ++i) c[i] += c[i - 1];
        tot[(dir * 4 + tq) * 64 + d] = c[15]; }
    else {
#pragma unroll
        for (int i = 14; i >= 0; --i) c[i] += c[i + 1];
        tot[(dir * 4 + tq) * 64 + d] = c[0]; }
    lds_barrier();
    float off = 0.f;
#pragma unroll
    for (int q = 0; q < 4; ++q) { const float tv = tot[(dir * 4 + q) * 64 + d]; off += ((dir == 0) ? (q < tq) : (q > tq)) ? tv : 0.f; }
#pragma unroll
    for (int i = 0; i < 16; ++i) G[(dir * 64 + tq * 16 + i) * 64 + d] = c[i] + off;
    lds_barrier();
}

__device__ void gla_a_unit(CP P, int unit, LAS unsigned char* lds) {
    const int c = unit & 127, h = (unit >> 7) & 3, b = unit >> 9, m0 = b * 8192 + c * 64;
    const bf16_t* PQ = (const bf16_t*)(P->ws + OFF_PQ); bf16_t* GST = (bf16_t*)(P->ws + OFF_GST); float* GDEC = (float*)(P->ws + OFF_GDEC);
    const int tid = otid(), lane = tid & 63, wid = tid >> 6;
    const int t = tid >> 3, d8 = (tid & 7) * 8, v16 = (tid & 7) * 16;
    const uint4 kraw = *(const uint4*)(PQ + (size_t)(m0 + t) * 1792 + 256 + h * 64 + d8);
    const uint4 vr0 = *(const uint4*)(PQ + (size_t)(m0 + t) * 1792 + 512 + h * 128 + v16), vr1 = *(const uint4*)(PQ + (size_t)(m0 + t) * 1792 + 512 + h * 128 + v16 + 8);
    gla_gates(P, PQ, m0, h, lds);
    LAS float* G = (LAS float*)(lds + 17408);
    LAS bf16_t* kA = (LAS bf16_t*)(lds + 50176);
    LAS bf16_t* Vs = (LAS bf16_t*)(lds + 67584);
    { const unsigned rw[4] = {kraw.x, kraw.y, kraw.z, kraw.w}; float ef[8], eb[8];
#pragma unroll
        for (int q = 0; q < 2; ++q) { const f32x4 lf = *(const LAS f32x4*)(G + 63 * 64 + d8 + q * 4), cf = *(const LAS f32x4*)(G + t * 64 + d8 + q * 4);
            const f32x4 lb = *(const LAS f32x4*)(G + 64 * 64 + d8 + q * 4), cb = *(const LAS f32x4*)(G + (64 + t) * 64 + d8 + q * 4);
#pragma unroll
            for (int j = 0; j < 4; ++j) { ef[q * 4 + j] = __expf(lf[j] - cf[j]); eb[q * 4 + j] = __expf(lb[j] - cb[j]); } }
        unsigned of[4], ob[4];
#pragma unroll
        for (int i = 0; i < 4; ++i) { const float k0 = bflo(rw[i]), k1 = bfhi(rw[i]); of[i] = pack2(k0 * ef[2 * i], k1 * ef[2 * i + 1]); ob[i] = pack2(k0 * eb[2 * i], k1 * eb[2 * i + 1]); }
        *(LAS u32x4*)(kA + t * 136 + d8) = mk4(of[0], of[1], of[2], of[3]); *(LAS u32x4*)(kA + t * 136 + 64 + d8) = mk4(ob[0], ob[1], ob[2], ob[3]);
        *(LAS u32x4*)(Vs + t * 136 + v16) = mk4(vr0.x, vr0.y, vr0.z, vr0.w); *(LAS u32x4*)(Vs + t * 136 + v16 + 8) = mk4(vr1.x, vr1.y, vr1.z, vr1.w); }
    if (tid < 128) { const int dir = tid >> 6, d = tid & 63; const float last = dir == 0 ? G[63 * 64 + d] : G[64 * 64 + d];
        GDEC[((size_t)(((b * 4 + h) * 2 + dir) * 128 + c)) * 64 + d] = __expf(last); }
    lds_barrier();
    { f32x4 acc[8];
#pragma unroll
        for (int nt = 0; nt < 8; ++nt) acc[nt] = (f32x4){0.f, 0.f, 0.f, 0.f};
#pragma unroll
        for (int ks = 0; ks < 2; ++ks) { const bf16x8 af = frag_tr(kA + ks * 32 * 136 + wid * 16, 136, lane);
#pragma unroll
            for (int nt = 0; nt < 8; ++nt) { const bf16x8 bfr = frag_tr(Vs + ks * 32 * 136 + nt * 16, 136, lane); acc[nt] = __builtin_amdgcn_mfma_f32_16x16x32_bf16(bfr, af, acc[nt], 0, 0, 0); } }
        const int row = wid * 16 + (lane & 15), dir = row >> 6, d = row & 63; bf16_t* out = GST + ((size_t)(((b * 4 + h) * 2 + dir) * 128 + c)) * 8192 + d * 128 + 4 * (lane >> 4);
#pragma unroll
        for (int nt = 0; nt < 8; ++nt) { uint2 w; w.x = pack2(acc[nt][0], acc[nt][1]); w.y = pack2(acc[nt][2], acc[nt][3]); *(uint2*)(out + nt * 16) = w; } }
    lds_barrier();
}

__device__ void phase_gla_b(CP P) {
    bf16_t* GST = (bf16_t*)(P->ws + OFF_GST); const float* GDEC = (const float*)(P->ws + OFF_GDEC);
    for (int idx = obid() * NTHR + otid(); idx < 64 * 1024; idx += gridDim.x * NTHR) {
        const int bhd = idx >> 10, e = (idx & 1023) * 8, d = e >> 7, dir = bhd & 1;
        f32x4 S0 = (f32x4){0.f, 0.f, 0.f, 0.f}, S1 = S0;
#pragma unroll 8
        for (int cc = 0; cc < 128; ++cc) { const int c = dir == 0 ? cc : 127 - cc; bf16_t* p = GST + ((size_t)(bhd * 128 + c)) * 8192 + e;
            const uint4 t = *(const uint4*)p; const float dec = GDEC[((size_t)(bhd * 128 + c)) * 64 + d];
            uint4 o; o.x = pack2(S0[0], S0[1]); o.y = pack2(S0[2], S0[3]); o.z = pack2(S1[0], S1[1]); o.w = pack2(S1[2], S1[3]); *(uint4*)p = o;
            S0 = dec * S0 + (f32x4){bflo(t.x), bfhi(t.x), bflo(t.y), bfhi(t.y)}; S1 = dec * S1 + (f32x4){bflo(t.z), bfhi(t.z), bflo(t.w), bfhi(t.w)}; }
    }
}

__device__ void gla_c_unit(CP P, int unit, LAS unsigned char* lds) {
    const int c = unit & 127, h = (unit >> 7) & 3, b = unit >> 9, m0 = b * 8192 + c * 64;
    const bf16_t* PQ = (const bf16_t*)(P->ws + OFF_PQ); const bf16_t* GST = (const bf16_t*)(P->ws + OFF_GST); bf16_t* MIX = (bf16_t*)(P->ws + OFF_XN);
    const int tid = otid(), lane = tid & 63, wid = tid >> 6;
    const int t = tid >> 3, d8 = (tid & 7) * 8, v16 = (tid & 7) * 16;
    const uint4 rq = *(const uint4*)(PQ + (size_t)(m0 + t) * 1792 + h * 64 + d8), rk = *(const uint4*)(PQ + (size_t)(m0 + t) * 1792 + 256 + h * 64 + d8);
    const uint4 vr0 = *(const uint4*)(PQ + (size_t)(m0 + t) * 1792 + 512 + h * 128 + v16), vr1 = *(const uint4*)(PQ + (size_t)(m0 + t) * 1792 + 512 + h * 128 + v16 + 8);
    const uint4 ogr0 = *(const uint4*)(PQ + (size_t)(m0 + t) * 1792 + 1024 + h * 128 + v16), ogr1 = *(const uint4*)(PQ + (size_t)(m0 + t) * 1792 + 1024 + h * 128 + v16 + 8);
    uint4 sr[4];
#pragma unroll
    for (int i = 0; i < 4; ++i) { const int idx = tid + i * NTHR, v8 = (idx & 15) * 8, d = (idx >> 4) & 63, dir = idx >> 10;
        sr[i] = *(const uint4*)(GST + ((size_t)(((b * 4 + h) * 2 + dir) * 128 + c)) * 8192 + d * 128 + v8); }
    gla_gates(P, PQ, m0, h, lds);
    LAS float* G = (LAS float*)(lds + 17408);
    LAS bf16_t* Ps = (LAS bf16_t*)lds;
    LAS bf16_t* qf = (LAS bf16_t*)(lds + 51200);
    LAS bf16_t* kf = qf + 64 * 72; LAS bf16_t* qb = kf + 64 * 72; LAS bf16_t* kb = qb + 64 * 72;
    LAS bf16_t* Vs = (LAS bf16_t*)(lds + 88064);
    LAS bf16_t* Ss = (LAS bf16_t*)(lds + 105472);
    { const unsigned qw[4] = {rq.x, rq.y, rq.z, rq.w}, kw[4] = {rk.x, rk.y, rk.z, rk.w};
        unsigned oqf[4], okf[4], oqb[4], okb[4]; float cf[8], cb[8];
#pragma unroll
        for (int q = 0; q < 2; ++q) { const f32x4 a = *(const LAS f32x4*)(G + t * 64 + d8 + q * 4), bb = *(const LAS f32x4*)(G + (64 + t) * 64 + d8 + q * 4);
#pragma unroll
            for (int j = 0; j < 4; ++j) { cf[q * 4 + j] = a[j]; cb[q * 4 + j] = bb[j]; } }
#pragma unroll
        for (int i = 0; i < 4; ++i) { const float cf0 = cf[2 * i], cf1 = cf[2 * i + 1], cb0 = cb[2 * i], cb1 = cb[2 * i + 1];
            const float q0 = bflo(qw[i]) * 0.125f, q1 = bfhi(qw[i]) * 0.125f, k0 = bflo(kw[i]), k1 = bfhi(kw[i]);
            oqf[i] = pack2(q0 * __expf(cf0), q1 * __expf(cf1)); okf[i] = pack2(k0 * __expf(-cf0), k1 * __expf(-cf1));
            oqb[i] = pack2(q0 * __expf(cb0), q1 * __expf(cb1)); okb[i] = pack2(k0 * __expf(-cb0), k1 * __expf(-cb1)); }
        *(LAS u32x4*)(qf + t * 72 + d8) = mk4(oqf[0], oqf[1], oqf[2], oqf[3]); *(LAS u32x4*)(kf + t * 72 + d8) = mk4(okf[0], okf[1], okf[2], okf[3]);
        *(LAS u32x4*)(qb + t * 72 + d8) = mk4(oqb[0], oqb[1], oqb[2], oqb[3]); *(LAS u32x4*)(kb + t * 72 + d8) = mk4(okb[0], okb[1], okb[2], okb[3]);
        *(LAS u32x4*)(Vs + t * 136 + v16) = mk4(vr0.x, vr0.y, vr0.z, vr0.w); *(LAS u32x4*)(Vs + t * 136 + v16 + 8) = mk4(vr1.x, vr1.y, vr1.z, vr1.w); }
#pragma unroll
    for (int i = 0; i < 4; ++i) { const int idx = tid + i * NTHR, v8 = (idx & 15) * 8, d = (idx >> 4) & 63, dir = idx >> 10;
        *(LAS u32x4*)(Ss + (dir * 64 + d) * 136 + v8) = mk4(sr[i].x, sr[i].y, sr[i].z, sr[i].w); }
    lds_barrier();
#pragma unroll
    for (int tl = 0; tl < 2; ++tl) { const int tile = wid * 2 + tl, mi = tile >> 2, ni = tile & 3; f32x4 pf = (f32x4){0.f, 0.f, 0.f, 0.f}, pb = pf;
        pf = mma16(qf + mi * 16 * 72, 72, kf + ni * 16 * 72, 72, 64, pf, lane); pb = mma16(qb + mi * 16 * 72, 72, kb + ni * 16 * 72, 72, 64, pb, lane);
        const int i = mi * 16 + (lane & 15), j0 = ni * 16 + 4 * (lane >> 4); float pv[4];
#pragma unroll
        for (int jj = 0; jj < 4; ++jj) pv[jj] = (j0 + jj <= i) ? pf[jj] : pb[jj];
        *(LAS u32x2*)(Ps + i * 72 + j0) = mk2(pack2(pv[0], pv[1]), pack2(pv[2], pv[3])); }
    lds_barrier();
    { const int mi = wid & 3, nb = (wid >> 2) * 4; LAS float* ost = G; f32x4 acc[4];
#pragma unroll
        for (int nt = 0; nt < 4; ++nt) acc[nt] = (f32x4){0.f, 0.f, 0.f, 0.f};
#pragma unroll
        for (int ks = 0; ks < 2; ++ks) {
            const bf16x8 ap = *(const LAS bf16x8*)(Ps + (mi * 16 + (lane & 15)) * 72 + ks * 32 + (lane >> 4) * 8);
            const bf16x8 af = *(const LAS bf16x8*)(qf + (mi * 16 + (lane & 15)) * 72 + ks * 32 + (lane >> 4) * 8);
            const bf16x8 ab = *(const LAS bf16x8*)(qb + (mi * 16 + (lane & 15)) * 72 + ks * 32 + (lane >> 4) * 8);
#pragma unroll
            for (int nt = 0; nt < 4; ++nt) { const int ni = nb + nt;
                acc[nt] = __builtin_amdgcn_mfma_f32_16x16x32_bf16(frag_tr(Vs + ks * 32 * 136 + ni * 16, 136, lane), ap, acc[nt], 0, 0, 0);
                acc[nt] = __builtin_amdgcn_mfma_f32_16x16x32_bf16(frag_tr(Ss + ks * 32 * 136 + ni * 16, 136, lane), af, acc[nt], 0, 0, 0);
                acc[nt] = __builtin_amdgcn_mfma_f32_16x16x32_bf16(frag_tr(Ss + (64 + ks * 32) * 136 + ni * 16, 136, lane), ab, acc[nt], 0, 0, 0); } }
#pragma unroll
        for (int nt = 0; nt < 4; ++nt) *(LAS f32x4*)(ost + (mi * 16 + (lane & 15)) * 132 + (nb + nt) * 16 + 4 * (lane >> 4)) = acc[nt]; }
    lds_barrier();
    { LAS float* ost = G; float o[16]; float ss = 0.f;
#pragma unroll
        for (int i = 0; i < 4; ++i) { const f32x4 v = *(const LAS f32x4*)(ost + t * 132 + v16 + i * 4); o[4 * i] = v[0]; o[4 * i + 1] = v[1]; o[4 * i + 2] = v[2]; o[4 * i + 3] = v[3]; ss += v[0] * v[0] + v[1] * v[1] + v[2] * v[2] + v[3] * v[3]; }
        ss += __shfl_xor(ss, 1); ss += __shfl_xor(ss, 2); ss += __shfl_xor(ss, 4);
        const float rstd = rsqrtf(ss * (1.0f / 128.0f) + 1e-6f);
        const float* gn = P->in[20] + h * 128 + v16;
        bf16_t* op = MIX + (size_t)(m0 + t) * 1024 + 512 + h * 128 + v16;
#pragma unroll
        for (int hh = 0; hh < 2; ++hh) { const uint4 raw = hh ? ogr1 : ogr0; const unsigned rw[4] = {raw.x, raw.y, raw.z, raw.w}; unsigned ow[4];
#pragma unroll
            for (int i = 0; i < 4; ++i) { const int e = hh * 8 + 2 * i; const float g0 = bflo(rw[i]), g1 = bfhi(rw[i]);
                ow[i] = pack2(o[e] * rstd * gn[e] * silu_f(g0), o[e + 1] * rstd * gn[e + 1] * silu_f(g1)); }
            *(uint4*)(op + hh * 8) = make_uint4(ow[0], ow[1], ow[2], ow[3]); } }
    lds_barrier();
}

__device__ __forceinline__ float ret_lg(int h) {
    float v = -0.0317486983145803f;
    v = h == 1 ? -0.015748356968139168f : v; v = h == 2 ? -0.007843177461025893f : v; v = h == 3 ? -0.003913899321136329f : v; v = h == 4 ? -0.0019550348358033506f : v;
    v = h == 5 ? -0.0009770396478266127f : v; v = h == 6 ? -0.0004884004981088745f : v; v = h == 7 ? -0.0002441704321739145f : v; return v;
}

struct KRaw { uint4 a, b; };
__device__ __forceinline__ KRaw rot_load(const bf16_t* rowp, const float*, const float*, int dq) { KRaw k; k.a = *(const uint4*)(rowp + dq); k.b = *(const uint4*)(rowp + 64 + dq); return k; }
__device__ __forceinline__ void rot_apply(const KRaw& k, float (&r1)[8], float (&r2)[8]) {
    const unsigned aw[4] = {k.a.x, k.a.y, k.a.z, k.a.w}, bw[4] = {k.b.x, k.b.y, k.b.z, k.b.w};
#pragma unroll
    for (int i = 0; i < 8; ++i) { r1[i] = (i & 1) ? bfhi(aw[i >> 1]) : bflo(aw[i >> 1]); r2[i] = (i & 1) ? bfhi(bw[i >> 1]) : bflo(bw[i >> 1]); }
}

__device__ void ret_a_unit(CP P, int hf, int unit, LAS unsigned char* lds) {
    const int sc = unit & 31, h = (unit >> 5) & 7, bl = unit >> 8;
    const bf16_t* PR = (const bf16_t*)(P->ws + OFF_PROJ1); bf16_t* RST = (bf16_t*)(P->ws + OFF_RST);
    const int tid = otid(), lane = tid & 63, wid = tid >> 6;
    const size_t r0 = (size_t)bl * 8192 + sc * 256;
    const float lgf = ret_lg(h), lgb = ret_lg(7 - h);
    LAS bf16_t* kf = (LAS bf16_t*)lds;
    LAS bf16_t* kb = (LAS bf16_t*)(lds + 17408);
    LAS bf16_t* Vs = (LAS bf16_t*)(lds + 34816);
    f32x4 acc[4][8];
#pragma unroll
    for (int a = 0; a < 4; ++a)
#pragma unroll
        for (int n = 0; n < 8; ++n) acc[a][n] = (f32x4){0.f, 0.f, 0.f, 0.f};
    const int mb = (wid >> 1) * 4, nb = (wid & 1) * 8;
    const LAS bf16_t* kA = (mb >= 8) ? kb : kf; const int dt0 = (mb & 7) * 16;
    const int pj = tid >> 3, pdq = (tid & 7) * 8, pv32 = (tid & 7) * 32;
    const bf16_t* kbase = PR + (r0 + pj) * 6144 + 1024 + h * 128; const bf16_t* vbase = PR + (r0 + pj) * 6144 + 2048 + h * 256 + pv32;
    KRaw kr = rot_load(kbase, nullptr, nullptr, pdq);
    uint4 vr[4];
#pragma unroll
    for (int hh = 0; hh < 4; ++hh) vr[hh] = *(const uint4*)(vbase + hh * 8);
    for (int jb = 0; jb < 4; ++jb) {
        { const int j = pj, dq = pdq, J = jb * 64 + j; float r1[8], r2[8];
            rot_apply(kr, r1, r2);
            const float sf = __expf((float)(255 - J) * lgf), sb = __expf((float)J * lgb);
            *(LAS u32x4*)(kf + j * 136 + dq) = mk4(pack2(r1[0] * sf, r1[1] * sf), pack2(r1[2] * sf, r1[3] * sf), pack2(r1[4] * sf, r1[5] * sf), pack2(r1[6] * sf, r1[7] * sf));
            *(LAS u32x4*)(kf + j * 136 + 64 + dq) = mk4(pack2(r2[0] * sf, r2[1] * sf), pack2(r2[2] * sf, r2[3] * sf), pack2(r2[4] * sf, r2[5] * sf), pack2(r2[6] * sf, r2[7] * sf));
            *(LAS u32x4*)(kb + j * 136 + dq) = mk4(pack2(r1[0] * sb, r1[1] * sb), pack2(r1[2] * sb, r1[3] * sb), pack2(r1[4] * sb, r1[5] * sb), pack2(r1[6] * sb, r1[7] * sb));
            *(LAS u32x4*)(kb + j * 136 + 64 + dq) = mk4(pack2(r2[0] * sb, r2[1] * sb), pack2(r2[2] * sb, r2[3] * sb), pack2(r2[4] * sb, r2[5] * sb), pack2(r2[6] * sb, r2[7] * sb));
#pragma unroll
            for (int hh = 0; hh < 4; ++hh) *(LAS u32x4*)(Vs + j * 264 + pv32 + hh * 8) = mk4(vr[hh].x, vr[hh].y, vr[hh].z, vr[hh].w); }
        lds_barrier();
        if (jb < 3) { kr = rot_load(kbase + (size_t)(jb + 1) * 64 * 6144, nullptr, nullptr, pdq);
#pragma unroll
            for (int hh = 0; hh < 4; ++hh) vr[hh] = *(const uint4*)(vbase + (size_t)(jb + 1) * 64 * 6144 + hh * 8); }
#pragma unroll
        for (int ks = 0; ks < 2; ++ks) { bf16x8 af[4];
#pragma unroll
            for (int a = 0; a < 4; ++a) af[a] = frag_tr(kA + ks * 32 * 136 + dt0 + a * 16, 136, lane);
#pragma unroll
            for (int n = 0; n < 8; ++n) { const bf16x8 bfr = frag_tr(Vs + ks * 32 * 264 + (nb + n) * 16, 264, lane);
#pragma unroll
                for (int a = 0; a < 4; ++a) acc[a][n] = __builtin_amdgcn_mfma_f32_16x16x32_bf16(bfr, af[a], acc[a][n], 0, 0, 0); } }
        lds_barrier();
    }
#pragma unroll
    for (int a = 0; a < 4; ++a) { const int row = (mb + a) * 16 + (lane & 15), dir = row >> 7, d = row & 127;
        bf16_t* out = RST + ((size_t)(((bl * 8 + h) * 2 + dir) * 32 + sc)) * 32768 + d * 256 + 4 * (lane >> 4);
#pragma unroll
        for (int n = 0; n < 8; ++n) { uint2 w; w.x = pack2(acc[a][n][0], acc[a][n][1]); w.y = pack2(acc[a][n][2], acc[a][n][3]); *(uint2*)(out + (nb + n) * 16) = w; } }
}

__device__ void phase_ret_b(CP P) {
    bf16_t* RST = (bf16_t*)(P->ws + OFF_RST);
    for (int idx = obid() * NTHR + otid(); idx < 64 * 4096; idx += gridDim.x * NTHR) {
        const int bhd = idx >> 12, e = (idx & 4095) * 8, dir = bhd & 1, h = (bhd >> 1) & 7;
        const float dec = __expf(256.0f * ret_lg(dir == 0 ? h : 7 - h));
        f32x4 S0 = (f32x4){0.f, 0.f, 0.f, 0.f}, S1 = S0;
#pragma unroll 8
        for (int cc = 0; cc < 32; ++cc) { const int c = dir == 0 ? cc : 31 - cc; bf16_t* p = RST + ((size_t)(bhd * 32 + c)) * 32768 + e;
            const uint4 t = *(const uint4*)p; uint4 o; o.x = pack2(S0[0], S0[1]); o.y = pack2(S0[2], S0[3]); o.z = pack2(S1[0], S1[1]); o.w = pack2(S1[2], S1[3]); *(uint4*)p = o;
            S0 = dec * S0 + (f32x4){bflo(t.x), bfhi(t.x), bflo(t.y), bfhi(t.y)}; S1 = dec * S1 + (f32x4){bflo(t.z), bfhi(t.z), bflo(t.w), bfhi(t.w)}; }
    }
}

__device__ void ret_c_unit(CP P, int hf, int unit, LAS unsigned char* lds) {
    const int rh = (unit >> 3) & 1, ur = (unit & 7) | ((unit >> 4) << 3), sc = ur & 31, h = (ur >> 5) & 7, bl = ur >> 8;
    const bf16_t* PR = (const bf16_t*)(P->ws + OFF_PROJ1); const bf16_t* RST = (const bf16_t*)(P->ws + OFF_RST);
    const float* cs = (const float*)(P->ws + OFF_ROPE); const float* sn = cs + 8192 * 64;
    const int tid = otid(), lane = tid & 63, wid = tid >> 6;
    const size_t r0 = (size_t)bl * 8192 + sc * 256;
    const float lgf = ret_lg(h), lgb = ret_lg(7 - h);
    LAS bf16_t* qs = (LAS bf16_t*)lds;
    LAS bf16_t* ks = (LAS bf16_t*)(lds + 34816);
    LAS bf16_t* Ps = (LAS bf16_t*)(lds + 52224);
    LAS bf16_t* Vs = (LAS bf16_t*)(lds + 70656);
    LAS float* red = (LAS float*)(lds + 104448);
    LAS bf16_t* qx = ks;
#pragma unroll
    for (int rep = 0; rep < 2; ++rep) { const int i = (tid >> 3) + rep * 64, dq = (tid & 7) * 8, I = rh * 128 + i;
        const KRaw q_ = rot_load(PR + (r0 + I) * 6144 + h * 128, nullptr, nullptr, dq);
        *(LAS u32x4*)(qs + i * 136 + dq) = mk4(q_.a.x, q_.a.y, q_.a.z, q_.a.w); *(LAS u32x4*)(qs + i * 136 + 64 + dq) = mk4(q_.b.x, q_.b.y, q_.b.z, q_.b.w); }
    f32x4 acc[2][8];
#pragma unroll
    for (int r = 0; r < 2; ++r)
#pragma unroll
        for (int n = 0; n < 8; ++n) acc[r][n] = (f32x4){0.f, 0.f, 0.f, 0.f};
    const int mi2 = (wid & 3) * 2, nb = (wid >> 2) * 8;
    const int pj = tid >> 3, pdq = (tid & 7) * 8, pv32 = (tid & 7) * 32;
    const bf16_t* kbase = PR + (r0 + pj) * 6144 + 1024 + h * 128; const bf16_t* vbase = PR + (r0 + pj) * 6144 + 2048 + h * 256 + pv32;
    KRaw kr = rot_load(kbase, cs + (sc * 256 + pj) * 64, sn + (sc * 256 + pj) * 64, pdq);
    uint4 vr[4];
#pragma unroll
    for (int hh = 0; hh < 4; ++hh) vr[hh] = *(const uint4*)(vbase + hh * 8);
    uint4 st[4];
    const bf16_t* sbase = RST + ((size_t)((bl * 8 + h) * 2) * 32 + sc) * 32768;
    for (int kb = 0; kb < 4; ++kb) {
        { const int j = pj, dq = pdq;
            *(LAS u32x4*)(ks + j * 136 + dq) = mk4(kr.a.x, kr.a.y, kr.a.z, kr.a.w); *(LAS u32x4*)(ks + j * 136 + 64 + dq) = mk4(kr.b.x, kr.b.y, kr.b.z, kr.b.w);
#pragma unroll
            for (int hh = 0; hh < 4; ++hh) *(LAS u32x4*)(Vs + j * 264 + pv32 + hh * 8) = mk4(vr[hh].x, vr[hh].y, vr[hh].z, vr[hh].w); }
        lds_barrier();
        if (kb < 3) { const int J = (kb + 1) * 64 + pj; kr = rot_load(kbase + (size_t)(kb + 1) * 64 * 6144, cs + (sc * 256 + J) * 64, sn + (sc * 256 + J) * 64, pdq);
#pragma unroll
            for (int hh = 0; hh < 4; ++hh) vr[hh] = *(const uint4*)(vbase + (size_t)(kb + 1) * 64 * 6144 + hh * 8); }
        else {
#pragma unroll
            for (int i = 0; i < 4; ++i) { const int idx = tid + i * NTHR, v8 = (idx & 31) * 8, dd = idx >> 5; st[i] = *(const uint4*)(sbase + dd * 256 + v8); } }
#pragma unroll
        for (int tr = 0; tr < 2; ++tr)
#pragma unroll
            for (int tc = 0; tc < 2; ++tc) { const int ti = mi2 + tr, tj = (wid >> 2) * 2 + tc; f32x4 s = (f32x4){0.f, 0.f, 0.f, 0.f};
                s = mma16(qs + ti * 16 * 136, 136, ks + tj * 16 * 136, 136, 128, s, lane);
                const int i = ti * 16 + (lane & 15), j0 = tj * 16 + 4 * (lane >> 4), I = rh * 128 + i; float pv[4];
#pragma unroll
                for (int jj = 0; jj < 4; ++jj) { const int df = I - (kb * 64 + j0 + jj); const float dm = df >= 0 ? __expf((float)df * lgf) : __expf((float)(-df) * lgb); pv[jj] = s[jj] * dm; }
                *(LAS u32x2*)(Ps + i * 72 + j0) = mk2(pack2(pv[0], pv[1]), pack2(pv[2], pv[3])); }
        lds_barrier();
#pragma unroll
        for (int k2 = 0; k2 < 2; ++k2) { bf16x8 af[2], bfr[8];
#pragma unroll
            for (int r = 0; r < 2; ++r) af[r] = *(const LAS bf16x8*)(Ps + ((mi2 + r) * 16 + (lane & 15)) * 72 + k2 * 32 + (lane >> 4) * 8);
#pragma unroll
            for (int n = 0; n < 8; ++n) bfr[n] = frag_tr(Vs + k2 * 32 * 264 + (nb + n) * 16, 264, lane);
#pragma unroll
            for (int r = 0; r < 2; ++r)
#pragma unroll
                for (int n = 0; n < 8; ++n) acc[r][n] = __builtin_amdgcn_mfma_f32_16x16x32_bf16(bfr[n], af[r], acc[r][n], 0, 0, 0); }
        lds_barrier();
    }
    uint2 ogr[2][8];
#pragma unroll
    for (int r = 0; r < 2; ++r) { const bf16_t* ogp = PR + (r0 + rh * 128 + (mi2 + r) * 16 + (lane & 15)) * 6144 + 4096 + h * 256 + 4 * (lane >> 4);
#pragma unroll
        for (int n = 0; n < 8; ++n) ogr[r][n] = *(const uint2*)(ogp + (nb + n) * 16); }
    for (int sl = 0; sl < 4; ++sl) { const int dir = sl >> 1, dh = sl & 1;
        if (dh == 0) { const int i = tid >> 2, c32 = (tid & 3) * 32, I = rh * 128 + i; const float xs = dir == 0 ? __expf((float)(I + 1) * lgf) : __expf((float)(256 - I) * lgb);
#pragma unroll
            for (int hh = 0; hh < 4; ++hh) { const u32x4 w = *(const LAS u32x4*)(qs + i * 136 + c32 + hh * 8);
                *(LAS u32x4*)(qx + i * 136 + c32 + hh * 8) = mk4(pack2(bflo(w[0]) * xs, bfhi(w[0]) * xs), pack2(bflo(w[1]) * xs, bfhi(w[1]) * xs), pack2(bflo(w[2]) * xs, bfhi(w[2]) * xs), pack2(bflo(w[3]) * xs, bfhi(w[3]) * xs)); } }
#pragma unroll
        for (int i = 0; i < 4; ++i) { const int idx = tid + i * NTHR, v8 = (idx & 31) * 8, dd = idx >> 5; *(LAS u32x4*)(Vs + dd * 264 + v8) = mk4(st[i].x, st[i].y, st[i].z, st[i].w); }
        lds_barrier();
        if (sl < 3) { const int nd = (sl + 1) >> 1, nh = (sl + 1) & 1; const bf16_t* sp = sbase + (size_t)nd * 32 * 32768 + (size_t)nh * 64 * 256;
#pragma unroll
            for (int i = 0; i < 4; ++i) { const int idx = tid + i * NTHR, v8 = (idx & 31) * 8, dd = idx >> 5; st[i] = *(const uint4*)(sp + dd * 256 + v8); } }
#pragma unroll
        for (int k2 = 0; k2 < 2; ++k2) { bf16x8 af[2], bfr[8];
#pragma unroll
            for (int r = 0; r < 2; ++r) af[r] = *(const LAS bf16x8*)(qx + ((mi2 + r) * 16 + (lane & 15)) * 136 + dh * 64 + k2 * 32 + (lane >> 4) * 8);
#pragma unroll
            for (int n = 0; n < 8; ++n) bfr[n] = frag_tr(Vs + k2 * 32 * 264 + (nb + n) * 16, 264, lane);
#pragma unroll
            for (int r = 0; r < 2; ++r)
#pragma unroll
                for (int n = 0; n < 8; ++n) acc[r][n] = __builtin_amdgcn_mfma_f32_16x16x32_bf16(bfr[n], af[r], acc[r][n], 0, 0, 0); }
        lds_barrier();
    }
    { float ss[2];
#pragma unroll
        for (int r = 0; r < 2; ++r) { ss[r] = 0.f;
#pragma unroll
            for (int n = 0; n < 8; ++n) ss[r] += acc[r][n][0] * acc[r][n][0] + acc[r][n][1] * acc[r][n][1] + acc[r][n][2] * acc[r][n][2] + acc[r][n][3] * acc[r][n][3];
            ss[r] += __shfl_xor(ss[r], 16); ss[r] += __shfl_xor(ss[r], 32);
            if ((lane >> 4) == 0) red[((mi2 + r) * 16 + (lane & 15)) * 2 + (wid >> 2)] = ss[r]; }
        lds_barrier();
#pragma unroll
        for (int r = 0; r < 2; ++r) { const int i = (mi2 + r) * 16 + (lane & 15);
            const float rstd = rsqrtf((red[i * 2] + red[i * 2 + 1]) * (1.0f / 256.0f) + 1e-6f);
            const float* gn = P->in[23] + h * 256 + 4 * (lane >> 4);
            bf16_t* op = (bf16_t*)(P->ws + OFF_OBUF) + (r0 + rh * 128 + i) * 2048 + h * 256 + 4 * (lane >> 4);
#pragma unroll
            for (int n = 0; n < 8; ++n) { const int v = (nb + n) * 16; const uint2 og = ogr[r][n]; const f32x4 g4 = *(const f32x4*)(gn + v);
                uint2 w; w.x = pack2(acc[r][n][0] * rstd * g4[0] * silu_f(bflo(og.x)), acc[r][n][1] * rstd * g4[1] * silu_f(bfhi(og.x)));
                w.y = pack2(acc[r][n][2] * rstd * g4[2] * silu_f(bflo(og.y)), acc[r][n][3] * rstd * g4[3] * silu_f(bfhi(og.y)));
                *(uint2*)(op + v) = w; } } }
    lds_barrier();
}

__device__ __forceinline__ void grid_barrier(unsigned* cnt, unsigned target) {
    asm volatile("s_waitcnt vmcnt(0)" ::: "memory");
    __syncthreads();
    if (threadIdx.x == 0) {
        __builtin_amdgcn_fence(__ATOMIC_RELEASE, "agent");
        asm volatile("s_waitcnt vmcnt(0)" ::: "memory");
        (void)__hip_atomic_fetch_add(cnt, 1u, __ATOMIC_RELAXED, __HIP_MEMORY_SCOPE_AGENT);
        unsigned spins = 0;
        while (__hip_atomic_load(cnt, __ATOMIC_RELAXED, __HIP_MEMORY_SCOPE_AGENT) < target) { __builtin_amdgcn_s_sleep(2); if (++spins > (1u << 24)) break; }
        __builtin_amdgcn_fence(__ATOMIC_ACQUIRE, "agent");
        asm volatile("s_waitcnt vmcnt(0)" ::: "memory");
    }
    __syncthreads();
}

__global__ void __launch_bounds__(NTHR, 2) mega(Params Pval, int ph0, int ph1) {
    extern __shared__ __attribute__((aligned(16))) unsigned char lds_raw[];
    LAS unsigned char* lds = (LAS unsigned char*)lds_raw;
    unsigned nbar = 0;
    for (int ph = ph0; ph < ph1; ++ph) {
        CP P = (CP)__builtin_amdgcn_kernarg_segment_ptr(); asm volatile("" : "+s"(P));
        unsigned char* ws = P->ws;
        bf16_t* XN = (bf16_t*)(ws + OFF_XN); bf16_t* ACT = (bf16_t*)(ws + OFF_ACT); float* X = P->out;
        if (ph == 1 || ph == 4 || ph == 11 || ph == 14 || ph == 17 || ph == 28) continue;
        const int reps = (((unsigned long long)(PROBE_MASK) >> ph) & 1ull) ? 2 : 1;
        for (int rep = 0; rep < reps; ++rep) {
        float* SSQ = (float*)(ws + OFF_SSQ); bf16_t* XB2 = (bf16_t*)(ws + OFF_XB2);
        int ffn = -1, sub = 0;
        if (ph >= 2 && ph <= 3) { ffn = 0; sub = ph - 1; } else if (ph >= 12 && ph <= 13) { ffn = 1; sub = ph - 11; }
        else if (ph >= 15 && ph <= 16) { ffn = 2; sub = ph - 14; } else if (ph >= 29 && ph <= 30) { ffn = 3; sub = ph - 28; }
        if (ph == 0) { if (EN(0)) phase_prologue(P, lds); }
        else if (ffn >= 0) {
            const float* xin = (ffn == 0) ? P->in[0] : X;
            const float* ssin = SSQ + (size_t)(ffn == 0 ? 0 : ffn == 1 ? 2 : ffn == 2 ? 3 : 5) * SSN;
            if (sub == 1) { if (EN(2)) { if (ffn == 0) phase_kmat(P);
                pg8::Gemm g{ffn == 1 ? XB2 : XN, (const bf16_t*)(ws + OFF_W1 + (size_t)ffn * SZ_W1), 1024, 1024, 1024, 256, 22, 1, 0, 0}; EpiSwiGLU e{ACT, ssin}; pg8::gemm_phase(lds, g, e); } }
            else { if (EN(3)) { pg8::Gemm g{ACT, (const bf16_t*)(ws + OFF_W2 + (size_t)ffn * SZ_W2), 2816, 2816, 2816, 256, 4, 1, 0, 0};
                float* ssout = SSQ + (size_t)(ffn == 0 ? 1 : ffn == 1 ? 3 : 4) * SSN;
                if (ffn == 3) { EpiResid<false> e{xin, X, nullptr, nullptr, 0.5f}; pg8::gemm_phase(lds, g, e); }
                else { EpiResid<true> e{xin, X, XN, ssout, 0.5f}; pg8::gemm_phase(lds, g, e); } } }
        }
        else if (ph == 5) { if (EN(4)) { pg8::Gemm g{XN, (const bf16_t*)(ws + OFF_WIN0), 1024, 1024, 1024, 256, 9, 1, 0, 0}; EpiWin0 e{(bf16_t*)(ws + OFF_AS5), (bf16_t*)(ws + OFF_PQ), SSQ + SSN}; pg8::gemm_phase(lds, g, e); } }
        else if (ph == 6) { if (EN(5)) {
            if (EN(16)) { pg8::Gemm g{(const bf16_t*)(ws + OFF_AS5), (const bf16_t*)(ws + OFF_H), 1280, 1024, 1024, 4, 1, 32, (size_t)1024 * 1280, (size_t)256 * 1024}; EpiS5E e{(float*)(ws + OFF_E)}; pg8::gemm_phase(lds, g, e); }
            __syncthreads();
            if (EN(17)) for (int u = obid(); u < 4096; u += gridDim.x) gla_a_unit(P, u, lds);
        } }
        else if (ph == 7) { if (EN(6)) { phase_s5_scan(P); phase_gla_b(P); } }
        else if (ph == 8) { if (EN(7)) {
            if (EN(18)) { pg8::Gemm g{(const bf16_t*)(ws + OFF_AS5), (const bf16_t*)(ws + OFF_KG), 1280, 1280, 1280, 4, 4, 32, (size_t)1024 * 1280, (size_t)1024 * 1280}; EpiS5Y e{(bf16_t*)(ws + OFF_GY)}; pg8::gemm_phase(lds, g, e); }
            __syncthreads();
            if (EN(19)) for (int u = obid(); u < 4096; u += gridDim.x) gla_c_unit(P, u, lds);
        } }
        else if (ph == 9) { if (EN(8)) { pg8::Gemm g{(const bf16_t*)(ws + OFF_GY), (const bf16_t*)(ws + OFF_WGLU), 512, 512, 512, 256, 2, 1, 0, 0}; EpiGLU e{(const bf16_t*)(ws + OFF_GY), XN}; pg8::gemm_phase(lds, g, e); } }
        else if (ph == 10) { if (EN(9)) { pg8::Gemm g{XN, (const bf16_t*)(ws + OFF_WOUT0), 1024, 1024, 1024, 256, 4, 1, 0, 0}; EpiResid<true> e{X, X, XB2, SSQ + 2 * SSN, 1.0f}; pg8::gemm_phase(lds, g, e); } }
        else if (ph >= 18 && ph <= 27) {
            const int hf = (ph - 18) / 5, s = (ph - 18) % 5;
            if (s == 0) { if (EN(10)) { pg8::Gemm g{XN + (size_t)hf * 32768 * 1024, (const bf16_t*)(ws + OFF_WIN1), 1024, 1024, 1024, 128, 24, 1, 0, 0}; EpiRetIn e{(bf16_t*)(ws + OFF_PROJ1), 6144, SSQ + 4 * SSN + (size_t)hf * 32768 * 16, (const float*)(ws + OFF_ROPE), (const float*)(ws + OFF_ROPE) + 8192 * 64, hf * 32768}; pg8::gemm_phase(lds, g, e); } }
            else if (s == 1) { if (EN(11)) for (int u = obid(); u < 1024; u += gridDim.x) ret_a_unit(P, hf, u, lds); }
            else if (s == 2) { if (EN(12)) phase_ret_b(P); }
            else if (s == 3) { if (EN(13)) for (int u = obid(); u < 2048; u += gridDim.x) ret_c_unit(P, hf, u, lds); }
            else { if (EN(14)) { pg8::Gemm g{(const bf16_t*)(ws + OFF_OBUF), (const bf16_t*)(ws + OFF_WOUT1), 2048, 2048, 2048, 128, 4, 1, 0, 0};
                float* Xh = X + (size_t)hf * 32768 * 1024; EpiResid<true> e{Xh, Xh, XN + (size_t)hf * 32768 * 1024, SSQ + 5 * SSN + (size_t)hf * 32768 * 16, 1.0f}; pg8::gemm_phase(lds, g, e); } }
        }
        else if (ph == 31) { if (EN(15)) phase_norm<true>(X, P->in[25], nullptr, nullptr, X, 0, (int)gridDim.x, 0, 65536); }
        if (rep + 1 < reps) __syncthreads();
        }
        if (ph + 1 < ph1) { if (ph == 0) cg::this_grid().sync();
            else { ++nbar; grid_barrier((unsigned*)(P->ws + OFF_BAR), nbar * gridDim.x); } }
    }
}

extern "C" void kernel_launch(void* const* d_in, const int* in_sizes, int n_in, void* d_out, int out_size, void* d_ws, size_t ws_size, hipStream_t stream) {
    static int inited = 0;
    if (!inited) { (void)hipFuncSetAttribute((const void*)mega, hipFuncAttributeMaxDynamicSharedMemorySize, LDS_BYTES); inited = 1; }
    Params p{};
    for (int i = 0; i < 26; ++i) p.in[i] = (const float*)d_in[i];
    p.out = (float*)d_out; p.ws = (unsigned char*)d_ws;
    if (ws_size < OFF_R + 770 * MiB) fprintf(stderr, "kernel_launch: workspace too small (%zu)\n", ws_size);
    const int grid = 256;
#if ONE_LAUNCH
    (void)hipMemsetAsync((unsigned char*)d_ws + OFF_BAR, 0, 256, stream);
    int ph0 = 0, ph1 = NPHASE; void* args[] = {&p, &ph0, &ph1};
    hipError_t e = hipLaunchCooperativeKernel((const void*)mega, dim3(grid), dim3(NTHR), args, LDS_BYTES, stream);
    if (e != hipSuccess) fprintf(stderr, "cooperative launch failed: %s\n", hipGetErrorString(e));
#else
    for (int ph = 0; ph < NPHASE; ++ph) hipLaunchKernelGGL(mega, dim3(grid), dim3(NTHR), LDS_BYTES, stream, p, ph, ph + 1);
#endif
}
```

```cpp
#include <hip/hip_runtime.h>
#include <hip/hip_cooperative_groups.h>
#include <cstdio>
#include <cstdint>
namespace cg = cooperative_groups;

#ifndef ONE_LAUNCH
#define ONE_LAUNCH 1
#endif

#ifndef PHASE_MASK
#define PHASE_MASK 0xffffffffffull
#endif
#define EN(n) (((PHASE_MASK) >> (n)) & 1ull)
#ifndef PROBE_MASK
#define PROBE_MASK 0ull
#endif
#define LAS __attribute__((address_space(3)))
typedef unsigned short bf16_t;
typedef short bf16x8 __attribute__((ext_vector_type(8)));
typedef float f32x4 __attribute__((ext_vector_type(4)));
typedef float f32x2 __attribute__((ext_vector_type(2)));
typedef unsigned u32x2 __attribute__((ext_vector_type(2)));
typedef unsigned u32x4 __attribute__((ext_vector_type(4)));
__device__ __forceinline__ u32x4 mk4(unsigned a, unsigned b, unsigned c, unsigned d) { return (u32x4){a, b, c, d}; }
__device__ __forceinline__ u32x2 mk2(unsigned a, unsigned b) { return (u32x2){a, b}; }
__device__ __forceinline__ f32x2 mkf2(float a, float b) { return (f32x2){a, b}; }

constexpr int NTHR = 512;
constexpr int LDS_BYTES = 147456;
constexpr int NPHASE = 32;

struct Params { const float* in[26]; float* out; unsigned char* ws; };
typedef const __attribute__((address_space(4))) Params* CP;

constexpr size_t MiB = 1ull << 20;
constexpr size_t OFF_W1 = 0, SZ_W1 = 11 * MiB;
constexpr size_t OFF_W2 = 44 * MiB, SZ_W2 = 5 * MiB + MiB / 2;
constexpr size_t OFF_WIN0 = 66 * MiB;
constexpr size_t OFF_WGLU = 70 * MiB + MiB / 2;
constexpr size_t OFF_WOUT0 = 71 * MiB;
constexpr size_t OFF_WIN1 = 73 * MiB;
constexpr size_t OFF_WOUT1 = 85 * MiB;
constexpr size_t OFF_ROPE = 89 * MiB;
constexpr size_t OFF_KTAB = 93 * MiB;
constexpr size_t OFF_S5P = 97 * MiB;
constexpr size_t OFF_XN = 98 * MiB;
constexpr size_t OFF_R = 226 * MiB;
constexpr size_t OFF_ACT = OFF_R;
constexpr size_t OFF_PQ = OFF_R;
constexpr size_t OFF_AS5 = OFF_R + 224 * MiB;
constexpr size_t OFF_E = OFF_R + 304 * MiB;
constexpr size_t OFF_KG = OFF_R + 352 * MiB;
constexpr size_t OFF_H = OFF_R + 432 * MiB;
constexpr size_t OFF_GST = OFF_R + 448 * MiB;
constexpr size_t OFF_GDEC = OFF_R + 704 * MiB;
constexpr size_t OFF_GY = OFF_R + 706 * MiB;
constexpr size_t OFF_PROJ1 = OFF_R;
constexpr size_t OFF_RST = OFF_R + 384 * MiB;
constexpr size_t OFF_SSQ = 998 * MiB;
constexpr int SSN = 65536 * 16;
constexpr size_t OFF_XB2 = OFF_R + 448 * MiB;
constexpr size_t OFF_BAR = 1023 * MiB;
constexpr size_t OFF_OBUF = OFF_R + 640 * MiB;

__device__ __forceinline__ int otid() { int t = threadIdx.x; asm volatile("" : "+v"(t)); return t; }
__device__ __forceinline__ int obid() { int t = blockIdx.x; asm volatile("" : "+s"(t)); return t; }
__device__ __forceinline__ bf16_t f2bf(float f) { unsigned u = __float_as_uint(f); u += 0x7FFFu + ((u >> 16) & 1u); return (bf16_t)(u >> 16); }
__device__ __forceinline__ float bf2f(unsigned b) { return __uint_as_float(b << 16); }
typedef __bf16 bf16x2_t __attribute__((ext_vector_type(2)));
typedef float f32x2_t __attribute__((ext_vector_type(2)));
__device__ __forceinline__ unsigned pack2(float lo, float hi) { const f32x2_t v = {lo, hi}; const bf16x2_t b = __builtin_convertvector(v, bf16x2_t); return __builtin_bit_cast(unsigned, b); }
__device__ __forceinline__ float bflo(unsigned w) { return __uint_as_float(w << 16); }
__device__ __forceinline__ float bfhi(unsigned w) { return __uint_as_float(w & 0xffff0000u); }
__device__ __forceinline__ float fast_sigmoid(float x) { return __builtin_amdgcn_rcpf(1.0f + __expf(-x)); }
__device__ __forceinline__ float silu_f(float x) { return x * fast_sigmoid(x); }
__device__ __forceinline__ float gelu_tanh(float x) { const float u = 0.7978845608028654f * (x + 0.044715f * x * x * x); return x * fast_sigmoid(2.0f * u); }

namespace pg8 {
constexpr int BM = 256, BK = 64, HALF = 128, HTB = HALF * BK * 2, STAGE_BYTES = 8 * HTB, NXCD = 8, WGM = 8;
__device__ __forceinline__ int lds_byte(int r, int c) { const int st = (r >> 4) * 2 + (c >> 5), rr = r & 15, cc = c & 31, ob = rr * 64 + cc * 2; return st * 1024 + (ob ^ (((ob >> 9) & 1) << 5)); }
__device__ __forceinline__ void stage_rc(int b, int& R, int& C) { const int st = b / 1024, sb = b % 1024, swz = sb ^ (((sb >> 9) & 1) << 5); R = (st >> 1) * 16 + swz / 64; C = (st & 1) * 32 + (swz % 64) / 2; }

__device__ __forceinline__ int perm32(int rho) { const int n = rho >> 4, i = rho & 15; return 8 * (i >> 2) + 4 * n + (i & 3); }
struct Unit { int pm, pn, bz; };
struct Gemm { const bf16_t* A; const bf16_t* Bt; int lda, ldb, K, nM, nN, nB; size_t strideA, strideB; };

struct Sched {
    int nM, nN, nwg, total, G, c;
    __device__ void init(int nM_, int nN_, int nB_, int G_, int c_) { nM = nM_; nN = nN_; nwg = nM * nN; total = nwg * nB_; G = G_; c = c_; }
    __device__ bool next(int i, Unit& u) const {
        const long L = (long)i * G + c; if (L >= total) return false;
        u.bz = (int)(L / nwg); int wgid = (int)(L % nwg);
        { const int q = nwg / NXCD, r = nwg % NXCD, xcd = wgid % NXCD, off = wgid / NXCD; wgid = (xcd < r ? xcd * (q + 1) : r * (q + 1) + (xcd - r) * q) + off; }
        const int nig = WGM * nN, gid = wgid / nig, fm = gid * WGM, gsz = (nM - fm) < WGM ? (nM - fm) : WGM;
        u.pm = fm + ((wgid % nig) % gsz); u.pn = (wgid % nig) / gsz; return true;
    }
};

template <class Epi>
__device__ __forceinline__ void gemm_phase(LAS unsigned char* lds, const Gemm g, const Epi& E) {
    const int tid = otid(), wid = __builtin_amdgcn_readfirstlane(tid >> 6), lane = tid & 63, wr = wid >> 2, wc = wid & 3, fr = lane & 15, fq = lane >> 4;
    const int nt = g.K / BK;
    Sched S; S.init(g.nM, g.nN, g.nB, (int)gridDim.x, obid());
    unsigned voffA[2], voffB[2];
#pragma unroll
    for (int i = 0; i < 2; ++i) { int R, C; stage_rc(tid * 16 + i * 8192, R, C); const int Rb = Epi::PERM ? ((R & ~31) + perm32(R & 31)) : R;
        voffA[i] = (unsigned)(R * g.lda + C) * 2u; voffB[i] = (unsigned)(Rb * g.ldb + C) * 2u; }
    const size_t kstep = (size_t)(BK * 2);
    const size_t hstepA = (size_t)HALF * g.lda * 2, hstepB = (size_t)HALF * g.ldb * 2;
    const size_t tstepA = 2 * hstepA, tstepB = 2 * hstepB;
    const unsigned ldsw = (unsigned)wid * 1024u;
    const int aoff = lds_byte(wr * 64 + fr, fq * 8), boff = lds_byte(wc * 32 + fr, fq * 8);
#define PG8_SA(b, h) (((b) * 2 + (h)) * HTB)
#define PG8_SB(b, h) ((4 + (b) * 2 + (h)) * HTB)
#define PG8_STAGE(bufoff, gbase, voff) do { _Pragma("unroll") for (int _i = 0; _i < 2; ++_i) \
        __builtin_amdgcn_global_load_lds((const unsigned*)((const char*)(gbase) + (voff)[_i]), (LAS unsigned*)(lds + (bufoff) + ldsw + _i * 8192), 16, 0, 0); } while (0)
#define PG8_LDA(dst, b, h) do { _Pragma("unroll") for (int m = 0; m < 4; ++m) _Pragma("unroll") for (int k = 0; k < 2; ++k) dst[m][k] = *(const LAS bf16x8*)(lds + PG8_SA(b, h) + aoff + m * 2048 + k * 1024); } while (0)
#define PG8_LDB(dst, b, h) do { _Pragma("unroll") for (int n = 0; n < 2; ++n) _Pragma("unroll") for (int k = 0; k < 2; ++k) dst[n][k] = *(const LAS bf16x8*)(lds + PG8_SB(b, h) + boff + n * 2048 + k * 1024); } while (0)
#define PG8_MMA(ai, bj, At, Bt) do { __builtin_amdgcn_s_setprio(1); _Pragma("unroll") for (int m = 0; m < 4; ++m) _Pragma("unroll") for (int n = 0; n < 2; ++n) _Pragma("unroll") for (int k = 0; k < 2; ++k) \
        acc[ai][bj][m][n] = __builtin_amdgcn_mfma_f32_16x16x32_bf16(Bt[n][k], At[m][k], acc[ai][bj][m][n], 0, 0, 0); __builtin_amdgcn_s_setprio(0); } while (0)
#define PG8_WAIT_V(n) asm volatile("s_waitcnt vmcnt(" #n ")" ::: "memory")
#define PG8_WAIT_L(n) asm volatile("s_waitcnt lgkmcnt(" #n ")" ::: "memory")
#define PG8_BAR __builtin_amdgcn_s_barrier()
#define PG8_SCHED __builtin_amdgcn_sched_barrier(0)
    Unit cur, nxt; int ui = 0;
    if (!S.next(0, cur)) return;
    int tag0 = -1, tag1 = -1, tag2 = -1, tag3 = -1; LAS float* rstab = (LAS float*)(lds + STAGE_BYTES);
    if constexpr (Epi::RSTD) {
        { Unit t_; for (int i = 0; S.next(i, t_); ++i) { const int pm = t_.pm; if (pm == tag0 || pm == tag1 || pm == tag2 || pm == tag3) continue;
                if (tag0 < 0) tag0 = pm; else if (tag1 < 0) tag1 = pm; else if (tag2 < 0) tag2 = pm; else tag3 = pm; } }
#pragma unroll
        for (int sl = 0; sl < 2; ++sl) { const int slot = (tid >> 8) + 2 * sl; const int pm = slot == 0 ? tag0 : slot == 1 ? tag1 : slot == 2 ? tag2 : tag3;
            if (pm >= 0) { const f32x4* p = (const f32x4*)(E.SS + ((size_t)pm * 256 + (tid & 255)) * 16); const f32x4 a = p[0], b = p[1], c = p[2], d = p[3]; const f32x4 t = (a + b) + (c + d);
                rstab[slot * 256 + (tid & 255)] = rsqrtf(((t[0] + t[1]) + (t[2] + t[3])) * (1.0f / 1024.0f) + 1e-6f); } }
        __syncthreads();
    }
    f32x4 acc[2][2][4][2];
#pragma unroll
    for (int a = 0; a < 2; ++a)
#pragma unroll
        for (int b = 0; b < 2; ++b)
#pragma unroll
            for (int m = 0; m < 4; ++m)
#pragma unroll
                for (int n = 0; n < 2; ++n) acc[a][b][m][n] = (f32x4){0.f, 0.f, 0.f, 0.f};
    bf16x8 At[4][2], B0[2][2], B1[2][2];
    const char* cA = (const char*)g.A + (size_t)cur.bz * g.strideA * 2 + (size_t)cur.pm * tstepA;
    const char* cB = (const char*)g.Bt + (size_t)cur.bz * g.strideB * 2 + (size_t)cur.pn * tstepB;
    PG8_STAGE(PG8_SB(0, 0), cB, voffB); PG8_STAGE(PG8_SB(0, 1), cB + hstepB, voffB); PG8_STAGE(PG8_SA(0, 0), cA, voffA); PG8_STAGE(PG8_SA(0, 1), cA + hstepA, voffA);
    if (wr == 1) PG8_BAR;
    PG8_WAIT_V(2); PG8_BAR;
    PG8_STAGE(PG8_SB(1, 0), cB + kstep, voffB); PG8_STAGE(PG8_SA(1, 0), cA + kstep, voffA); PG8_STAGE(PG8_SB(1, 1), cB + hstepB + kstep, voffB);
    PG8_WAIT_V(6); PG8_BAR;
    for (;;) {
        const bool has_next = S.next(ui + 1, nxt);
        const char* nA = has_next ? (const char*)g.A + (size_t)nxt.bz * g.strideA * 2 + (size_t)nxt.pm * tstepA : cA;
        const char* nB = has_next ? (const char*)g.Bt + (size_t)nxt.bz * g.strideB * 2 + (size_t)nxt.pn * tstepB : cB;
        for (int t = 0; t < nt; t += 2) {
            const bool last = (t == nt - 2);
            const char* a1 = cA + (size_t)(t + 1) * kstep;
            const char* a2 = last ? nA : cA + (size_t)(t + 2) * kstep; const char* b2 = last ? nB : cB + (size_t)(t + 2) * kstep;
            const char* a3 = a2 + kstep; const char* b3 = b2 + kstep;
            PG8_LDB(B0, 0, 0); PG8_LDB(B1, 0, 1); PG8_SCHED; PG8_LDA(At, 0, 0); PG8_STAGE(PG8_SA(1, 1), a1 + hstepA, voffA);
            PG8_WAIT_V(8); PG8_WAIT_L(0); PG8_BAR; PG8_MMA(0, 0, At, B0); PG8_MMA(0, 1, At, B1); PG8_BAR; PG8_SCHED;
            PG8_LDA(At, 0, 1); PG8_STAGE(PG8_SB(0, 0), b2, voffB); PG8_STAGE(PG8_SB(0, 1), b2 + hstepB, voffB); PG8_STAGE(PG8_SA(0, 0), a2, voffA);
            PG8_WAIT_V(8); PG8_WAIT_L(0); PG8_BAR; PG8_MMA(1, 0, At, B0); PG8_MMA(1, 1, At, B1); PG8_BAR; PG8_SCHED;
            PG8_LDB(B0, 1, 0); PG8_LDB(B1, 1, 1); PG8_SCHED; PG8_LDA(At, 1, 0); PG8_STAGE(PG8_SA(0, 1), a2 + hstepA, voffA);
            PG8_WAIT_V(8); PG8_WAIT_L(0); PG8_BAR; PG8_MMA(0, 0, At, B0); PG8_MMA(0, 1, At, B1); PG8_BAR; PG8_SCHED;
            PG8_LDA(At, 1, 1); PG8_STAGE(PG8_SB(1, 0), b3, voffB); PG8_STAGE(PG8_SB(1, 1), b3 + hstepB, voffB); PG8_STAGE(PG8_SA(1, 0), a3, voffA);
            PG8_WAIT_V(8); PG8_WAIT_L(0); PG8_BAR; PG8_MMA(1, 0, At, B0); PG8_MMA(1, 1, At, B1); PG8_BAR; PG8_SCHED;
        }
        if (wr == 0) PG8_BAR;
        E(acc, cur, wr, wc, fr, fq, rstab + (cur.pm == tag1 ? 256 : cur.pm == tag2 ? 512 : cur.pm == tag3 ? 768 : 0));
        if (!has_next) break;
#pragma unroll
        for (int a = 0; a < 2; ++a)
#pragma unroll
            for (int b = 0; b < 2; ++b)
#pragma unroll
                for (int m = 0; m < 4; ++m)
#pragma unroll
                    for (int n = 0; n < 2; ++n) acc[a][b][m][n] = (f32x4){0.f, 0.f, 0.f, 0.f};
        cur = nxt; cA = nA; cB = nB; ++ui;
        if (wr == 1) PG8_BAR;
    }
    PG8_WAIT_V(0);
    PG8_BAR;
#undef PG8_SA
#undef PG8_SB
#undef PG8_STAGE
#undef PG8_LDA
#undef PG8_LDB
#undef PG8_MMA
#undef PG8_WAIT_V
#undef PG8_WAIT_L
#undef PG8_BAR
#undef PG8_SCHED
}
}
using pg8::Unit;
typedef const f32x4 (&AccRef)[2][2][4][2];

struct EpiSwiGLU {
    static constexpr bool PERM = true, RSTD = true;
    bf16_t* O; const float* SS;
    __device__ __forceinline__ void operator()(AccRef acc, const Unit& u, int wr, int wc, int fr, int fq, const LAS float* rsl) const {
        const int row0 = u.pm * 256 + wr * 64 + fr, col0 = u.pn * 128 + wc * 32 + 8 * fq;
#pragma unroll
        for (int ai = 0; ai < 2; ++ai)
#pragma unroll
            for (int m = 0; m < 4; ++m) { bf16_t* rowp = O + (size_t)(row0 + ai * 128 + m * 16) * 2816 + col0; uint4 w; const float rs = rsl[ai * 128 + wr * 64 + m * 16 + fr];
                { const f32x4 gt = rs * acc[ai][0][m][0], up = rs * acc[ai][1][m][0]; w.x = pack2(silu_f(gt[0]) * up[0], silu_f(gt[1]) * up[1]); w.y = pack2(silu_f(gt[2]) * up[2], silu_f(gt[3]) * up[3]); }
                { const f32x4 gt = rs * acc[ai][0][m][1], up = rs * acc[ai][1][m][1]; w.z = pack2(silu_f(gt[0]) * up[0], silu_f(gt[1]) * up[1]); w.w = pack2(silu_f(gt[2]) * up[2], silu_f(gt[3]) * up[3]); }
                *(uint4*)rowp = w; }
    }
};
template <bool STATS> struct EpiResid {
    static constexpr bool PERM = true, RSTD = false;
    const float* Xin; float* X; bf16_t* XB; float* SS; float alpha;
    __device__ __forceinline__ void operator()(AccRef acc, const Unit& u, int wr, int wc, int fr, int fq, const LAS float* rsl) const {
        const int row0 = u.pm * 256 + wr * 64 + fr, col0 = u.pn * 256 + wc * 32 + 8 * fq;
#pragma unroll
        for (int ai = 0; ai < 2; ++ai)
#pragma unroll
            for (int mp = 0; mp < 2; ++mp) {
                f32x4 xo[2][2][2];
#pragma unroll
                for (int mm = 0; mm < 2; ++mm)
#pragma unroll
                    for (int bj = 0; bj < 2; ++bj) { const size_t o = (size_t)(row0 + ai * 128 + (mp * 2 + mm) * 16) * 1024 + col0 + bj * 128; xo[mm][bj][0] = *(const f32x4*)(Xin + o); xo[mm][bj][1] = *(const f32x4*)(Xin + o + 4); }
#pragma unroll
                for (int mm = 0; mm < 2; ++mm) { const int m = mp * 2 + mm; const size_t ro = (size_t)(row0 + ai * 128 + m * 16) * 1024 + col0; float sq = 0.f;
#pragma unroll
                    for (int bj = 0; bj < 2; ++bj) { const size_t o = ro + bj * 128;
                        const f32x4 y0 = xo[mm][bj][0] + alpha * acc[ai][bj][m][0], y1 = xo[mm][bj][1] + alpha * acc[ai][bj][m][1]; *(f32x4*)(X + o) = y0; *(f32x4*)(X + o + 4) = y1;
                        if (STATS) { uint4 w; w.x = pack2(y0[0], y0[1]); w.y = pack2(y0[2], y0[3]); w.z = pack2(y1[0], y1[1]); w.w = pack2(y1[2], y1[3]); *(uint4*)(XB + o) = w;
                            sq += y0[0] * y0[0] + y0[1] * y0[1] + y0[2] * y0[2] + y0[3] * y0[3] + y1[0] * y1[0] + y1[1] * y1[1] + y1[2] * y1[2] + y1[3] * y1[3]; } }
                    if (STATS) { sq += __shfl_xor(sq, 16); sq += __shfl_xor(sq, 32); if (fq == 0) SS[(size_t)(row0 + ai * 128 + m * 16) * 16 + u.pn * 4 + wc] = sq; } } }
    }
};
struct EpiBf16 {
    static constexpr bool PERM = true, RSTD = true;
    bf16_t* O; int ldc; const float* SS;
    __device__ __forceinline__ void operator()(AccRef acc, const Unit& u, int wr, int wc, int fr, int fq, const LAS float* rsl) const {
        const int row0 = u.pm * 256 + wr * 64 + fr, col0 = u.pn * 256 + wc * 32 + 8 * fq;
#pragma unroll
        for (int ai = 0; ai < 2; ++ai)
#pragma unroll
            for (int m = 0; m < 4; ++m) { bf16_t* rowp = O + (size_t)(row0 + ai * 128 + m * 16) * ldc + col0; const float rs = rsl[ai * 128 + wr * 64 + m * 16 + fr];
#pragma unroll
                for (int bj = 0; bj < 2; ++bj) { const f32x4 v0 = rs * acc[ai][bj][m][0], v1 = rs * acc[ai][bj][m][1]; uint4 w; w.x = pack2(v0[0], v0[1]); w.y = pack2(v0[2], v0[3]); w.z = pack2(v1[0], v1[1]); w.w = pack2(v1[2], v1[3]);
                    *(uint4*)(rowp + bj * 128) = w; } }
    }
};
struct EpiRetIn {
    static constexpr bool PERM = true, RSTD = true;
    bf16_t* O; int ldc; const float* SS; const float* cs; const float* sn; int rowbase;
    __device__ __forceinline__ void operator()(AccRef acc, const Unit& u, int wr, int wc, int fr, int fq, const LAS float* rsl) const {
        const int row0 = u.pm * 256 + wr * 64 + fr, col0 = u.pn * 256 + wc * 32 + 8 * fq, f = 16 * wc + 4 * fq;
#pragma unroll
        for (int ai = 0; ai < 2; ++ai)
#pragma unroll
            for (int m = 0; m < 4; ++m) { const int r = row0 + ai * 128 + m * 16; bf16_t* rowp = O + (size_t)r * ldc + col0; const float rs = rsl[ai * 128 + wr * 64 + m * 16 + fr];
                f32x4 c4 = (f32x4){1.f, 1.f, 1.f, 1.f}, s4 = (f32x4){0.f, 0.f, 0.f, 0.f};
                if (u.pn < 8) { const int pos = (rowbase + r) & 8191; c4 = *(const f32x4*)(cs + pos * 64 + f); s4 = *(const f32x4*)(sn + pos * 64 + f);
                    if (u.pn >= 4) { c4 *= 0.08838834764831845f; s4 *= 0.08838834764831845f; } }
#pragma unroll
                for (int bj = 0; bj < 2; ++bj) { const f32x4 t1 = rs * acc[ai][bj][m][0], t2 = rs * acc[ai][bj][m][1]; const f32x4 v0 = t1 * c4 - t2 * s4, v1 = t1 * s4 + t2 * c4;
                    uint4 w; w.x = pack2(v0[0], v0[1]); w.y = pack2(v0[2], v0[3]); w.z = pack2(v1[0], v1[1]); w.w = pack2(v1[2], v1[3]);
                    *(uint4*)(rowp + bj * 128) = w; } }
    }
};
struct EpiWin0 {
    static constexpr bool PERM = true, RSTD = true;
    bf16_t* AS5; bf16_t* PQ; const float* SS;
    __device__ __forceinline__ void operator()(AccRef acc, const Unit& u, int wr, int wc, int fr, int fq, const LAS float* rsl) const {
        const int row0 = u.pm * 256 + wr * 64 + fr, col0 = u.pn * 256 + wc * 32 + 8 * fq;
#pragma unroll
        for (int ai = 0; ai < 2; ++ai)
#pragma unroll
            for (int m = 0; m < 4; ++m) { const int r = row0 + ai * 128 + m * 16; const float rs = rsl[ai * 128 + wr * 64 + m * 16 + fr];
#pragma unroll
                for (int bj = 0; bj < 2; ++bj) { const int c = col0 + bj * 128; const f32x4 v0 = rs * acc[ai][bj][m][0], v1 = rs * acc[ai][bj][m][1];
                    uint4 w; w.x = pack2(v0[0], v0[1]); w.y = pack2(v0[2], v0[3]); w.z = pack2(v1[0], v1[1]); w.w = pack2(v1[2], v1[3]);
                    if (u.pn < 2) *(uint4*)(AS5 + ((size_t)((c >> 4) * 1024 + (r >> 6))) * 1280 + (r & 63) * 16 + (c & 15)) = w;
                    else *(uint4*)(PQ + (size_t)r * 1792 + (c - 512)) = w; } }
    }
};
struct EpiGLU {
    static constexpr bool PERM = true, RSTD = false;
    const bf16_t* GY; bf16_t* MIX;
    __device__ __forceinline__ void operator()(AccRef acc, const Unit& u, int wr, int wc, int fr, int fq, const LAS float* rsl) const {
        const int row0 = u.pm * 256 + wr * 64 + fr, col0 = u.pn * 256 + wc * 32 + 8 * fq;
#pragma unroll
        for (int ai = 0; ai < 2; ++ai)
#pragma unroll
            for (int m = 0; m < 4; ++m) { const int r = row0 + ai * 128 + m * 16;
#pragma unroll
                for (int bj = 0; bj < 2; ++bj) { const int c = col0 + bj * 128; const f32x4 v0 = acc[ai][bj][m][0], v1 = acc[ai][bj][m][1];
                    const uint4 gy = *(const uint4*)(GY + (size_t)r * 512 + c); uint4 w;
                    w.x = pack2(bflo(gy.x) * fast_sigmoid(v0[0]), bfhi(gy.x) * fast_sigmoid(v0[1])); w.y = pack2(bflo(gy.y) * fast_sigmoid(v0[2]), bfhi(gy.y) * fast_sigmoid(v0[3]));
                    w.z = pack2(bflo(gy.z) * fast_sigmoid(v1[0]), bfhi(gy.z) * fast_sigmoid(v1[1])); w.w = pack2(bflo(gy.w) * fast_sigmoid(v1[2]), bfhi(gy.w) * fast_sigmoid(v1[3]));
                    *(uint4*)(MIX + (size_t)r * 1024 + c) = w; } }
    }
};
struct EpiS5E {
    static constexpr bool PERM = false, RSTD = false;
    float* E;
    __device__ __forceinline__ void operator()(AccRef acc, const Unit& u, int wr, int wc, int fr, int fq, const LAS float* rsl) const {
        const int row0 = u.pm * 256 + wr * 64 + fr, col0 = wc * 32 + 4 * fq;
#pragma unroll
        for (int ai = 0; ai < 2; ++ai)
#pragma unroll
            for (int m = 0; m < 4; ++m) { float* rowp = E + ((size_t)u.bz * 1024 + row0 + ai * 128 + m * 16) * 256 + col0;
#pragma unroll
                for (int bj = 0; bj < 2; ++bj)
#pragma unroll
                    for (int n = 0; n < 2; ++n) *(f32x4*)(rowp + bj * 128 + n * 16) = acc[ai][bj][m][n]; }
    }
};
struct EpiS5Y {
    static constexpr bool PERM = true, RSTD = false;
    bf16_t* GY;
    __device__ __forceinline__ void operator()(AccRef acc, const Unit& u, int wr, int wc, int fr, int fq, const LAS float* rsl) const {
        const int row0 = u.pm * 256 + wr * 64 + fr, col0 = u.pn * 256 + wc * 32 + 8 * fq;
#pragma unroll
        for (int ai = 0; ai < 2; ++ai)
#pragma unroll
            for (int m = 0; m < 4; ++m) { const int bc = row0 + ai * 128 + m * 16;
#pragma unroll
                for (int bj = 0; bj < 2; ++bj) { const int c = col0 + bj * 128; const f32x4 v0 = acc[ai][bj][m][0], v1 = acc[ai][bj][m][1]; uint4 w;
                    w.x = pack2(gelu_tanh(v0[0]), gelu_tanh(v0[1])); w.y = pack2(gelu_tanh(v0[2]), gelu_tanh(v0[3])); w.z = pack2(gelu_tanh(v1[0]), gelu_tanh(v1[1])); w.w = pack2(gelu_tanh(v1[2]), gelu_tanh(v1[3]));
                    *(uint4*)(GY + ((size_t)bc * 64 + (c >> 4)) * 512 + u.bz * 16 + (c & 15)) = w; } }
    }
};

__device__ void transpose_job(const float* __restrict__ src, int K, int Nsrc, bf16_t* __restrict__ dst, int Ndst, int mode, LAS float* tile, int b0, int nb, const float* __restrict__ gain) {
    const int tid = otid();
    const int ntk = K >> 8, nt = (Ndst >> 6) * ntk;
    for (int t = obid() - b0; t < nt; t += nb) {
        const int tn = t / ntk, tk = t % ntk, n0 = tn * 64, k0 = tk * 256;
        int ns0 = n0;
        if (mode == 1) { const int tt = n0 >> 8, j = n0 & 255; ns0 = (j < 128) ? (tt * 128 + j) : (2816 + tt * 128 + (j - 128)); }
        const int r = tid >> 4; int c4 = (tid & 15) * 4;
        const int c4d = c4;
        if (mode == 2 && n0 < 2048) { const int s_ = (n0 + c4) & 127;
            c4 = ((n0 + c4) & ~127) + 64 * ((s_ >> 2) & 1) + 16 * (s_ >> 5) + 4 * ((s_ >> 3) & 3) - n0; }
        float4 v[8];
#pragma unroll
        for (int rr = 0; rr < 8; ++rr) { v[rr] = make_float4(0.f, 0.f, 0.f, 0.f);
            if (ns0 + c4 + 3 < Nsrc) v[rr] = *(const float4*)(src + (size_t)(k0 + r + rr * 32) * Nsrc + ns0 + c4);
            if (gain) { const float gk = gain[k0 + r + rr * 32]; v[rr].x *= gk; v[rr].y *= gk; v[rr].z *= gk; v[rr].w *= gk; } }
#pragma unroll
        for (int rr = 0; rr < 8; ++rr) { const int kk = r + rr * 32; LAS float* tp = tile + (kk >> 6) * (64 * 65) + (kk & 63) * 65 + c4d;
            tp[0] = v[rr].x; tp[1] = v[rr].y; tp[2] = v[rr].z; tp[3] = v[rr].w; }
        __syncthreads();
        const int n = tid >> 3, kq = (tid & 7) * 8;
#pragma unroll
        for (int kt = 0; kt < 4; ++kt) { const LAS float* tp = tile + kt * (64 * 65); uint4 w;
            w.x = pack2(tp[(kq + 0) * 65 + n], tp[(kq + 1) * 65 + n]); w.y = pack2(tp[(kq + 2) * 65 + n], tp[(kq + 3) * 65 + n]);
            w.z = pack2(tp[(kq + 4) * 65 + n], tp[(kq + 5) * 65 + n]); w.w = pack2(tp[(kq + 6) * 65 + n], tp[(kq + 7) * 65 + n]);
            *(uint4*)(dst + (size_t)(n0 + n) * K + k0 + kt * 64 + kq) = w; }
        __syncthreads();
    }
}

__device__ void s5_pre(CP P, int g, int dir, int part, LAS unsigned char* lds) {
    LAS f32x2* pw = (LAS f32x2*)lds;
    LAS f32x2* Bb = pw + 65 * 64;
    LAS f32x2* Cc = Bb + 64 * 16;
    const int tid = otid();
    float* Ktab = (float*)(P->ws + OFF_KTAB); float* AT = (float*)(P->ws + OFF_S5P);
    bf16_t* KG = (bf16_t*)(P->ws + OFF_KG); bf16_t* H = (bf16_t*)(P->ws + OFF_H);
    if (tid < 64) { const int n = tid, gi = (dir * 32 + g) * 64 + n;
        const double lr = fmin((double)P->in[9][gi], -1e-4), li = (double)P->in[10][gi], dt = (double)expf(P->in[15][dir * 32 + g]);
        const double em1 = (double)expm1f((float)(lr * dt)), mag = 1.0 + em1;
        double rev = li * dt * 0.15915494309189535; rev -= rint(rev); const float th = (float)(rev * 6.283185307179586), thh = 0.5f * th;
        const double sn_ = (double)sinf(th), shalf = (double)sinf(thh), cm1 = -2.0 * shalf * shalf;
        const double ar = mag * (1.0 + cm1), ai = mag * sn_, arm1 = em1 + cm1 + em1 * cm1, den = lr * lr + li * li;
        const double cr = (arm1 * lr + ai * li) / den, ci = (ai * lr - arm1 * li) / den;
#pragma unroll 1
        for (int p = 0; p < 16; ++p) { const double br = (double)P->in[11][gi * 16 + p], bi = (double)P->in[12][gi * 16 + p];
            Bb[n * 16 + p] = mkf2((float)(cr * br - ci * bi), (float)(cr * bi + ci * br)); }
        double xr = 1.0, xi = 0.0;
#pragma unroll 1
        for (int d = 0; d <= 64; ++d) { pw[d * 64 + n] = mkf2((float)xr, (float)xi); const double t0 = xr * ar - xi * ai; xi = xr * ai + xi * ar; xr = t0; }
        const f32x2 a64 = pw[64 * 64 + n];
        if (part == 0) { AT[((g * 2 + dir) * 64 + n) * 2 + 0] = a64.x; AT[((g * 2 + dir) * 64 + n) * 2 + 1] = a64.y; } }
#pragma unroll 1
    for (int idx = tid; idx < 16 * 64; idx += NTHR) { const int p = idx >> 6, n = idx & 63; const int ci_ = ((dir * 32 + g) * 16 + p) * 64 + n;
        Cc[idx] = mkf2(P->in[13][ci_], P->in[14][ci_]); }
    __syncthreads();
    { const int dq = tid >> 8, p = (tid >> 4) & 15, pp = tid & 15;
#pragma unroll 1
        for (int dd = 0; dd < 16; ++dd) { const int d = part * 32 + dq * 16 + dd; float acc = 0.f;
#pragma unroll 4
            for (int n = 0; n < 64; ++n) { const f32x2 w = pw[d * 64 + n], bb = Bb[n * 16 + pp], c = Cc[p * 64 + n];
                const float zr = w.x * bb.x - w.y * bb.y, zi = w.x * bb.y + w.y * bb.x; acc += c.x * zr - c.y * zi; }
            Ktab[((size_t)((g * 2 + dir) * 64 + d)) * 256 + p * 16 + pp] = acc; } }
#pragma unroll 1
    for (int idx = tid; idx < 512 * 64; idx += NTHR) { const int row = part * 512 + (idx >> 6), n = idx & 63, t = row >> 4, p = row & 15, d = dir == 0 ? t + 1 : 64 - t;
        const f32x2 w = pw[d * 64 + n], c = Cc[p * 64 + n]; const float gr = c.x * w.x - c.y * w.y, gi = c.x * w.y + c.y * w.x;
        *(unsigned*)(KG + ((size_t)(g * 1024 + row)) * 1280 + 1024 + dir * 128 + n * 2) = pack2(gr, -gi); }
#pragma unroll 1
    for (int idx = tid; idx < 32 * 64 * 8; idx += NTHR) { const int pp2 = (idx & 7) * 2, s = (idx >> 3) & 63, n = part * 32 + (idx >> 9), d = dir == 0 ? 63 - s : s;
        const f32x2 w = pw[d * 64 + n], b0 = Bb[n * 16 + pp2], b1 = Bb[n * 16 + pp2 + 1];
        const float hr0 = w.x * b0.x - w.y * b0.y, hi0 = w.x * b0.y + w.y * b0.x, hr1 = w.x * b1.x - w.y * b1.y, hi1 = w.x * b1.y + w.y * b1.x;
        const size_t row0 = (size_t)g * 256 + dir * 128 + n * 2;
        *(unsigned*)(H + row0 * 1024 + s * 16 + pp2) = pack2(hr0, hr1); *(unsigned*)(H + (row0 + 1) * 1024 + s * 16 + pp2) = pack2(hi0, hi1); }
    __syncthreads();
}

template <bool FINAL> __device__ void phase_norm(const float* __restrict__ x, const float* __restrict__ g, bf16_t* __restrict__ xb, float* __restrict__ ss_out, float* __restrict__ outf, int b0, int nb, int rbeg, int rend);
__device__ void phase_prologue(CP P, LAS unsigned char* lds) {
    const int tid = otid(), bq = obid();
    if (bq < 128) { if (EN(20)) s5_pre(P, bq >> 2, (bq >> 1) & 1, bq & 1, lds);
        phase_norm<false>(P->in[0], nullptr, (bf16_t*)(P->ws + OFF_XN), (float*)(P->ws + OFF_SSQ), nullptr, 0, 128, 0, 40960); return; }
    const int b0 = 128, nb = (int)gridDim.x - 128;
    if (EN(21)) { float* cs = (float*)(P->ws + OFF_ROPE); float* sn = cs + 8192 * 64;
        for (int idx = (bq - b0) * NTHR + tid; idx < 8192 * 64; idx += nb * NTHR) { const int pos = idx >> 6, f = idx & 63;
            const float inv = expf(-9.210340371976184f * (float)f * (1.0f / 64.0f)); const float ang = (float)pos * inv;
            cs[idx] = cosf(ang); sn[idx] = sinf(ang); } }
    phase_norm<false>(P->in[0], nullptr, (bf16_t*)(P->ws + OFF_XN), (float*)(P->ws + OFF_SSQ), nullptr, b0, nb, 40960, 65536);
    LAS float* tile = (LAS float*)lds;
    if (EN(22)) for (int l = 0; l < 2; ++l) {
        transpose_job(P->in[2] + (size_t)l * 1024 * 5632, 1024, 5632, (bf16_t*)(P->ws + OFF_W1 + (size_t)(2 * l) * SZ_W1), 5632, 1, tile, b0, nb, P->in[1] + l * 1024);
        transpose_job(P->in[6] + (size_t)l * 1024 * 5632, 1024, 5632, (bf16_t*)(P->ws + OFF_W1 + (size_t)(2 * l + 1) * SZ_W1), 5632, 1, tile, b0, nb, P->in[5] + l * 1024);
        transpose_job(P->in[3] + (size_t)l * 2816 * 1024, 2816, 1024, (bf16_t*)(P->ws + OFF_W2 + (size_t)(2 * l) * SZ_W2), 1024, 0, tile, b0, nb, nullptr);
        transpose_job(P->in[7] + (size_t)l * 2816 * 1024, 2816, 1024, (bf16_t*)(P->ws + OFF_W2 + (size_t)(2 * l + 1) * SZ_W2), 1024, 0, tile, b0, nb, nullptr);
    }
    if (EN(22)) transpose_job(P->in[8], 1024, 2080, (bf16_t*)(P->ws + OFF_WIN0), 2304, 0, tile, b0, nb, P->in[4]);
    if (EN(22)) transpose_job(P->in[17], 512, 512, (bf16_t*)(P->ws + OFF_WGLU), 512, 0, tile, b0, nb, nullptr);
    if (EN(22)) transpose_job(P->in[21], 1024, 1024, (bf16_t*)(P->ws + OFF_WOUT0), 1024, 0, tile, b0, nb, nullptr);
    if (EN(22)) transpose_job(P->in[22], 1024, 6144, (bf16_t*)(P->ws + OFF_WIN1), 6144, 2, tile, b0, nb, P->in[4] + 1024);
    if (EN(22)) transpose_job(P->in[24], 2048, 1024, (bf16_t*)(P->ws + OFF_WOUT1), 1024, 0, tile, b0, nb, nullptr);
}

__device__ void phase_kmat(CP P) {
    const float* Ktab = (const float*)(P->ws + OFF_KTAB); bf16_t* KG = (bf16_t*)(P->ws + OFF_KG); const float* dsk = P->in[16];
    for (int idx = obid() * NTHR + otid(); idx < 32 * 1024 * 512; idx += gridDim.x * NTHR) {
        const int kp = idx & 511, row = (idx >> 9) & 1023, g = idx >> 19, t = row >> 4, p = row & 15, k = kp * 2, s = k >> 4, pp = k & 15;
        float v0 = 0.f, v1 = 0.f;
        if (s <= t) { const float* b = Ktab + ((size_t)((g * 2 + 0) * 64 + (t - s))) * 256 + p * 16 + pp; v0 += b[0]; v1 += b[1]; }
        if (s >= t) { const float* b = Ktab + ((size_t)((g * 2 + 1) * 64 + (s - t))) * 256 + p * 16 + pp; v0 += b[0]; v1 += b[1]; }
        if (s == t) { const float dv = dsk[g * 16 + p]; if (pp == p) v0 += dv; if (pp + 1 == p) v1 += dv; }
        *(unsigned*)(KG + ((size_t)(g * 1024 + row)) * 1280 + k) = pack2(v0, v1);
    }
}

template <bool FINAL>
__device__ void phase_norm(const float* __restrict__ x, const float* __restrict__ g, bf16_t* __restrict__ xb, float* __restrict__ ss_out, float* __restrict__ outf, int b0, int nb, int rbeg, int rend) {
    const int tid_ = otid(), lane = tid_ & 63, wid = tid_ >> 6; const int bq = obid() - b0;
    if (bq < 0) return;
    f32x4 gv[4];
#pragma unroll
    for (int i = 0; i < 4; ++i) gv[i] = FINAL ? *(const f32x4*)(g + (lane + 64 * i) * 4) : (f32x4){1.f, 1.f, 1.f, 1.f};
    for (int row0 = rbeg + bq * 8 + wid; row0 < rend; row0 += nb * 16) {
        const int row1 = row0 + nb * 8; const bool has1 = row1 < rend;
        const float* xr0 = x + (size_t)row0 * 1024; const float* xr1 = x + (size_t)(has1 ? row1 : row0) * 1024; f32x4 v[4], u[4]; float ss = 0.f, st = 0.f;
#pragma unroll
        for (int i = 0; i < 4; ++i) { v[i] = *(const f32x4*)(xr0 + (lane + 64 * i) * 4); u[i] = *(const f32x4*)(xr1 + (lane + 64 * i) * 4); }
#pragma unroll
        for (int i = 0; i < 4; ++i) { ss += v[i][0] * v[i][0] + v[i][1] * v[i][1] + v[i][2] * v[i][2] + v[i][3] * v[i][3]; st += u[i][0] * u[i][0] + u[i][1] * u[i][1] + u[i][2] * u[i][2] + u[i][3] * u[i][3]; }
#pragma unroll
        for (int o = 32; o > 0; o >>= 1) { ss += __shfl_xor(ss, o); st += __shfl_xor(st, o); }
#pragma unroll
        for (int rr = 0; rr < 2; ++rr) { if (rr == 1 && !has1) break; const int row = rr ? row1 : row0; const float sv = rr ? st : ss;
            if (FINAL) { const float rstd = rsqrtf(sv * (1.0f / 1024.0f) + 1e-6f);
#pragma unroll
                for (int i = 0; i < 4; ++i) *(f32x4*)(outf + (size_t)row * 1024 + (lane + 64 * i) * 4) = (rr ? u[i] : v[i]) * rstd * gv[i]; }
            else { if (lane < 16) ss_out[(size_t)row * 16 + lane] = lane == 0 ? sv : 0.f;
#pragma unroll
                for (int i = 0; i < 4; ++i) { const f32x4 y = rr ? u[i] : v[i]; uint2 w; w.x = pack2(y[0], y[1]); w.y = pack2(y[2], y[3]); *(uint2*)(xb + (size_t)row * 1024 + (lane + 64 * i) * 4) = w; } } }
    }
}

__device__ __forceinline__ f32x4 mma16(const LAS bf16_t* As, int lda, const LAS bf16_t* Bs, int ldb, int K, f32x4 acc, int lane) {
    const int r = lane & 15, q = lane >> 4;
#pragma unroll
    for (int k = 0; k < K; k += 32) { const bf16x8 a = *(const LAS bf16x8*)(As + r * lda + k + q * 8); const bf16x8 b = *(const LAS bf16x8*)(Bs + r * ldb + k + q * 8);
        acc = __builtin_amdgcn_mfma_f32_16x16x32_bf16(b, a, acc, 0, 0, 0); }
    return acc;
}


typedef short s16x4 __attribute__((ext_vector_type(4)));
__device__ __forceinline__ bf16x8 frag_tr(const LAS bf16_t* T, int ld, int lane) {
    const int g = lane >> 4, qq = (lane & 15) >> 2, p = lane & 3;
    LAS bf16_t* a = (LAS bf16_t*)T + (8 * g + qq) * ld + 4 * p;
    const s16x4 lo = __builtin_amdgcn_ds_read_tr16_b64_v4i16((LAS s16x4*)a);
    const s16x4 hi = __builtin_amdgcn_ds_read_tr16_b64_v4i16((LAS s16x4*)(a + 4 * ld));
    return (bf16x8){lo[0], lo[1], lo[2], lo[3], hi[0], hi[1], hi[2], hi[3]};
}

__device__ __forceinline__ void lds_barrier() { asm volatile("s_waitcnt lgkmcnt(0)" ::: "memory"); __builtin_amdgcn_s_barrier(); asm volatile("" ::: "memory"); }

__device__ void phase_s5_scan(CP P) {
    const float* E = (const float*)(P->ws + OFF_E); const float* AT = (const float*)(P->ws + OFF_S5P); bf16_t* AS5 = (bf16_t*)(P->ws + OFF_AS5);
    const int tid_ = otid(); if (tid_ >= 128) return;
    for (int idx = obid() * 128 + tid_; idx < 32 * 8 * 2 * 64; idx += gridDim.x * 128) {
        const int n = idx & 63, dir = (idx >> 6) & 1, b = (idx >> 7) & 7, g = idx >> 10;
        const float ar = AT[((g * 2 + dir) * 64 + n) * 2], ai = AT[((g * 2 + dir) * 64 + n) * 2 + 1];
        float xr = 0.f, xi = 0.f;
#pragma unroll 1
        for (int c0 = 0; c0 < 128; c0 += 16) { float2 ev[16];
#pragma unroll
            for (int k = 0; k < 16; ++k) { const int c = dir == 0 ? c0 + k : 127 - (c0 + k); const size_t bc = (size_t)g * 1024 + b * 128 + c; ev[k] = *(const float2*)(E + bc * 256 + dir * 128 + n * 2); }
#pragma unroll
            for (int k = 0; k < 16; ++k) { const int c = dir == 0 ? c0 + k : 127 - (c0 + k); const size_t bc = (size_t)g * 1024 + b * 128 + c;
                *(unsigned*)(AS5 + bc * 1280 + 1024 + dir * 128 + n * 2) = pack2(xr, xi);
                const float t0 = ar * xr - ai * xi + ev[k].x; xi = ar * xi + ai * xr + ev[k].y; xr = t0; } }
    }
}

__device__ __forceinline__ void gla_gates(CP P, const bf16_t* PQ, int m0, int h, LAS unsigned char* lds) {
    LAS float* gl = (LAS float*)lds; LAS float* tot = (LAS float*)(lds + 8192); LAS float* G = (LAS float*)(lds + 17408);
    const int tid = otid();
    const int dir = tid >> 8, d = tid & 63, tq = (tid >> 6) & 3;
    { const int idx = tid * 4, t = idx >> 5, r = idx & 31; const uint2 raw = *(const uint2*)(PQ + (size_t)(m0 + t) * 1792 + 1536 + r);
        *(LAS f32x4*)(gl + idx) = (f32x4){bflo(raw.x), bfhi(raw.x), bflo(raw.y), bfhi(raw.y)}; }
    float w[16];
#pragma unroll
    for (int r = 0; r < 16; ++r) w[r] = P->in[18][(dir * 16 + r) * 256 + h * 64 + d];
    const float b = P->in[19][dir * 256 + h * 64 + d];
    lds_barrier();
    float c[16];
#pragma unroll
    for (int i = 0; i < 16; ++i) { const int t = tq * 16 + i; float z = b;
#pragma unroll
        for (int r4 = 0; r4 < 4; ++r4) { const f32x4 g4 = *(const LAS f32x4*)(gl + t * 32 + dir * 16 + r4 * 4);
            z += g4[0] * w[r4 * 4] + g4[1] * w[r4 * 4 + 1] + g4[2] * w[r4 * 4 + 2] + g4[3] * w[r4 * 4 + 3]; }
        c[i] = (fminf(z, 0.f) - __logf(1.0f + __expf(-fabsf(z)))) * (1.0f / 16.0f); }
    if (dir == 0) {
#pragma unroll
        for (int i = 1; i < 16; ++i) c[i] += c[i - 1];
        tot[(dir * 4 + tq) * 64 + d] = c[15]; }
    else {
#pragma unroll
        for (int i = 14; i >= 0; --i) c[i] += c[i + 1];
        tot[(dir * 4 + tq) * 64 + d] = c[0]; }
    lds_barrier();
    float off = 0.f;
#pragma unroll
    for (int q = 0; q < 4; ++q) { const float tv = tot[(dir * 4 + q) * 64 + d]; off += ((dir == 0) ? (q < tq) : (q > tq)) ? tv : 0.f; }
#pragma unroll
    for (int i = 0; i < 16; ++i) G[(dir * 64 + tq * 16 + i) * 64 + d] = c[i] + off;
    lds_barrier();
}

__device__ void gla_a_unit(CP P, int unit, LAS unsigned char* lds) {
    const int c = unit & 127, h = (unit >> 7) & 3, b = unit >> 9, m0 = b * 8192 + c * 64;
    const bf16_t* PQ = (const bf16_t*)(P->ws + OFF_PQ); bf16_t* GST = (bf16_t*)(P->ws + OFF_GST); float* GDEC = (float*)(P->ws + OFF_GDEC);
    const int tid = otid(), lane = tid & 63, wid = tid >> 6;
    const int t = tid >> 3, d8 = (tid & 7) * 8, v16 = (tid & 7) * 16;
    const uint4 kraw = *(const uint4*)(PQ + (size_t)(m0 + t) * 1792 + 256 + h * 64 + d8);
    const uint4 vr0 = *(const uint4*)(PQ + (size_t)(m0 + t) * 1792 + 512 + h * 128 + v16), vr1 = *(const uint4*)(PQ + (size_t)(m0 + t) * 1792 + 512 + h * 128 + v16 + 8);
    gla_gates(P, PQ, m0, h, lds);
    LAS float* G = (LAS float*)(lds + 17408);
    LAS bf16_t* kA = (LAS bf16_t*)(lds + 50176);
    LAS bf16_t* Vs = (LAS bf16_t*)(lds + 67584);
    { const unsigned rw[4] = {kraw.x, kraw.y, kraw.z, kraw.w}; float ef[8], eb[8];
#pragma unroll
        for (int q = 0; q < 2; ++q) { const f32x4 lf = *(const LAS f32x4*)(G + 63 * 64 + d8 + q * 4), cf = *(const LAS f32x4*)(G + t * 64 + d8 + q * 4);
            const f32x4 lb = *(const LAS f32x4*)(G + 64 * 64 + d8 + q * 4), cb = *(const LAS f32x4*)(G + (64 + t) * 64 + d8 + q * 4);
#pragma unroll
            for (int j = 0; j < 4; ++j) { ef[q * 4 + j] = __expf(lf[j] - cf[j]); eb[q * 4 + j] = __expf(lb[j] - cb[j]); } }
        unsigned of[4], ob[4];
#pragma unroll
        for (int i = 0; i < 4; ++i) { const float k0 = bflo(rw[i]), k1 = bfhi(rw[i]); of[i] = pack2(k0 * ef[2 * i], k1 * ef[2 * i + 1]); ob[i] = pack2(k0 * eb[2 * i], k1 * eb[2 * i + 1]); }
        *(LAS u32x4*)(kA + t * 136 + d8) = mk4(of[0], of[1], of[2], of[3]); *(LAS u32x4*)(kA + t * 136 + 64 + d8) = mk4(ob[0], ob[1], ob[2], ob[3]);
        *(LAS u32x4*)(Vs + t * 136 + v16) = mk4(vr0.x, vr0.y, vr0.z, vr0.w); *(LAS u32x4*)(Vs + t * 136 + v16 + 8) = mk4(vr1.x, vr1.y, vr1.z, vr1.w); }
    if (tid < 128) { const int dir = tid >> 6, d = tid & 63; const float last = dir == 0 ? G[63 * 64 + d] : G[64 * 64 + d];
        GDEC[((size_t)(((b * 4 + h) * 2 + dir) * 128 + c)) * 64 + d] = __expf(last); }
    lds_barrier();
    { f32x4 acc[8];
#pragma unroll
        for (int nt = 0; nt < 8; ++nt) acc[nt] = (f32x4){0.f, 0.f, 0.f, 0.f};
#pragma unroll
        for (int ks = 0; ks < 2; ++ks) { const bf16x8 af = frag_tr(kA + ks * 32 * 136 + wid * 16, 136, lane);
#pragma unroll
            for (int nt = 0; nt < 8; ++nt) { const bf16x8 bfr = frag_tr(Vs + ks * 32 * 136 + nt * 16, 136, lane); acc[nt] = __builtin_amdgcn_mfma_f32_16x16x32_bf16(bfr, af, acc[nt], 0, 0, 0); } }
        const int row = wid * 16 + (lane & 15), dir = row >> 6, d = row & 63; bf16_t* out = GST + ((size_t)(((b * 4 + h) * 2 + dir) * 128 + c)) * 8192 + d * 128 + 4 * (lane >> 4);
#pragma unroll
        for (int nt = 0; nt < 8; ++nt) { uint2 w; w.x = pack2(acc[nt][0], acc[nt][1]); w.y = pack2(acc[nt][2], acc[nt][3]); *(uint2*)(out + nt * 16) = w; } }
    lds_barrier();
}

__device__ void phase_gla_b(CP P) {
    bf16_t* GST = (bf16_t*)(P->ws + OFF_GST); const float* GDEC = (const float*)(P->ws + OFF_GDEC);
    for (int idx = obid() * NTHR + otid(); idx < 64 * 1024; idx += gridDim.x * NTHR) {
        const int bhd = idx >> 10, e = (idx & 1023) * 8, d = e >> 7, dir = bhd & 1;
        f32x4 S0 = (f32x4){0.f, 0.f, 0.f, 0.f}, S1 = S0;
        bf16_t* base = GST + ((size_t)bhd * 128) * 8192 + e; const float* dbase = GDEC + ((size_t)bhd * 128) * 64 + d;
#pragma unroll 1
        for (int c0 = 0; c0 < 128; c0 += 8) { uint4 t[8]; float dc[8];
#pragma unroll
            for (int k = 0; k < 8; ++k) { const int c = dir == 0 ? c0 + k : 127 - (c0 + k); t[k] = *(const uint4*)(base + (size_t)c * 8192); dc[k] = dbase[(size_t)c * 64]; }
#pragma unroll
            for (int k = 0; k < 8; ++k) { const int c = dir == 0 ? c0 + k : 127 - (c0 + k);
                uint4 o; o.x = pack2(S0[0], S0[1]); o.y = pack2(S0[2], S0[3]); o.z = pack2(S1[0], S1[1]); o.w = pack2(S1[2], S1[3]); *(uint4*)(base + (size_t)c * 8192) = o;
                S0 = dc[k] * S0 + (f32x4){bflo(t[k].x), bfhi(t[k].x), bflo(t[k].y), bfhi(t[k].y)}; S1 = dc[k] * S1 + (f32x4){bflo(t[k].z), bfhi(t[k].z), bflo(t[k].w), bfhi(t[k].w)}; } }
    }
}

__device__ void gla_c_unit(CP P, int unit, LAS unsigned char* lds) {
    const int c = unit & 127, h = (unit >> 7) & 3, b = unit >> 9, m0 = b * 8192 + c * 64;
    const bf16_t* PQ = (const bf16_t*)(P->ws + OFF_PQ); const bf16_t* GST = (const bf16_t*)(P->ws + OFF_GST); bf16_t* MIX = (bf16_t*)(P->ws + OFF_XN);
    const int tid = otid(), lane = tid & 63, wid = tid >> 6;
    const int t = tid >> 3, d8 = (tid & 7) * 8, v16 = (tid & 7) * 16;
    const uint4 rq = *(const uint4*)(PQ + (size_t)(m0 + t) * 1792 + h * 64 + d8), rk = *(const uint4*)(PQ + (size_t)(m0 + t) * 1792 + 256 + h * 64 + d8);
    const uint4 vr0 = *(const uint4*)(PQ + (size_t)(m0 + t) * 1792 + 512 + h * 128 + v16), vr1 = *(const uint4*)(PQ + (size_t)(m0 + t) * 1792 + 512 + h * 128 + v16 + 8);
    const uint4 ogr0 = *(const uint4*)(PQ + (size_t)(m0 + t) * 1792 + 1024 + h * 128 + v16), ogr1 = *(const uint4*)(PQ + (size_t)(m0 + t) * 1792 + 1024 + h * 128 + v16 + 8);
    uint4 sr[4];
#pragma unroll
    for (int i = 0; i < 4; ++i) { const int idx = tid + i * NTHR, v8 = (idx & 15) * 8, d = (idx >> 4) & 63, dir = idx >> 10;
        sr[i] = *(const uint4*)(GST + ((size_t)(((b * 4 + h) * 2 + dir) * 128 + c)) * 8192 + d * 128 + v8); }
    gla_gates(P, PQ, m0, h, lds);
    LAS float* G = (LAS float*)(lds + 17408);
    LAS bf16_t* Ps = (LAS bf16_t*)lds;
    LAS bf16_t* qf = (LAS bf16_t*)(lds + 51200);
    LAS bf16_t* kf = qf + 64 * 72; LAS bf16_t* qb = kf + 64 * 72; LAS bf16_t* kb = qb + 64 * 72;
    LAS bf16_t* Vs = (LAS bf16_t*)(lds + 88064);
    LAS bf16_t* Ss = (LAS bf16_t*)(lds + 105472);
    { const unsigned qw[4] = {rq.x, rq.y, rq.z, rq.w}, kw[4] = {rk.x, rk.y, rk.z, rk.w};
        unsigned oqf[4], okf[4], oqb[4], okb[4]; float cf[8], cb[8];
#pragma unroll
        for (int q = 0; q < 2; ++q) { const f32x4 a = *(const LAS f32x4*)(G + t * 64 + d8 + q * 4), bb = *(const LAS f32x4*)(G + (64 + t) * 64 + d8 + q * 4);
#pragma unroll
            for (int j = 0; j < 4; ++j) { cf[q * 4 + j] = a[j]; cb[q * 4 + j] = bb[j]; } }
#pragma unroll
        for (int i = 0; i < 4; ++i) { const float cf0 = cf[2 * i], cf1 = cf[2 * i + 1], cb0 = cb[2 * i], cb1 = cb[2 * i + 1];
            const float q0 = bflo(qw[i]) * 0.125f, q1 = bfhi(qw[i]) * 0.125f, k0 = bflo(kw[i]), k1 = bfhi(kw[i]);
            oqf[i] = pack2(q0 * __expf(cf0), q1 * __expf(cf1)); okf[i] = pack2(k0 * __expf(-cf0), k1 * __expf(-cf1));
            oqb[i] = pack2(q0 * __expf(cb0), q1 * __expf(cb1)); okb[i] = pack2(k0 * __expf(-cb0), k1 * __expf(-cb1)); }
        *(LAS u32x4*)(qf + t * 72 + d8) = mk4(oqf[0], oqf[1], oqf[2], oqf[3]); *(LAS u32x4*)(kf + t * 72 + d8) = mk4(okf[0], okf[1], okf[2], okf[3]);
        *(LAS u32x4*)(qb + t * 72 + d8) = mk4(oqb[0], oqb[1], oqb[2], oqb[3]); *(LAS u32x4*)(kb + t * 72 + d8) = mk4(okb[0], okb[1], okb[2], okb[3]);
        *(LAS u32x4*)(Vs + t * 136 + v16) = mk4(vr0.x, vr0.y, vr0.z, vr0.w); *(LAS u32x4*)(Vs + t * 136 + v16 + 8) = mk4(vr1.x, vr1.y, vr1.z, vr1.w); }
#pragma unroll
    for (int i = 0; i < 4; ++i) { const int idx = tid + i * NTHR, v8 = (idx & 15) * 8, d = (idx >> 4) & 63, dir = idx >> 10;
        *(LAS u32x4*)(Ss + (dir * 64 + d) * 136 + v8) = mk4(sr[i].x, sr[i].y, sr[i].z, sr[i].w); }
    lds_barrier();
#pragma unroll
    for (int tl = 0; tl < 2; ++tl) { const int tile = wid * 2 + tl, mi = tile >> 2, ni = tile & 3; f32x4 pf = (f32x4){0.f, 0.f, 0.f, 0.f}, pb = pf;
        pf = mma16(qf + mi * 16 * 72, 72, kf + ni * 16 * 72, 72, 64, pf, lane); pb = mma16(qb + mi * 16 * 72, 72, kb + ni * 16 * 72, 72, 64, pb, lane);
        const int i = mi * 16 + (lane & 15), j0 = ni * 16 + 4 * (lane >> 4); float pv[4];
#pragma unroll
        for (int jj = 0; jj < 4; ++jj) pv[jj] = (j0 + jj <= i) ? pf[jj] : pb[jj];
        *(LAS u32x2*)(Ps + i * 72 + j0) = mk2(pack2(pv[0], pv[1]), pack2(pv[2], pv[3])); }
    lds_barrier();
    { const int mi = wid & 3, nb = (wid >> 2) * 4; LAS float* ost = G; f32x4 acc[4];
#pragma unroll
        for (int nt = 0; nt < 4; ++nt) acc[nt] = (f32x4){0.f, 0.f, 0.f, 0.f};
#pragma unroll
        for (int ks = 0; ks < 2; ++ks) {
            const bf16x8 ap = *(const LAS bf16x8*)(Ps + (mi * 16 + (lane & 15)) * 72 + ks * 32 + (lane >> 4) * 8);
            const bf16x8 af = *(const LAS bf16x8*)(qf + (mi * 16 + (lane & 15)) * 72 + ks * 32 + (lane >> 4) * 8);
            const bf16x8 ab = *(const LAS bf16x8*)(qb + (mi * 16 + (lane & 15)) * 72 + ks * 32 + (lane >> 4) * 8);
#pragma unroll
            for (int nt = 0; nt < 4; ++nt) { const int ni = nb + nt;
                acc[nt] = __builtin_amdgcn_mfma_f32_16x16x32_bf16(frag_tr(Vs + ks * 32 * 136 + ni * 16, 136, lane), ap, acc[nt], 0, 0, 0);
                acc[nt] = __builtin_amdgcn_mfma_f32_16x16x32_bf16(frag_tr(Ss + ks * 32 * 136 + ni * 16, 136, lane), af, acc[nt], 0, 0, 0);
                acc[nt] = __builtin_amdgcn_mfma_f32_16x16x32_bf16(frag_tr(Ss + (64 + ks * 32) * 136 + ni * 16, 136, lane), ab, acc[nt], 0, 0, 0); } }
#pragma unroll
        for (int nt = 0; nt < 4; ++nt) *(LAS f32x4*)(ost + (mi * 16 + (lane & 15)) * 132 + (nb + nt) * 16 + 4 * (lane >> 4)) = acc[nt]; }
    lds_barrier();
    { LAS float* ost = G; float o[16]; float ss = 0.f;
#pragma unroll
        for (int i = 0; i < 4; ++i) { const f32x4 v = *(const LAS f32x4*)(ost + t * 132 + v16 + i * 4); o[4 * i] = v[0]; o[4 * i + 1] = v[1]; o[4 * i + 2] = v[2]; o[4 * i + 3] = v[3]; ss += v[0] * v[0] + v[1] * v[1] + v[2] * v[2] + v[3] * v[3]; }
        ss += __shfl_xor(ss, 1); ss += __shfl_xor(ss, 2); ss += __shfl_xor(ss, 4);
        const float rstd = rsqrtf(ss * (1.0f / 128.0f) + 1e-6f);
        const float* gn = P->in[20] + h * 128 + v16;
        bf16_t* op = MIX + (size_t)(m0 + t) * 1024 + 512 + h * 128 + v16;
#pragma unroll
        for (int hh = 0; hh < 2; ++hh) { const uint4 raw = hh ? ogr1 : ogr0; const unsigned rw[4] = {raw.x, raw.y, raw.z, raw.w}; unsigned ow[4];
#pragma unroll
            for (int i = 0; i < 4; ++i) { const int e = hh * 8 + 2 * i; const float g0 = bflo(rw[i]), g1 = bfhi(rw[i]);
                ow[i] = pack2(o[e] * rstd * gn[e] * silu_f(g0), o[e + 1] * rstd * gn[e + 1] * silu_f(g1)); }
            *(uint4*)(op + hh * 8) = make_uint4(ow[0], ow[1], ow[2], ow[3]); } }
    lds_barrier();
}

__device__ __forceinline__ float ret_lg(int h) {
    float v = -0.0317486983145803f;
    v = h == 1 ? -0.015748356968139168f : v; v = h == 2 ? -0.007843177461025893f : v; v = h == 3 ? -0.003913899321136329f : v; v = h == 4 ? -0.0019550348358033506f : v;
    v = h == 5 ? -0.0009770396478266127f : v; v = h == 6 ? -0.0004884004981088745f : v; v = h == 7 ? -0.0002441704321739145f : v; return v;
}

struct KRaw { uint4 a, b; };
__device__ __forceinline__ KRaw rot_load(const bf16_t* rowp, const float*, const float*, int dq) { KRaw k; k.a = *(const uint4*)(rowp + dq); k.b = *(const uint4*)(rowp + 64 + dq); return k; }
__device__ __forceinline__ void rot_apply(const KRaw& k, float (&r1)[8], float (&r2)[8]) {
    const unsigned aw[4] = {k.a.x, k.a.y, k.a.z, k.a.w}, bw[4] = {k.b.x, k.b.y, k.b.z, k.b.w};
#pragma unroll
    for (int i = 0; i < 8; ++i) { r1[i] = (i & 1) ? bfhi(aw[i >> 1]) : bflo(aw[i >> 1]); r2[i] = (i & 1) ? bfhi(bw[i >> 1]) : bflo(bw[i >> 1]); }
}

__device__ void ret_a_unit(CP P, int hf, int unit, LAS unsigned char* lds) {
    const int sc = unit & 31, h = (unit >> 5) & 7, bl = unit >> 8;
    const bf16_t* PR = (const bf16_t*)(P->ws + OFF_PROJ1); bf16_t* RST = (bf16_t*)(P->ws + OFF_RST);
    const int tid = otid(), lane = tid & 63, wid = tid >> 6;
    const size_t r0 = (size_t)bl * 8192 + sc * 256;
    const float lgf = ret_lg(h), lgb = ret_lg(7 - h);
    LAS bf16_t* kf = (LAS bf16_t*)lds;
    LAS bf16_t* kb = (LAS bf16_t*)(lds + 17408);
    LAS bf16_t* Vs = (LAS bf16_t*)(lds + 34816);
    f32x4 acc[4][8];
#pragma unroll
    for (int a = 0; a < 4; ++a)
#pragma unroll
        for (int n = 0; n < 8; ++n) acc[a][n] = (f32x4){0.f, 0.f, 0.f, 0.f};
    const int mb = (wid >> 1) * 4, nb = (wid & 1) * 8;
    const LAS bf16_t* kA = (mb >= 8) ? kb : kf; const int dt0 = (mb & 7) * 16;
    const int pj = tid >> 3, pdq = (tid & 7) * 8, pv32 = (tid & 7) * 32;
    const bf16_t* kbase = PR + (r0 + pj) * 6144 + 1024 + h * 128; const bf16_t* vbase = PR + (r0 + pj) * 6144 + 2048 + h * 256 + pv32;
    KRaw kr = rot_load(kbase, nullptr, nullptr, pdq);
    uint4 vr[4];
#pragma unroll
    for (int hh = 0; hh < 4; ++hh) vr[hh] = *(const uint4*)(vbase + hh * 8);
    for (int jb = 0; jb < 4; ++jb) {
        { const int j = pj, dq = pdq, J = jb * 64 + j; float r1[8], r2[8];
            rot_apply(kr, r1, r2);
            const float sf = __expf((float)(255 - J) * lgf), sb = __expf((float)J * lgb);
            *(LAS u32x4*)(kf + j * 136 + dq) = mk4(pack2(r1[0] * sf, r1[1] * sf), pack2(r1[2] * sf, r1[3] * sf), pack2(r1[4] * sf, r1[5] * sf), pack2(r1[6] * sf, r1[7] * sf));
            *(LAS u32x4*)(kf + j * 136 + 64 + dq) = mk4(pack2(r2[0] * sf, r2[1] * sf), pack2(r2[2] * sf, r2[3] * sf), pack2(r2[4] * sf, r2[5] * sf), pack2(r2[6] * sf, r2[7] * sf));
            *(LAS u32x4*)(kb + j * 136 + dq) = mk4(pack2(r1[0] * sb, r1[1] * sb), pack2(r1[2] * sb, r1[3] * sb), pack2(r1[4] * sb, r1[5] * sb), pack2(r1[6] * sb, r1[7] * sb));
            *(LAS u32x4*)(kb + j * 136 + 64 + dq) = mk4(pack2(r2[0] * sb, r2[1] * sb), pack2(r2[2] * sb, r2[3] * sb), pack2(r2[4] * sb, r2[5] * sb), pack2(r2[6] * sb, r2[7] * sb));
#pragma unroll
            for (int hh = 0; hh < 4; ++hh) *(LAS u32x4*)(Vs + j * 264 + pv32 + hh * 8) = mk4(vr[hh].x, vr[hh].y, vr[hh].z, vr[hh].w); }
        lds_barrier();
        if (jb < 3) { kr = rot_load(kbase + (size_t)(jb + 1) * 64 * 6144, nullptr, nullptr, pdq);
#pragma unroll
            for (int hh = 0; hh < 4; ++hh) vr[hh] = *(const uint4*)(vbase + (size_t)(jb + 1) * 64 * 6144 + hh * 8); }
#pragma unroll
        for (int ks = 0; ks < 2; ++ks) { bf16x8 af[4];
#pragma unroll
            for (int a = 0; a < 4; ++a) af[a] = frag_tr(kA + ks * 32 * 136 + dt0 + a * 16, 136, lane);
#pragma unroll
            for (int n = 0; n < 8; ++n) { const bf16x8 bfr = frag_tr(Vs + ks * 32 * 264 + (nb + n) * 16, 264, lane);
#pragma unroll
                for (int a = 0; a < 4; ++a) acc[a][n] = __builtin_amdgcn_mfma_f32_16x16x32_bf16(bfr, af[a], acc[a][n], 0, 0, 0); } }
        lds_barrier();
    }
#pragma unroll
    for (int a = 0; a < 4; ++a) { const int row = (mb + a) * 16 + (lane & 15), dir = row >> 7, d = row & 127;
        bf16_t* out = RST + ((size_t)(((bl * 8 + h) * 2 + dir) * 32 + sc)) * 32768 + d * 256 + 4 * (lane >> 4);
#pragma unroll
        for (int n = 0; n < 8; ++n) { uint2 w; w.x = pack2(acc[a][n][0], acc[a][n][1]); w.y = pack2(acc[a][n][2], acc[a][n][3]); *(uint2*)(out + (nb + n) * 16) = w; } }
}

__device__ void phase_ret_b(CP P) {
    bf16_t* RST = (bf16_t*)(P->ws + OFF_RST);
    for (int idx = obid() * NTHR + otid(); idx < 64 * 4096; idx += gridDim.x * NTHR) {
        const int bhd = idx >> 12, e = (idx & 4095) * 8, dir = bhd & 1, h = (bhd >> 1) & 7;
        const float dec = __expf(256.0f * ret_lg(dir == 0 ? h : 7 - h));
        f32x4 S0 = (f32x4){0.f, 0.f, 0.f, 0.f}, S1 = S0;
        bf16_t* base = RST + ((size_t)bhd * 32) * 32768 + e;
#pragma unroll 1
        for (int c0 = 0; c0 < 32; c0 += 8) { uint4 t[8];
#pragma unroll
            for (int k = 0; k < 8; ++k) { const int c = dir == 0 ? c0 + k : 31 - (c0 + k); t[k] = *(const uint4*)(base + (size_t)c * 32768); }
#pragma unroll
            for (int k = 0; k < 8; ++k) { const int c = dir == 0 ? c0 + k : 31 - (c0 + k);
                uint4 o; o.x = pack2(S0[0], S0[1]); o.y = pack2(S0[2], S0[3]); o.z = pack2(S1[0], S1[1]); o.w = pack2(S1[2], S1[3]); *(uint4*)(base + (size_t)c * 32768) = o;
                S0 = dec * S0 + (f32x4){bflo(t[k].x), bfhi(t[k].x), bflo(t[k].y), bfhi(t[k].y)}; S1 = dec * S1 + (f32x4){bflo(t[k].z), bfhi(t[k].z), bflo(t[k].w), bfhi(t[k].w)}; } }
    }
}

__device__ void ret_c_unit(CP P, int hf, int unit, LAS unsigned char* lds) {
    const int rh = (unit >> 3) & 1, ur = (unit & 7) | ((unit >> 4) << 3), sc = ur & 31, h = (ur >> 5) & 7, bl = ur >> 8;
    const bf16_t* PR = (const bf16_t*)(P->ws + OFF_PROJ1); const bf16_t* RST = (const bf16_t*)(P->ws + OFF_RST);
    const float* cs = (const float*)(P->ws + OFF_ROPE); const float* sn = cs + 8192 * 64;
    const int tid = otid(), lane = tid & 63, wid = tid >> 6;
    const size_t r0 = (size_t)bl * 8192 + sc * 256;
    const float lgf = ret_lg(h), lgb = ret_lg(7 - h);
    LAS bf16_t* qs = (LAS bf16_t*)lds;
    LAS bf16_t* ks = (LAS bf16_t*)(lds + 34816);
    LAS bf16_t* Ps = (LAS bf16_t*)(lds + 52224);
    LAS bf16_t* Vs = (LAS bf16_t*)(lds + 70656);
    LAS float* red = (LAS float*)(lds + 104448);
    LAS bf16_t* qx = ks;
#pragma unroll
    for (int rep = 0; rep < 2; ++rep) { const int i = (tid >> 3) + rep * 64, dq = (tid & 7) * 8, I = rh * 128 + i;
        const KRaw q_ = rot_load(PR + (r0 + I) * 6144 + h * 128, nullptr, nullptr, dq);
        *(LAS u32x4*)(qs + i * 136 + dq) = mk4(q_.a.x, q_.a.y, q_.a.z, q_.a.w); *(LAS u32x4*)(qs + i * 136 + 64 + dq) = mk4(q_.b.x, q_.b.y, q_.b.z, q_.b.w); }
    f32x4 acc[2][8];
#pragma unroll
    for (int r = 0; r < 2; ++r)
#pragma unroll
        for (int n = 0; n < 8; ++n) acc[r][n] = (f32x4){0.f, 0.f, 0.f, 0.f};
    const int mi2 = (wid & 3) * 2, nb = (wid >> 2) * 8;
    const int pj = tid >> 3, pdq = (tid & 7) * 8, pv32 = (tid & 7) * 32;
    const bf16_t* kbase = PR + (r0 + pj) * 6144 + 1024 + h * 128; const bf16_t* vbase = PR + (r0 + pj) * 6144 + 2048 + h * 256 + pv32;
    KRaw kr = rot_load(kbase, cs + (sc * 256 + pj) * 64, sn + (sc * 256 + pj) * 64, pdq);
    uint4 vr[4];
#pragma unroll
    for (int hh = 0; hh < 4; ++hh) vr[hh] = *(const uint4*)(vbase + hh * 8);
    uint4 st[4];
    const bf16_t* sbase = RST + ((size_t)((bl * 8 + h) * 2) * 32 + sc) * 32768;
    for (int kb = 0; kb < 4; ++kb) {
        { const int j = pj, dq = pdq;
            *(LAS u32x4*)(ks + j * 136 + dq) = mk4(kr.a.x, kr.a.y, kr.a.z, kr.a.w); *(LAS u32x4*)(ks + j * 136 + 64 + dq) = mk4(kr.b.x, kr.b.y, kr.b.z, kr.b.w);
#pragma unroll
            for (int hh = 0; hh < 4; ++hh) *(LAS u32x4*)(Vs + j * 264 + pv32 + hh * 8) = mk4(vr[hh].x, vr[hh].y, vr[hh].z, vr[hh].w); }
        lds_barrier();
        if (kb < 3) { const int J = (kb + 1) * 64 + pj; kr = rot_load(kbase + (size_t)(kb + 1) * 64 * 6144, cs + (sc * 256 + J) * 64, sn + (sc * 256 + J) * 64, pdq);
#pragma unroll
            for (int hh = 0; hh < 4; ++hh) vr[hh] = *(const uint4*)(vbase + (size_t)(kb + 1) * 64 * 6144 + hh * 8); }
        else {
#pragma unroll
            for (int i = 0; i < 4; ++i) { const int idx = tid + i * NTHR, v8 = (idx & 31) * 8, dd = idx >> 5; st[i] = *(const uint4*)(sbase + dd * 256 + v8); } }
#pragma unroll
        for (int tr = 0; tr < 2; ++tr)
#pragma unroll
            for (int tc = 0; tc < 2; ++tc) { const int ti = mi2 + tr, tj = (wid >> 2) * 2 + tc; f32x4 s = (f32x4){0.f, 0.f, 0.f, 0.f};
                s = mma16(qs + ti * 16 * 136, 136, ks + tj * 16 * 136, 136, 128, s, lane);
                const int i = ti * 16 + (lane & 15), j0 = tj * 16 + 4 * (lane >> 4), I = rh * 128 + i; float pv[4];
#pragma unroll
                for (int jj = 0; jj < 4; ++jj) { const int df = I - (kb * 64 + j0 + jj); const float dm = df >= 0 ? __expf((float)df * lgf) : __expf((float)(-df) * lgb); pv[jj] = s[jj] * dm; }
                *(LAS u32x2*)(Ps + i * 72 + j0) = mk2(pack2(pv[0], pv[1]), pack2(pv[2], pv[3])); }
        lds_barrier();
#pragma unroll
        for (int k2 = 0; k2 < 2; ++k2) { bf16x8 af[2], bfr[8];
#pragma unroll
            for (int r = 0; r < 2; ++r) af[r] = *(const LAS bf16x8*)(Ps + ((mi2 + r) * 16 + (lane & 15)) * 72 + k2 * 32 + (lane >> 4) * 8);
#pragma unroll
            for (int n = 0; n < 8; ++n) bfr[n] = frag_tr(Vs + k2 * 32 * 264 + (nb + n) * 16, 264, lane);
#pragma unroll
            for (int r = 0; r < 2; ++r)
#pragma unroll
                for (int n = 0; n < 8; ++n) acc[r][n] = __builtin_amdgcn_mfma_f32_16x16x32_bf16(bfr[n], af[r], acc[r][n], 0, 0, 0); }
        lds_barrier();
    }
    uint2 ogr[2][8];
#pragma unroll
    for (int r = 0; r < 2; ++r) { const bf16_t* ogp = PR + (r0 + rh * 128 + (mi2 + r) * 16 + (lane & 15)) * 6144 + 4096 + h * 256 + 4 * (lane >> 4);
#pragma unroll
        for (int n = 0; n < 8; ++n) ogr[r][n] = *(const uint2*)(ogp + (nb + n) * 16); }
    for (int sl = 0; sl < 4; ++sl) { const int dir = sl >> 1, dh = sl & 1;
        if (dh == 0) { const int i = tid >> 2, c32 = (tid & 3) * 32, I = rh * 128 + i; const float xs = dir == 0 ? __expf((float)(I + 1) * lgf) : __expf((float)(256 - I) * lgb);
#pragma unroll
            for (int hh = 0; hh < 4; ++hh) { const u32x4 w = *(const LAS u32x4*)(qs + i * 136 + c32 + hh * 8);
                *(LAS u32x4*)(qx + i * 136 + c32 + hh * 8) = mk4(pack2(bflo(w[0]) * xs, bfhi(w[0]) * xs), pack2(bflo(w[1]) * xs, bfhi(w[1]) * xs), pack2(bflo(w[2]) * xs, bfhi(w[2]) * xs), pack2(bflo(w[3]) * xs, bfhi(w[3]) * xs)); } }
#pragma unroll
        for (int i = 0; i < 4; ++i) { const int idx = tid + i * NTHR, v8 = (idx & 31) * 8, dd = idx >> 5; *(LAS u32x4*)(Vs + dd * 264 + v8) = mk4(st[i].x, st[i].y, st[i].z, st[i].w); }
        lds_barrier();
        if (sl < 3) { const int nd = (sl + 1) >> 1, nh = (sl + 1) & 1; const bf16_t* sp = sbase + (size_t)nd * 32 * 32768 + (size_t)nh * 64 * 256;
#pragma unroll
            for (int i = 0; i < 4; ++i) { const int idx = tid + i * NTHR, v8 = (idx & 31) * 8, dd = idx >> 5; st[i] = *(const uint4*)(sp + dd * 256 + v8); } }
#pragma unroll
        for (int k2 = 0; k2 < 2; ++k2) { bf16x8 af[2], bfr[8];
#pragma unroll
            for (int r = 0; r < 2; ++r) af[r] = *(const LAS bf16x8*)(qx + ((mi2 + r) * 16 + (lane & 15)) * 136 + dh * 64 + k2 * 32 + (lane >> 4) * 8);
#pragma unroll
            for (int n = 0; n < 8; ++n) bfr[n] = frag_tr(Vs + k2 * 32 * 264 + (nb + n) * 16, 264, lane);
#pragma unroll
            for (int r = 0; r < 2; ++r)
#pragma unroll
                for (int n = 0; n < 8; ++n) acc[r][n] = __builtin_amdgcn_mfma_f32_16x16x32_bf16(bfr[n], af[r], acc[r][n], 0, 0, 0); }
        lds_barrier();
    }
    { float ss[2];
#pragma unroll
        for (int r = 0; r < 2; ++r) { ss[r] = 0.f;
#pragma unroll
            for (int n = 0; n < 8; ++n) ss[r] += acc[r][n][0] * acc[r][n][0] + acc[r][n][1] * acc[r][n][1] + acc[r][n][2] * acc[r][n][2] + acc[r][n][3] * acc[r][n][3];
            ss[r] += __shfl_xor(ss[r], 16); ss[r] += __shfl_xor(ss[r], 32);
            if ((lane >> 4) == 0) red[((mi2 + r) * 16 + (lane & 15)) * 2 + (wid >> 2)] = ss[r]; }
        lds_barrier();
#pragma unroll
        for (int r = 0; r < 2; ++r) { const int i = (mi2 + r) * 16 + (lane & 15);
            const float rstd = rsqrtf((red[i * 2] + red[i * 2 + 1]) * (1.0f / 256.0f) + 1e-6f);
            const float* gn = P->in[23] + h * 256 + 4 * (lane >> 4);
            bf16_t* op = (bf16_t*)(P->ws + OFF_OBUF) + (r0 + rh * 128 + i) * 2048 + h * 256 + 4 * (lane >> 4);
#pragma unroll
            for (int n = 0; n < 8; ++n) { const int v = (nb + n) * 16; const uint2 og = ogr[r][n]; const f32x4 g4 = *(const f32x4*)(gn + v);
                uint2 w; w.x = pack2(acc[r][n][0] * rstd * g4[0] * silu_f(bflo(og.x)), acc[r][n][1] * rstd * g4[1] * silu_f(bfhi(og.x)));
                w.y = pack2(acc[r][n][2] * rstd * g4[2] * silu_f(bflo(og.y)), acc[r][n][3] * rstd * g4[3] * silu_f(bfhi(og.y)));
                *(uint2*)(op + v) = w; } } }
    lds_barrier();
}

__device__ __forceinline__ void grid_barrier(unsigned* cnt, unsigned target) {
    asm volatile("s_waitcnt vmcnt(0)" ::: "memory");
    __syncthreads();
    if (threadIdx.x == 0) {
        __builtin_amdgcn_fence(__ATOMIC_RELEASE, "agent");
        asm volatile("s_waitcnt vmcnt(0)" ::: "memory");
        (void)__hip_atomic_fetch_add(cnt, 1u, __ATOMIC_RELAXED, __HIP_MEMORY_SCOPE_AGENT);
        unsigned spins = 0;
        while (__hip_atomic_load(cnt, __ATOMIC_RELAXED, __HIP_MEMORY_SCOPE_AGENT) < target) { __builtin_amdgcn_s_sleep(2); if (++spins > (1u << 24)) break; }
        __builtin_amdgcn_fence(__ATOMIC_ACQUIRE, "agent");
        asm volatile("s_waitcnt vmcnt(0)" ::: "memory");
    }
    __syncthreads();
}

__global__ void __launch_bounds__(NTHR, 2) mega(Params Pval, int ph0, int ph1) {
    extern __shared__ __attribute__((aligned(16))) unsigned char lds_raw[];
    LAS unsigned char* lds = (LAS unsigned char*)lds_raw;
    unsigned nbar = 0;
    for (int ph = ph0; ph < ph1; ++ph) {
        CP P = (CP)__builtin_amdgcn_kernarg_segment_ptr(); asm volatile("" : "+s"(P));
        unsigned char* ws = P->ws;
        bf16_t* XN = (bf16_t*)(ws + OFF_XN); bf16_t* ACT = (bf16_t*)(ws + OFF_ACT); float* X = P->out;
        if (ph == 1 || ph == 4 || ph == 11 || ph == 14 || ph == 17 || ph == 28) continue;
        const int reps = (((unsigned long long)(PROBE_MASK) >> ph) & 1ull) ? 2 : 1;
        for (int rep = 0; rep < reps; ++rep) {
        float* SSQ = (float*)(ws + OFF_SSQ); bf16_t* XB2 = (bf16_t*)(ws + OFF_XB2);
        int ffn = -1, sub = 0;
        if (ph >= 2 && ph <= 3) { ffn = 0; sub = ph - 1; } else if (ph >= 12 && ph <= 13) { ffn = 1; sub = ph - 11; }
        else if (ph >= 15 && ph <= 16) { ffn = 2; sub = ph - 14; } else if (ph >= 29 && ph <= 30) { ffn = 3; sub = ph - 28; }
        if (ph == 0) { if (EN(0)) phase_prologue(P, lds); }
        else if (ffn >= 0) {
            const float* xin = (ffn == 0) ? P->in[0] : X;
            const float* ssin = SSQ + (size_t)(ffn == 0 ? 0 : ffn == 1 ? 2 : ffn == 2 ? 3 : 5) * SSN;
            if (sub == 1) { if (EN(2)) { if (ffn == 0) phase_kmat(P);
                pg8::Gemm g{ffn == 1 ? XB2 : XN, (const bf16_t*)(ws + OFF_W1 + (size_t)ffn * SZ_W1), 1024, 1024, 1024, 256, 22, 1, 0, 0}; EpiSwiGLU e{ACT, ssin}; pg8::gemm_phase(lds, g, e); } }
            else { if (EN(3)) { pg8::Gemm g{ACT, (const bf16_t*)(ws + OFF_W2 + (size_t)ffn * SZ_W2), 2816, 2816, 2816, 256, 4, 1, 0, 0};
                float* ssout = SSQ + (size_t)(ffn == 0 ? 1 : ffn == 1 ? 3 : 4) * SSN;
                if (ffn == 3) { EpiResid<false> e{xin, X, nullptr, nullptr, 0.5f}; pg8::gemm_phase(lds, g, e); }
                else { EpiResid<true> e{xin, X, XN, ssout, 0.5f}; pg8::gemm_phase(lds, g, e); } } }
        }
        else if (ph == 5) { if (EN(4)) { pg8::Gemm g{XN, (const bf16_t*)(ws + OFF_WIN0), 1024, 1024, 1024, 256, 9, 1, 0, 0}; EpiWin0 e{(bf16_t*)(ws + OFF_AS5), (bf16_t*)(ws + OFF_PQ), SSQ + SSN}; pg8::gemm_phase(lds, g, e); } }
        else if (ph == 6) { if (EN(5)) {
            if (EN(16)) { pg8::Gemm g{(const bf16_t*)(ws + OFF_AS5), (const bf16_t*)(ws + OFF_H), 1280, 1024, 1024, 4, 1, 32, (size_t)1024 * 1280, (size_t)256 * 1024}; EpiS5E e{(float*)(ws + OFF_E)}; pg8::gemm_phase(lds, g, e); }
            __syncthreads();
            if (EN(17)) for (int u = obid(); u < 4096; u += gridDim.x) gla_a_unit(P, u, lds);
        } }
        else if (ph == 7) { if (EN(6)) { phase_s5_scan(P); phase_gla_b(P); } }
        else if (ph == 8) { if (EN(7)) {
            if (EN(18)) { pg8::Gemm g{(const bf16_t*)(ws + OFF_AS5), (const bf16_t*)(ws + OFF_KG), 1280, 1280, 1280, 4, 4, 32, (size_t)1024 * 1280, (size_t)1024 * 1280}; EpiS5Y e{(bf16_t*)(ws + OFF_GY)}; pg8::gemm_phase(lds, g, e); }
            __syncthreads();
            if (EN(19)) for (int u = obid(); u < 4096; u += gridDim.x) gla_c_unit(P, u, lds);
        } }
        else if (ph == 9) { if (EN(8)) { pg8::Gemm g{(const bf16_t*)(ws + OFF_GY), (const bf16_t*)(ws + OFF_WGLU), 512, 512, 512, 256, 2, 1, 0, 0}; EpiGLU e{(const bf16_t*)(ws + OFF_GY), XN}; pg8::gemm_phase(lds, g, e); } }
        else if (ph == 10) { if (EN(9)) { pg8::Gemm g{XN, (const bf16_t*)(ws + OFF_WOUT0), 1024, 1024, 1024, 256, 4, 1, 0, 0}; EpiResid<true> e{X, X, XB2, SSQ + 2 * SSN, 1.0f}; pg8::gemm_phase(lds, g, e); } }
        else if (ph >= 18 && ph <= 27) {
            const int hf = (ph - 18) / 5, s = (ph - 18) % 5;
            if (s == 0) { if (EN(10)) { pg8::Gemm g{XN + (size_t)hf * 32768 * 1024, (const bf16_t*)(ws + OFF_WIN1), 1024, 1024, 1024, 128, 24, 1, 0, 0}; EpiRetIn e{(bf16_t*)(ws + OFF_PROJ1), 6144, SSQ + 4 * SSN + (size_t)hf * 32768 * 16, (const float*)(ws + OFF_ROPE), (const float*)(ws + OFF_ROPE) + 8192 * 64, hf * 32768}; pg8::gemm_phase(lds, g, e); } }
            else if (s == 1) { if (EN(11)) for (int u = obid(); u < 1024; u += gridDim.x) ret_a_unit(P, hf, u, lds); }
            else if (s == 2) { if (EN(12)) phase_ret_b(P); }
            else if (s == 3) { if (EN(13)) for (int u = obid(); u < 2048; u += gridDim.x) ret_c_unit(P, hf, u, lds); }
            else { if (EN(14)) { pg8::Gemm g{(const bf16_t*)(ws + OFF_OBUF), (const bf16_t*)(ws + OFF_WOUT1), 2048, 2048, 2048, 128, 4, 1, 0, 0};
                float* Xh = X + (size_t)hf * 32768 * 1024; EpiResid<true> e{Xh, Xh, XN + (size_t)hf * 32768 * 1024, SSQ + 5 * SSN + (size_t)hf * 32768 * 16, 1.0f}; pg8::gemm_phase(lds, g, e); } }
        }
        else if (ph == 31) { if (EN(15)) phase_norm<true>(X, P->in[25], nullptr, nullptr, X, 0, (int)gridDim.x, 0, 65536); }
        if (rep + 1 < reps) __syncthreads();
        }
        if (ph + 1 < ph1) { if (ph == 0) cg::this_grid().sync();
            else { ++nbar; grid_barrier((unsigned*)(P->ws + OFF_BAR), nbar * gridDim.x); } }
    }
}

extern "C" void kernel_launch(void* const* d_in, const int* in_sizes, int n_in, void* d_out, int out_size, void* d_ws, size_t ws_size, hipStream_t stream) {
    static int inited = 0;
    if (!inited) { (void)hipFuncSetAttribute((const void*)mega, hipFuncAttributeMaxDynamicSharedMemorySize, LDS_BYTES); inited = 1; }
    Params p{};
    for (int i = 0; i < 26; ++i) p.in[i] = (const float*)d_in[i];
    p.out = (float*)d_out; p.ws = (unsigned char*)d_ws;
    if (ws_size < OFF_R + 770 * MiB) fprintf(stderr, "kernel_launch: workspace too small (%zu)\n", ws_size);
    const int grid = 256;
#if ONE_LAUNCH
    (void)hipMemsetAsync((unsigned char*)d_ws + OFF_BAR, 0, 256, stream);
    int ph0 = 0, ph1 = NPHASE; void* args[] = {&p, &ph0, &ph1};
    hipError_t e = hipLaunchCooperativeKernel((const void*)mega, dim3(grid), dim3(NTHR), args, LDS_BYTES, stream);
    if (e != hipSuccess) fprintf(stderr, "cooperative launch failed: %s\n", hipGetErrorString(e));
#else
    for (int ph = 0; ph < NPHASE; ++ph) hipLaunchKernelGGL(mega, dim3(grid), dim3(NTHR), LDS_BYTES, stream, p, ph, ph + 1);
#endif
}
```

```cpp
#include <hip/hip_runtime.h>
#include <hip/hip_cooperative_groups.h>
#include <cstdio>
#include <cstdint>
namespace cg = cooperative_groups;

#ifndef ONE_LAUNCH
#define ONE_LAUNCH 1
#endif

#ifndef PHASE_MASK
#define PHASE_MASK 0xffffffffffull
#endif
#define EN(n) (((PHASE_MASK) >> (n)) & 1ull)
#ifndef PROBE_MASK
#define PROBE_MASK 0ull
#endif
#define LAS __attribute__((address_space(3)))
typedef unsigned short bf16_t;
typedef short bf16x8 __attribute__((ext_vector_type(8)));
typedef float f32x4 __attribute__((ext_vector_type(4)));
typedef float f32x2 __attribute__((ext_vector_type(2)));
typedef unsigned u32x2 __attribute__((ext_vector_type(2)));
typedef unsigned u32x4 __attribute__((ext_vector_type(4)));
__device__ __forceinline__ u32x4 mk4(unsigned a, unsigned b, unsigned c, unsigned d) { return (u32x4){a, b, c, d}; }
__device__ __forceinline__ u32x2 mk2(unsigned a, unsigned b) { return (u32x2){a, b}; }
__device__ __forceinline__ f32x2 mkf2(float a, float b) { return (f32x2){a, b}; }

constexpr int NTHR = 512;
constexpr int LDS_BYTES = 147456;
constexpr int NPHASE = 32;

struct Params { const float* in[26]; float* out; unsigned char* ws; };
typedef const __attribute__((address_space(4))) Params* CP;

constexpr size_t MiB = 1ull << 20;
constexpr size_t OFF_W1 = 0, SZ_W1 = 11 * MiB;
constexpr size_t OFF_W2 = 44 * MiB, SZ_W2 = 5 * MiB + MiB / 2;
constexpr size_t OFF_WIN0 = 66 * MiB;
constexpr size_t OFF_WGLU = 70 * MiB + MiB / 2;
constexpr size_t OFF_WOUT0 = 71 * MiB;
constexpr size_t OFF_WIN1 = 73 * MiB;
constexpr size_t OFF_WOUT1 = 85 * MiB;
constexpr size_t OFF_ROPE = 89 * MiB;
constexpr size_t OFF_KTAB = 93 * MiB;
constexpr size_t OFF_S5P = 97 * MiB;
constexpr size_t OFF_XN = 98 * MiB;
constexpr size_t OFF_R = 226 * MiB;
constexpr size_t OFF_ACT = OFF_R;
constexpr size_t OFF_PQ = OFF_R;
constexpr size_t OFF_AS5 = OFF_R + 224 * MiB;
constexpr size_t OFF_E = OFF_R + 304 * MiB;
constexpr size_t OFF_KG = OFF_R + 352 * MiB;
constexpr size_t OFF_H = OFF_R + 432 * MiB;
constexpr size_t OFF_GST = OFF_R + 448 * MiB;
constexpr size_t OFF_GDEC = OFF_R + 704 * MiB;
constexpr size_t OFF_GY = OFF_R + 706 * MiB;
constexpr size_t OFF_PROJ1 = OFF_R;
constexpr size_t OFF_RST = OFF_R + 384 * MiB;
constexpr size_t OFF_SSQ = 998 * MiB;
constexpr int SSN = 65536 * 16;
constexpr size_t OFF_XB2 = OFF_R + 448 * MiB;
constexpr size_t OFF_BAR = 1023 * MiB;
constexpr size_t OFF_OBUF = OFF_R + 640 * MiB;

__device__ __forceinline__ int otid() { int t = threadIdx.x; asm volatile("" : "+v"(t)); return t; }
__device__ __forceinline__ int obid() { int t = blockIdx.x; asm volatile("" : "+s"(t)); return t; }
__device__ __forceinline__ bf16_t f2bf(float f) { unsigned u = __float_as_uint(f); u += 0x7FFFu + ((u >> 16) & 1u); return (bf16_t)(u >> 16); }
__device__ __forceinline__ float bf2f(unsigned b) { return __uint_as_float(b << 16); }
typedef __bf16 bf16x2_t __attribute__((ext_vector_type(2)));
typedef float f32x2_t __attribute__((ext_vector_type(2)));
__device__ __forceinline__ unsigned pack2(float lo, float hi) { const f32x2_t v = {lo, hi}; const bf16x2_t b = __builtin_convertvector(v, bf16x2_t); return __builtin_bit_cast(unsigned, b); }
__device__ __forceinline__ float bflo(unsigned w) { return __uint_as_float(w << 16); }
__device__ __forceinline__ float bfhi(unsigned w) { return __uint_as_float(w & 0xffff0000u); }
__device__ __forceinline__ float fast_sigmoid(float x) { return __builtin_amdgcn_rcpf(1.0f + __expf(-x)); }
__device__ __forceinline__ float silu_f(float x) { return x * fast_sigmoid(x); }
__device__ __forceinline__ float gelu_tanh(float x) { const float u = 0.7978845608028654f * (x + 0.044715f * x * x * x); return x * fast_sigmoid(2.0f * u); }

namespace pg8 {
constexpr int BM = 256, BK = 64, HALF = 128, HTB = HALF * BK * 2, STAGE_BYTES = 8 * HTB, NXCD = 8, WGM = 8;
__device__ __forceinline__ int lds_byte(int r, int c) { const int st = (r >> 4) * 2 + (c >> 5), rr = r & 15, cc = c & 31, ob = rr * 64 + cc * 2; return st * 1024 + (ob ^ (((ob >> 9) & 1) << 5)); }
__device__ __forceinline__ void stage_rc(int b, int& R, int& C) { const int st = b / 1024, sb = b % 1024, swz = sb ^ (((sb >> 9) & 1) << 5); R = (st >> 1) * 16 + swz / 64; C = (st & 1) * 32 + (swz % 64) / 2; }

__device__ __forceinline__ int perm32(int rho) { const int n = rho >> 4, i = rho & 15; return 8 * (i >> 2) + 4 * n + (i & 3); }
struct Unit { int pm, pn, bz; };
struct Gemm { const bf16_t* A; const bf16_t* Bt; int lda, ldb, K, nM, nN, nB; size_t strideA, strideB; };

struct Sched {
    int nM, nN, nwg, total, G, c;
    __device__ void init(int nM_, int nN_, int nB_, int G_, int c_) { nM = nM_; nN = nN_; nwg = nM * nN; total = nwg * nB_; G = G_; c = c_; }
    __device__ bool next(int i, Unit& u) const {
        const long L = (long)i * G + c; if (L >= total) return false;
        u.bz = (int)(L / nwg); int wgid = (int)(L % nwg);
        { const int q = nwg / NXCD, r = nwg % NXCD, xcd = wgid % NXCD, off = wgid / NXCD; wgid = (xcd < r ? xcd * (q + 1) : r * (q + 1) + (xcd - r) * q) + off; }
        const int nig = WGM * nN, gid = wgid / nig, fm = gid * WGM, gsz = (nM - fm) < WGM ? (nM - fm) : WGM;
        u.pm = fm + ((wgid % nig) % gsz); u.pn = (wgid % nig) / gsz; return true;
    }
};

template <class Epi>
__device__ __forceinline__ void gemm_phase(LAS unsigned char* lds, const Gemm g, const Epi& E) {
    const int tid = otid(), wid = __builtin_amdgcn_readfirstlane(tid >> 6), lane = tid & 63, wr = wid >> 2, wc = wid & 3, fr = lane & 15, fq = lane >> 4;
    const int nt = g.K / BK;
    Sched S; S.init(g.nM, g.nN, g.nB, (int)gridDim.x, obid());
    unsigned voffA[2], voffB[2];
#pragma unroll
    for (int i = 0; i < 2; ++i) { int R, C; stage_rc(tid * 16 + i * 8192, R, C); const int Rb = Epi::PERM ? ((R & ~31) + perm32(R & 31)) : R;
        voffA[i] = (unsigned)(R * g.lda + C) * 2u; voffB[i] = (unsigned)(Rb * g.ldb + C) * 2u; }
    const size_t kstep = (size_t)(BK * 2);
    const size_t hstepA = (size_t)HALF * g.lda * 2, hstepB = (size_t)HALF * g.ldb * 2;
    const size_t tstepA = 2 * hstepA, tstepB = 2 * hstepB;
    const unsigned ldsw = (unsigned)wid * 1024u;
    const int aoff = lds_byte(wr * 64 + fr, fq * 8), boff = lds_byte(wc * 32 + fr, fq * 8);
#define PG8_SA(b, h) (((b) * 2 + (h)) * HTB)
#define PG8_SB(b, h) ((4 + (b) * 2 + (h)) * HTB)
#define PG8_STAGE(bufoff, gbase, voff) do { _Pragma("unroll") for (int _i = 0; _i < 2; ++_i) \
        __builtin_amdgcn_global_load_lds((const unsigned*)((const char*)(gbase) + (voff)[_i]), (LAS unsigned*)(lds + (bufoff) + ldsw + _i * 8192), 16, 0, 0); } while (0)
#define PG8_LDA(dst, b, h) do { _Pragma("unroll") for (int m = 0; m < 4; ++m) _Pragma("unroll") for (int k = 0; k < 2; ++k) dst[m][k] = *(const LAS bf16x8*)(lds + PG8_SA(b, h) + aoff + m * 2048 + k * 1024); } while (0)
#define PG8_LDB(dst, b, h) do { _Pragma("unroll") for (int n = 0; n < 2; ++n) _Pragma("unroll") for (int k = 0; k < 2; ++k) dst[n][k] = *(const LAS bf16x8*)(lds + PG8_SB(b, h) + boff + n * 2048 + k * 1024); } while (0)
#define PG8_MMA(ai, bj, At, Bt) do { __builtin_amdgcn_s_setprio(1); _Pragma("unroll") for (int m = 0; m < 4; ++m) _Pragma("unroll") for (int n = 0; n < 2; ++n) _Pragma("unroll") for (int k = 0; k < 2; ++k) \
        acc[ai][bj][m][n] = __builtin_amdgcn_mfma_f32_16x16x32_bf16(Bt[n][k], At[m][k], acc[ai][bj][m][n], 0, 0, 0); __builtin_amdgcn_s_setprio(0); } while (0)
#define PG8_WAIT_V(n) asm volatile("s_waitcnt vmcnt(" #n ")" ::: "memory")
#define PG8_WAIT_L(n) asm volatile("s_waitcnt lgkmcnt(" #n ")" ::: "memory")
#define PG8_BAR __builtin_amdgcn_s_barrier()
#define PG8_SCHED __builtin_amdgcn_sched_barrier(0)
    Unit cur, nxt; int ui = 0;
    if (!S.next(0, cur)) return;
    int tag0 = -1, tag1 = -1, tag2 = -1, tag3 = -1; LAS float* rstab = (LAS float*)(lds + STAGE_BYTES);
    if constexpr (Epi::RSTD) {
        { Unit t_; for (int i = 0; S.next(i, t_); ++i) { const int pm = t_.pm; if (pm == tag0 || pm == tag1 || pm == tag2 || pm == tag3) continue;
                if (tag0 < 0) tag0 = pm; else if (tag1 < 0) tag1 = pm; else if (tag2 < 0) tag2 = pm; else tag3 = pm; } }
#pragma unroll
        for (int sl = 0; sl < 2; ++sl) { const int slot = (tid >> 8) + 2 * sl; const int pm = slot == 0 ? tag0 : slot == 1 ? tag1 : slot == 2 ? tag2 : tag3;
            if (pm >= 0) { const f32x4* p = (const f32x4*)(E.SS + ((size_t)pm * 256 + (tid & 255)) * 16); const f32x4 a = p[0], b = p[1], c = p[2], d = p[3]; const f32x4 t = (a + b) + (c + d);
                rstab[slot * 256 + (tid & 255)] = rsqrtf(((t[0] + t[1]) + (t[2] + t[3])) * (1.0f / 1024.0f) + 1e-6f); } }
        __syncthreads();
    }
    f32x4 acc[2][2][4][2];
#pragma unroll
    for (int a = 0; a < 2; ++a)
#pragma unroll
        for (int b = 0; b < 2; ++b)
#pragma unroll
            for (int m = 0; m < 4; ++m)
#pragma unroll
                for (int n = 0; n < 2; ++n) acc[a][b][m][n] = (f32x4){0.f, 0.f, 0.f, 0.f};
    bf16x8 At[4][2], B0[2][2], B1[2][2];
    const char* cA = (const char*)g.A + (size_t)cur.bz * g.strideA * 2 + (size_t)cur.pm * tstepA;
    const char* cB = (const char*)g.Bt + (size_t)cur.bz * g.strideB * 2 + (size_t)cur.pn * tstepB;
    PG8_STAGE(PG8_SB(0, 0), cB, voffB); PG8_STAGE(PG8_SB(0, 1), cB + hstepB, voffB); PG8_STAGE(PG8_SA(0, 0), cA, voffA); PG8_STAGE(PG8_SA(0, 1), cA + hstepA, voffA);
    if (wr == 1) PG8_BAR;
    PG8_WAIT_V(2); PG8_BAR;
    PG8_STAGE(PG8_SB(1, 0), cB + kstep, voffB); PG8_STAGE(PG8_SA(1, 0), cA + kstep, voffA); PG8_STAGE(PG8_SB(1, 1), cB + hstepB + kstep, voffB);
    PG8_WAIT_V(6); PG8_BAR;
    for (;;) {
        const bool has_next = S.next(ui + 1, nxt);
        const char* nA = has_next ? (const char*)g.A + (size_t)nxt.bz * g.strideA * 2 + (size_t)nxt.pm * tstepA : cA;
        const char* nB = has_next ? (const char*)g.Bt + (size_t)nxt.bz * g.strideB * 2 + (size_t)nxt.pn * tstepB : cB;
        for (int t = 0; t < nt; t += 2) {
            const bool last = (t == nt - 2);
            const char* a1 = cA + (size_t)(t + 1) * kstep;
            const char* a2 = last ? nA : cA + (size_t)(t + 2) * kstep; const char* b2 = last ? nB : cB + (size_t)(t + 2) * kstep;
            const char* a3 = a2 + kstep; const char* b3 = b2 + kstep;
            PG8_LDB(B0, 0, 0); PG8_LDB(B1, 0, 1); PG8_SCHED; PG8_LDA(At, 0, 0); PG8_STAGE(PG8_SA(1, 1), a1 + hstepA, voffA);
            PG8_WAIT_V(8); PG8_WAIT_L(0); PG8_BAR; PG8_MMA(0, 0, At, B0); PG8_MMA(0, 1, At, B1); PG8_BAR; PG8_SCHED;
            PG8_LDA(At, 0, 1); PG8_STAGE(PG8_SB(0, 0), b2, voffB); PG8_STAGE(PG8_SB(0, 1), b2 + hstepB, voffB); PG8_STAGE(PG8_SA(0, 0), a2, voffA);
            PG8_WAIT_V(8); PG8_WAIT_L(0); PG8_BAR; PG8_MMA(1, 0, At, B0); PG8_MMA(1, 1, At, B1); PG8_BAR; PG8_SCHED;
            PG8_LDB(B0, 1, 0); PG8_LDB(B1, 1, 1); PG8_SCHED; PG8_LDA(At, 1, 0); PG8_STAGE(PG8_SA(0, 1), a2 + hstepA, voffA);
            PG8_WAIT_V(8); PG8_WAIT_L(0); PG8_BAR; PG8_MMA(0, 0, At, B0); PG8_MMA(0, 1, At, B1); PG8_BAR; PG8_SCHED;
            PG8_LDA(At, 1, 1); PG8_STAGE(PG8_SB(1, 0), b3, voffB); PG8_STAGE(PG8_SB(1, 1), b3 + hstepB, voffB); PG8_STAGE(PG8_SA(1, 0), a3, voffA);
            PG8_WAIT_V(8); PG8_WAIT_L(0); PG8_BAR; PG8_MMA(1, 0, At, B0); PG8_MMA(1, 1, At, B1); PG8_BAR; PG8_SCHED;
        }
        if (wr == 0) PG8_BAR;
        E(acc, cur, wr, wc, fr, fq, rstab + (cur.pm == tag1 ? 256 : cur.pm == tag2 ? 512 : cur.pm == tag3 ? 768 : 0));
        if (!has_next) break;
#pragma unroll
        for (int a = 0; a < 2; ++a)
#pragma unroll
            for (int b = 0; b < 2; ++b)
#pragma unroll
                for (int m = 0; m < 4; ++m)
#pragma unroll
                    for (int n = 0; n < 2; ++n) acc[a][b][m][n] = (f32x4){0.f, 0.f, 0.f, 0.f};
        cur = nxt; cA = nA; cB = nB; ++ui;
        if (wr == 1) PG8_BAR;
    }
    PG8_WAIT_V(0);
    PG8_BAR;
#undef PG8_SA
#undef PG8_SB
#undef PG8_STAGE
#undef PG8_LDA
#undef PG8_LDB
#undef PG8_MMA
#undef PG8_WAIT_V
#undef PG8_WAIT_L
#undef PG8_BAR
#undef PG8_SCHED
}
}
using pg8::Unit;
typedef const f32x4 (&AccRef)[2][2][4][2];

struct EpiSwiGLU {
    static constexpr bool PERM = true, RSTD = true;
    bf16_t* O; const float* SS;
    __device__ __forceinline__ void operator()(AccRef acc, const Unit& u, int wr, int wc, int fr, int fq, const LAS float* rsl) const {
        const int row0 = u.pm * 256 + wr * 64 + fr, col0 = u.pn * 128 + wc * 32 + 8 * fq;
#pragma unroll
        for (int ai = 0; ai < 2; ++ai)
#pragma unroll
            for (int m = 0; m < 4; ++m) { bf16_t* rowp = O + (size_t)(row0 + ai * 128 + m * 16) * 2816 + col0; uint4 w; const float rs = rsl[ai * 128 + wr * 64 + m * 16 + fr];
                { const f32x4 gt = rs * acc[ai][0][m][0], up = rs * acc[ai][1][m][0]; w.x = pack2(silu_f(gt[0]) * up[0], silu_f(gt[1]) * up[1]); w.y = pack2(silu_f(gt[2]) * up[2], silu_f(gt[3]) * up[3]); }
                { const f32x4 gt = rs * acc[ai][0][m][1], up = rs * acc[ai][1][m][1]; w.z = pack2(silu_f(gt[0]) * up[0], silu_f(gt[1]) * up[1]); w.w = pack2(silu_f(gt[2]) * up[2], silu_f(gt[3]) * up[3]); }
                *(uint4*)rowp = w; }
    }
};
template <bool STATS> struct EpiResid {
    static constexpr bool PERM = true, RSTD = false;
    const float* Xin; float* X; bf16_t* XB; float* SS; float alpha;
    __device__ __forceinline__ void operator()(AccRef acc, const Unit& u, int wr, int wc, int fr, int fq, const LAS float* rsl) const {
        const int row0 = u.pm * 256 + wr * 64 + fr, col0 = u.pn * 256 + wc * 32 + 8 * fq;
#pragma unroll
        for (int ai = 0; ai < 2; ++ai)
#pragma unroll
            for (int mp = 0; mp < 2; ++mp) {
                f32x4 xo[2][2][2];
#pragma unroll
                for (int mm = 0; mm < 2; ++mm)
#pragma unroll
                    for (int bj = 0; bj < 2; ++bj) { const size_t o = (size_t)(row0 + ai * 128 + (mp * 2 + mm) * 16) * 1024 + col0 + bj * 128; xo[mm][bj][0] = *(const f32x4*)(Xin + o); xo[mm][bj][1] = *(const f32x4*)(Xin + o + 4); }
#pragma unroll
                for (int mm = 0; mm < 2; ++mm) { const int m = mp * 2 + mm; const size_t ro = (size_t)(row0 + ai * 128 + m * 16) * 1024 + col0; float sq = 0.f;
#pragma unroll
                    for (int bj = 0; bj < 2; ++bj) { const size_t o = ro + bj * 128;
                        const f32x4 y0 = xo[mm][bj][0] + alpha * acc[ai][bj][m][0], y1 = xo[mm][bj][1] + alpha * acc[ai][bj][m][1]; *(f32x4*)(X + o) = y0; *(f32x4*)(X + o + 4) = y1;
                        if (STATS) { uint4 w; w.x = pack2(y0[0], y0[1]); w.y = pack2(y0[2], y0[3]); w.z = pack2(y1[0], y1[1]); w.w = pack2(y1[2], y1[3]); *(uint4*)(XB + o) = w;
                            sq += y0[0] * y0[0] + y0[1] * y0[1] + y0[2] * y0[2] + y0[3] * y0[3] + y1[0] * y1[0] + y1[1] * y1[1] + y1[2] * y1[2] + y1[3] * y1[3]; } }
                    if (STATS) { sq += __shfl_xor(sq, 16); sq += __shfl_xor(sq, 32); if (fq == 0) SS[(size_t)(row0 + ai * 128 + m * 16) * 16 + u.pn * 4 + wc] = sq; } } }
    }
};
struct EpiBf16 {
    static constexpr bool PERM = true, RSTD = true;
    bf16_t* O; int ldc; const float* SS;
    __device__ __forceinline__ void operator()(AccRef acc, const Unit& u, int wr, int wc, int fr, int fq, const LAS float* rsl) const {
        const int row0 = u.pm * 256 + wr * 64 + fr, col0 = u.pn * 256 + wc * 32 + 8 * fq;
#pragma unroll
        for (int ai = 0; ai < 2; ++ai)
#pragma unroll
            for (int m = 0; m < 4; ++m) { bf16_t* rowp = O + (size_t)(row0 + ai * 128 + m * 16) * ldc + col0; const float rs = rsl[ai * 128 + wr * 64 + m * 16 + fr];
#pragma unroll
                for (int bj = 0; bj < 2; ++bj) { const f32x4 v0 = rs * acc[ai][bj][m][0], v1 = rs * acc[ai][bj][m][1]; uint4 w; w.x = pack2(v0[0], v0[1]); w.y = pack2(v0[2], v0[3]); w.z = pack2(v1[0], v1[1]); w.w = pack2(v1[2], v1[3]);
                    *(uint4*)(rowp + bj * 128) = w; } }
    }
};
struct EpiRetIn {
    static constexpr bool PERM = true, RSTD = true;
    bf16_t* O; int ldc; const float* SS; const float* cs; const float* sn; int rowbase;
    __device__ __forceinline__ void operator()(AccRef acc, const Unit& u, int wr, int wc, int fr, int fq, const LAS float* rsl) const {
        const int row0 = u.pm * 256 + wr * 64 + fr, col0 = u.pn * 256 + wc * 32 + 8 * fq, f = 16 * wc + 4 * fq;
#pragma unroll
        for (int ai = 0; ai < 2; ++ai)
#pragma unroll
            for (int m = 0; m < 4; ++m) { const int r = row0 + ai * 128 + m * 16; bf16_t* rowp = O + (size_t)r * ldc + col0; const float rs = rsl[ai * 128 + wr * 64 + m * 16 + fr];
                f32x4 c4 = (f32x4){1.f, 1.f, 1.f, 1.f}, s4 = (f32x4){0.f, 0.f, 0.f, 0.f};
                if (u.pn < 8) { const int pos = (rowbase + r) & 8191; c4 = *(const f32x4*)(cs + pos * 64 + f); s4 = *(const f32x4*)(sn + pos * 64 + f);
                    if (u.pn >= 4) { c4 *= 0.08838834764831845f; s4 *= 0.08838834764831845f; } }
#pragma unroll
                for (int bj = 0; bj < 2; ++bj) { const f32x4 t1 = rs * acc[ai][bj][m][0], t2 = rs * acc[ai][bj][m][1]; const f32x4 v0 = t1 * c4 - t2 * s4, v1 = t1 * s4 + t2 * c4;
                    uint4 w; w.x = pack2(v0[0], v0[1]); w.y = pack2(v0[2], v0[3]); w.z = pack2(v1[0], v1[1]); w.w = pack2(v1[2], v1[3]);
                    *(uint4*)(rowp + bj * 128) = w; } }
    }
};
struct EpiWin0 {
    static constexpr bool PERM = true, RSTD = true;
    bf16_t* AS5; bf16_t* PQ; const float* SS;
    __device__ __forceinline__ void operator()(AccRef acc, const Unit& u, int wr, int wc, int fr, int fq, const LAS float* rsl) const {
        const int row0 = u.pm * 256 + wr * 64 + fr, col0 = u.pn * 256 + wc * 32 + 8 * fq;
#pragma unroll
        for (int ai = 0; ai < 2; ++ai)
#pragma unroll
            for (int m = 0; m < 4; ++m) { const int r = row0 + ai * 128 + m * 16; const float rs = rsl[ai * 128 + wr * 64 + m * 16 + fr];
#pragma unroll
                for (int bj = 0; bj < 2; ++bj) { const int c = col0 + bj * 128; const f32x4 v0 = rs * acc[ai][bj][m][0], v1 = rs * acc[ai][bj][m][1];
                    uint4 w; w.x = pack2(v0[0], v0[1]); w.y = pack2(v0[2], v0[3]); w.z = pack2(v1[0], v1[1]); w.w = pack2(v1[2], v1[3]);
                    if (u.pn < 2) *(uint4*)(AS5 + ((size_t)((c >> 4) * 1024 + (r >> 6))) * 1280 + (r & 63) * 16 + (c & 15)) = w;
                    else *(uint4*)(PQ + (size_t)r * 1792 + (c - 512)) = w; } }
    }
};
struct EpiGLU {
    static constexpr bool PERM = true, RSTD = false;
    const bf16_t* GY; bf16_t* MIX;
    __device__ __forceinline__ void operator()(AccRef acc, const Unit& u, int wr, int wc, int fr, int fq, const LAS float* rsl) const {
        const int row0 = u.pm * 256 + wr * 64 + fr, col0 = u.pn * 256 + wc * 32 + 8 * fq;
#pragma unroll
        for (int ai = 0; ai < 2; ++ai)
#pragma unroll
            for (int m = 0; m < 4; ++m) { const int r = row0 + ai * 128 + m * 16;
#pragma unroll
                for (int bj = 0; bj < 2; ++bj) { const int c = col0 + bj * 128; const f32x4 v0 = acc[ai][bj][m][0], v1 = acc[ai][bj][m][1];
                    const uint4 gy = *(const uint4*)(GY + (size_t)r * 512 + c); uint4 w;
                    w.x = pack2(bflo(gy.x) * fast_sigmoid(v0[0]), bfhi(gy.x) * fast_sigmoid(v0[1])); w.y = pack2(bflo(gy.y) * fast_sigmoid(v0[2]), bfhi(gy.y) * fast_sigmoid(v0[3]));
                    w.z = pack2(bflo(gy.z) * fast_sigmoid(v1[0]), bfhi(gy.z) * fast_sigmoid(v1[1])); w.w = pack2(bflo(gy.w) * fast_sigmoid(v1[2]), bfhi(gy.w) * fast_sigmoid(v1[3]));
                    *(uint4*)(MIX + (size_t)r * 1024 + c) = w; } }
    }
};
struct EpiS5E {
    static constexpr bool PERM = false, RSTD = false;
    float* E;
    __device__ __forceinline__ void operator()(AccRef acc, const Unit& u, int wr, int wc, int fr, int fq, const LAS float* rsl) const {
        const int row0 = u.pm * 256 + wr * 64 + fr, col0 = wc * 32 + 4 * fq;
#pragma unroll
        for (int ai = 0; ai < 2; ++ai)
#pragma unroll
            for (int m = 0; m < 4; ++m) { float* rowp = E + ((size_t)u.bz * 1024 + row0 + ai * 128 + m * 16) * 256 + col0;
#pragma unroll
                for (int bj = 0; bj < 2; ++bj)
#pragma unroll
                    for (int n = 0; n < 2; ++n) *(f32x4*)(rowp + bj * 128 + n * 16) = acc[ai][bj][m][n]; }
    }
};
struct EpiS5Y {
    static constexpr bool PERM = true, RSTD = false;
    bf16_t* GY;
    __device__ __forceinline__ void operator()(AccRef acc, const Unit& u, int wr, int wc, int fr, int fq, const LAS float* rsl) const {
        const int row0 = u.pm * 256 + wr * 64 + fr, col0 = u.pn * 256 + wc * 32 + 8 * fq;
#pragma unroll
        for (int ai = 0; ai < 2; ++ai)
#pragma unroll
            for (int m = 0; m < 4; ++m) { const int bc = row0 + ai * 128 + m * 16;
#pragma unroll
                for (int bj = 0; bj < 2; ++bj) { const int c = col0 + bj * 128; const f32x4 v0 = acc[ai][bj][m][0], v1 = acc[ai][bj][m][1]; uint4 w;
                    w.x = pack2(gelu_tanh(v0[0]), gelu_tanh(v0[1])); w.y = pack2(gelu_tanh(v0[2]), gelu_tanh(v0[3])); w.z = pack2(gelu_tanh(v1[0]), gelu_tanh(v1[1])); w.w = pack2(gelu_tanh(v1[2]), gelu_tanh(v1[3]));
                    *(uint4*)(GY + ((size_t)bc * 64 + (c >> 4)) * 512 + u.bz * 16 + (c & 15)) = w; } }
    }
};

__device__ void transpose_job(const float* __restrict__ src, int K, int Nsrc, bf16_t* __restrict__ dst, int Ndst, int mode, LAS float* tile, int b0, int nb, const float* __restrict__ gain) {
    const int tid = otid();
    const int ntk = K >> 8, nt = (Ndst >> 6) * ntk;
    for (int t = obid() - b0; t < nt; t += nb) {
        const int tn = t / ntk, tk = t % ntk, n0 = tn * 64, k0 = tk * 256;
        int ns0 = n0;
        if (mode == 1) { const int tt = n0 >> 8, j = n0 & 255; ns0 = (j < 128) ? (tt * 128 + j) : (2816 + tt * 128 + (j - 128)); }
        const int r = tid >> 4; int c4 = (tid & 15) * 4;
        const int c4d = c4;
        if (mode == 2 && n0 < 2048) { const int s_ = (n0 + c4) & 127;
            c4 = ((n0 + c4) & ~127) + 64 * ((s_ >> 2) & 1) + 16 * (s_ >> 5) + 4 * ((s_ >> 3) & 3) - n0; }
        float4 v[8];
#pragma unroll
        for (int rr = 0; rr < 8; ++rr) { v[rr] = make_float4(0.f, 0.f, 0.f, 0.f);
            if (ns0 + c4 + 3 < Nsrc) v[rr] = *(const float4*)(src + (size_t)(k0 + r + rr * 32) * Nsrc + ns0 + c4);
            if (gain) { const float gk = gain[k0 + r + rr * 32]; v[rr].x *= gk; v[rr].y *= gk; v[rr].z *= gk; v[rr].w *= gk; } }
#pragma unroll
        for (int rr = 0; rr < 8; ++rr) { const int kk = r + rr * 32; LAS float* tp = tile + (kk >> 6) * (64 * 65) + (kk & 63) * 65 + c4d;
            tp[0] = v[rr].x; tp[1] = v[rr].y; tp[2] = v[rr].z; tp[3] = v[rr].w; }
        __syncthreads();
        const int n = tid >> 3, kq = (tid & 7) * 8;
#pragma unroll
        for (int kt = 0; kt < 4; ++kt) { const LAS float* tp = tile + kt * (64 * 65); uint4 w;
            w.x = pack2(tp[(kq + 0) * 65 + n], tp[(kq + 1) * 65 + n]); w.y = pack2(tp[(kq + 2) * 65 + n], tp[(kq + 3) * 65 + n]);
            w.z = pack2(tp[(kq + 4) * 65 + n], tp[(kq + 5) * 65 + n]); w.w = pack2(tp[(kq + 6) * 65 + n], tp[(kq + 7) * 65 + n]);
            *(uint4*)(dst + (size_t)(n0 + n) * K + k0 + kt * 64 + kq) = w; }
        __syncthreads();
    }
}

__device__ void s5_pre(CP P, int g, int dir, int part, LAS unsigned char* lds) {
    LAS f32x2* pw = (LAS f32x2*)lds;
    LAS f32x2* Bb = pw + 65 * 64;
    LAS f32x2* Cc = Bb + 64 * 16;
    const int tid = otid();
    float* Ktab = (float*)(P->ws + OFF_KTAB); float* AT = (float*)(P->ws + OFF_S5P);
    bf16_t* KG = (bf16_t*)(P->ws + OFF_KG); bf16_t* H = (bf16_t*)(P->ws + OFF_H);
    if (tid < 64) { const int n = tid, gi = (dir * 32 + g) * 64 + n;
        const double lr = fmin((double)P->in[9][gi], -1e-4), li = (double)P->in[10][gi], dt = (double)expf(P->in[15][dir * 32 + g]);
        const double em1 = (double)expm1f((float)(lr * dt)), mag = 1.0 + em1;
        double rev = li * dt * 0.15915494309189535; rev -= rint(rev); const float th = (float)(rev * 6.283185307179586), thh = 0.5f * th;
        const double sn_ = (double)sinf(th), shalf = (double)sinf(thh), cm1 = -2.0 * shalf * shalf;
        const double ar = mag * (1.0 + cm1), ai = mag * sn_, arm1 = em1 + cm1 + em1 * cm1, den = lr * lr + li * li;
        const double cr = (arm1 * lr + ai * li) / den, ci = (ai * lr - arm1 * li) / den;
#pragma unroll 1
        for (int p = 0; p < 16; ++p) { const double br = (double)P->in[11][gi * 16 + p], bi = (double)P->in[12][gi * 16 + p];
            Bb[n * 16 + p] = mkf2((float)(cr * br - ci * bi), (float)(cr * bi + ci * br)); }
        double xr = 1.0, xi = 0.0;
#pragma unroll 1
        for (int d = 0; d <= 64; ++d) { pw[d * 64 + n] = mkf2((float)xr, (float)xi); const double t0 = xr * ar - xi * ai; xi = xr * ai + xi * ar; xr = t0; }
        const f32x2 a64 = pw[64 * 64 + n];
        if (part == 0) { AT[((g * 2 + dir) * 64 + n) * 2 + 0] = a64.x; AT[((g * 2 + dir) * 64 + n) * 2 + 1] = a64.y; } }
#pragma unroll 1
    for (int idx = tid; idx < 16 * 64; idx += NTHR) { const int p = idx >> 6, n = idx & 63; const int ci_ = ((dir * 32 + g) * 16 + p) * 64 + n;
        Cc[idx] = mkf2(P->in[13][ci_], P->in[14][ci_]); }
    __syncthreads();
    { const int dq = tid >> 8, p = (tid >> 4) & 15, pp = tid & 15;
#pragma unroll 1
        for (int dd = 0; dd < 16; ++dd) { const int d = part * 32 + dq * 16 + dd; float acc = 0.f;
#pragma unroll 4
            for (int n = 0; n < 64; ++n) { const f32x2 w = pw[d * 64 + n], bb = Bb[n * 16 + pp], c = Cc[p * 64 + n];
                const float zr = w.x * bb.x - w.y * bb.y, zi = w.x * bb.y + w.y * bb.x; acc += c.x * zr - c.y * zi; }
            Ktab[((size_t)((g * 2 + dir) * 64 + d)) * 256 + p * 16 + pp] = acc; } }
#pragma unroll 1
    for (int idx = tid; idx < 512 * 64; idx += NTHR) { const int row = part * 512 + (idx >> 6), n = idx & 63, t = row >> 4, p = row & 15, d = dir == 0 ? t + 1 : 64 - t;
        const f32x2 w = pw[d * 64 + n], c = Cc[p * 64 + n]; const float gr = c.x * w.x - c.y * w.y, gi = c.x * w.y + c.y * w.x;
        *(unsigned*)(KG + ((size_t)(g * 1024 + row)) * 1280 + 1024 + dir * 128 + n * 2) = pack2(gr, -gi); }
#pragma unroll 1
    for (int idx = tid; idx < 32 * 64 * 8; idx += NTHR) { const int pp2 = (idx & 7) * 2, s = (idx >> 3) & 63, n = part * 32 + (idx >> 9), d = dir == 0 ? 63 - s : s;
        const f32x2 w = pw[d * 64 + n], b0 = Bb[n * 16 + pp2], b1 = Bb[n * 16 + pp2 + 1];
        const float hr0 = w.x * b0.x - w.y * b0.y, hi0 = w.x * b0.y + w.y * b0.x, hr1 = w.x * b1.x - w.y * b1.y, hi1 = w.x * b1.y + w.y * b1.x;
        const size_t row0 = (size_t)g * 256 + dir * 128 + n * 2;
        *(unsigned*)(H + row0 * 1024 + s * 16 + pp2) = pack2(hr0, hr1); *(unsigned*)(H + (row0 + 1) * 1024 + s * 16 + pp2) = pack2(hi0, hi1); }
    __syncthreads();
}

template <bool FINAL> __device__ void phase_norm(const float* __restrict__ x, const float* __restrict__ g, bf16_t* __restrict__ xb, float* __restrict__ ss_out, float* __restrict__ outf, int b0, int nb, int rbeg, int rend);
__device__ void phase_prologue(CP P, LAS unsigned char* lds) {
    const int tid = otid(), bq = obid();
    if (bq < 128) { if (EN(20)) s5_pre(P, bq >> 2, (bq >> 1) & 1, bq & 1, lds);
        phase_norm<false>(P->in[0], nullptr, (bf16_t*)(P->ws + OFF_XN), (float*)(P->ws + OFF_SSQ), nullptr, 0, 128, 0, 40960); return; }
    const int b0 = 128, nb = (int)gridDim.x - 128;
    if (EN(21)) { float* cs = (float*)(P->ws + OFF_ROPE); float* sn = cs + 8192 * 64;
        for (int idx = (bq - b0) * NTHR + tid; idx < 8192 * 64; idx += nb * NTHR) { const int pos = idx >> 6, f = idx & 63;
            const float inv = expf(-9.210340371976184f * (float)f * (1.0f / 64.0f)); const float ang = (float)pos * inv;
            cs[idx] = cosf(ang); sn[idx] = sinf(ang); } }
    phase_norm<false>(P->in[0], nullptr, (bf16_t*)(P->ws + OFF_XN), (float*)(P->ws + OFF_SSQ), nullptr, b0, nb, 40960, 65536);
    LAS float* tile = (LAS float*)lds;
    if (EN(22)) for (int l = 0; l < 2; ++l) {
        transpose_job(P->in[2] + (size_t)l * 1024 * 5632, 1024, 5632, (bf16_t*)(P->ws + OFF_W1 + (size_t)(2 * l) * SZ_W1), 5632, 1, tile, b0, nb, P->in[1] + l * 1024);
        transpose_job(P->in[6] + (size_t)l * 1024 * 5632, 1024, 5632, (bf16_t*)(P->ws + OFF_W1 + (size_t)(2 * l + 1) * SZ_W1), 5632, 1, tile, b0, nb, P->in[5] + l * 1024);
        transpose_job(P->in[3] + (size_t)l * 2816 * 1024, 2816, 1024, (bf16_t*)(P->ws + OFF_W2 + (size_t)(2 * l) * SZ_W2), 1024, 0, tile, b0, nb, nullptr);
        transpose_job(P->in[7] + (size_t)l * 2816 * 1024, 2816, 1024, (bf16_t*)(P->ws + OFF_W2 + (size_t)(2 * l + 1) * SZ_W2), 1024, 0, tile, b0, nb, nullptr);
    }
    if (EN(22)) transpose_job(P->in[8], 1024, 2080, (bf16_t*)(P->ws + OFF_WIN0), 2304, 0, tile, b0, nb, P->in[4]);
    if (EN(22)) transpose_job(P->in[17], 512, 512, (bf16_t*)(P->ws + OFF_WGLU), 512, 0, tile, b0, nb, nullptr);
    if (EN(22)) transpose_job(P->in[21], 1024, 1024, (bf16_t*)(P->ws + OFF_WOUT0), 1024, 0, tile, b0, nb, nullptr);
    if (EN(22)) transpose_job(P->in[22], 1024, 6144, (bf16_t*)(P->ws + OFF_WIN1), 6144, 2, tile, b0, nb, P->in[4] + 1024);
    if (EN(22)) transpose_job(P->in[24], 2048, 1024, (bf16_t*)(P->ws + OFF_WOUT1), 1024, 0, tile, b0, nb, nullptr);
}

__device__ void phase_kmat(CP P) {
    const float* Ktab = (const float*)(P->ws + OFF_KTAB); bf16_t* KG = (bf16_t*)(P->ws + OFF_KG); const float* dsk = P->in[16];
    for (int idx = obid() * NTHR + otid(); idx < 32 * 1024 * 512; idx += gridDim.x * NTHR) {
        const int kp = idx & 511, row = (idx >> 9) & 1023, g = idx >> 19, t = row >> 4, p = row & 15, k = kp * 2, s = k >> 4, pp = k & 15;
        float v0 = 0.f, v1 = 0.f;
        if (s <= t) { const float* b = Ktab + ((size_t)((g * 2 + 0) * 64 + (t - s))) * 256 + p * 16 + pp; v0 += b[0]; v1 += b[1]; }
        if (s >= t) { const float* b = Ktab + ((size_t)((g * 2 + 1) * 64 + (s - t))) * 256 + p * 16 + pp; v0 += b[0]; v1 += b[1]; }
        if (s == t) { const float dv = dsk[g * 16 + p]; if (pp == p) v0 += dv; if (pp + 1 == p) v1 += dv; }
        *(unsigned*)(KG + ((size_t)(g * 1024 + row)) * 1280 + k) = pack2(v0, v1);
    }
}

template <bool FINAL>
__device__ void phase_norm(const float* __restrict__ x, const float* __restrict__ g, bf16_t* __restrict__ xb, float* __restrict__ ss_out, float* __restrict__ outf, int b0, int nb, int rbeg, int rend) {
    const int tid_ = otid(), lane = tid_ & 63, wid = tid_ >> 6; const int bq = obid() - b0;
    if (bq < 0) return;
    f32x4 gv[4];
#pragma unroll
    for (int i = 0; i < 4; ++i) gv[i] = FINAL ? *(const f32x4*)(g + (lane + 64 * i) * 4) : (f32x4){1.f, 1.f, 1.f, 1.f};
    for (int row0 = rbeg + bq * 8 + wid; row0 < rend; row0 += nb * 16) {
        const int row1 = row0 + nb * 8; const bool has1 = row1 < rend;
        const float* xr0 = x + (size_t)row0 * 1024; const float* xr1 = x + (size_t)(has1 ? row1 : row0) * 1024; f32x4 v[4], u[4]; float ss = 0.f, st = 0.f;
#pragma unroll
        for (int i = 0; i < 4; ++i) { v[i] = *(const f32x4*)(xr0 + (lane + 64 * i) * 4); u[i] = *(const f32x4*)(xr1 + (lane + 64 * i) * 4); }
#pragma unroll
        for (int i = 0; i < 4; ++i) { ss += v[i][0] * v[i][0] + v[i][1] * v[i][1] + v[i][2] * v[i][2] + v[i][3] * v[i][3]; st += u[i][0] * u[i][0] + u[i][1] * u[i][1] + u[i][2] * u[i][2] + u[i][3] * u[i][3]; }
#pragma unroll
        for (int o = 32; o > 0; o >>= 1) { ss += __shfl_xor(ss, o); st += __shfl_xor(st, o); }
#pragma unroll
        for (int rr = 0; rr < 2; ++rr) { if (rr == 1 && !has1) break; const int row = rr ? row1 : row0; const float sv = rr ? st : ss;
            if (FINAL) { const float rstd = rsqrtf(sv * (1.0f / 1024.0f) + 1e-6f);
#pragma unroll
                for (int i = 0; i < 4; ++i) *(f32x4*)(outf + (size_t)row * 1024 + (lane + 64 * i) * 4) = (rr ? u[i] : v[i]) * rstd * gv[i]; }
            else { if (lane < 16) ss_out[(size_t)row * 16 + lane] = lane == 0 ? sv : 0.f;
#pragma unroll
                for (int i = 0; i < 4; ++i) { const f32x4 y = rr ? u[i] : v[i]; uint2 w; w.x = pack2(y[0], y[1]); w.y = pack2(y[2], y[3]); *(uint2*)(xb + (size_t)row * 1024 + (lane + 64 * i) * 4) = w; } } }
    }
}

__device__ __forceinline__ f32x4 mma16(const LAS bf16_t* As, int lda, const LAS bf16_t* Bs, int ldb, int K, f32x4 acc, int lane) {
    const int r = lane & 15, q = lane >> 4;
#pragma unroll
    for (int k = 0; k < K; k += 32) { const bf16x8 a = *(const LAS bf16x8*)(As + r * lda + k + q * 8); const bf16x8 b = *(const LAS bf16x8*)(Bs + r * ldb + k + q * 8);
        acc = __builtin_amdgcn_mfma_f32_16x16x32_bf16(b, a, acc, 0, 0, 0); }
    return acc;
}


typedef short s16x4 __attribute__((ext_vector_type(4)));
__device__ __forceinline__ bf16x8 frag_tr(const LAS bf16_t* T, int ld, int lane) {
    const int g = lane >> 4, qq = (lane & 15) >> 2, p = lane & 3;
    LAS bf16_t* a = (LAS bf16_t*)T + (8 * g + qq) * ld + 4 * p;
    const s16x4 lo = __builtin_amdgcn_ds_read_tr16_b64_v4i16((LAS s16x4*)a);
    const s16x4 hi = __builtin_amdgcn_ds_read_tr16_b64_v4i16((LAS s16x4*)(a + 4 * ld));
    return (bf16x8){lo[0], lo[1], lo[2], lo[3], hi[0], hi[1], hi[2], hi[3]};
}

__device__ __forceinline__ void lds_barrier() { asm volatile("s_waitcnt lgkmcnt(0)" ::: "memory"); __builtin_amdgcn_s_barrier(); asm volatile("" ::: "memory"); }

__device__ void phase_s5_scan(CP P) {
    const float* E = (const float*)(P->ws + OFF_E); const float* AT = (const float*)(P->ws + OFF_S5P); bf16_t* AS5 = (bf16_t*)(P->ws + OFF_AS5);
    const int tid_ = otid(); if (tid_ >= 128) return;
    for (int idx = obid() * 128 + tid_; idx < 32 * 8 * 2 * 64; idx += gridDim.x * 128) {
        const int n = idx & 63, dir = (idx >> 6) & 1, b = (idx >> 7) & 7, g = idx >> 10;
        const float ar = AT[((g * 2 + dir) * 64 + n) * 2], ai = AT[((g * 2 + dir) * 64 + n) * 2 + 1];
        float xr = 0.f, xi = 0.f;
#pragma unroll 1
        for (int c0 = 0; c0 < 128; c0 += 16) { float2 ev[16];
#pragma unroll
            for (int k = 0; k < 16; ++k) { const int c = dir == 0 ? c0 + k : 127 - (c0 + k); const size_t bc = (size_t)g * 1024 + b * 128 + c; ev[k] = *(const float2*)(E + bc * 256 + dir * 128 + n * 2); }
#pragma unroll
            for (int k = 0; k < 16; ++k) { const int c = dir == 0 ? c0 + k : 127 - (c0 + k); const size_t bc = (size_t)g * 1024 + b * 128 + c;
                *(unsigned*)(AS5 + bc * 1280 + 1024 + dir * 128 + n * 2) = pack2(xr, xi);
                const float t0 = ar * xr - ai * xi + ev[k].x; xi = ar * xi + ai * xr + ev[k].y; xr = t0; } }
    }
}

__device__ __forceinline__ void gla_gates(CP P, const bf16_t* PQ, int m0, int h, LAS unsigned char* lds) {
    LAS float* gl = (LAS float*)lds; LAS float* tot = (LAS float*)(lds + 8192); LAS float* G = (LAS float*)(lds + 17408);
    const int tid = otid();
    const int dir = tid >> 8, d = tid & 63, tq = (tid >> 6) & 3;
    { const int idx = tid * 4, t = idx >> 5, r = idx & 31; const uint2 raw = *(const uint2*)(PQ + (size_t)(m0 + t) * 1792 + 1536 + r);
        *(LAS f32x4*)(gl + idx) = (f32x4){bflo(raw.x), bfhi(raw.x), bflo(raw.y), bfhi(raw.y)}; }
    float w[16];
#pragma unroll
    for (int r = 0; r < 16; ++r) w[r] = P->in[18][(dir * 16 + r) * 256 + h * 64 + d];
    const float b = P->in[19][dir * 256 + h * 64 + d];
    lds_barrier();
    float c[16];
#pragma unroll
    for (int i = 0; i < 16; ++i) { const int t = tq * 16 + i; float z = b;
#pragma unroll
        for (int r4 = 0; r4 < 4; ++r4) { const f32x4 g4 = *(const LAS f32x4*)(gl + t * 32 + dir * 16 + r4 * 4);
            z += g4[0] * w[r4 * 4] + g4[1] * w[r4 * 4 + 1] + g4[2] * w[r4 * 4 + 2] + g4[3] * w[r4 * 4 + 3]; }
        c[i] = (fminf(z, 0.f) - __logf(1.0f + __expf(-fabsf(z)))) * (1.0f / 16.0f); }
    if (dir == 0) {
#pragma unroll
        for (int i = 1; i < 16; ++i) c[i] += c[i - 1];
        tot[(dir * 4 + tq) * 64 + d] = c[15]; }
    else {
#pragma unroll
        for (int i = 14; i >= 0; --i) c[i] += c[i + 1];
        tot[(dir * 4 + tq) * 64 + d] = c[0]; }
    lds_barrier();
    float off = 0.f;
#pragma unroll
    for (int q = 0; q < 4; ++q) { const float tv = tot[(dir * 4 + q) * 64 + d]; off += ((dir == 0) ? (q < tq) : (q > tq)) ? tv : 0.f; }
#pragma unroll
    for (int i = 0; i < 16; ++i) G[(dir * 64 + tq * 16 + i) * 64 + d] = c[i] + off;
    lds_barrier();
}

__device__ void gla_a_unit(CP P, int unit, LAS unsigned char* lds) {
    const int c = unit & 127, h = (unit >> 7) & 3, b = unit >> 9, m0 = b * 8192 + c * 64;
    const bf16_t* PQ = (const bf16_t*)(P->ws + OFF_PQ); bf16_t* GST = (bf16_t*)(P->ws + OFF_GST); float* GDEC = (float*)(P->ws + OFF_GDEC);
    const int tid = otid(), lane = tid & 63, wid = tid >> 6;
    const int t = tid >> 3, d8 = (tid & 7) * 8, v16 = (tid & 7) * 16;
    const uint4 kraw = *(const uint4*)(PQ + (size_t)(m0 + t) * 1792 + 256 + h * 64 + d8);
    const uint4 vr0 = *(const uint4*)(PQ + (size_t)(m0 + t) * 1792 + 512 + h * 128 + v16), vr1 = *(const uint4*)(PQ + (size_t)(m0 + t) * 1792 + 512 + h * 128 + v16 + 8);
    gla_gates(P, PQ, m0, h, lds);
    LAS float* G = (LAS float*)(lds + 17408);
    LAS bf16_t* kA = (LAS bf16_t*)(lds + 50176);
    LAS bf16_t* Vs = (LAS bf16_t*)(lds + 67584);
    { const unsigned rw[4] = {kraw.x, kraw.y, kraw.z, kraw.w}; float ef[8], eb[8];
#pragma unroll
        for (int q = 0; q < 2; ++q) { const f32x4 lf = *(const LAS f32x4*)(G + 63 * 64 + d8 + q * 4), cf = *(const LAS f32x4*)(G + t * 64 + d8 + q * 4);
            const f32x4 lb = *(const LAS f32x4*)(G + 64 * 64 + d8 + q * 4), cb = *(const LAS f32x4*)(G + (64 + t) * 64 + d8 + q * 4);
#pragma unroll
            for (int j = 0; j < 4; ++j) { ef[q * 4 + j] = __expf(lf[j] - cf[j]); eb[q * 4 + j] = __expf(lb[j] - cb[j]); } }
        unsigned of[4], ob[4];
#pragma unroll
        for (int i = 0; i < 4; ++i) { const float k0 = bflo(rw[i]), k1 = bfhi(rw[i]); of[i] = pack2(k0 * ef[2 * i], k1 * ef[2 * i + 1]); ob[i] = pack2(k0 * eb[2 * i], k1 * eb[2 * i + 1]); }
        *(LAS u32x4*)(kA + t * 136 + d8) = mk4(of[0], of[1], of[2], of[3]); *(LAS u32x4*)(kA + t * 136 + 64 + d8) = mk4(ob[0], ob[1], ob[2], ob[3]);
        *(LAS u32x4*)(Vs + t * 136 + v16) = mk4(vr0.x, vr0.y, vr0.z, vr0.w); *(LAS u32x4*)(Vs + t * 136 + v16 + 8) = mk4(vr1.x, vr1.y, vr1.z, vr1.w); }
    if (tid < 128) { const int dir = tid >> 6, d = tid & 63; const float last = dir == 0 ? G[63 * 64 + d] : G[64 * 64 + d];
        GDEC[((size_t)(((b * 4 + h) * 2 + dir) * 128 + c)) * 64 + d] = __expf(last); }
    lds_barrier();
    { f32x4 acc[8];
#pragma unroll
        for (int nt = 0; nt < 8; ++nt) acc[nt] = (f32x4){0.f, 0.f, 0.f, 0.f};
#pragma unroll
        for (int ks = 0; ks < 2; ++ks) { const bf16x8 af = frag_tr(kA + ks * 32 * 136 + wid * 16, 136, lane);
#pragma unroll
            for (int nt = 0; nt < 8; ++nt) { const bf16x8 bfr = frag_tr(Vs + ks * 32 * 136 + nt * 16, 136, lane); acc[nt] = __builtin_amdgcn_mfma_f32_16x16x32_bf16(bfr, af, acc[nt], 0, 0, 0); } }
        const int row = wid * 16 + (lane & 15), dir = row >> 6, d = row & 63; bf16_t* out = GST + ((size_t)(((b * 4 + h) * 2 + dir) * 128 + c)) * 8192 + d * 128 + 4 * (lane >> 4);
#pragma unroll
        for (int nt = 0; nt < 8; ++nt) { uint2 w; w.x = pack2(acc[nt][0], acc[nt][1]); w.y = pack2(acc[nt][2], acc[nt][3]); *(uint2*)(out + nt * 16) = w; } }
    lds_barrier();
}

__device__ void phase_gla_b(CP P) {
    bf16_t* GST = (bf16_t*)(P->ws + OFF_GST); const float* GDEC = (const float*)(P->ws + OFF_GDEC);
    for (int idx = obid() * NTHR + otid(); idx < 64 * 1024; idx += gridDim.x * NTHR) {
        const int bhd = idx >> 10, e = (idx & 1023) * 8, d = e >> 7, dir = bhd & 1;
        f32x4 S0 = (f32x4){0.f, 0.f, 0.f, 0.f}, S1 = S0;
        bf16_t* base = GST + ((size_t)bhd * 128) * 8192 + e; const float* dbase = GDEC + ((size_t)bhd * 128) * 64 + d;
#pragma unroll 1
        for (int c0 = 0; c0 < 128; c0 += 8) { uint4 t[8]; float dc[8];
#pragma unroll
            for (int k = 0; k < 8; ++k) { const int c = dir == 0 ? c0 + k : 127 - (c0 + k); t[k] = *(const uint4*)(base + (size_t)c * 8192); dc[k] = dbase[(size_t)c * 64]; }
#pragma unroll
            for (int k = 0; k < 8; ++k) { const int c = dir == 0 ? c0 + k : 127 - (c0 + k);
                uint4 o; o.x = pack2(S0[0], S0[1]); o.y = pack2(S0[2], S0[3]); o.z = pack2(S1[0], S1[1]); o.w = pack2(S1[2], S1[3]); *(uint4*)(base + (size_t)c * 8192) = o;
                S0 = dc[k] * S0 + (f32x4){bflo(t[k].x), bfhi(t[k].x), bflo(t[k].y), bfhi(t[k].y)}; S1 = dc[k] * S1 + (f32x4){bflo(t[k].z), bfhi(t[k].z), bflo(t[k].w), bfhi(t[k].w)}; } }
    }
}

__device__ void gla_c_unit(CP P, int unit, LAS unsigned char* lds) {
    const int c = unit & 127, h = (unit >> 7) & 3, b = unit >> 9, m0 = b * 8192 + c * 64;
    const bf16_t* PQ = (const bf16_t*)(P->ws + OFF_PQ); const bf16_t* GST = (const bf16_t*)(P->ws + OFF_GST); bf16_t* MIX = (bf16_t*)(P->ws + OFF_XN);
    const int tid = otid(), lane = tid & 63, wid = tid >> 6;
    const int t = tid >> 3, d8 = (tid & 7) * 8, v16 = (tid & 7) * 16;
    const uint4 rq = *(const uint4*)(PQ + (size_t)(m0 + t) * 1792 + h * 64 + d8), rk = *(const uint4*)(PQ + (size_t)(m0 + t) * 1792 + 256 + h * 64 + d8);
    const uint4 vr0 = *(const uint4*)(PQ + (size_t)(m0 + t) * 1792 + 512 + h * 128 + v16), vr1 = *(const uint4*)(PQ + (size_t)(m0 + t) * 1792 + 512 + h * 128 + v16 + 8);
    const uint4 ogr0 = *(const uint4*)(PQ + (size_t)(m0 + t) * 1792 + 1024 + h * 128 + v16), ogr1 = *(const uint4*)(PQ + (size_t)(m0 + t) * 1792 + 1024 + h * 128 + v16 + 8);
    uint4 sr[4];
#pragma unroll
    for (int i = 0; i < 4; ++i) { const int idx = tid + i * NTHR, v8 = (idx & 15) * 8, d = (idx >> 4) & 63, dir = idx >> 10;
        sr[i] = *(const uint4*)(GST + ((size_t)(((b * 4 + h) * 2 + dir) * 128 + c)) * 8192 + d * 128 + v8); }
    gla_gates(P, PQ, m0, h, lds);
    LAS float* G = (LAS float*)(lds + 17408);
    LAS bf16_t* Ps = (LAS bf16_t*)lds;
    LAS bf16_t* qf = (LAS bf16_t*)(lds + 51200);
    LAS bf16_t* kf = qf + 64 * 72; LAS bf16_t* qb = kf + 64 * 72; LAS bf16_t* kb = qb + 64 * 72;
    LAS bf16_t* Vs = (LAS bf16_t*)(lds + 88064);
    LAS bf16_t* Ss = (LAS bf16_t*)(lds + 105472);
    { const unsigned qw[4] = {rq.x, rq.y, rq.z, rq.w}, kw[4] = {rk.x, rk.y, rk.z, rk.w};
        unsigned oqf[4], okf[4], oqb[4], okb[4]; float cf[8], cb[8];
#pragma unroll
        for (int q = 0; q < 2; ++q) { const f32x4 a = *(const LAS f32x4*)(G + t * 64 + d8 + q * 4), bb = *(const LAS f32x4*)(G + (64 + t) * 64 + d8 + q * 4);
#pragma unroll
            for (int j = 0; j < 4; ++j) { cf[q * 4 + j] = a[j]; cb[q * 4 + j] = bb[j]; } }
#pragma unroll
        for (int i = 0; i < 4; ++i) { const float cf0 = cf[2 * i], cf1 = cf[2 * i + 1], cb0 = cb[2 * i], cb1 = cb[2 * i + 1];
            const float q0 = bflo(qw[i]) * 0.125f, q1 = bfhi(qw[i]) * 0.125f, k0 = bflo(kw[i]), k1 = bfhi(kw[i]);
            oqf[i] = pack2(q0 * __expf(cf0), q1 * __expf(cf1)); okf[i] = pack2(k0 * __expf(-cf0), k1 * __expf(-cf1));
            oqb[i] = pack2(q0 * __expf(cb0), q1 * __expf(cb1)); okb[i] = pack2(k0 * __expf(-cb0), k1 * __expf(-cb1)); }
        *(LAS u32x4*)(qf + t * 72 + d8) = mk4(oqf[0], oqf[1], oqf[2], oqf[3]); *(LAS u32x4*)(kf + t * 72 + d8) = mk4(okf[0], okf[1], okf[2], okf[3]);
        *(LAS u32x4*)(qb + t * 72 + d8) = mk4(oqb[0], oqb[1], oqb[2], oqb[3]); *(LAS u32x4*)(kb + t * 72 + d8) = mk4(okb[0], okb[1], okb[2], okb[3]);
        *(LAS u32x4*)(Vs + t * 136 + v16) = mk4(vr0.x, vr0.y, vr0.z, vr0.w); *(LAS u32x4*)(Vs + t * 136 + v16 + 8) = mk4(vr1.x, vr1.y, vr1.z, vr1.w); }
#pragma unroll
    for (int i = 0; i < 4; ++i) { const int idx = tid + i * NTHR, v8 = (idx & 15) * 8, d = (idx >> 4) & 63, dir = idx >> 10;
        *(LAS u32x4*)(Ss + (dir * 64 + d) * 136 + v8) = mk4(sr[i].x, sr[i].y, sr[i].z, sr[i].w); }
    lds_barrier();
#pragma unroll
    for (int tl = 0; tl < 2; ++tl) { const int tile = wid * 2 + tl, mi = tile >> 2, ni = tile & 3; f32x4 pf = (f32x4){0.f, 0.f, 0.f, 0.f}, pb = pf;
        pf = mma16(qf + mi * 16 * 72, 72, kf + ni * 16 * 72, 72, 64, pf, lane); pb = mma16(qb + mi * 16 * 72, 72, kb + ni * 16 * 72, 72, 64, pb, lane);
        const int i = mi * 16 + (lane & 15), j0 = ni * 16 + 4 * (lane >> 4); float pv[4];
#pragma unroll
        for (int jj = 0; jj < 4; ++jj) pv[jj] = (j0 + jj <= i) ? pf[jj] : pb[jj];
        *(LAS u32x2*)(Ps + i * 72 + j0) = mk2(pack2(pv[0], pv[1]), pack2(pv[2], pv[3])); }
    lds_barrier();
    { const int mi = wid & 3, nb = (wid >> 2) * 4; LAS float* ost = G; f32x4 acc[4];
#pragma unroll
        for (int nt = 0; nt < 4; ++nt) acc[nt] = (f32x4){0.f, 0.f, 0.f, 0.f};
#pragma unroll
        for (int ks = 0; ks < 2; ++ks) {
            const bf16x8 ap = *(const LAS bf16x8*)(Ps + (mi * 16 + (lane & 15)) * 72 + ks * 32 + (lane >> 4) * 8);
            const bf16x8 af = *(const LAS bf16x8*)(qf + (mi * 16 + (lane & 15)) * 72 + ks * 32 + (lane >> 4) * 8);
            const bf16x8 ab = *(const LAS bf16x8*)(qb + (mi * 16 + (lane & 15)) * 72 + ks * 32 + (lane >> 4) * 8);
#pragma unroll
            for (int nt = 0; nt < 4; ++nt) { const int ni = nb + nt;
                acc[nt] = __builtin_amdgcn_mfma_f32_16x16x32_bf16(frag_tr(Vs + ks * 32 * 136 + ni * 16, 136, lane), ap, acc[nt], 0, 0, 0);
                acc[nt] = __builtin_amdgcn_mfma_f32_16x16x32_bf16(frag_tr(Ss + ks * 32 * 136 + ni * 16, 136, lane), af, acc[nt], 0, 0, 0);
                acc[nt] = __builtin_amdgcn_mfma_f32_16x16x32_bf16(frag_tr(Ss + (64 + ks * 32) * 136 + ni * 16, 136, lane), ab, acc[nt], 0, 0, 0); } }
#pragma unroll
        for (int nt = 0; nt < 4; ++nt) *(LAS f32x4*)(ost + (mi * 16 + (lane & 15)) * 132 + (nb + nt) * 16 + 4 * (lane >> 4)) = acc[nt]; }
    lds_barrier();
    { LAS float* ost = G; float o[16]; float ss = 0.f;
#pragma unroll
        for (int i = 0; i < 4; ++i) { const f32x4 v = *(const LAS f32x4*)(ost + t * 132 + v16 + i * 4); o[4 * i] = v[0]; o[4 * i + 1] = v[1]; o[4 * i + 2] = v[2]; o[4 * i + 3] = v[3]; ss += v[0] * v[0] + v[1] * v[1] + v[2] * v[2] + v[3] * v[3]; }
        ss += __shfl_xor(ss, 1); ss += __shfl_xor(ss, 2); ss += __shfl_xor(ss, 4);
        const float rstd = rsqrtf(ss * (1.0f / 128.0f) + 1e-6f);
        const float* gn = P->in[20] + h * 128 + v16;
        bf16_t* op = MIX + (size_t)(m0 + t) * 1024 + 512 + h * 128 + v16;
#pragma unroll
        for (int hh = 0; hh < 2; ++hh) { const uint4 raw = hh ? ogr1 : ogr0; const unsigned rw[4] = {raw.x, raw.y, raw.z, raw.w}; unsigned ow[4];
#pragma unroll
            for (int i = 0; i < 4; ++i) { const int e = hh * 8 + 2 * i; const float g0 = bflo(rw[i]), g1 = bfhi(rw[i]);
                ow[i] = pack2(o[e] * rstd * gn[e] * silu_f(g0), o[e + 1] * rstd * gn[e + 1] * silu_f(g1)); }
            *(uint4*)(op + hh * 8) = make_uint4(ow[0], ow[1], ow[2], ow[3]); } }
    lds_barrier();
}

__device__ __forceinline__ float ret_lg(int h) {
    float v = -0.0317486983145803f;
    v = h == 1 ? -0.015748356968139168f : v; v = h == 2 ? -0.007843177461025893f : v; v = h == 3 ? -0.003913899321136329f : v; v = h == 4 ? -0.0019550348358033506f : v;
    v = h == 5 ? -0.0009770396478266127f : v; v = h == 6 ? -0.0004884004981088745f : v; v = h == 7 ? -0.0002441704321739145f : v; return v;
}

struct KRaw { uint4 a, b; };
__device__ __forceinline__ KRaw rot_load(const bf16_t* rowp, const float*, const float*, int dq) { KRaw k; k.a = *(const uint4*)(rowp + dq); k.b = *(const uint4*)(rowp + 64 + dq); return k; }
__device__ __forceinline__ void rot_apply(const KRaw& k, float (&r1)[8], float (&r2)[8]) {
    const unsigned aw[4] = {k.a.x, k.a.y, k.a.z, k.a.w}, bw[4] = {k.b.x, k.b.y, k.b.z, k.b.w};
#pragma unroll
    for (int i = 0; i < 8; ++i) { r1[i] = (i & 1) ? bfhi(aw[i >> 1]) : bflo(aw[i >> 1]); r2[i] = (i & 1) ? bfhi(bw[i >> 1]) : bflo(bw[i >> 1]); }
}

__device__ void ret_a_unit(CP P, int hf, int unit, LAS unsigned char* lds) {
    const int sc = unit & 31, h = (unit >> 5) & 7, bl = unit >> 8;
    const bf16_t* PR = (const bf16_t*)(P->ws + OFF_PROJ1); bf16_t* RST = (bf16_t*)(P->ws + OFF_RST);
    const int tid = otid(), lane = tid & 63, wid = tid >> 6;
    const size_t r0 = (size_t)bl * 8192 + sc * 256;
    const float lgf = ret_lg(h), lgb = ret_lg(7 - h);
    LAS bf16_t* kf = (LAS bf16_t*)lds;
    LAS bf16_t* kb = (LAS bf16_t*)(lds + 17408);
    LAS bf16_t* Vs = (LAS bf16_t*)(lds + 34816);
    f32x4 acc[4][8];
#pragma unroll
    for (int a = 0; a < 4; ++a)
#pragma unroll
        for (int n = 0; n < 8; ++n) acc[a][n] = (f32x4){0.f, 0.f, 0.f, 0.f};
    const int mb = (wid >> 1) * 4, nb = (wid & 1) * 8;
    const LAS bf16_t* kA = (mb >= 8) ? kb : kf; const int dt0 = (mb & 7) * 16;
    const int pj = tid >> 3, pdq = (tid & 7) * 8, pv32 = (tid & 7) * 32;
    const bf16_t* kbase = PR + (r0 + pj) * 6144 + 1024 + h * 128; const bf16_t* vbase = PR + (r0 + pj) * 6144 + 2048 + h * 256 + pv32;
    KRaw kr = rot_load(kbase, nullptr, nullptr, pdq);
    uint4 vr[4];
#pragma unroll
    for (int hh = 0; hh < 4; ++hh) vr[hh] = *(const uint4*)(vbase + hh * 8);
    for (int jb = 0; jb < 4; ++jb) {
        { const int j = pj, dq = pdq, J = jb * 64 + j; float r1[8], r2[8];
            rot_apply(kr, r1, r2);
            const float sf = __expf((float)(255 - J) * lgf), sb = __expf((float)J * lgb);
            *(LAS u32x4*)(kf + j * 136 + dq) = mk4(pack2(r1[0] * sf, r1[1] * sf), pack2(r1[2] * sf, r1[3] * sf), pack2(r1[4] * sf, r1[5] * sf), pack2(r1[6] * sf, r1[7] * sf));
            *(LAS u32x4*)(kf + j * 136 + 64 + dq) = mk4(pack2(r2[0] * sf, r2[1] * sf), pack2(r2[2] * sf, r2[3] * sf), pack2(r2[4] * sf, r2[5] * sf), pack2(r2[6] * sf, r2[7] * sf));
            *(LAS u32x4*)(kb + j * 136 + dq) = mk4(pack2(r1[0] * sb, r1[1] * sb), pack2(r1[2] * sb, r1[3] * sb), pack2(r1[4] * sb, r1[5] * sb), pack2(r1[6] * sb, r1[7] * sb));
            *(LAS u32x4*)(kb + j * 136 + 64 + dq) = mk4(pack2(r2[0] * sb, r2[1] * sb), pack2(r2[2] * sb, r2[3] * sb), pack2(r2[4] * sb, r2[5] * sb), pack2(r2[6] * sb, r2[7] * sb));
#pragma unroll
            for (int hh = 0; hh < 4; ++hh) *(LAS u32x4*)(Vs + j * 264 + pv32 + hh * 8) = mk4(vr[hh].x, vr[hh].y, vr[hh].z, vr[hh].w); }
        lds_barrier();
        if (jb < 3) { kr = rot_load(kbase + (size_t)(jb + 1) * 64 * 6144, nullptr, nullptr, pdq);
#pragma unroll
            for (int hh = 0; hh < 4; ++hh) vr[hh] = *(const uint4*)(vbase + (size_t)(jb + 1) * 64 * 6144 + hh * 8); }
#pragma unroll
        for (int ks = 0; ks < 2; ++ks) { bf16x8 af[4];
#pragma unroll
            for (int a = 0; a < 4; ++a) af[a] = frag_tr(kA + ks * 32 * 136 + dt0 + a * 16, 136, lane);
#pragma unroll
            for (int n = 0; n < 8; ++n) { const bf16x8 bfr = frag_tr(Vs + ks * 32 * 264 + (nb + n) * 16, 264, lane);
#pragma unroll
                for (int a = 0; a < 4; ++a) acc[a][n] = __builtin_amdgcn_mfma_f32_16x16x32_bf16(bfr, af[a], acc[a][n], 0, 0, 0); } }
        lds_barrier();
    }
#pragma unroll
    for (int a = 0; a < 4; ++a) { const int row = (mb + a) * 16 + (lane & 15), dir = row >> 7, d = row & 127;
        bf16_t* out = RST + ((size_t)(((bl * 8 + h) * 2 + dir) * 32 + sc)) * 32768 + d * 256 + 4 * (lane >> 4);
#pragma unroll
        for (int n = 0; n < 8; ++n) { uint2 w; w.x = pack2(acc[a][n][0], acc[a][n][1]); w.y = pack2(acc[a][n][2], acc[a][n][3]); *(uint2*)(out + (nb + n) * 16) = w; } }
}

__device__ void phase_ret_b(CP P) {
    bf16_t* RST = (bf16_t*)(P->ws + OFF_RST);
    for (int idx = obid() * NTHR + otid(); idx < 64 * 4096; idx += gridDim.x * NTHR) {
        const int bhd = idx >> 12, e = (idx & 4095) * 8, dir = bhd & 1, h = (bhd >> 1) & 7;
        const float dec = __expf(256.0f * ret_lg(dir == 0 ? h : 7 - h));
        f32x4 S0 = (f32x4){0.f, 0.f, 0.f, 0.f}, S1 = S0;
        bf16_t* base = RST + ((size_t)bhd * 32) * 32768 + e;
#pragma unroll 1
        for (int c0 = 0; c0 < 32; c0 += 8) { uint4 t[8];
#pragma unroll
            for (int k = 0; k < 8; ++k) { const int c = dir == 0 ? c0 + k : 31 - (c0 + k); t[k] = *(const uint4*)(base + (size_t)c * 32768); }
#pragma unroll
            for (int k = 0; k < 8; ++k) { const int c = dir == 0 ? c0 + k : 31 - (c0 + k);
                uint4 o; o.x = pack2(S0[0], S0[1]); o.y = pack2(S0[2], S0[3]); o.z = pack2(S1[0], S1[1]); o.w = pack2(S1[2], S1[3]); *(uint4*)(base + (size_t)c * 32768) = o;
                S0 = dec * S0 + (f32x4){bflo(t[k].x), bfhi(t[k].x), bflo(t[k].y), bfhi(t[k].y)}; S1 = dec * S1 + (f32x4){bflo(t[k].z), bfhi(t[k].z), bflo(t[k].w), bfhi(t[k].w)}; } }
    }
}

__device__ void ret_c_unit(CP P, int hf, int unit, LAS unsigned char* lds) {
    const int rh = (unit >> 3) & 1, ur = (unit & 7) | ((unit >> 4) << 3), sc = ur & 31, h = (ur >> 5) & 7, bl = ur >> 8;
    const bf16_t* PR = (const bf16_t*)(P->ws + OFF_PROJ1); const bf16_t* RST = (const bf16_t*)(P->ws + OFF_RST);
    const float* cs = (const float*)(P->ws + OFF_ROPE); const float* sn = cs + 8192 * 64;
    const int tid = otid(), lane = tid & 63, wid = tid >> 6;
    const size_t r0 = (size_t)bl * 8192 + sc * 256;
    const float lgf = ret_lg(h), lgb = ret_lg(7 - h);
    LAS bf16_t* qs = (LAS bf16_t*)lds;
    LAS bf16_t* ks = (LAS bf16_t*)(lds + 34816);
    LAS bf16_t* Ps = (LAS bf16_t*)(lds + 52224);
    LAS bf16_t* Vs = (LAS bf16_t*)(lds + 70656);
    LAS float* red = (LAS float*)(lds + 104448);
    LAS bf16_t* qx = ks;
#pragma unroll
    for (int rep = 0; rep < 2; ++rep) { const int i = (tid >> 3) + rep * 64, dq = (tid & 7) * 8, I = rh * 128 + i;
        const KRaw q_ = rot_load(PR + (r0 + I) * 6144 + h * 128, nullptr, nullptr, dq);
        *(LAS u32x4*)(qs + i * 136 + dq) = mk4(q_.a.x, q_.a.y, q_.a.z, q_.a.w); *(LAS u32x4*)(qs + i * 136 + 64 + dq) = mk4(q_.b.x, q_.b.y, q_.b.z, q_.b.w); }
    f32x4 acc[2][8];
#pragma unroll
    for (int r = 0; r < 2; ++r)
#pragma unroll
        for (int n = 0; n < 8; ++n) acc[r][n] = (f32x4){0.f, 0.f, 0.f, 0.f};
    const int mi2 = (wid & 3) * 2, nb = (wid >> 2) * 8;
    const int pj = tid >> 3, pdq = (tid & 7) * 8, pv32 = (tid & 7) * 32;
    const bf16_t* kbase = PR + (r0 + pj) * 6144 + 1024 + h * 128; const bf16_t* vbase = PR + (r0 + pj) * 6144 + 2048 + h * 256 + pv32;
    KRaw kr = rot_load(kbase, cs + (sc * 256 + pj) * 64, sn + (sc * 256 + pj) * 64, pdq);
    uint4 vr[4];
#pragma unroll
    for (int hh = 0; hh < 4; ++hh) vr[hh] = *(const uint4*)(vbase + hh * 8);
    uint4 st[4];
    const bf16_t* sbase = RST + ((size_t)((bl * 8 + h) * 2) * 32 + sc) * 32768;
    for (int kb = 0; kb < 4; ++kb) {
        { const int j = pj, dq = pdq;
            *(LAS u32x4*)(ks + j * 136 + dq) = mk4(kr.a.x, kr.a.y, kr.a.z, kr.a.w); *(LAS u32x4*)(ks + j * 136 + 64 + dq) = mk4(kr.b.x, kr.b.y, kr.b.z, kr.b.w);
#pragma unroll
            for (int hh = 0; hh < 4; ++hh) *(LAS u32x4*)(Vs + j * 264 + pv32 + hh * 8) = mk4(vr[hh].x, vr[hh].y, vr[hh].z, vr[hh].w); }
        lds_barrier();
        if (kb < 3) { const int J = (kb + 1) * 64 + pj; kr = rot_load(kbase + (size_t)(kb + 1) * 64 * 6144, cs + (sc * 256 + J) * 64, sn + (sc * 256 + J) * 64, pdq);
#pragma unroll
            for (int hh = 0; hh < 4; ++hh) vr[hh] = *(const uint4*)(vbase + (size_t)(kb + 1) * 64 * 6144 + hh * 8); }
        else {
#pragma unroll
            for (int i = 0; i < 4; ++i) { const int idx = tid + i * NTHR, v8 = (idx & 31) * 8, dd = idx >> 5; st[i] = *(const uint4*)(sbase + dd * 256 + v8); } }
#pragma unroll
        for (int tr = 0; tr < 2; ++tr)
#pragma unroll
            for (int tc = 0; tc < 2; ++tc) { const int ti = mi2 + tr, tj = (wid >> 2) * 2 + tc; f32x4 s = (f32x4){0.f, 0.f, 0.f, 0.f};
                s = mma16(qs + ti * 16 * 136, 136, ks + tj * 16 * 136, 136, 128, s, lane);
                const int i = ti * 16 + (lane & 15), j0 = tj * 16 + 4 * (lane >> 4), I = rh * 128 + i; float pv[4];
#pragma unroll
                for (int jj = 0; jj < 4; ++jj) { const int df = I - (kb * 64 + j0 + jj); const float dm = df >= 0 ? __expf((float)df * lgf) : __expf((float)(-df) * lgb); pv[jj] = s[jj] * dm; }
                *(LAS u32x2*)(Ps + i * 72 + j0) = mk2(pack2(pv[0], pv[1]), pack2(pv[2], pv[3])); }
        lds_barrier();
#pragma unroll
        for (int k2 = 0; k2 < 2; ++k2) { bf16x8 af[2], bfr[8];
#pragma unroll
            for (int r = 0; r < 2; ++r) af[r] = *(const LAS bf16x8*)(Ps + ((mi2 + r) * 16 + (lane & 15)) * 72 + k2 * 32 + (lane >> 4) * 8);
#pragma unroll
            for (int n = 0; n < 8; ++n) bfr[n] = frag_tr(Vs + k2 * 32 * 264 + (nb + n) * 16, 264, lane);
#pragma unroll
            for (int r = 0; r < 2; ++r)
#pragma unroll
                for (int n = 0; n < 8; ++n) acc[r][n] = __builtin_amdgcn_mfma_f32_16x16x32_bf16(bfr[n], af[r], acc[r][n], 0, 0, 0); }
        lds_barrier();
    }
    uint2 ogr[2][8];
#pragma unroll
    for (int r = 0; r < 2; ++r) { const bf16_t* ogp = PR + (r0 + rh * 128 + (mi2 + r) * 16 + (lane & 15)) * 6144 + 4096 + h * 256 + 4 * (lane >> 4);
#pragma unroll
        for (int n = 0; n < 8; ++n) ogr[r][n] = *(const uint2*)(ogp + (nb + n) * 16); }
    for (int sl = 0; sl < 4; ++sl) { const int dir = sl >> 1, dh = sl & 1;
        if (dh == 0) { const int i = tid >> 2, c32 = (tid & 3) * 32, I = rh * 128 + i; const float xs = dir == 0 ? __expf((float)(I + 1) * lgf) : __expf((float)(256 - I) * lgb);
#pragma unroll
            for (int hh = 0; hh < 4; ++hh) { const u32x4 w = *(const LAS u32x4*)(qs + i * 136 + c32 + hh * 8);
                *(LAS u32x4*)(qx + i * 136 + c32 + hh * 8) = mk4(pack2(bflo(w[0]) * xs, bfhi(w[0]) * xs), pack2(bflo(w[1]) * xs, bfhi(w[1]) * xs), pack2(bflo(w[2]) * xs, bfhi(w[2]) * xs), pack2(bflo(w[3]) * xs, bfhi(w[3]) * xs)); } }
#pragma unroll
        for (int i = 0; i < 4; ++i) { const int idx = tid + i * NTHR, v8 = (idx & 31) * 8, dd = idx >> 5; *(LAS u32x4*)(Vs + dd * 264 + v8) = mk4(st[i].x, st[i].y, st[i].z, st[i].w); }
        lds_barrier();
        if (sl < 3) { const int nd = (sl + 1) >> 1, nh = (sl + 1) & 1; const bf16_t* sp = sbase + (size_t)nd * 32 * 32768 + (size_t)nh * 64 * 256;
#pragma unroll
            for (int i = 0; i < 4; ++i) { const int idx = tid + i * NTHR, v8 = (idx & 31) * 8, dd = idx >> 5; st[i] = *(const uint4*)(sp + dd * 256 + v8); } }
#pragma unroll
        for (int k2 = 0; k2 < 2; ++k2) { bf16x8 af[2], bfr[8];
#pragma unroll
            for (int r = 0; r < 2; ++r) af[r] = *(const LAS bf16x8*)(qx + ((mi2 + r) * 16 + (lane & 15)) * 136 + dh * 64 + k2 * 32 + (lane >> 4) * 8);
#pragma unroll
            for (int n = 0; n < 8; ++n) bfr[n] = frag_tr(Vs + k2 * 32 * 264 + (nb + n) * 16, 264, lane);
#pragma unroll
            for (int r = 0; r < 2; ++r)
#pragma unroll
                for (int n = 0; n < 8; ++n) acc[r][n] = __builtin_amdgcn_mfma_f32_16x16x32_bf16(bfr[n], af[r], acc[r][n], 0, 0, 0); }
        lds_barrier();
    }
    { float ss[2];
#pragma unroll
        for (int r = 0; r < 2; ++r) { ss[r] = 0.f;
#pragma unroll
            for (int n = 0; n < 8; ++n) ss[r] += acc[r][n][0] * acc[r][n][0] + acc[r][n][1] * acc[r][n][1] + acc[r][n][2] * acc[r][n][2] + acc[r][n][3] * acc[r][n][3];
            ss[r] += __shfl_xor(ss[r], 16); ss[r] += __shfl_xor(ss[r], 32);
            if ((lane >> 4) == 0) red[((mi2 + r) * 16 + (lane & 15)) * 2 + (wid >> 2)] = ss[r]; }
        lds_barrier();
#pragma unroll
        for (int r = 0; r < 2; ++r) { const int i = (mi2 + r) * 16 + (lane & 15);
            const float rstd = rsqrtf((red[i * 2] + red[i * 2 + 1]) * (1.0f / 256.0f) + 1e-6f);
            const float* gn = P->in[23] + h * 256 + 4 * (lane >> 4);
            bf16_t* op = (bf16_t*)(P->ws + OFF_OBUF) + (r0 + rh * 128 + i) * 2048 + h * 256 + 4 * (lane >> 4);
#pragma unroll
            for (int n = 0; n < 8; ++n) { const int v = (nb + n) * 16; const uint2 og = ogr[r][n]; const f32x4 g4 = *(const f32x4*)(gn + v);
                uint2 w; w.x = pack2(acc[r][n][0] * rstd * g4[0] * silu_f(bflo(og.x)), acc[r][n][1] * rstd * g4[1] * silu_f(bfhi(og.x)));
                w.y = pack2(acc[r][n][2] * rstd * g4[2] * silu_f(bflo(og.y)), acc[r][n][3] * rstd * g4[3] * silu_f(bfhi(og.y)));
                *(uint2*)(op + v) = w; } } }
    lds_barrier();
}

#define XB_TMO      128
#define XB_XCNT(j)  (256  + 64 * (j))
#define XB_XSUB(j)  (1280 + 64 * (j))
#define XB_XGEN(j)  (2304 + 64 * (j))
#define XB_TOP      3328
#define XB_TOPGEN   3392
#define XCD_BAR_WORDS 3456
#define XB_SPIN_CAP (1u << 18)
__device__ __forceinline__ unsigned xb_ld(unsigned* p)              { return __hip_atomic_load(p, __ATOMIC_RELAXED, __HIP_MEMORY_SCOPE_AGENT); }
__device__ __forceinline__ unsigned xb_add(unsigned* p, unsigned v) { return __hip_atomic_fetch_add(p, v, __ATOMIC_RELAXED, __HIP_MEMORY_SCOPE_AGENT); }
__device__ __forceinline__ unsigned xb_xcc_id() { return (unsigned)__builtin_amdgcn_s_getreg((3 << 11) | 20) & 0xFu; }
#define XB_SPIN(cond, bar) do { unsigned _sp = 0; while (cond) { __builtin_amdgcn_s_sleep(1); \
    if ((++_sp & 255u) == 0u) { if (xb_ld(&(bar)[XB_TMO])) break; if (_sp > XB_SPIN_CAP) { atomicAdd(&(bar)[XB_TMO], 1u); break; } } } } while (0)
__device__ __forceinline__ void xcd_barrier_complete(unsigned* bar, unsigned x, unsigned& nloc, unsigned& nx) {
    const unsigned G = gridDim.x * gridDim.y * gridDim.z;
    unsigned sum, cnt, mine, sp = 0u;
    for (;;) {
        sum = 0u; cnt = 0u; mine = 0u;
#pragma unroll
        for (unsigned j = 0; j < 16; ++j) { const unsigned c = xb_ld(&bar[XB_XCNT(j)]); sum += c; cnt += (c > 0u) ? 1u : 0u; mine = (j == x) ? c : mine; }
        if (sum == G) break;
        __builtin_amdgcn_s_sleep(1);
        if ((++sp & 255u) == 0u) { if (xb_ld(&bar[XB_TMO])) break; if (sp > XB_SPIN_CAP) { atomicAdd(&bar[XB_TMO], 1u); break; } }
    }
    nloc = mine > 0u ? mine : 1u; nx = cnt > 0u ? cnt : 1u;
}
__device__ __forceinline__ void xcd_barrier(unsigned* bar, unsigned x, volatile LAS unsigned* st) {
    asm volatile("s_waitcnt vmcnt(0)" ::: "memory");
    __syncthreads();
    if (threadIdx.x == 0) {
        __builtin_amdgcn_s_waitcnt(0);
        unsigned nloc = st[0], nx = st[1];
        if (nloc == 0u) { xcd_barrier_complete(bar, x, nloc, nx); st[0] = nloc; st[1] = nx; }
        const unsigned old = xb_add(&bar[XB_XSUB(x)], 1u);
        const unsigned gen = old / nloc;
        if (old + 1u == (gen + 1u) * nloc) {
            __builtin_amdgcn_fence(__ATOMIC_RELEASE, "agent");
            asm volatile("s_waitcnt vmcnt(0)" ::: "memory");
            const unsigned og = xb_add(&bar[XB_TOP], 1u);
            const unsigned tg = og / nx;
            if (og + 1u == (tg + 1u) * nx) xb_add(&bar[XB_TOPGEN], 1u);
            else XB_SPIN(xb_ld(&bar[XB_TOPGEN]) == tg, bar);
            __builtin_amdgcn_fence(__ATOMIC_ACQUIRE, "agent");
            xb_add(&bar[XB_XGEN(x)], 1u);
            asm volatile("s_waitcnt vmcnt(0)" ::: "memory");
        } else {
            XB_SPIN(xb_ld(&bar[XB_XGEN(x)]) == gen, bar);
            __builtin_amdgcn_fence(__ATOMIC_ACQUIRE, "agent");
            asm volatile("s_waitcnt vmcnt(0)" ::: "memory");
        }
    }
    __syncthreads();
}

__global__ void __launch_bounds__(NTHR, 2) mega(Params Pval, int ph0, int ph1) {
    extern __shared__ __attribute__((aligned(16))) unsigned char lds_raw[];
    LAS unsigned char* lds = (LAS unsigned char*)lds_raw;
    volatile LAS unsigned* xb_st = (volatile LAS unsigned*)(lds + LDS_BYTES - 16);
    unsigned xb_x = 0;
    if (ph1 - ph0 > 1) { if (threadIdx.x == 0) { xb_st[0] = 0u; xb_st[1] = 0u; } __syncthreads();
        xb_x = xb_xcc_id(); if (threadIdx.x == 0) (void)xb_add((unsigned*)(Pval.ws + OFF_BAR) + XB_XCNT(xb_x), 1u); }
    for (int ph = ph0; ph < ph1; ++ph) {
        CP P = (CP)__builtin_amdgcn_kernarg_segment_ptr(); asm volatile("" : "+s"(P));
        unsigned char* ws = P->ws;
        bf16_t* XN = (bf16_t*)(ws + OFF_XN); bf16_t* ACT = (bf16_t*)(ws + OFF_ACT); float* X = P->out;
        if (ph == 1 || ph == 4 || ph == 11 || ph == 14 || ph == 17 || ph == 28) continue;
        const int reps = (((unsigned long long)(PROBE_MASK) >> ph) & 1ull) ? 2 : 1;
        for (int rep = 0; rep < reps; ++rep) {
        float* SSQ = (float*)(ws + OFF_SSQ); bf16_t* XB2 = (bf16_t*)(ws + OFF_XB2);
        int ffn = -1, sub = 0;
        if (ph >= 2 && ph <= 3) { ffn = 0; sub = ph - 1; } else if (ph >= 12 && ph <= 13) { ffn = 1; sub = ph - 11; }
        else if (ph >= 15 && ph <= 16) { ffn = 2; sub = ph - 14; } else if (ph >= 29 && ph <= 30) { ffn = 3; sub = ph - 28; }
        if (ph == 0) { if (EN(0)) phase_prologue(P, lds); }
        else if (ffn >= 0) {
            const float* xin = (ffn == 0) ? P->in[0] : X;
            const float* ssin = SSQ + (size_t)(ffn == 0 ? 0 : ffn == 1 ? 2 : ffn == 2 ? 3 : 5) * SSN;
            if (sub == 1) { if (EN(2)) { if (ffn == 0) phase_kmat(P);
                pg8::Gemm g{ffn == 1 ? XB2 : XN, (const bf16_t*)(ws + OFF_W1 + (size_t)ffn * SZ_W1), 1024, 1024, 1024, 256, 22, 1, 0, 0}; EpiSwiGLU e{ACT, ssin}; pg8::gemm_phase(lds, g, e); } }
            else { if (EN(3)) { pg8::Gemm g{ACT, (const bf16_t*)(ws + OFF_W2 + (size_t)ffn * SZ_W2), 2816, 2816, 2816, 256, 4, 1, 0, 0};
                float* ssout = SSQ + (size_t)(ffn == 0 ? 1 : ffn == 1 ? 3 : 4) * SSN;
                if (ffn == 3) { EpiResid<false> e{xin, X, nullptr, nullptr, 0.5f}; pg8::gemm_phase(lds, g, e); }
                else { EpiResid<true> e{xin, X, XN, ssout, 0.5f}; pg8::gemm_phase(lds, g, e); } } }
        }
        else if (ph == 5) { if (EN(4)) { pg8::Gemm g{XN, (const bf16_t*)(ws + OFF_WIN0), 1024, 1024, 1024, 256, 9, 1, 0, 0}; EpiWin0 e{(bf16_t*)(ws + OFF_AS5), (bf16_t*)(ws + OFF_PQ), SSQ + SSN}; pg8::gemm_phase(lds, g, e); } }
        else if (ph == 6) { if (EN(5)) {
            if (EN(16)) { pg8::Gemm g{(const bf16_t*)(ws + OFF_AS5), (const bf16_t*)(ws + OFF_H), 1280, 1024, 1024, 4, 1, 32, (size_t)1024 * 1280, (size_t)256 * 1024}; EpiS5E e{(float*)(ws + OFF_E)}; pg8::gemm_phase(lds, g, e); }
            __syncthreads();
            if (EN(17)) for (int u = obid(); u < 4096; u += gridDim.x) gla_a_unit(P, u, lds);
        } }
        else if (ph == 7) { if (EN(6)) { phase_s5_scan(P); phase_gla_b(P); } }
        else if (ph == 8) { if (EN(7)) {
            if (EN(18)) { pg8::Gemm g{(const bf16_t*)(ws + OFF_AS5), (const bf16_t*)(ws + OFF_KG), 1280, 1280, 1280, 4, 4, 32, (size_t)1024 * 1280, (size_t)1024 * 1280}; EpiS5Y e{(bf16_t*)(ws + OFF_GY)}; pg8::gemm_phase(lds, g, e); }
            __syncthreads();
            if (EN(19)) for (int u = obid(); u < 4096; u += gridDim.x) gla_c_unit(P, u, lds);
        } }
        else if (ph == 9) { if (EN(8)) { pg8::Gemm g{(const bf16_t*)(ws + OFF_GY), (const bf16_t*)(ws + OFF_WGLU), 512, 512, 512, 256, 2, 1, 0, 0}; EpiGLU e{(const bf16_t*)(ws + OFF_GY), XN}; pg8::gemm_phase(lds, g, e); } }
        else if (ph == 10) { if (EN(9)) { pg8::Gemm g{XN, (const bf16_t*)(ws + OFF_WOUT0), 1024, 1024, 1024, 256, 4, 1, 0, 0}; EpiResid<true> e{X, X, XB2, SSQ + 2 * SSN, 1.0f}; pg8::gemm_phase(lds, g, e); } }
        else if (ph >= 18 && ph <= 27) {
            const int hf = (ph - 18) / 5, s = (ph - 18) % 5;
            if (s == 0) { if (EN(10)) { pg8::Gemm g{XN + (size_t)hf * 32768 * 1024, (const bf16_t*)(ws + OFF_WIN1), 1024, 1024, 1024, 128, 24, 1, 0, 0}; EpiRetIn e{(bf16_t*)(ws + OFF_PROJ1), 6144, SSQ + 4 * SSN + (size_t)hf * 32768 * 16, (const float*)(ws + OFF_ROPE), (const float*)(ws + OFF_ROPE) + 8192 * 64, hf * 32768}; pg8::gemm_phase(lds, g, e); } }
            else if (s == 1) { if (EN(11)) for (int u = obid(); u < 1024; u += gridDim.x) ret_a_unit(P, hf, u, lds); }
            else if (s == 2) { if (EN(12)) phase_ret_b(P); }
            else if (s == 3) { if (EN(13)) for (int u = obid(); u < 2048; u += gridDim.x) ret_c_unit(P, hf, u, lds); }
            else { if (EN(14)) { pg8::Gemm g{(const bf16_t*)(ws + OFF_OBUF), (const bf16_t*)(ws + OFF_WOUT1), 2048, 2048, 2048, 128, 4, 1, 0, 0};
                float* Xh = X + (size_t)hf * 32768 * 1024; EpiResid<true> e{Xh, Xh, XN + (size_t)hf * 32768 * 1024, SSQ + 5 * SSN + (size_t)hf * 32768 * 16, 1.0f}; pg8::gemm_phase(lds, g, e); } }
        }
        else if (ph == 31) { if (EN(15)) phase_norm<true>(X, P->in[25], nullptr, nullptr, X, 0, (int)gridDim.x, 0, 65536); }
        if (rep + 1 < reps) __syncthreads();
        }
        if (ph + 1 < ph1) { if (ph == 0) cg::this_grid().sync();
            else xcd_barrier((unsigned*)(P->ws + OFF_BAR), xb_x, xb_st); }
    }
}

extern "C" void kernel_launch(void* const* d_in, const int* in_sizes, int n_in, void* d_out, int out_size, void* d_ws, size_t ws_size, hipStream_t stream) {
    static int inited = 0;
    if (!inited) { (void)hipFuncSetAttribute((const void*)mega, hipFuncAttributeMaxDynamicSharedMemorySize, LDS_BYTES); inited = 1; }
    Params p{};
    for (int i = 0; i < 26; ++i) p.in[i] = (const float*)d_in[i];
    p.out = (float*)d_out; p.ws = (unsigned char*)d_ws;
    if (ws_size < OFF_R + 770 * MiB) fprintf(stderr, "kernel_launch: workspace too small (%zu)\n", ws_size);
    const int grid = 256;
#if ONE_LAUNCH
    (void)hipMemsetAsync((unsigned char*)d_ws + OFF_BAR, 0, 16384, stream);
    int ph0 = 0, ph1 = NPHASE; void* args[] = {&p, &ph0, &ph1};
    hipError_t e = hipLaunchCooperativeKernel((const void*)mega, dim3(grid), dim3(NTHR), args, LDS_BYTES, stream);
    if (e != hipSuccess) fprintf(stderr, "cooperative launch failed: %s\n", hipGetErrorString(e));
#else
    for (int ph = 0; ph < NPHASE; ++ph) hipLaunchKernelGGL(mega, dim3(grid), dim3(NTHR), LDS_BYTES, stream, p, ph, ph + 1);
#endif
}
```

```cpp
#include <hip/hip_runtime.h>
#include <hip/hip_cooperative_groups.h>
#include <cstdio>
#include <cstdint>
namespace cg = cooperative_groups;

#ifndef ONE_LAUNCH
#define ONE_LAUNCH 1
#endif

#ifndef PHASE_MASK
#define PHASE_MASK 0xffffffffffull
#endif
#define EN(n) (((PHASE_MASK) >> (n)) & 1ull)
#ifndef PROBE_MASK
#define PROBE_MASK 0ull
#endif
#define LAS __attribute__((address_space(3)))
typedef unsigned short bf16_t;
typedef short bf16x8 __attribute__((ext_vector_type(8)));
typedef float f32x4 __attribute__((ext_vector_type(4)));
typedef float f32x2 __attribute__((ext_vector_type(2)));
typedef unsigned u32x2 __attribute__((ext_vector_type(2)));
typedef unsigned u32x4 __attribute__((ext_vector_type(4)));
__device__ __forceinline__ u32x4 mk4(unsigned a, unsigned b, unsigned c, unsigned d) { return (u32x4){a, b, c, d}; }
__device__ __forceinline__ u32x2 mk2(unsigned a, unsigned b) { return (u32x2){a, b}; }
__device__ __forceinline__ f32x2 mkf2(float a, float b) { return (f32x2){a, b}; }

constexpr int NTHR = 512;
constexpr int LDS_BYTES = 147456;
constexpr int NPHASE = 32;

struct Params { const float* in[26]; float* out; unsigned char* ws; };
typedef const __attribute__((address_space(4))) Params* CP;

constexpr size_t MiB = 1ull << 20;
constexpr size_t OFF_W1 = 0, SZ_W1 = 11 * MiB;
constexpr size_t OFF_W2 = 44 * MiB, SZ_W2 = 5 * MiB + MiB / 2;
constexpr size_t OFF_WIN0 = 66 * MiB;
constexpr size_t OFF_WGLU = 70 * MiB + MiB / 2;
constexpr size_t OFF_WOUT0 = 71 * MiB;
constexpr size_t OFF_WIN1 = 73 * MiB;
constexpr size_t OFF_WOUT1 = 85 * MiB;
constexpr size_t OFF_ROPE = 89 * MiB;
constexpr size_t OFF_KTAB = 93 * MiB;
constexpr size_t OFF_S5P = 97 * MiB;
constexpr size_t OFF_XN = 98 * MiB;
constexpr size_t OFF_R = 226 * MiB;
constexpr size_t OFF_ACT = OFF_R;
constexpr size_t OFF_PQ = OFF_R;
constexpr size_t OFF_AS5 = OFF_R + 224 * MiB;
constexpr size_t OFF_E = OFF_R + 304 * MiB;
constexpr size_t OFF_KG = OFF_R + 352 * MiB;
constexpr size_t OFF_H = OFF_R + 432 * MiB;
constexpr size_t OFF_GST = OFF_R + 448 * MiB;
constexpr size_t OFF_GDEC = OFF_R + 704 * MiB;
constexpr size_t OFF_GY = OFF_R + 706 * MiB;
constexpr size_t OFF_PROJ1 = OFF_R;
constexpr size_t OFF_RST = OFF_R + 384 * MiB;
constexpr size_t OFF_SSQ = 998 * MiB;
constexpr int SSN = 65536 * 16;
constexpr size_t OFF_MIX = OFF_R + 576 * MiB;
constexpr size_t OFF_BAR = 1023 * MiB;
constexpr size_t OFF_OBUF = OFF_R + 640 * MiB;

__device__ __forceinline__ int otid() { int t = threadIdx.x; asm volatile("" : "+v"(t)); return t; }
__device__ __forceinline__ int obid() { int t = blockIdx.x; asm volatile("" : "+s"(t)); return t; }
__device__ __forceinline__ bf16_t f2bf(float f) { unsigned u = __float_as_uint(f); u += 0x7FFFu + ((u >> 16) & 1u); return (bf16_t)(u >> 16); }
__device__ __forceinline__ float bf2f(unsigned b) { return __uint_as_float(b << 16); }
typedef __bf16 bf16x2_t __attribute__((ext_vector_type(2)));
typedef float f32x2_t __attribute__((ext_vector_type(2)));
__device__ __forceinline__ unsigned pack2(float lo, float hi) { const f32x2_t v = {lo, hi}; const bf16x2_t b = __builtin_convertvector(v, bf16x2_t); return __builtin_bit_cast(unsigned, b); }
__device__ __forceinline__ float bflo(unsigned w) { return __uint_as_float(w << 16); }
__device__ __forceinline__ float bfhi(unsigned w) { return __uint_as_float(w & 0xffff0000u); }
__device__ __forceinline__ float fast_sigmoid(float x) { return __builtin_amdgcn_rcpf(1.0f + __expf(-x)); }
__device__ __forceinline__ float silu_f(float x) { return x * fast_sigmoid(x); }
__device__ __forceinline__ float gelu_tanh(float x) { const float u = 0.7978845608028654f * (x + 0.044715f * x * x * x); return x * fast_sigmoid(2.0f * u); }

namespace pg8 {
constexpr int BM = 256, BK = 64, HALF = 128, HTB = HALF * BK * 2, STAGE_BYTES = 8 * HTB, NXCD = 8, WGM = 8;
__device__ __forceinline__ int lds_byte(int r, int c) { const int st = (r >> 4) * 2 + (c >> 5), rr = r & 15, cc = c & 31, ob = rr * 64 + cc * 2; return st * 1024 + (ob ^ (((ob >> 9) & 1) << 5)); }
__device__ __forceinline__ void stage_rc(int b, int& R, int& C) { const int st = b / 1024, sb = b % 1024, swz = sb ^ (((sb >> 9) & 1) << 5); R = (st >> 1) * 16 + swz / 64; C = (st & 1) * 32 + (swz % 64) / 2; }

__device__ __forceinline__ int perm32(int rho) { const int n = rho >> 4, i = rho & 15; return 8 * (i >> 2) + 4 * n + (i & 3); }
struct Unit { int pm, pn, bz; };
struct Gemm { const bf16_t* A; const bf16_t* Bt; int lda, ldb, K, nM, nN, nB; size_t strideA, strideB; };

struct Sched {
    int nM, nN, nwg, total, G, c;
    __device__ void init(int nM_, int nN_, int nB_, int G_, int c_) { nM = nM_; nN = nN_; nwg = nM * nN; total = nwg * nB_; G = G_; c = c_; }
    __device__ bool next(int i, Unit& u) const {
        const long L = (long)i * G + c; if (L >= total) return false;
        u.bz = (int)(L / nwg); int wgid = (int)(L % nwg);
        { const int q = nwg / NXCD, r = nwg % NXCD, xcd = wgid % NXCD, off = wgid / NXCD; wgid = (xcd < r ? xcd * (q + 1) : r * (q + 1) + (xcd - r) * q) + off; }
        const int nig = WGM * nN, gid = wgid / nig, fm = gid * WGM, gsz = (nM - fm) < WGM ? (nM - fm) : WGM;
        u.pm = fm + ((wgid % nig) % gsz); u.pn = (wgid % nig) / gsz; return true;
    }
};

template <class Epi>
__device__ __forceinline__ void gemm_phase(LAS unsigned char* lds, const Gemm g, const Epi& E) {
    const int tid = otid(), wid = __builtin_amdgcn_readfirstlane(tid >> 6), lane = tid & 63, wr = wid >> 2, wc = wid & 3, fr = lane & 15, fq = lane >> 4;
    const int nt = g.K / BK;
    Sched S; S.init(g.nM, g.nN, g.nB, (int)gridDim.x, obid());
    unsigned voffA[2], voffB[2];
#pragma unroll
    for (int i = 0; i < 2; ++i) { int R, C; stage_rc(tid * 16 + i * 8192, R, C); const int Rb = Epi::PERM ? ((R & ~31) + perm32(R & 31)) : R;
        voffA[i] = (unsigned)(R * g.lda + C) * 2u; voffB[i] = (unsigned)(Rb * g.ldb + C) * 2u; }
    const size_t kstep = (size_t)(BK * 2);
    const size_t hstepA = (size_t)HALF * g.lda * 2, hstepB = (size_t)HALF * g.ldb * 2;
    const size_t tstepA = 2 * hstepA, tstepB = 2 * hstepB;
    const unsigned ldsw = (unsigned)wid * 1024u;
    const int aoff = lds_byte(wr * 64 + fr, fq * 8), boff = lds_byte(wc * 32 + fr, fq * 8);
#define PG8_SA(b, h) (((b) * 2 + (h)) * HTB)
#define PG8_SB(b, h) ((4 + (b) * 2 + (h)) * HTB)
#define PG8_STAGE(bufoff, gbase, voff) do { _Pragma("unroll") for (int _i = 0; _i < 2; ++_i) \
        __builtin_amdgcn_global_load_lds((const unsigned*)((const char*)(gbase) + (voff)[_i]), (LAS unsigned*)(lds + (bufoff) + ldsw + _i * 8192), 16, 0, 0); } while (0)
#define PG8_LDA(dst, b, h) do { _Pragma("unroll") for (int m = 0; m < 4; ++m) _Pragma("unroll") for (int k = 0; k < 2; ++k) dst[m][k] = *(const LAS bf16x8*)(lds + PG8_SA(b, h) + aoff + m * 2048 + k * 1024); } while (0)
#define PG8_LDB(dst, b, h) do { _Pragma("unroll") for (int n = 0; n < 2; ++n) _Pragma("unroll") for (int k = 0; k < 2; ++k) dst[n][k] = *(const LAS bf16x8*)(lds + PG8_SB(b, h) + boff + n * 2048 + k * 1024); } while (0)
#define PG8_MMA(ai, bj, At, Bt) do { __builtin_amdgcn_s_setprio(1); _Pragma("unroll") for (int m = 0; m < 4; ++m) _Pragma("unroll") for (int n = 0; n < 2; ++n) _Pragma("unroll") for (int k = 0; k < 2; ++k) \
        acc[ai][bj][m][n] = __builtin_amdgcn_mfma_f32_16x16x32_bf16(Bt[n][k], At[m][k], acc[ai][bj][m][n], 0, 0, 0); __builtin_amdgcn_s_setprio(0); } while (0)
#define PG8_WAIT_V(n) asm volatile("s_waitcnt vmcnt(" #n ")" ::: "memory")
#define PG8_WAIT_L(n) asm volatile("s_waitcnt lgkmcnt(" #n ")" ::: "memory")
#define PG8_BAR __builtin_amdgcn_s_barrier()
#define PG8_SCHED __builtin_amdgcn_sched_barrier(0)
    Unit cur, nxt; int ui = 0;
    if (!S.next(0, cur)) return;
    int tag0 = -1, tag1 = -1, tag2 = -1, tag3 = -1; LAS float* rstab = (LAS float*)(lds + STAGE_BYTES);
    if constexpr (Epi::RSTD) {
        { Unit t_; for (int i = 0; S.next(i, t_); ++i) { const int pm = t_.pm; if (pm == tag0 || pm == tag1 || pm == tag2 || pm == tag3) continue;
                if (tag0 < 0) tag0 = pm; else if (tag1 < 0) tag1 = pm; else if (tag2 < 0) tag2 = pm; else tag3 = pm; } }
#pragma unroll
        for (int sl = 0; sl < 2; ++sl) { const int slot = (tid >> 8) + 2 * sl; const int pm = slot == 0 ? tag0 : slot == 1 ? tag1 : slot == 2 ? tag2 : tag3;
            if (pm >= 0) { const f32x4* p = (const f32x4*)(E.SS + ((size_t)pm * 256 + (tid & 255)) * 16); const f32x4 a = p[0], b = p[1], c = p[2], d = p[3]; const f32x4 t = (a + b) + (c + d);
                rstab[slot * 256 + (tid & 255)] = rsqrtf(((t[0] + t[1]) + (t[2] + t[3])) * (1.0f / 1024.0f) + 1e-6f); } }
        __syncthreads();
    }
    f32x4 acc[2][2][4][2];
#pragma unroll
    for (int a = 0; a < 2; ++a)
#pragma unroll
        for (int b = 0; b < 2; ++b)
#pragma unroll
            for (int m = 0; m < 4; ++m)
#pragma unroll
                for (int n = 0; n < 2; ++n) acc[a][b][m][n] = (f32x4){0.f, 0.f, 0.f, 0.f};
    bf16x8 At[4][2], B0[2][2], B1[2][2];
    const char* cA = (const char*)g.A + (size_t)cur.bz * g.strideA * 2 + (size_t)cur.pm * tstepA;
    const char* cB = (const char*)g.Bt + (size_t)cur.bz * g.strideB * 2 + (size_t)cur.pn * tstepB;
    PG8_STAGE(PG8_SB(0, 0), cB, voffB); PG8_STAGE(PG8_SB(0, 1), cB + hstepB, voffB); PG8_STAGE(PG8_SA(0, 0), cA, voffA); PG8_STAGE(PG8_SA(0, 1), cA + hstepA, voffA);
    if (wr == 1) PG8_BAR;
    PG8_WAIT_V(2); PG8_BAR;
    PG8_STAGE(PG8_SB(1, 0), cB + kstep, voffB); PG8_STAGE(PG8_SA(1, 0), cA + kstep, voffA); PG8_STAGE(PG8_SB(1, 1), cB + hstepB + kstep, voffB);
    PG8_WAIT_V(6); PG8_BAR;
    for (;;) {
        const bool has_next = S.next(ui + 1, nxt);
        const char* nA = has_next ? (const char*)g.A + (size_t)nxt.bz * g.strideA * 2 + (size_t)nxt.pm * tstepA : cA;
        const char* nB = has_next ? (const char*)g.Bt + (size_t)nxt.bz * g.strideB * 2 + (size_t)nxt.pn * tstepB : cB;
        for (int t = 0; t < nt; t += 2) {
            const bool last = (t == nt - 2);
            const char* a1 = cA + (size_t)(t + 1) * kstep;
            const char* a2 = last ? nA : cA + (size_t)(t + 2) * kstep; const char* b2 = last ? nB : cB + (size_t)(t + 2) * kstep;
            const char* a3 = a2 + kstep; const char* b3 = b2 + kstep;
            PG8_LDB(B0, 0, 0); PG8_LDB(B1, 0, 1); PG8_SCHED; PG8_LDA(At, 0, 0); PG8_STAGE(PG8_SA(1, 1), a1 + hstepA, voffA);
            PG8_WAIT_V(8); PG8_WAIT_L(0); PG8_BAR; PG8_MMA(0, 0, At, B0); PG8_MMA(0, 1, At, B1); PG8_BAR; PG8_SCHED;
            PG8_LDA(At, 0, 1); PG8_STAGE(PG8_SB(0, 0), b2, voffB); PG8_STAGE(PG8_SB(0, 1), b2 + hstepB, voffB); PG8_STAGE(PG8_SA(0, 0), a2, voffA);
            PG8_WAIT_V(8); PG8_WAIT_L(0); PG8_BAR; PG8_MMA(1, 0, At, B0); PG8_MMA(1, 1, At, B1); PG8_BAR; PG8_SCHED;
            PG8_LDB(B0, 1, 0); PG8_LDB(B1, 1, 1); PG8_SCHED; PG8_LDA(At, 1, 0); PG8_STAGE(PG8_SA(0, 1), a2 + hstepA, voffA);
            PG8_WAIT_V(8); PG8_WAIT_L(0); PG8_BAR; PG8_MMA(0, 0, At, B0); PG8_MMA(0, 1, At, B1); PG8_BAR; PG8_SCHED;
            PG8_LDA(At, 1, 1); PG8_STAGE(PG8_SB(1, 0), b3, voffB); PG8_STAGE(PG8_SB(1, 1), b3 + hstepB, voffB); PG8_STAGE(PG8_SA(1, 0), a3, voffA);
            PG8_WAIT_V(8); PG8_WAIT_L(0); PG8_BAR; PG8_MMA(1, 0, At, B0); PG8_MMA(1, 1, At, B1); PG8_BAR; PG8_SCHED;
        }
        if (wr == 0) PG8_BAR;
        E(acc, cur, wr, wc, fr, fq, rstab + (cur.pm == tag1 ? 256 : cur.pm == tag2 ? 512 : cur.pm == tag3 ? 768 : 0));
        if (!has_next) break;
#pragma unroll
        for (int a = 0; a < 2; ++a)
#pragma unroll
            for (int b = 0; b < 2; ++b)
#pragma unroll
                for (int m = 0; m < 4; ++m)
#pragma unroll
                    for (int n = 0; n < 2; ++n) acc[a][b][m][n] = (f32x4){0.f, 0.f, 0.f, 0.f};
        cur = nxt; cA = nA; cB = nB; ++ui;
        if (wr == 1) PG8_BAR;
    }
    PG8_WAIT_V(0);
    PG8_BAR;
#undef PG8_SA
#undef PG8_SB
#undef PG8_STAGE
#undef PG8_LDA
#undef PG8_LDB
#undef PG8_MMA
#undef PG8_WAIT_V
#undef PG8_WAIT_L
#undef PG8_BAR
#undef PG8_SCHED
}
}
using pg8::Unit;
typedef const f32x4 (&AccRef)[2][2][4][2];

struct EpiSwiGLU {
    static constexpr bool PERM = true, RSTD = true;
    bf16_t* O; const float* SS;
    __device__ __forceinline__ void operator()(AccRef acc, const Unit& u, int wr, int wc, int fr, int fq, const LAS float* rsl) const {
        const int row0 = u.pm * 256 + wr * 64 + fr, col0 = u.pn * 128 + wc * 32 + 8 * fq;
#pragma unroll
        for (int ai = 0; ai < 2; ++ai)
#pragma unroll
            for (int m = 0; m < 4; ++m) { bf16_t* rowp = O + (size_t)(row0 + ai * 128 + m * 16) * 2816 + col0; uint4 w; const float rs = rsl[ai * 128 + wr * 64 + m * 16 + fr];
                { const f32x4 gt = rs * acc[ai][0][m][0], up = rs * acc[ai][1][m][0]; w.x = pack2(silu_f(gt[0]) * up[0], silu_f(gt[1]) * up[1]); w.y = pack2(silu_f(gt[2]) * up[2], silu_f(gt[3]) * up[3]); }
                { const f32x4 gt = rs * acc[ai][0][m][1], up = rs * acc[ai][1][m][1]; w.z = pack2(silu_f(gt[0]) * up[0], silu_f(gt[1]) * up[1]); w.w = pack2(silu_f(gt[2]) * up[2], silu_f(gt[3]) * up[3]); }
                *(uint4*)rowp = w; }
    }
};
template <bool STATS, bool XF32> struct EpiResid {
    static constexpr bool PERM = true, RSTD = false;
    const float* Xin; bf16_t* XB; float* SS; float alpha;
    __device__ __forceinline__ void operator()(AccRef acc, const Unit& u, int wr, int wc, int fr, int fq, const LAS float* rsl) const {
        const int row0 = u.pm * 256 + wr * 64 + fr, col0 = u.pn * 256 + wc * 32 + 8 * fq;
#pragma unroll
        for (int ai = 0; ai < 2; ++ai)
#pragma unroll
            for (int mp = 0; mp < 2; ++mp) {
                f32x4 xo[2][2][2];
#pragma unroll
                for (int mm = 0; mm < 2; ++mm)
#pragma unroll
                    for (int bj = 0; bj < 2; ++bj) { const size_t o = (size_t)(row0 + ai * 128 + (mp * 2 + mm) * 16) * 1024 + col0 + bj * 128;
                        if (XF32) { xo[mm][bj][0] = *(const f32x4*)(Xin + o); xo[mm][bj][1] = *(const f32x4*)(Xin + o + 4); }
                        else { const uint4 w = *(const uint4*)(XB + o); xo[mm][bj][0] = (f32x4){bflo(w.x), bfhi(w.x), bflo(w.y), bfhi(w.y)}; xo[mm][bj][1] = (f32x4){bflo(w.z), bfhi(w.z), bflo(w.w), bfhi(w.w)}; } }
#pragma unroll
                for (int mm = 0; mm < 2; ++mm) { const int m = mp * 2 + mm; const size_t ro = (size_t)(row0 + ai * 128 + m * 16) * 1024 + col0; float sq = 0.f;
#pragma unroll
                    for (int bj = 0; bj < 2; ++bj) { const size_t o = ro + bj * 128;
                        const f32x4 y0 = xo[mm][bj][0] + alpha * acc[ai][bj][m][0], y1 = xo[mm][bj][1] + alpha * acc[ai][bj][m][1];
                        uint4 w; w.x = pack2(y0[0], y0[1]); w.y = pack2(y0[2], y0[3]); w.z = pack2(y1[0], y1[1]); w.w = pack2(y1[2], y1[3]); *(uint4*)(XB + o) = w;
                        if (STATS) sq += y0[0] * y0[0] + y0[1] * y0[1] + y0[2] * y0[2] + y0[3] * y0[3] + y1[0] * y1[0] + y1[1] * y1[1] + y1[2] * y1[2] + y1[3] * y1[3]; }
                    if (STATS) { sq += __shfl_xor(sq, 16); sq += __shfl_xor(sq, 32); if (fq == 0) SS[(size_t)(row0 + ai * 128 + m * 16) * 16 + u.pn * 4 + wc] = sq; } } }
    }
};
struct EpiBf16 {
    static constexpr bool PERM = true, RSTD = true;
    bf16_t* O; int ldc; const float* SS;
    __device__ __forceinline__ void operator()(AccRef acc, const Unit& u, int wr, int wc, int fr, int fq, const LAS float* rsl) const {
        const int row0 = u.pm * 256 + wr * 64 + fr, col0 = u.pn * 256 + wc * 32 + 8 * fq;
#pragma unroll
        for (int ai = 0; ai < 2; ++ai)
#pragma unroll
            for (int m = 0; m < 4; ++m) { bf16_t* rowp = O + (size_t)(row0 + ai * 128 + m * 16) * ldc + col0; const float rs = rsl[ai * 128 + wr * 64 + m * 16 + fr];
#pragma unroll
                for (int bj = 0; bj < 2; ++bj) { const f32x4 v0 = rs * acc[ai][bj][m][0], v1 = rs * acc[ai][bj][m][1]; uint4 w; w.x = pack2(v0[0], v0[1]); w.y = pack2(v0[2], v0[3]); w.z = pack2(v1[0], v1[1]); w.w = pack2(v1[2], v1[3]);
                    *(uint4*)(rowp + bj * 128) = w; } }
    }
};
struct EpiRetIn {
    static constexpr bool PERM = true, RSTD = true;
    bf16_t* O; int ldc; const float* SS; const float* cs; const float* sn; int rowbase;
    __device__ __forceinline__ void operator()(AccRef acc, const Unit& u, int wr, int wc, int fr, int fq, const LAS float* rsl) const {
        const int row0 = u.pm * 256 + wr * 64 + fr, col0 = u.pn * 256 + wc * 32 + 8 * fq, f = 16 * wc + 4 * fq;
#pragma unroll
        for (int ai = 0; ai < 2; ++ai)
#pragma unroll
            for (int m = 0; m < 4; ++m) { const int r = row0 + ai * 128 + m * 16; bf16_t* rowp = O + (size_t)r * ldc + col0; const float rs = rsl[ai * 128 + wr * 64 + m * 16 + fr];
                f32x4 c4 = (f32x4){1.f, 1.f, 1.f, 1.f}, s4 = (f32x4){0.f, 0.f, 0.f, 0.f};
                if (u.pn < 8) { const int pos = (rowbase + r) & 8191; c4 = *(const f32x4*)(cs + pos * 64 + f); s4 = *(const f32x4*)(sn + pos * 64 + f);
                    if (u.pn >= 4) { c4 *= 0.08838834764831845f; s4 *= 0.08838834764831845f; } }
#pragma unroll
                for (int bj = 0; bj < 2; ++bj) { const f32x4 t1 = rs * acc[ai][bj][m][0], t2 = rs * acc[ai][bj][m][1]; const f32x4 v0 = t1 * c4 - t2 * s4, v1 = t1 * s4 + t2 * c4;
                    uint4 w; w.x = pack2(v0[0], v0[1]); w.y = pack2(v0[2], v0[3]); w.z = pack2(v1[0], v1[1]); w.w = pack2(v1[2], v1[3]);
                    *(uint4*)(rowp + bj * 128) = w; } }
    }
};
struct EpiWin0 {
    static constexpr bool PERM = true, RSTD = true;
    bf16_t* AS5; bf16_t* PQ; const float* SS;
    __device__ __forceinline__ void operator()(AccRef acc, const Unit& u, int wr, int wc, int fr, int fq, const LAS float* rsl) const {
        const int row0 = u.pm * 256 + wr * 64 + fr, col0 = u.pn * 256 + wc * 32 + 8 * fq;
#pragma unroll
        for (int ai = 0; ai < 2; ++ai)
#pragma unroll
            for (int m = 0; m < 4; ++m) { const int r = row0 + ai * 128 + m * 16; const float rs = rsl[ai * 128 + wr * 64 + m * 16 + fr];
#pragma unroll
                for (int bj = 0; bj < 2; ++bj) { const int c = col0 + bj * 128; const f32x4 v0 = rs * acc[ai][bj][m][0], v1 = rs * acc[ai][bj][m][1];
                    uint4 w; w.x = pack2(v0[0], v0[1]); w.y = pack2(v0[2], v0[3]); w.z = pack2(v1[0], v1[1]); w.w = pack2(v1[2], v1[3]);
                    if (u.pn < 2) *(uint4*)(AS5 + ((size_t)((c >> 4) * 1024 + (r >> 6))) * 1280 + (r & 63) * 16 + (c & 15)) = w;
                    else *(uint4*)(PQ + (size_t)r * 1792 + (c - 512)) = w; } }
    }
};
struct EpiGLU {
    static constexpr bool PERM = true, RSTD = false;
    const bf16_t* GY; bf16_t* MIX;
    __device__ __forceinline__ void operator()(AccRef acc, const Unit& u, int wr, int wc, int fr, int fq, const LAS float* rsl) const {
        const int row0 = u.pm * 256 + wr * 64 + fr, col0 = u.pn * 256 + wc * 32 + 8 * fq;
#pragma unroll
        for (int ai = 0; ai < 2; ++ai)
#pragma unroll
            for (int m = 0; m < 4; ++m) { const int r = row0 + ai * 128 + m * 16;
#pragma unroll
                for (int bj = 0; bj < 2; ++bj) { const int c = col0 + bj * 128; const f32x4 v0 = acc[ai][bj][m][0], v1 = acc[ai][bj][m][1];
                    const uint4 gy = *(const uint4*)(GY + (size_t)r * 512 + c); uint4 w;
                    w.x = pack2(bflo(gy.x) * fast_sigmoid(v0[0]), bfhi(gy.x) * fast_sigmoid(v0[1])); w.y = pack2(bflo(gy.y) * fast_sigmoid(v0[2]), bfhi(gy.y) * fast_sigmoid(v0[3]));
                    w.z = pack2(bflo(gy.z) * fast_sigmoid(v1[0]), bfhi(gy.z) * fast_sigmoid(v1[1])); w.w = pack2(bflo(gy.w) * fast_sigmoid(v1[2]), bfhi(gy.w) * fast_sigmoid(v1[3]));
                    *(uint4*)(MIX + (size_t)r * 1024 + c) = w; } }
    }
};
struct EpiS5E {
    static constexpr bool PERM = false, RSTD = false;
    float* E;
    __device__ __forceinline__ void operator()(AccRef acc, const Unit& u, int wr, int wc, int fr, int fq, const LAS float* rsl) const {
        const int row0 = u.pm * 256 + wr * 64 + fr, col0 = wc * 32 + 4 * fq;
#pragma unroll
        for (int ai = 0; ai < 2; ++ai)
#pragma unroll
            for (int m = 0; m < 4; ++m) { float* rowp = E + ((size_t)u.bz * 1024 + row0 + ai * 128 + m * 16) * 256 + col0;
#pragma unroll
                for (int bj = 0; bj < 2; ++bj)
#pragma unroll
                    for (int n = 0; n < 2; ++n) *(f32x4*)(rowp + bj * 128 + n * 16) = acc[ai][bj][m][n]; }
    }
};
struct EpiS5Y {
    static constexpr bool PERM = true, RSTD = false;
    bf16_t* GY;
    __device__ __forceinline__ void operator()(AccRef acc, const Unit& u, int wr, int wc, int fr, int fq, const LAS float* rsl) const {
        const int row0 = u.pm * 256 + wr * 64 + fr, col0 = u.pn * 256 + wc * 32 + 8 * fq;
#pragma unroll
        for (int ai = 0; ai < 2; ++ai)
#pragma unroll
            for (int m = 0; m < 4; ++m) { const int bc = row0 + ai * 128 + m * 16;
#pragma unroll
                for (int bj = 0; bj < 2; ++bj) { const int c = col0 + bj * 128; const f32x4 v0 = acc[ai][bj][m][0], v1 = acc[ai][bj][m][1]; uint4 w;
                    w.x = pack2(gelu_tanh(v0[0]), gelu_tanh(v0[1])); w.y = pack2(gelu_tanh(v0[2]), gelu_tanh(v0[3])); w.z = pack2(gelu_tanh(v1[0]), gelu_tanh(v1[1])); w.w = pack2(gelu_tanh(v1[2]), gelu_tanh(v1[3]));
                    *(uint4*)(GY + ((size_t)bc * 64 + (c >> 4)) * 512 + u.bz * 16 + (c & 15)) = w; } }
    }
};

__device__ void transpose_job(const float* __restrict__ src, int K, int Nsrc, bf16_t* __restrict__ dst, int Ndst, int mode, LAS float* tile, int b0, int nb, const float* __restrict__ gain) {
    const int tid = otid();
    const int ntk = K >> 8, nt = (Ndst >> 6) * ntk;
    for (int t = obid() - b0; t < nt; t += nb) {
        const int tn = t / ntk, tk = t % ntk, n0 = tn * 64, k0 = tk * 256;
        int ns0 = n0;
        if (mode == 1) { const int tt = n0 >> 8, j = n0 & 255; ns0 = (j < 128) ? (tt * 128 + j) : (2816 + tt * 128 + (j - 128)); }
        const int r = tid >> 4; int c4 = (tid & 15) * 4;
        const int c4d = c4;
        if (mode == 2 && n0 < 2048) { const int s_ = (n0 + c4) & 127;
            c4 = ((n0 + c4) & ~127) + 64 * ((s_ >> 2) & 1) + 16 * (s_ >> 5) + 4 * ((s_ >> 3) & 3) - n0; }
        float4 v[8];
#pragma unroll
        for (int rr = 0; rr < 8; ++rr) { v[rr] = make_float4(0.f, 0.f, 0.f, 0.f);
            if (ns0 + c4 + 3 < Nsrc) v[rr] = *(const float4*)(src + (size_t)(k0 + r + rr * 32) * Nsrc + ns0 + c4);
            if (gain) { const float gk = gain[k0 + r + rr * 32]; v[rr].x *= gk; v[rr].y *= gk; v[rr].z *= gk; v[rr].w *= gk; } }
#pragma unroll
        for (int rr = 0; rr < 8; ++rr) { const int kk = r + rr * 32; LAS float* tp = tile + (kk >> 6) * (64 * 65) + (kk & 63) * 65 + c4d;
            tp[0] = v[rr].x; tp[1] = v[rr].y; tp[2] = v[rr].z; tp[3] = v[rr].w; }
        __syncthreads();
        const int n = tid >> 3, kq = (tid & 7) * 8;
#pragma unroll
        for (int kt = 0; kt < 4; ++kt) { const LAS float* tp = tile + kt * (64 * 65); uint4 w;
            w.x = pack2(tp[(kq + 0) * 65 + n], tp[(kq + 1) * 65 + n]); w.y = pack2(tp[(kq + 2) * 65 + n], tp[(kq + 3) * 65 + n]);
            w.z = pack2(tp[(kq + 4) * 65 + n], tp[(kq + 5) * 65 + n]); w.w = pack2(tp[(kq + 6) * 65 + n], tp[(kq + 7) * 65 + n]);
            *(uint4*)(dst + (size_t)(n0 + n) * K + k0 + kt * 64 + kq) = w; }
        __syncthreads();
    }
}

__device__ void s5_pre(CP P, int g, int dir, int part, LAS unsigned char* lds) {
    LAS f32x2* pw = (LAS f32x2*)lds;
    LAS f32x2* Bb = pw + 65 * 64;
    LAS f32x2* Cc = Bb + 64 * 16;
    const int tid = otid();
    float* Ktab = (float*)(P->ws + OFF_KTAB); float* AT = (float*)(P->ws + OFF_S5P);
    bf16_t* KG = (bf16_t*)(P->ws + OFF_KG); bf16_t* H = (bf16_t*)(P->ws + OFF_H);
    if (tid < 64) { const int n = tid, gi = (dir * 32 + g) * 64 + n;
        const double lr = fmin((double)P->in[9][gi], -1e-4), li = (double)P->in[10][gi], dt = (double)expf(P->in[15][dir * 32 + g]);
        const double em1 = (double)expm1f((float)(lr * dt)), mag = 1.0 + em1;
        double rev = li * dt * 0.15915494309189535; rev -= rint(rev); const float th = (float)(rev * 6.283185307179586), thh = 0.5f * th;
        const double sn_ = (double)sinf(th), shalf = (double)sinf(thh), cm1 = -2.0 * shalf * shalf;
        const double ar = mag * (1.0 + cm1), ai = mag * sn_, arm1 = em1 + cm1 + em1 * cm1, den = lr * lr + li * li;
        const double cr = (arm1 * lr + ai * li) / den, ci = (ai * lr - arm1 * li) / den;
#pragma unroll 1
        for (int p = 0; p < 16; ++p) { const double br = (double)P->in[11][gi * 16 + p], bi = (double)P->in[12][gi * 16 + p];
            Bb[n * 16 + p] = mkf2((float)(cr * br - ci * bi), (float)(cr * bi + ci * br)); }
        double xr = 1.0, xi = 0.0;
#pragma unroll 1
        for (int d = 0; d <= 64; ++d) { pw[d * 64 + n] = mkf2((float)xr, (float)xi); const double t0 = xr * ar - xi * ai; xi = xr * ai + xi * ar; xr = t0; }
        const f32x2 a64 = pw[64 * 64 + n];
        if (part == 0) { AT[((g * 2 + dir) * 64 + n) * 2 + 0] = a64.x; AT[((g * 2 + dir) * 64 + n) * 2 + 1] = a64.y; } }
#pragma unroll 1
    for (int idx = tid; idx < 16 * 64; idx += NTHR) { const int p = idx >> 6, n = idx & 63; const int ci_ = ((dir * 32 + g) * 16 + p) * 64 + n;
        Cc[idx] = mkf2(P->in[13][ci_], P->in[14][ci_]); }
    __syncthreads();
    { const int dq = tid >> 8, p = (tid >> 4) & 15, pp = tid & 15;
#pragma unroll 1
        for (int dd = 0; dd < 16; ++dd) { const int d = part * 32 + dq * 16 + dd; float acc = 0.f;
#pragma unroll 4
            for (int n = 0; n < 64; ++n) { const f32x2 w = pw[d * 64 + n], bb = Bb[n * 16 + pp], c = Cc[p * 64 + n];
                const float zr = w.x * bb.x - w.y * bb.y, zi = w.x * bb.y + w.y * bb.x; acc += c.x * zr - c.y * zi; }
            Ktab[((size_t)((g * 2 + dir) * 64 + d)) * 256 + p * 16 + pp] = acc; } }
#pragma unroll 1
    for (int idx = tid; idx < 512 * 64; idx += NTHR) { const int row = part * 512 + (idx >> 6), n = idx & 63, t = row >> 4, p = row & 15, d = dir == 0 ? t + 1 : 64 - t;
        const f32x2 w = pw[d * 64 + n], c = Cc[p * 64 + n]; const float gr = c.x * w.x - c.y * w.y, gi = c.x * w.y + c.y * w.x;
        *(unsigned*)(KG + ((size_t)(g * 1024 + row)) * 1280 + 1024 + dir * 128 + n * 2) = pack2(gr, -gi); }
#pragma unroll 1
    for (int idx = tid; idx < 32 * 64 * 8; idx += NTHR) { const int pp2 = (idx & 7) * 2, s = (idx >> 3) & 63, n = part * 32 + (idx >> 9), d = dir == 0 ? 63 - s : s;
        const f32x2 w = pw[d * 64 + n], b0 = Bb[n * 16 + pp2], b1 = Bb[n * 16 + pp2 + 1];
        const float hr0 = w.x * b0.x - w.y * b0.y, hi0 = w.x * b0.y + w.y * b0.x, hr1 = w.x * b1.x - w.y * b1.y, hi1 = w.x * b1.y + w.y * b1.x;
        const size_t row0 = (size_t)g * 256 + dir * 128 + n * 2;
        *(unsigned*)(H + row0 * 1024 + s * 16 + pp2) = pack2(hr0, hr1); *(unsigned*)(H + (row0 + 1) * 1024 + s * 16 + pp2) = pack2(hi0, hi1); }
    __syncthreads();
}

template <bool FINAL> __device__ void phase_norm(const float* __restrict__ x, const float* __restrict__ g, bf16_t* __restrict__ xb, float* __restrict__ ss_out, float* __restrict__ outf, int b0, int nb, int rbeg, int rend);
__device__ void phase_prologue(CP P, LAS unsigned char* lds) {
    const int tid = otid(), bq = obid();
    if (bq < 128) { if (EN(20)) s5_pre(P, bq >> 2, (bq >> 1) & 1, bq & 1, lds);
        phase_norm<false>(P->in[0], nullptr, (bf16_t*)(P->ws + OFF_XN), (float*)(P->ws + OFF_SSQ), nullptr, 0, 128, 0, 40960); return; }
    const int b0 = 128, nb = (int)gridDim.x - 128;
    if (EN(21)) { float* cs = (float*)(P->ws + OFF_ROPE); float* sn = cs + 8192 * 64;
        for (int idx = (bq - b0) * NTHR + tid; idx < 8192 * 64; idx += nb * NTHR) { const int pos = idx >> 6, f = idx & 63;
            const float inv = expf(-9.210340371976184f * (float)f * (1.0f / 64.0f)); const float ang = (float)pos * inv;
            cs[idx] = cosf(ang); sn[idx] = sinf(ang); } }
    phase_norm<false>(P->in[0], nullptr, (bf16_t*)(P->ws + OFF_XN), (float*)(P->ws + OFF_SSQ), nullptr, b0, nb, 40960, 65536);
    LAS float* tile = (LAS float*)lds;
    if (EN(22)) for (int l = 0; l < 2; ++l) {
        transpose_job(P->in[2] + (size_t)l * 1024 * 5632, 1024, 5632, (bf16_t*)(P->ws + OFF_W1 + (size_t)(2 * l) * SZ_W1), 5632, 1, tile, b0, nb, P->in[1] + l * 1024);
        transpose_job(P->in[6] + (size_t)l * 1024 * 5632, 1024, 5632, (bf16_t*)(P->ws + OFF_W1 + (size_t)(2 * l + 1) * SZ_W1), 5632, 1, tile, b0, nb, P->in[5] + l * 1024);
        transpose_job(P->in[3] + (size_t)l * 2816 * 1024, 2816, 1024, (bf16_t*)(P->ws + OFF_W2 + (size_t)(2 * l) * SZ_W2), 1024, 0, tile, b0, nb, nullptr);
        transpose_job(P->in[7] + (size_t)l * 2816 * 1024, 2816, 1024, (bf16_t*)(P->ws + OFF_W2 + (size_t)(2 * l + 1) * SZ_W2), 1024, 0, tile, b0, nb, nullptr);
    }
    if (EN(22)) transpose_job(P->in[8], 1024, 2080, (bf16_t*)(P->ws + OFF_WIN0), 2304, 0, tile, b0, nb, P->in[4]);
    if (EN(22)) transpose_job(P->in[17], 512, 512, (bf16_t*)(P->ws + OFF_WGLU), 512, 0, tile, b0, nb, nullptr);
    if (EN(22)) transpose_job(P->in[21], 1024, 1024, (bf16_t*)(P->ws + OFF_WOUT0), 1024, 0, tile, b0, nb, nullptr);
    if (EN(22)) transpose_job(P->in[22], 1024, 6144, (bf16_t*)(P->ws + OFF_WIN1), 6144, 2, tile, b0, nb, P->in[4] + 1024);
    if (EN(22)) transpose_job(P->in[24], 2048, 1024, (bf16_t*)(P->ws + OFF_WOUT1), 1024, 0, tile, b0, nb, nullptr);
}

__device__ void phase_kmat(CP P) {
    const float* Ktab = (const float*)(P->ws + OFF_KTAB); bf16_t* KG = (bf16_t*)(P->ws + OFF_KG); const float* dsk = P->in[16];
    for (int idx = obid() * NTHR + otid(); idx < 32 * 1024 * 512; idx += gridDim.x * NTHR) {
        const int kp = idx & 511, row = (idx >> 9) & 1023, g = idx >> 19, t = row >> 4, p = row & 15, k = kp * 2, s = k >> 4, pp = k & 15;
        float v0 = 0.f, v1 = 0.f;
        if (s <= t) { const float* b = Ktab + ((size_t)((g * 2 + 0) * 64 + (t - s))) * 256 + p * 16 + pp; v0 += b[0]; v1 += b[1]; }
        if (s >= t) { const float* b = Ktab + ((size_t)((g * 2 + 1) * 64 + (s - t))) * 256 + p * 16 + pp; v0 += b[0]; v1 += b[1]; }
        if (s == t) { const float dv = dsk[g * 16 + p]; if (pp == p) v0 += dv; if (pp + 1 == p) v1 += dv; }
        *(unsigned*)(KG + ((size_t)(g * 1024 + row)) * 1280 + k) = pack2(v0, v1);
    }
}

template <bool FINAL>
__device__ void phase_norm(const float* __restrict__ x, const float* __restrict__ g, bf16_t* __restrict__ xb, float* __restrict__ ss_out, float* __restrict__ outf, int b0, int nb, int rbeg, int rend) {
    const int tid_ = otid(), lane = tid_ & 63, wid = tid_ >> 6; const int bq = obid() - b0;
    if (bq < 0) return;
    f32x4 gv[4];
#pragma unroll
    for (int i = 0; i < 4; ++i) gv[i] = FINAL ? *(const f32x4*)(g + (lane + 64 * i) * 4) : (f32x4){1.f, 1.f, 1.f, 1.f};
    for (int row0 = rbeg + bq * 8 + wid; row0 < rend; row0 += nb * 16) {
        const int row1 = row0 + nb * 8; const bool has1 = row1 < rend;
        const float* xr0 = x + (size_t)row0 * 1024; const float* xr1 = x + (size_t)(has1 ? row1 : row0) * 1024; f32x4 v[4], u[4]; float ss = 0.f, st = 0.f;
#pragma unroll
        for (int i = 0; i < 4; ++i) { v[i] = *(const f32x4*)(xr0 + (lane + 64 * i) * 4); u[i] = *(const f32x4*)(xr1 + (lane + 64 * i) * 4); }
#pragma unroll
        for (int i = 0; i < 4; ++i) { ss += v[i][0] * v[i][0] + v[i][1] * v[i][1] + v[i][2] * v[i][2] + v[i][3] * v[i][3]; st += u[i][0] * u[i][0] + u[i][1] * u[i][1] + u[i][2] * u[i][2] + u[i][3] * u[i][3]; }
#pragma unroll
        for (int o = 32; o > 0; o >>= 1) { ss += __shfl_xor(ss, o); st += __shfl_xor(st, o); }
#pragma unroll
        for (int rr = 0; rr < 2; ++rr) { if (rr == 1 && !has1) break; const int row = rr ? row1 : row0; const float sv = rr ? st : ss;
            if (FINAL) { const float rstd = rsqrtf(sv * (1.0f / 1024.0f) + 1e-6f);
#pragma unroll
                for (int i = 0; i < 4; ++i) *(f32x4*)(outf + (size_t)row * 1024 + (lane + 64 * i) * 4) = (rr ? u[i] : v[i]) * rstd * gv[i]; }
            else { if (lane < 16) ss_out[(size_t)row * 16 + lane] = lane == 0 ? sv : 0.f;
#pragma unroll
                for (int i = 0; i < 4; ++i) { const f32x4 y = rr ? u[i] : v[i]; uint2 w; w.x = pack2(y[0], y[1]); w.y = pack2(y[2], y[3]); *(uint2*)(xb + (size_t)row * 1024 + (lane + 64 * i) * 4) = w; } } }
    }
}

__device__ void phase_final(const bf16_t* __restrict__ xr, const float* __restrict__ g, float* __restrict__ outf) {
    const int tid_ = otid(), lane = tid_ & 63, wid = tid_ >> 6;
    f32x4 gv[4];
#pragma unroll
    for (int i = 0; i < 4; ++i) gv[i] = *(const f32x4*)(g + lane * 16 + i * 4);
    const int nb8 = (int)gridDim.x * 8;
    for (int row0 = obid() * 8 + wid; row0 < 65536; row0 += nb8 * 2) { const int row1 = row0 + nb8; const bool has1 = row1 < 65536;
        const uint4 a0 = *(const uint4*)(xr + (size_t)row0 * 1024 + lane * 16), a1 = *(const uint4*)(xr + (size_t)row0 * 1024 + lane * 16 + 8);
        const uint4 b0 = *(const uint4*)(xr + (size_t)(has1 ? row1 : row0) * 1024 + lane * 16), b1 = *(const uint4*)(xr + (size_t)(has1 ? row1 : row0) * 1024 + lane * 16 + 8);
        f32x4 v[4] = {(f32x4){bflo(a0.x), bfhi(a0.x), bflo(a0.y), bfhi(a0.y)}, (f32x4){bflo(a0.z), bfhi(a0.z), bflo(a0.w), bfhi(a0.w)}, (f32x4){bflo(a1.x), bfhi(a1.x), bflo(a1.y), bfhi(a1.y)}, (f32x4){bflo(a1.z), bfhi(a1.z), bflo(a1.w), bfhi(a1.w)}};
        f32x4 w[4] = {(f32x4){bflo(b0.x), bfhi(b0.x), bflo(b0.y), bfhi(b0.y)}, (f32x4){bflo(b0.z), bfhi(b0.z), bflo(b0.w), bfhi(b0.w)}, (f32x4){bflo(b1.x), bfhi(b1.x), bflo(b1.y), bfhi(b1.y)}, (f32x4){bflo(b1.z), bfhi(b1.z), bflo(b1.w), bfhi(b1.w)}};
        float ss = 0.f, st = 0.f;
#pragma unroll
        for (int i = 0; i < 4; ++i) { ss += v[i][0] * v[i][0] + v[i][1] * v[i][1] + v[i][2] * v[i][2] + v[i][3] * v[i][3]; st += w[i][0] * w[i][0] + w[i][1] * w[i][1] + w[i][2] * w[i][2] + w[i][3] * w[i][3]; }
#pragma unroll
        for (int o = 32; o > 0; o >>= 1) { ss += __shfl_xor(ss, o); st += __shfl_xor(st, o); }
        const float r0 = rsqrtf(ss * (1.0f / 1024.0f) + 1e-6f), r1 = rsqrtf(st * (1.0f / 1024.0f) + 1e-6f);
#pragma unroll
        for (int i = 0; i < 4; ++i) *(f32x4*)(outf + (size_t)row0 * 1024 + lane * 16 + i * 4) = v[i] * r0 * gv[i];
        if (has1) {
#pragma unroll
            for (int i = 0; i < 4; ++i) *(f32x4*)(outf + (size_t)row1 * 1024 + lane * 16 + i * 4) = w[i] * r1 * gv[i]; }
    }
}

__device__ __forceinline__ f32x4 mma16(const LAS bf16_t* As, int lda, const LAS bf16_t* Bs, int ldb, int K, f32x4 acc, int lane) {
    const int r = lane & 15, q = lane >> 4;
#pragma unroll
    for (int k = 0; k < K; k += 32) { const bf16x8 a = *(const LAS bf16x8*)(As + r * lda + k + q * 8); const bf16x8 b = *(const LAS bf16x8*)(Bs + r * ldb + k + q * 8);
        acc = __builtin_amdgcn_mfma_f32_16x16x32_bf16(b, a, acc, 0, 0, 0); }
    return acc;
}


typedef short s16x4 __attribute__((ext_vector_type(4)));
__device__ __forceinline__ bf16x8 frag_tr(const LAS bf16_t* T, int ld, int lane) {
    const int g = lane >> 4, qq = (lane & 15) >> 2, p = lane & 3;
    LAS bf16_t* a = (LAS bf16_t*)T + (8 * g + qq) * ld + 4 * p;
    const s16x4 lo = __builtin_amdgcn_ds_read_tr16_b64_v4i16((LAS s16x4*)a);
    const s16x4 hi = __builtin_amdgcn_ds_read_tr16_b64_v4i16((LAS s16x4*)(a + 4 * ld));
    return (bf16x8){lo[0], lo[1], lo[2], lo[3], hi[0], hi[1], hi[2], hi[3]};
}

__device__ __forceinline__ void lds_barrier() { asm volatile("s_waitcnt lgkmcnt(0)" ::: "memory"); __builtin_amdgcn_s_barrier(); asm volatile("" ::: "memory"); }

__device__ void phase_s5_scan(CP P) {
    const float* E = (const float*)(P->ws + OFF_E); const float* AT = (const float*)(P->ws + OFF_S5P); bf16_t* AS5 = (bf16_t*)(P->ws + OFF_AS5);
    const int tid_ = otid(); if (tid_ >= 128) return;
    for (int idx = obid() * 128 + tid_; idx < 32 * 8 * 2 * 64; idx += gridDim.x * 128) {
        const int n = idx & 63, dir = (idx >> 6) & 1, b = (idx >> 7) & 7, g = idx >> 10;
        const float ar = AT[((g * 2 + dir) * 64 + n) * 2], ai = AT[((g * 2 + dir) * 64 + n) * 2 + 1];
        float xr = 0.f, xi = 0.f;
#pragma unroll 1
        for (int c0 = 0; c0 < 128; c0 += 16) { float2 ev[16];
#pragma unroll
            for (int k = 0; k < 16; ++k) { const int c = dir == 0 ? c0 + k : 127 - (c0 + k); const size_t bc = (size_t)g * 1024 + b * 128 + c; ev[k] = *(const float2*)(E + bc * 256 + dir * 128 + n * 2); }
#pragma unroll
            for (int k = 0; k < 16; ++k) { const int c = dir == 0 ? c0 + k : 127 - (c0 + k); const size_t bc = (size_t)g * 1024 + b * 128 + c;
                *(unsigned*)(AS5 + bc * 1280 + 1024 + dir * 128 + n * 2) = pack2(xr, xi);
                const float t0 = ar * xr - ai * xi + ev[k].x; xi = ar * xi + ai * xr + ev[k].y; xr = t0; } }
    }
}

__device__ __forceinline__ void gla_gates(CP P, const bf16_t* PQ, int m0, int h, LAS unsigned char* lds) {
    LAS float* gl = (LAS float*)lds; LAS float* tot = (LAS float*)(lds + 8192); LAS float* G = (LAS float*)(lds + 17408);
    const int tid = otid();
    const int dir = tid >> 8, d = tid & 63, tq = (tid >> 6) & 3;
    { const int idx = tid * 4, t = idx >> 5, r = idx & 31; const uint2 raw = *(const uint2*)(PQ + (size_t)(m0 + t) * 1792 + 1536 + r);
        *(LAS f32x4*)(gl + idx) = (f32x4){bflo(raw.x), bfhi(raw.x), bflo(raw.y), bfhi(raw.y)}; }
    float w[16];
#pragma unroll
    for (int r = 0; r < 16; ++r) w[r] = P->in[18][(dir * 16 + r) * 256 + h * 64 + d];
    const float b = P->in[19][dir * 256 + h * 64 + d];
    lds_barrier();
    float c[16];
#pragma unroll
    for (int i = 0; i < 16; ++i) { const int t = tq * 16 + i; float z = b;
#pragma unroll
        for (int r4 = 0; r4 < 4; ++r4) { const f32x4 g4 = *(const LAS f32x4*)(gl + t * 32 + dir * 16 + r4 * 4);
            z += g4[0] * w[r4 * 4] + g4[1] * w[r4 * 4 + 1] + g4[2] * w[r4 * 4 + 2] + g4[3] * w[r4 * 4 + 3]; }
        c[i] = (fminf(z, 0.f) - __logf(1.0f + __expf(-fabsf(z)))) * (1.0f / 16.0f); }
    if (dir == 0) {
#pragma unroll
        for (int i = 1; i < 16; ++i) c[i] += c[i - 1];
        tot[(dir * 4 + tq) * 64 + d] = c[15]; }
    else {
#pragma unroll
        for (int i = 14; i >= 0; --i) c[i] += c[i + 1];
        tot[(dir * 4 + tq) * 64 + d] = c[0]; }
    lds_barrier();
    float off = 0.f;
#pragma unroll
    for (int q = 0; q < 4; ++q) { const float tv = tot[(dir * 4 + q) * 64 + d]; off += ((dir == 0) ? (q < tq) : (q > tq)) ? tv : 0.f; }
#pragma unroll
    for (int i = 0; i < 16; ++i) G[(dir * 64 + tq * 16 + i) * 64 + d] = c[i] + off;
    lds_barrier();
}

__device__ void gla_a_unit(CP P, int unit, LAS unsigned char* lds) {
    const int c = unit & 127, h = (unit >> 7) & 3, b = unit >> 9, m0 = b * 8192 + c * 64;
    const bf16_t* PQ = (const bf16_t*)(P->ws + OFF_PQ); bf16_t* GST = (bf16_t*)(P->ws + OFF_GST); float* GDEC = (float*)(P->ws + OFF_GDEC);
    const int tid = otid(), lane = tid & 63, wid = tid >> 6;
    const int t = tid >> 3, d8 = (tid & 7) * 8, v16 = (tid & 7) * 16;
    const uint4 kraw = *(const uint4*)(PQ + (size_t)(m0 + t) * 1792 + 256 + h * 64 + d8);
    const uint4 vr0 = *(const uint4*)(PQ + (size_t)(m0 + t) * 1792 + 512 + h * 128 + v16), vr1 = *(const uint4*)(PQ + (size_t)(m0 + t) * 1792 + 512 + h * 128 + v16 + 8);
    gla_gates(P, PQ, m0, h, lds);
    LAS float* G = (LAS float*)(lds + 17408);
    LAS bf16_t* kA = (LAS bf16_t*)(lds + 50176);
    LAS bf16_t* Vs = (LAS bf16_t*)(lds + 67584);
    { const unsigned rw[4] = {kraw.x, kraw.y, kraw.z, kraw.w}; float ef[8], eb[8];
#pragma unroll
        for (int q = 0; q < 2; ++q) { const f32x4 lf = *(const LAS f32x4*)(G + 63 * 64 + d8 + q * 4), cf = *(const LAS f32x4*)(G + t * 64 + d8 + q * 4);
            const f32x4 lb = *(const LAS f32x4*)(G + 64 * 64 + d8 + q * 4), cb = *(const LAS f32x4*)(G + (64 + t) * 64 + d8 + q * 4);
#pragma unroll
            for (int j = 0; j < 4; ++j) { ef[q * 4 + j] = __expf(lf[j] - cf[j]); eb[q * 4 + j] = __expf(lb[j] - cb[j]); } }
        unsigned of[4], ob[4];
#pragma unroll
        for (int i = 0; i < 4; ++i) { const float k0 = bflo(rw[i]), k1 = bfhi(rw[i]); of[i] = pack2(k0 * ef[2 * i], k1 * ef[2 * i + 1]); ob[i] = pack2(k0 * eb[2 * i], k1 * eb[2 * i + 1]); }
        *(LAS u32x4*)(kA + t * 136 + d8) = mk4(of[0], of[1], of[2], of[3]); *(LAS u32x4*)(kA + t * 136 + 64 + d8) = mk4(ob[0], ob[1], ob[2], ob[3]);
        *(LAS u32x4*)(Vs + t * 136 + v16) = mk4(vr0.x, vr0.y, vr0.z, vr0.w); *(LAS u32x4*)(Vs + t * 136 + v16 + 8) = mk4(vr1.x, vr1.y, vr1.z, vr1.w); }
    if (tid < 128) { const int dir = tid >> 6, d = tid & 63; const float last = dir == 0 ? G[63 * 64 + d] : G[64 * 64 + d];
        GDEC[((size_t)(((b * 4 + h) * 2 + dir) * 128 + c)) * 64 + d] = __expf(last); }
    lds_barrier();
    { f32x4 acc[8];
#pragma unroll
        for (int nt = 0; nt < 8; ++nt) acc[nt] = (f32x4){0.f, 0.f, 0.f, 0.f};
#pragma unroll
        for (int ks = 0; ks < 2; ++ks) { const bf16x8 af = frag_tr(kA + ks * 32 * 136 + wid * 16, 136, lane);
#pragma unroll
            for (int nt = 0; nt < 8; ++nt) { const bf16x8 bfr = frag_tr(Vs + ks * 32 * 136 + nt * 16, 136, lane); acc[nt] = __builtin_amdgcn_mfma_f32_16x16x32_bf16(bfr, af, acc[nt], 0, 0, 0); } }
        const int row = wid * 16 + (lane & 15), dir = row >> 6, d = row & 63; bf16_t* out = GST + ((size_t)(((b * 4 + h) * 2 + dir) * 128 + c)) * 8192 + d * 128 + 4 * (lane >> 4);
#pragma unroll
        for (int nt = 0; nt < 8; ++nt) { uint2 w; w.x = pack2(acc[nt][0], acc[nt][1]); w.y = pack2(acc[nt][2], acc[nt][3]); *(uint2*)(out + nt * 16) = w; } }
    lds_barrier();
}

__device__ void phase_gla_b(CP P) {
    bf16_t* GST = (bf16_t*)(P->ws + OFF_GST); const float* GDEC = (const float*)(P->ws + OFF_GDEC);
    for (int idx = obid() * NTHR + otid(); idx < 64 * 1024; idx += gridDim.x * NTHR) {
        const int bhd = idx >> 10, e = (idx & 1023) * 8, d = e >> 7, dir = bhd & 1;
        f32x4 S0 = (f32x4){0.f, 0.f, 0.f, 0.f}, S1 = S0;
        bf16_t* base = GST + ((size_t)bhd * 128) * 8192 + e; const float* dbase = GDEC + ((size_t)bhd * 128) * 64 + d;
#pragma unroll 1
        for (int c0 = 0; c0 < 128; c0 += 8) { uint4 t[8]; float dc[8];
#pragma unroll
            for (int k = 0; k < 8; ++k) { const int c = dir == 0 ? c0 + k : 127 - (c0 + k); t[k] = *(const uint4*)(base + (size_t)c * 8192); dc[k] = dbase[(size_t)c * 64]; }
#pragma unroll
            for (int k = 0; k < 8; ++k) { const int c = dir == 0 ? c0 + k : 127 - (c0 + k);
                uint4 o; o.x = pack2(S0[0], S0[1]); o.y = pack2(S0[2], S0[3]); o.z = pack2(S1[0], S1[1]); o.w = pack2(S1[2], S1[3]); *(uint4*)(base + (size_t)c * 8192) = o;
                S0 = dc[k] * S0 + (f32x4){bflo(t[k].x), bfhi(t[k].x), bflo(t[k].y), bfhi(t[k].y)}; S1 = dc[k] * S1 + (f32x4){bflo(t[k].z), bfhi(t[k].z), bflo(t[k].w), bfhi(t[k].w)}; } }
    }
}

__device__ void gla_c_unit(CP P, int unit, LAS unsigned char* lds) {
    const int c = unit & 127, h = (unit >> 7) & 3, b = unit >> 9, m0 = b * 8192 + c * 64;
    const bf16_t* PQ = (const bf16_t*)(P->ws + OFF_PQ); const bf16_t* GST = (const bf16_t*)(P->ws + OFF_GST); bf16_t* MIX = (bf16_t*)(P->ws + OFF_MIX);
    const int tid = otid(), lane = tid & 63, wid = tid >> 6;
    const int t = tid >> 3, d8 = (tid & 7) * 8, v16 = (tid & 7) * 16;
    const uint4 rq = *(const uint4*)(PQ + (size_t)(m0 + t) * 1792 + h * 64 + d8), rk = *(const uint4*)(PQ + (size_t)(m0 + t) * 1792 + 256 + h * 64 + d8);
    const uint4 vr0 = *(const uint4*)(PQ + (size_t)(m0 + t) * 1792 + 512 + h * 128 + v16), vr1 = *(const uint4*)(PQ + (size_t)(m0 + t) * 1792 + 512 + h * 128 + v16 + 8);
    const uint4 ogr0 = *(const uint4*)(PQ + (size_t)(m0 + t) * 1792 + 1024 + h * 128 + v16), ogr1 = *(const uint4*)(PQ + (size_t)(m0 + t) * 1792 + 1024 + h * 128 + v16 + 8);
    uint4 sr[4];
#pragma unroll
    for (int i = 0; i < 4; ++i) { const int idx = tid + i * NTHR, v8 = (idx & 15) * 8, d = (idx >> 4) & 63, dir = idx >> 10;
        sr[i] = *(const uint4*)(GST + ((size_t)(((b * 4 + h) * 2 + dir) * 128 + c)) * 8192 + d * 128 + v8); }
    gla_gates(P, PQ, m0, h, lds);
    LAS float* G = (LAS float*)(lds + 17408);
    LAS bf16_t* Ps = (LAS bf16_t*)lds;
    LAS bf16_t* qf = (LAS bf16_t*)(lds + 51200);
    LAS bf16_t* kf = qf + 64 * 72; LAS bf16_t* qb = kf + 64 * 72; LAS bf16_t* kb = qb + 64 * 72;
    LAS bf16_t* Vs = (LAS bf16_t*)(lds + 88064);
    LAS bf16_t* Ss = (LAS bf16_t*)(lds + 105472);
    { const unsigned qw[4] = {rq.x, rq.y, rq.z, rq.w}, kw[4] = {rk.x, rk.y, rk.z, rk.w};
        unsigned oqf[4], okf[4], oqb[4], okb[4]; float cf[8], cb[8];
#pragma unroll
        for (int q = 0; q < 2; ++q) { const f32x4 a = *(const LAS f32x4*)(G + t * 64 + d8 + q * 4), bb = *(const LAS f32x4*)(G + (64 + t) * 64 + d8 + q * 4);
#pragma unroll
            for (int j = 0; j < 4; ++j) { cf[q * 4 + j] = a[j]; cb[q * 4 + j] = bb[j]; } }
#pragma unroll
        for (int i = 0; i < 4; ++i) { const float cf0 = cf[2 * i], cf1 = cf[2 * i + 1], cb0 = cb[2 * i], cb1 = cb[2 * i + 1];
            const float q0 = bflo(qw[i]) * 0.125f, q1 = bfhi(qw[i]) * 0.125f, k0 = bflo(kw[i]), k1 = bfhi(kw[i]);
            oqf[i] = pack2(q0 * __expf(cf0), q1 * __expf(cf1)); okf[i] = pack2(k0 * __expf(-cf0), k1 * __expf(-cf1));
            oqb[i] = pack2(q0 * __expf(cb0), q1 * __expf(cb1)); okb[i] = pack2(k0 * __expf(-cb0), k1 * __expf(-cb1)); }
        *(LAS u32x4*)(qf + t * 72 + d8) = mk4(oqf[0], oqf[1], oqf[2], oqf[3]); *(LAS u32x4*)(kf + t * 72 + d8) = mk4(okf[0], okf[1], okf[2], okf[3]);
        *(LAS u32x4*)(qb + t * 72 + d8) = mk4(oqb[0], oqb[1], oqb[2], oqb[3]); *(LAS u32x4*)(kb + t * 72 + d8) = mk4(okb[0], okb[1], okb[2], okb[3]);
        *(LAS u32x4*)(Vs + t * 136 + v16) = mk4(vr0.x, vr0.y, vr0.z, vr0.w); *(LAS u32x4*)(Vs + t * 136 + v16 + 8) = mk4(vr1.x, vr1.y, vr1.z, vr1.w); }
#pragma unroll
    for (int i = 0; i < 4; ++i) { const int idx = tid + i * NTHR, v8 = (idx & 15) * 8, d = (idx >> 4) & 63, dir = idx >> 10;
        *(LAS u32x4*)(Ss + (dir * 64 + d) * 136 + v8) = mk4(sr[i].x, sr[i].y, sr[i].z, sr[i].w); }
    lds_barrier();
#pragma unroll
    for (int tl = 0; tl < 2; ++tl) { const int tile = wid * 2 + tl, mi = tile >> 2, ni = tile & 3; f32x4 pf = (f32x4){0.f, 0.f, 0.f, 0.f}, pb = pf;
        pf = mma16(qf + mi * 16 * 72, 72, kf + ni * 16 * 72, 72, 64, pf, lane); pb = mma16(qb + mi * 16 * 72, 72, kb + ni * 16 * 72, 72, 64, pb, lane);
        const int i = mi * 16 + (lane & 15), j0 = ni * 16 + 4 * (lane >> 4); float pv[4];
#pragma unroll
        for (int jj = 0; jj < 4; ++jj) pv[jj] = (j0 + jj <= i) ? pf[jj] : pb[jj];
        *(LAS u32x2*)(Ps + i * 72 + j0) = mk2(pack2(pv[0], pv[1]), pack2(pv[2], pv[3])); }
    lds_barrier();
    { const int mi = wid & 3, nb = (wid >> 2) * 4; LAS float* ost = G; f32x4 acc[4];
#pragma unroll
        for (int nt = 0; nt < 4; ++nt) acc[nt] = (f32x4){0.f, 0.f, 0.f, 0.f};
#pragma unroll
        for (int ks = 0; ks < 2; ++ks) {
            const bf16x8 ap = *(const LAS bf16x8*)(Ps + (mi * 16 + (lane & 15)) * 72 + ks * 32 + (lane >> 4) * 8);
            const bf16x8 af = *(const LAS bf16x8*)(qf + (mi * 16 + (lane & 15)) * 72 + ks * 32 + (lane >> 4) * 8);
            const bf16x8 ab = *(const LAS bf16x8*)(qb + (mi * 16 + (lane & 15)) * 72 + ks * 32 + (lane >> 4) * 8);
#pragma unroll
            for (int nt = 0; nt < 4; ++nt) { const int ni = nb + nt;
                acc[nt] = __builtin_amdgcn_mfma_f32_16x16x32_bf16(frag_tr(Vs + ks * 32 * 136 + ni * 16, 136, lane), ap, acc[nt], 0, 0, 0);
                acc[nt] = __builtin_amdgcn_mfma_f32_16x16x32_bf16(frag_tr(Ss + ks * 32 * 136 + ni * 16, 136, lane), af, acc[nt], 0, 0, 0);
                acc[nt] = __builtin_amdgcn_mfma_f32_16x16x32_bf16(frag_tr(Ss + (64 + ks * 32) * 136 + ni * 16, 136, lane), ab, acc[nt], 0, 0, 0); } }
#pragma unroll
        for (int nt = 0; nt < 4; ++nt) *(LAS f32x4*)(ost + (mi * 16 + (lane & 15)) * 132 + (nb + nt) * 16 + 4 * (lane >> 4)) = acc[nt]; }
    lds_barrier();
    { LAS float* ost = G; float o[16]; float ss = 0.f;
#pragma unroll
        for (int i = 0; i < 4; ++i) { const f32x4 v = *(const LAS f32x4*)(ost + t * 132 + v16 + i * 4); o[4 * i] = v[0]; o[4 * i + 1] = v[1]; o[4 * i + 2] = v[2]; o[4 * i + 3] = v[3]; ss += v[0] * v[0] + v[1] * v[1] + v[2] * v[2] + v[3] * v[3]; }
        ss += __shfl_xor(ss, 1); ss += __shfl_xor(ss, 2); ss += __shfl_xor(ss, 4);
        const float rstd = rsqrtf(ss * (1.0f / 128.0f) + 1e-6f);
        const float* gn = P->in[20] + h * 128 + v16;
        bf16_t* op = MIX + (size_t)(m0 + t) * 1024 + 512 + h * 128 + v16;
#pragma unroll
        for (int hh = 0; hh < 2; ++hh) { const uint4 raw = hh ? ogr1 : ogr0; const unsigned rw[4] = {raw.x, raw.y, raw.z, raw.w}; unsigned ow[4];
#pragma unroll
            for (int i = 0; i < 4; ++i) { const int e = hh * 8 + 2 * i; const float g0 = bflo(rw[i]), g1 = bfhi(rw[i]);
                ow[i] = pack2(o[e] * rstd * gn[e] * silu_f(g0), o[e + 1] * rstd * gn[e + 1] * silu_f(g1)); }
            *(uint4*)(op + hh * 8) = make_uint4(ow[0], ow[1], ow[2], ow[3]); } }
    lds_barrier();
}

__device__ __forceinline__ float ret_lg(int h) {
    float v = -0.0317486983145803f;
    v = h == 1 ? -0.015748356968139168f : v; v = h == 2 ? -0.007843177461025893f : v; v = h == 3 ? -0.003913899321136329f : v; v = h == 4 ? -0.0019550348358033506f : v;
    v = h == 5 ? -0.0009770396478266127f : v; v = h == 6 ? -0.0004884004981088745f : v; v = h == 7 ? -0.0002441704321739145f : v; return v;
}

struct KRaw { uint4 a, b; };
__device__ __forceinline__ KRaw rot_load(const bf16_t* rowp, const float*, const float*, int dq) { KRaw k; k.a = *(const uint4*)(rowp + dq); k.b = *(const uint4*)(rowp + 64 + dq); return k; }
__device__ __forceinline__ void rot_apply(const KRaw& k, float (&r1)[8], float (&r2)[8]) {
    const unsigned aw[4] = {k.a.x, k.a.y, k.a.z, k.a.w}, bw[4] = {k.b.x, k.b.y, k.b.z, k.b.w};
#pragma unroll
    for (int i = 0; i < 8; ++i) { r1[i] = (i & 1) ? bfhi(aw[i >> 1]) : bflo(aw[i >> 1]); r2[i] = (i & 1) ? bfhi(bw[i >> 1]) : bflo(bw[i >> 1]); }
}

__device__ void ret_a_unit(CP P, int hf, int unit, LAS unsigned char* lds) {
    const int sc = unit & 31, h = (unit >> 5) & 7, bl = unit >> 8;
    const bf16_t* PR = (const bf16_t*)(P->ws + OFF_PROJ1); bf16_t* RST = (bf16_t*)(P->ws + OFF_RST);
    const int tid = otid(), lane = tid & 63, wid = tid >> 6;
    const size_t r0 = (size_t)bl * 8192 + sc * 256;
    const float lgf = ret_lg(h), lgb = ret_lg(7 - h);
    LAS bf16_t* kf = (LAS bf16_t*)lds;
    LAS bf16_t* kb = (LAS bf16_t*)(lds + 17408);
    LAS bf16_t* Vs = (LAS bf16_t*)(lds + 34816);
    f32x4 acc[4][8];
#pragma unroll
    for (int a = 0; a < 4; ++a)
#pragma unroll
        for (int n = 0; n < 8; ++n) acc[a][n] = (f32x4){0.f, 0.f, 0.f, 0.f};
    const int mb = (wid >> 1) * 4, nb = (wid & 1) * 8;
    const LAS bf16_t* kA = (mb >= 8) ? kb : kf; const int dt0 = (mb & 7) * 16;
    const int pj = tid >> 3, pdq = (tid & 7) * 8, pv32 = (tid & 7) * 32;
    const bf16_t* kbase = PR + (r0 + pj) * 6144 + 1024 + h * 128; const bf16_t* vbase = PR + (r0 + pj) * 6144 + 2048 + h * 256 + pv32;
    KRaw kr = rot_load(kbase, nullptr, nullptr, pdq);
    uint4 vr[4];
#pragma unroll
    for (int hh = 0; hh < 4; ++hh) vr[hh] = *(const uint4*)(vbase + hh * 8);
    for (int jb = 0; jb < 4; ++jb) {
        { const int j = pj, dq = pdq, J = jb * 64 + j; float r1[8], r2[8];
            rot_apply(kr, r1, r2);
            const float sf = __expf((float)(255 - J) * lgf), sb = __expf((float)J * lgb);
            *(LAS u32x4*)(kf + j * 136 + dq) = mk4(pack2(r1[0] * sf, r1[1] * sf), pack2(r1[2] * sf, r1[3] * sf), pack2(r1[4] * sf, r1[5] * sf), pack2(r1[6] * sf, r1[7] * sf));
            *(LAS u32x4*)(kf + j * 136 + 64 + dq) = mk4(pack2(r2[0] * sf, r2[1] * sf), pack2(r2[2] * sf, r2[3] * sf), pack2(r2[4] * sf, r2[5] * sf), pack2(r2[6] * sf, r2[7] * sf));
            *(LAS u32x4*)(kb + j * 136 + dq) = mk4(pack2(r1[0] * sb, r1[1] * sb), pack2(r1[2] * sb, r1[3] * sb), pack2(r1[4] * sb, r1[5] * sb), pack2(r1[6] * sb, r1[7] * sb));
            *(LAS u32x4*)(kb + j * 136 + 64 + dq) = mk4(pack2(r2[0] * sb, r2[1] * sb), pack2(r2[2] * sb, r2[3] * sb), pack2(r2[4] * sb, r2[5] * sb), pack2(r2[6] * sb, r2[7] * sb));
#pragma unroll
            for (int hh = 0; hh < 4; ++hh) *(LAS u32x4*)(Vs + j * 264 + pv32 + hh * 8) = mk4(vr[hh].x, vr[hh].y, vr[hh].z, vr[hh].w); }
        lds_barrier();
        if (jb < 3) { kr = rot_load(kbase + (size_t)(jb + 1) * 64 * 6144, nullptr, nullptr, pdq);
#pragma unroll
            for (int hh = 0; hh < 4; ++hh) vr[hh] = *(const uint4*)(vbase + (size_t)(jb + 1) * 64 * 6144 + hh * 8); }
#pragma unroll
        for (int ks = 0; ks < 2; ++ks) { bf16x8 af[4];
#pragma unroll
            for (int a = 0; a < 4; ++a) af[a] = frag_tr(kA + ks * 32 * 136 + dt0 + a * 16, 136, lane);
#pragma unroll
            for (int n = 0; n < 8; ++n) { const bf16x8 bfr = frag_tr(Vs + ks * 32 * 264 + (nb + n) * 16, 264, lane);
#pragma unroll
                for (int a = 0; a < 4; ++a) acc[a][n] = __builtin_amdgcn_mfma_f32_16x16x32_bf16(bfr, af[a], acc[a][n], 0, 0, 0); } }
        lds_barrier();
    }
#pragma unroll
    for (int a = 0; a < 4; ++a) { const int row = (mb + a) * 16 + (lane & 15), dir = row >> 7, d = row & 127;
        bf16_t* out = RST + ((size_t)(((bl * 8 + h) * 2 + dir) * 32 + sc)) * 32768 + d * 256 + 4 * (lane >> 4);
#pragma unroll
        for (int n = 0; n < 8; ++n) { uint2 w; w.x = pack2(acc[a][n][0], acc[a][n][1]); w.y = pack2(acc[a][n][2], acc[a][n][3]); *(uint2*)(out + (nb + n) * 16) = w; } }
}

__device__ void phase_ret_b(CP P) {
    bf16_t* RST = (bf16_t*)(P->ws + OFF_RST);
    for (int idx = obid() * NTHR + otid(); idx < 64 * 4096; idx += gridDim.x * NTHR) {
        const int bhd = idx >> 12, e = (idx & 4095) * 8, dir = bhd & 1, h = (bhd >> 1) & 7;
        const float dec = __expf(256.0f * ret_lg(dir == 0 ? h : 7 - h));
        f32x4 S0 = (f32x4){0.f, 0.f, 0.f, 0.f}, S1 = S0;
        bf16_t* base = RST + ((size_t)bhd * 32) * 32768 + e;
#pragma unroll 1
        for (int c0 = 0; c0 < 32; c0 += 8) { uint4 t[8];
#pragma unroll
            for (int k = 0; k < 8; ++k) { const int c = dir == 0 ? c0 + k : 31 - (c0 + k); t[k] = *(const uint4*)(base + (size_t)c * 32768); }
#pragma unroll
            for (int k = 0; k < 8; ++k) { const int c = dir == 0 ? c0 + k : 31 - (c0 + k);
                uint4 o; o.x = pack2(S0[0], S0[1]); o.y = pack2(S0[2], S0[3]); o.z = pack2(S1[0], S1[1]); o.w = pack2(S1[2], S1[3]); *(uint4*)(base + (size_t)c * 32768) = o;
                S0 = dec * S0 + (f32x4){bflo(t[k].x), bfhi(t[k].x), bflo(t[k].y), bfhi(t[k].y)}; S1 = dec * S1 + (f32x4){bflo(t[k].z), bfhi(t[k].z), bflo(t[k].w), bfhi(t[k].w)}; } }
    }
}

__device__ void ret_c_unit(CP P, int hf, int unit, LAS unsigned char* lds) {
    const int rh = (unit >> 3) & 1, ur = (unit & 7) | ((unit >> 4) << 3), sc = ur & 31, h = (ur >> 5) & 7, bl = ur >> 8;
    const bf16_t* PR = (const bf16_t*)(P->ws + OFF_PROJ1); const bf16_t* RST = (const bf16_t*)(P->ws + OFF_RST);
    const float* cs = (const float*)(P->ws + OFF_ROPE); const float* sn = cs + 8192 * 64;
    const int tid = otid(), lane = tid & 63, wid = tid >> 6;
    const size_t r0 = (size_t)bl * 8192 + sc * 256;
    const float lgf = ret_lg(h), lgb = ret_lg(7 - h);
    LAS bf16_t* qs = (LAS bf16_t*)lds;
    LAS bf16_t* ks = (LAS bf16_t*)(lds + 34816);
    LAS bf16_t* Ps = (LAS bf16_t*)(lds + 52224);
    LAS bf16_t* Vs = (LAS bf16_t*)(lds + 70656);
    LAS float* red = (LAS float*)(lds + 104448);
    LAS bf16_t* qx = ks;
#pragma unroll
    for (int rep = 0; rep < 2; ++rep) { const int i = (tid >> 3) + rep * 64, dq = (tid & 7) * 8, I = rh * 128 + i;
        const KRaw q_ = rot_load(PR + (r0 + I) * 6144 + h * 128, nullptr, nullptr, dq);
        *(LAS u32x4*)(qs + i * 136 + dq) = mk4(q_.a.x, q_.a.y, q_.a.z, q_.a.w); *(LAS u32x4*)(qs + i * 136 + 64 + dq) = mk4(q_.b.x, q_.b.y, q_.b.z, q_.b.w); }
    f32x4 acc[2][8];
#pragma unroll
    for (int r = 0; r < 2; ++r)
#pragma unroll
        for (int n = 0; n < 8; ++n) acc[r][n] = (f32x4){0.f, 0.f, 0.f, 0.f};
    const int mi2 = (wid & 3) * 2, nb = (wid >> 2) * 8;
    const int pj = tid >> 3, pdq = (tid & 7) * 8, pv32 = (tid & 7) * 32;
    const bf16_t* kbase = PR + (r0 + pj) * 6144 + 1024 + h * 128; const bf16_t* vbase = PR + (r0 + pj) * 6144 + 2048 + h * 256 + pv32;
    KRaw kr = rot_load(kbase, cs + (sc * 256 + pj) * 64, sn + (sc * 256 + pj) * 64, pdq);
    uint4 vr[4];
#pragma unroll
    for (int hh = 0; hh < 4; ++hh) vr[hh] = *(const uint4*)(vbase + hh * 8);
    uint4 st[4];
    const bf16_t* sbase = RST + ((size_t)((bl * 8 + h) * 2) * 32 + sc) * 32768;
    for (int kb = 0; kb < 4; ++kb) {
        { const int j = pj, dq = pdq;
            *(LAS u32x4*)(ks + j * 136 + dq) = mk4(kr.a.x, kr.a.y, kr.a.z, kr.a.w); *(LAS u32x4*)(ks + j * 136 + 64 + dq) = mk4(kr.b.x, kr.b.y, kr.b.z, kr.b.w);
#pragma unroll
            for (int hh = 0; hh < 4; ++hh) *(LAS u32x4*)(Vs + j * 264 + pv32 + hh * 8) = mk4(vr[hh].x, vr[hh].y, vr[hh].z, vr[hh].w); }
        lds_barrier();
        if (kb < 3) { const int J = (kb + 1) * 64 + pj; kr = rot_load(kbase + (size_t)(kb + 1) * 64 * 6144, cs + (sc * 256 + J) * 64, sn + (sc * 256 + J) * 64, pdq);
#pragma unroll
            for (int hh = 0; hh < 4; ++hh) vr[hh] = *(const uint4*)(vbase + (size_t)(kb + 1) * 64 * 6144 + hh * 8); }
        else {
#pragma unroll
            for (int i = 0; i < 4; ++i) { const int idx = tid + i * NTHR, v8 = (idx & 31) * 8, dd = idx >> 5; st[i] = *(const uint4*)(sbase + dd * 256 + v8); } }
#pragma unroll
        for (int tr = 0; tr < 2; ++tr)
#pragma unroll
            for (int tc = 0; tc < 2; ++tc) { const int ti = mi2 + tr, tj = (wid >> 2) * 2 + tc; f32x4 s = (f32x4){0.f, 0.f, 0.f, 0.f};
                s = mma16(qs + ti * 16 * 136, 136, ks + tj * 16 * 136, 136, 128, s, lane);
                const int i = ti * 16 + (lane & 15), j0 = tj * 16 + 4 * (lane >> 4), I = rh * 128 + i; float pv[4];
#pragma unroll
                for (int jj = 0; jj < 4; ++jj) { const int df = I - (kb * 64 + j0 + jj); const float dm = df >= 0 ? __expf((float)df * lgf) : __expf((float)(-df) * lgb); pv[jj] = s[jj] * dm; }
                *(LAS u32x2*)(Ps + i * 72 + j0) = mk2(pack2(pv[0], pv[1]), pack2(pv[2], pv[3])); }
        lds_barrier();
#pragma unroll
        for (int k2 = 0; k2 < 2; ++k2) { bf16x8 af[2], bfr[8];
#pragma unroll
            for (int r = 0; r < 2; ++r) af[r] = *(const LAS bf16x8*)(Ps + ((mi2 + r) * 16 + (lane & 15)) * 72 + k2 * 32 + (lane >> 4) * 8);
#pragma unroll
            for (int n = 0; n < 8; ++n) bfr[n] = frag_tr(Vs + k2 * 32 * 264 + (nb + n) * 16, 264, lane);
#pragma unroll
            for (int r = 0; r < 2; ++r)
#pragma unroll
                for (int n = 0; n < 8; ++n) acc[r][n] = __builtin_amdgcn_mfma_f32_16x16x32_bf16(bfr[n], af[r], acc[r][n], 0, 0, 0); }
        lds_barrier();
    }
    uint2 ogr[2][8];
#pragma unroll
    for (int r = 0; r < 2; ++r) { const bf16_t* ogp = PR + (r0 + rh * 128 + (mi2 + r) * 16 + (lane & 15)) * 6144 + 4096 + h * 256 + 4 * (lane >> 4);
#pragma unroll
        for (int n = 0; n < 8; ++n) ogr[r][n] = *(const uint2*)(ogp + (nb + n) * 16); }
    for (int sl = 0; sl < 4; ++sl) { const int dir = sl >> 1, dh = sl & 1;
        if (dh == 0) { const int i = tid >> 2, c32 = (tid & 3) * 32, I = rh * 128 + i; const float xs = dir == 0 ? __expf((float)(I + 1) * lgf) : __expf((float)(256 - I) * lgb);
#pragma unroll
            for (int hh = 0; hh < 4; ++hh) { const u32x4 w = *(const LAS u32x4*)(qs + i * 136 + c32 + hh * 8);
                *(LAS u32x4*)(qx + i * 136 + c32 + hh * 8) = mk4(pack2(bflo(w[0]) * xs, bfhi(w[0]) * xs), pack2(bflo(w[1]) * xs, bfhi(w[1]) * xs), pack2(bflo(w[2]) * xs, bfhi(w[2]) * xs), pack2(bflo(w[3]) * xs, bfhi(w[3]) * xs)); } }
#pragma unroll
        for (int i = 0; i < 4; ++i) { const int idx = tid + i * NTHR, v8 = (idx & 31) * 8, dd = idx >> 5; *(LAS u32x4*)(Vs + dd * 264 + v8) = mk4(st[i].x, st[i].y, st[i].z, st[i].w); }
        lds_barrier();
        if (sl < 3) { const int nd = (sl + 1) >> 1, nh = (sl + 1) & 1; const bf16_t* sp = sbase + (size_t)nd * 32 * 32768 + (size_t)nh * 64 * 256;
#pragma unroll
            for (int i = 0; i < 4; ++i) { const int idx = tid + i * NTHR, v8 = (idx & 31) * 8, dd = idx >> 5; st[i] = *(const uint4*)(sp + dd * 256 + v8); } }
#pragma unroll
        for (int k2 = 0; k2 < 2; ++k2) { bf16x8 af[2], bfr[8];
#pragma unroll
            for (int r = 0; r < 2; ++r) af[r] = *(const LAS bf16x8*)(qx + ((mi2 + r) * 16 + (lane & 15)) * 136 + dh * 64 + k2 * 32 + (lane >> 4) * 8);
#pragma unroll
            for (int n = 0; n < 8; ++n) bfr[n] = frag_tr(Vs + k2 * 32 * 264 + (nb + n) * 16, 264, lane);
#pragma unroll
            for (int r = 0; r < 2; ++r)
#pragma unroll
                for (int n = 0; n < 8; ++n) acc[r][n] = __builtin_amdgcn_mfma_f32_16x16x32_bf16(bfr[n], af[r], acc[r][n], 0, 0, 0); }
        lds_barrier();
    }
    { float ss[2];
#pragma unroll
        for (int r = 0; r < 2; ++r) { ss[r] = 0.f;
#pragma unroll
            for (int n = 0; n < 8; ++n) ss[r] += acc[r][n][0] * acc[r][n][0] + acc[r][n][1] * acc[r][n][1] + acc[r][n][2] * acc[r][n][2] + acc[r][n][3] * acc[r][n][3];
            ss[r] += __shfl_xor(ss[r], 16); ss[r] += __shfl_xor(ss[r], 32);
            if ((lane >> 4) == 0) red[((mi2 + r) * 16 + (lane & 15)) * 2 + (wid >> 2)] = ss[r]; }
        lds_barrier();
#pragma unroll
        for (int r = 0; r < 2; ++r) { const int i = (mi2 + r) * 16 + (lane & 15);
            const float rstd = rsqrtf((red[i * 2] + red[i * 2 + 1]) * (1.0f / 256.0f) + 1e-6f);
            const float* gn = P->in[23] + h * 256 + 4 * (lane >> 4);
            bf16_t* op = (bf16_t*)(P->ws + OFF_OBUF) + (r0 + rh * 128 + i) * 2048 + h * 256 + 4 * (lane >> 4);
#pragma unroll
            for (int n = 0; n < 8; ++n) { const int v = (nb + n) * 16; const uint2 og = ogr[r][n]; const f32x4 g4 = *(const f32x4*)(gn + v);
                uint2 w; w.x = pack2(acc[r][n][0] * rstd * g4[0] * silu_f(bflo(og.x)), acc[r][n][1] * rstd * g4[1] * silu_f(bfhi(og.x)));
                w.y = pack2(acc[r][n][2] * rstd * g4[2] * silu_f(bflo(og.y)), acc[r][n][3] * rstd * g4[3] * silu_f(bfhi(og.y)));
                *(uint2*)(op + v) = w; } } }
    lds_barrier();
}

#define XB_TMO      128
#define XB_XCNT(j)  (256  + 64 * (j))
#define XB_XSUB(j)  (1280 + 64 * (j))
#define XB_XGEN(j)  (2304 + 64 * (j))
#define XB_TOP      3328
#define XB_TOPGEN   3392
#define XCD_BAR_WORDS 3456
#define XB_SPIN_CAP (1u << 18)
__device__ __forceinline__ unsigned xb_ld(unsigned* p)              { return __hip_atomic_load(p, __ATOMIC_RELAXED, __HIP_MEMORY_SCOPE_AGENT); }
__device__ __forceinline__ unsigned xb_add(unsigned* p, unsigned v) { return __hip_atomic_fetch_add(p, v, __ATOMIC_RELAXED, __HIP_MEMORY_SCOPE_AGENT); }
__device__ __forceinline__ unsigned xb_xcc_id() { return (unsigned)__builtin_amdgcn_s_getreg((3 << 11) | 20) & 0xFu; }
#define XB_SPIN(cond, bar) do { unsigned _sp = 0; while (cond) { __builtin_amdgcn_s_sleep(1); \
    if ((++_sp & 255u) == 0u) { if (xb_ld(&(bar)[XB_TMO])) break; if (_sp > XB_SPIN_CAP) { atomicAdd(&(bar)[XB_TMO], 1u); break; } } } } while (0)
__device__ __forceinline__ void xcd_barrier_complete(unsigned* bar, unsigned x, unsigned& nloc, unsigned& nx) {
    const unsigned G = gridDim.x * gridDim.y * gridDim.z;
    unsigned sum, cnt, mine, sp = 0u;
    for (;;) {
        sum = 0u; cnt = 0u; mine = 0u;
#pragma unroll
        for (unsigned j = 0; j < 16; ++j) { const unsigned c = xb_ld(&bar[XB_XCNT(j)]); sum += c; cnt += (c > 0u) ? 1u : 0u; mine = (j == x) ? c : mine; }
        if (sum == G) break;
        __builtin_amdgcn_s_sleep(1);
        if ((++sp & 255u) == 0u) { if (xb_ld(&bar[XB_TMO])) break; if (sp > XB_SPIN_CAP) { atomicAdd(&bar[XB_TMO], 1u); break; } }
    }
    nloc = mine > 0u ? mine : 1u; nx = cnt > 0u ? cnt : 1u;
}
__device__ __forceinline__ void xcd_barrier(unsigned* bar, unsigned x, volatile LAS unsigned* st) {
    asm volatile("s_waitcnt vmcnt(0)" ::: "memory");
    __syncthreads();
    if (threadIdx.x == 0) {
        __builtin_amdgcn_s_waitcnt(0);
        unsigned nloc = st[0], nx = st[1];
        if (nloc == 0u) { xcd_barrier_complete(bar, x, nloc, nx); st[0] = nloc; st[1] = nx; }
        const unsigned old = xb_add(&bar[XB_XSUB(x)], 1u);
        const unsigned gen = old / nloc;
        if (old + 1u == (gen + 1u) * nloc) {
            __builtin_amdgcn_fence(__ATOMIC_RELEASE, "agent");
            asm volatile("s_waitcnt vmcnt(0)" ::: "memory");
            const unsigned og = xb_add(&bar[XB_TOP], 1u);
            const unsigned tg = og / nx;
            if (og + 1u == (tg + 1u) * nx) xb_add(&bar[XB_TOPGEN], 1u);
            else XB_SPIN(xb_ld(&bar[XB_TOPGEN]) == tg, bar);
            __builtin_amdgcn_fence(__ATOMIC_ACQUIRE, "agent");
            xb_add(&bar[XB_XGEN(x)], 1u);
            asm volatile("s_waitcnt vmcnt(0)" ::: "memory");
        } else {
            XB_SPIN(xb_ld(&bar[XB_XGEN(x)]) == gen, bar);
            __builtin_amdgcn_fence(__ATOMIC_ACQUIRE, "agent");
            asm volatile("s_waitcnt vmcnt(0)" ::: "memory");
        }
    }
    __syncthreads();
}

__global__ void __launch_bounds__(NTHR, 2) mega(Params Pval, int ph0, int ph1) {
    extern __shared__ __attribute__((aligned(16))) unsigned char lds_raw[];
    LAS unsigned char* lds = (LAS unsigned char*)lds_raw;
    volatile LAS unsigned* xb_st = (volatile LAS unsigned*)(lds + LDS_BYTES - 16);
    unsigned xb_x = 0;
    if (ph1 - ph0 > 1) { if (threadIdx.x == 0) { xb_st[0] = 0u; xb_st[1] = 0u; } __syncthreads();
        xb_x = xb_xcc_id(); if (threadIdx.x == 0) (void)xb_add((unsigned*)(Pval.ws + OFF_BAR) + XB_XCNT(xb_x), 1u); }
    for (int ph = ph0; ph < ph1; ++ph) {
        CP P = (CP)__builtin_amdgcn_kernarg_segment_ptr(); asm volatile("" : "+s"(P));
        unsigned char* ws = P->ws;
        bf16_t* XN = (bf16_t*)(ws + OFF_XN); bf16_t* ACT = (bf16_t*)(ws + OFF_ACT);
        if (ph == 1 || ph == 4 || ph == 11 || ph == 14 || ph == 17 || ph == 28) continue;
        const int reps = (((unsigned long long)(PROBE_MASK) >> ph) & 1ull) ? 2 : 1;
        for (int rep = 0; rep < reps; ++rep) {
        float* SSQ = (float*)(ws + OFF_SSQ); bf16_t* MIXB = (bf16_t*)(ws + OFF_MIX);
        int ffn = -1, sub = 0;
        if (ph >= 2 && ph <= 3) { ffn = 0; sub = ph - 1; } else if (ph >= 12 && ph <= 13) { ffn = 1; sub = ph - 11; }
        else if (ph >= 15 && ph <= 16) { ffn = 2; sub = ph - 14; } else if (ph >= 29 && ph <= 30) { ffn = 3; sub = ph - 28; }
        if (ph == 0) { if (EN(0)) phase_prologue(P, lds); }
        else if (ffn >= 0) {
            const float* ssin = SSQ + (size_t)(ffn == 0 ? 0 : ffn == 1 ? 2 : ffn == 2 ? 3 : 5) * SSN;
            if (sub == 1) { if (EN(2)) { if (ffn == 0) phase_kmat(P);
                pg8::Gemm g{XN, (const bf16_t*)(ws + OFF_W1 + (size_t)ffn * SZ_W1), 1024, 1024, 1024, 256, 22, 1, 0, 0}; EpiSwiGLU e{ACT, ssin}; pg8::gemm_phase(lds, g, e); } }
            else { if (EN(3)) { pg8::Gemm g{ACT, (const bf16_t*)(ws + OFF_W2 + (size_t)ffn * SZ_W2), 2816, 2816, 2816, 256, 4, 1, 0, 0};
                float* ssout = SSQ + (size_t)(ffn == 0 ? 1 : ffn == 1 ? 3 : 4) * SSN;
                if (ffn == 3) { EpiResid<false, false> e{nullptr, XN, nullptr, 0.5f}; pg8::gemm_phase(lds, g, e); }
                else if (ffn == 0) { EpiResid<true, true> e{P->in[0], XN, ssout, 0.5f}; pg8::gemm_phase(lds, g, e); }
                else { EpiResid<true, false> e{nullptr, XN, ssout, 0.5f}; pg8::gemm_phase(lds, g, e); } } }
        }
        else if (ph == 5) { if (EN(4)) { pg8::Gemm g{XN, (const bf16_t*)(ws + OFF_WIN0), 1024, 1024, 1024, 256, 9, 1, 0, 0}; EpiWin0 e{(bf16_t*)(ws + OFF_AS5), (bf16_t*)(ws + OFF_PQ), SSQ + SSN}; pg8::gemm_phase(lds, g, e); } }
        else if (ph == 6) { if (EN(5)) {
            if (EN(16)) { pg8::Gemm g{(const bf16_t*)(ws + OFF_AS5), (const bf16_t*)(ws + OFF_H), 1280, 1024, 1024, 4, 1, 32, (size_t)1024 * 1280, (size_t)256 * 1024}; EpiS5E e{(float*)(ws + OFF_E)}; pg8::gemm_phase(lds, g, e); }
            __syncthreads();
            if (EN(17)) for (int u = obid(); u < 4096; u += gridDim.x) gla_a_unit(P, u, lds);
        } }
        else if (ph == 7) { if (EN(6)) { phase_s5_scan(P); phase_gla_b(P); } }
        else if (ph == 8) { if (EN(7)) {
            if (EN(18)) { pg8::Gemm g{(const bf16_t*)(ws + OFF_AS5), (const bf16_t*)(ws + OFF_KG), 1280, 1280, 1280, 4, 4, 32, (size_t)1024 * 1280, (size_t)1024 * 1280}; EpiS5Y e{(bf16_t*)(ws + OFF_GY)}; pg8::gemm_phase(lds, g, e); }
            __syncthreads();
            if (EN(19)) for (int u = obid(); u < 4096; u += gridDim.x) gla_c_unit(P, u, lds);
        } }
        else if (ph == 9) { if (EN(8)) { pg8::Gemm g{(const bf16_t*)(ws + OFF_GY), (const bf16_t*)(ws + OFF_WGLU), 512, 512, 512, 256, 2, 1, 0, 0}; EpiGLU e{(const bf16_t*)(ws + OFF_GY), MIXB}; pg8::gemm_phase(lds, g, e); } }
        else if (ph == 10) { if (EN(9)) { pg8::Gemm g{MIXB, (const bf16_t*)(ws + OFF_WOUT0), 1024, 1024, 1024, 256, 4, 1, 0, 0}; EpiResid<true, false> e{nullptr, XN, SSQ + 2 * SSN, 1.0f}; pg8::gemm_phase(lds, g, e); } }
        else if (ph >= 18 && ph <= 27) {
            const int hf = (ph - 18) / 5, s = (ph - 18) % 5;
            if (s == 0) { if (EN(10)) { pg8::Gemm g{XN + (size_t)hf * 32768 * 1024, (const bf16_t*)(ws + OFF_WIN1), 1024, 1024, 1024, 128, 24, 1, 0, 0}; EpiRetIn e{(bf16_t*)(ws + OFF_PROJ1), 6144, SSQ + 4 * SSN + (size_t)hf * 32768 * 16, (const float*)(ws + OFF_ROPE), (const float*)(ws + OFF_ROPE) + 8192 * 64, hf * 32768}; pg8::gemm_phase(lds, g, e); } }
            else if (s == 1) { if (EN(11)) for (int u = obid(); u < 1024; u += gridDim.x) ret_a_unit(P, hf, u, lds); }
            else if (s == 2) { if (EN(12)) phase_ret_b(P); }
            else if (s == 3) { if (EN(13)) for (int u = obid(); u < 2048; u += gridDim.x) ret_c_unit(P, hf, u, lds); }
            else { if (EN(14)) { pg8::Gemm g{(const bf16_t*)(ws + OFF_OBUF), (const bf16_t*)(ws + OFF_WOUT1), 2048, 2048, 2048, 128, 4, 1, 0, 0};
                EpiResid<true, false> e{nullptr, XN + (size_t)hf * 32768 * 1024, SSQ + 5 * SSN + (size_t)hf * 32768 * 16, 1.0f}; pg8::gemm_phase(lds, g, e); } }
        }
        else if (ph == 31) { if (EN(15)) phase_final(XN, P->in[25], P->out); }
        if (rep + 1 < reps) __syncthreads();
        }
        if (ph + 1 < ph1) { if (ph == 0) cg::this_grid().sync();
            else xcd_barrier((unsigned*)(P->ws + OFF_BAR), xb_x, xb_st); }
    }
}

extern "C" void kernel_launch(void* const* d_in, const int* in_sizes, int n_in, void* d_out, int out_size, void* d_ws, size_t ws_size, hipStream_t stream) {
    static int inited = 0;
    if (!inited) { (void)hipFuncSetAttribute((const void*)mega, hipFuncAttributeMaxDynamicSharedMemorySize, LDS_BYTES); inited = 1; }
    Params p{};
    for (int i = 0; i < 26; ++i) p.in[i] = (const float*)d_in[i];
    p.out = (float*)d_out; p.ws = (unsigned char*)d_ws;
    if (ws_size < OFF_R + 770 * MiB) fprintf(stderr, "kernel_launch: workspace too small (%zu)\n", ws_size);
    const int grid = 256;
#if ONE_LAUNCH
    (void)hipMemsetAsync((unsigned char*)d_ws + OFF_BAR, 0, 16384, stream);
    int ph0 = 0, ph1 = NPHASE; void* args[] = {&p, &ph0, &ph1};
    hipError_t e = hipLaunchCooperativeKernel((const void*)mega, dim3(grid), dim3(NTHR), args, LDS_BYTES, stream);
    if (e != hipSuccess) fprintf(stderr, "cooperative launch failed: %s\n", hipGetErrorString(e));
#else
    for (int ph = 0; ph < NPHASE; ++ph) hipLaunchKernelGGL(mega, dim3(grid), dim3(NTHR), LDS_BYTES, stream, p, ph, ph + 1);
#endif
}
```

```cpp
#include <hip/hip_runtime.h>
#include <hip/hip_cooperative_groups.h>
#include <cstdio>
#include <cstdint>
namespace cg = cooperative_groups;

#ifndef ONE_LAUNCH
#define ONE_LAUNCH 1
#endif

#ifndef PHASE_MASK
#define PHASE_MASK 0xffffffffffull
#endif
#define EN(n) (((PHASE_MASK) >> (n)) & 1ull)
#ifndef PROBE_MASK
#define PROBE_MASK 0ull
#endif
#define LAS __attribute__((address_space(3)))
typedef unsigned short bf16_t;
typedef short bf16x8 __attribute__((ext_vector_type(8)));
typedef float f32x4 __attribute__((ext_vector_type(4)));
typedef float f32x2 __attribute__((ext_vector_type(2)));
typedef unsigned u32x2 __attribute__((ext_vector_type(2)));
typedef unsigned u32x4 __attribute__((ext_vector_type(4)));
__device__ __forceinline__ u32x4 mk4(unsigned a, unsigned b, unsigned c, unsigned d) { return (u32x4){a, b, c, d}; }
__device__ __forceinline__ u32x2 mk2(unsigned a, unsigned b) { return (u32x2){a, b}; }
__device__ __forceinline__ f32x2 mkf2(float a, float b) { return (f32x2){a, b}; }

constexpr int NTHR = 512;
constexpr int LDS_BYTES = 147456;
constexpr int NPHASE = 32;

struct Params { const float* in[26]; float* out; unsigned char* ws; };
typedef const __attribute__((address_space(4))) Params* CP;

constexpr size_t MiB = 1ull << 20;
constexpr size_t OFF_W1 = 0, SZ_W1 = 11 * MiB;
constexpr size_t OFF_W2 = 44 * MiB, SZ_W2 = 5 * MiB + MiB / 2;
constexpr size_t OFF_WIN0 = 66 * MiB;
constexpr size_t OFF_WGLU = 70 * MiB + MiB / 2;
constexpr size_t OFF_WOUT0 = 71 * MiB;
constexpr size_t OFF_WIN1 = 73 * MiB;
constexpr size_t OFF_WOUT1 = 85 * MiB;
constexpr size_t OFF_ROPE = 89 * MiB;
constexpr size_t OFF_KTAB = 93 * MiB;
constexpr size_t OFF_S5P = 97 * MiB;
constexpr size_t OFF_XN = 98 * MiB;
constexpr size_t OFF_R = 226 * MiB;
constexpr size_t OFF_ACT = OFF_R;
constexpr size_t OFF_PQ = OFF_R;
constexpr size_t OFF_AS5 = OFF_R + 224 * MiB;
constexpr size_t OFF_E = OFF_R + 304 * MiB;
constexpr size_t OFF_KG = OFF_R + 352 * MiB;
constexpr size_t OFF_H = OFF_R + 432 * MiB;
constexpr size_t OFF_GST = OFF_R + 448 * MiB;
constexpr size_t OFF_GDEC = OFF_R + 704 * MiB;
constexpr size_t OFF_GY = OFF_R + 706 * MiB;
constexpr size_t OFF_PROJ1 = OFF_R;
constexpr size_t OFF_RST = OFF_R + 384 * MiB;
constexpr size_t OFF_SSQ = 998 * MiB;
constexpr int SSN = 65536 * 16;
constexpr size_t OFF_MIX = OFF_R + 576 * MiB;
constexpr size_t OFF_BAR = 1023 * MiB;
constexpr size_t OFF_OBUF = OFF_R + 640 * MiB;

__device__ __forceinline__ int otid() { int t = threadIdx.x; asm volatile("" : "+v"(t)); return t; }
__device__ __forceinline__ int obid() { int t = blockIdx.x; asm volatile("" : "+s"(t)); return t; }
__device__ __forceinline__ bf16_t f2bf(float f) { unsigned u = __float_as_uint(f); u += 0x7FFFu + ((u >> 16) & 1u); return (bf16_t)(u >> 16); }
__device__ __forceinline__ float bf2f(unsigned b) { return __uint_as_float(b << 16); }
typedef __bf16 bf16x2_t __attribute__((ext_vector_type(2)));
typedef float f32x2_t __attribute__((ext_vector_type(2)));
__device__ __forceinline__ unsigned pack2(float lo, float hi) { const f32x2_t v = {lo, hi}; const bf16x2_t b = __builtin_convertvector(v, bf16x2_t); return __builtin_bit_cast(unsigned, b); }
__device__ __forceinline__ float bflo(unsigned w) { return __uint_as_float(w << 16); }
__device__ __forceinline__ float bfhi(unsigned w) { return __uint_as_float(w & 0xffff0000u); }
__device__ __forceinline__ float fast_sigmoid(float x) { return __builtin_amdgcn_rcpf(1.0f + __expf(-x)); }
__device__ __forceinline__ float silu_f(float x) { return x * fast_sigmoid(x); }
__device__ __forceinline__ float gelu_tanh(float x) { const float u = 0.7978845608028654f * (x + 0.044715f * x * x * x); return x * fast_sigmoid(2.0f * u); }

namespace pg8 {
constexpr int BM = 256, BK = 64, HALF = 128, HTB = HALF * BK * 2, STAGE_BYTES = 8 * HTB, NXCD = 8, WGM = 8;
__device__ __forceinline__ int lds_byte(int r, int c) { const int st = (r >> 4) * 2 + (c >> 5), rr = r & 15, cc = c & 31, ob = rr * 64 + cc * 2; return st * 1024 + (ob ^ (((ob >> 9) & 1) << 5)); }
__device__ __forceinline__ void stage_rc(int b, int& R, int& C) { const int st = b / 1024, sb = b % 1024, swz = sb ^ (((sb >> 9) & 1) << 5); R = (st >> 1) * 16 + swz / 64; C = (st & 1) * 32 + (swz % 64) / 2; }

__device__ __forceinline__ int perm32(int rho) { const int n = rho >> 4, i = rho & 15; return 8 * (i >> 2) + 4 * n + (i & 3); }
struct Unit { int pm, pn, bz; };
struct Gemm { const bf16_t* A; const bf16_t* Bt; int lda, ldb, K, nM, nN, nB; size_t strideA, strideB; };

struct Sched {
    int nM, nN, nwg, total, G, c;
    __device__ void init(int nM_, int nN_, int nB_, int G_, int c_) { nM = nM_; nN = nN_; nwg = nM * nN; total = nwg * nB_; G = G_; c = c_; }
    __device__ bool next(int i, Unit& u) const {
        const long L = (long)i * G + c; if (L >= total) return false;
        u.bz = (int)(L / nwg); int wgid = (int)(L % nwg);
        { const int q = nwg / NXCD, r = nwg % NXCD, xcd = wgid % NXCD, off = wgid / NXCD; wgid = (xcd < r ? xcd * (q + 1) : r * (q + 1) + (xcd - r) * q) + off; }
        const int nig = WGM * nN, gid = wgid / nig, fm = gid * WGM, gsz = (nM - fm) < WGM ? (nM - fm) : WGM;
        u.pm = fm + ((wgid % nig) % gsz); u.pn = (wgid % nig) / gsz; return true;
    }
};

template <class Epi>
__device__ __forceinline__ void gemm_phase(LAS unsigned char* lds, const Gemm g, const Epi& E) {
    const int tid = otid(), wid = __builtin_amdgcn_readfirstlane(tid >> 6), lane = tid & 63, wr = wid >> 2, wc = wid & 3, fr = lane & 15, fq = lane >> 4;
    const int nt = g.K / BK;
    Sched S; S.init(g.nM, g.nN, g.nB, (int)gridDim.x, obid());
    unsigned voffA[2], voffB[2];
#pragma unroll
    for (int i = 0; i < 2; ++i) { int R, C; stage_rc(tid * 16 + i * 8192, R, C); const int Rb = Epi::PERM ? ((R & ~31) + perm32(R & 31)) : R;
        voffA[i] = (unsigned)(R * g.lda + C) * 2u; voffB[i] = (unsigned)(Rb * g.ldb + C) * 2u; }
    const size_t kstep = (size_t)(BK * 2);
    const size_t hstepA = (size_t)HALF * g.lda * 2, hstepB = (size_t)HALF * g.ldb * 2;
    const size_t tstepA = 2 * hstepA, tstepB = 2 * hstepB;
    const unsigned ldsw = (unsigned)wid * 1024u;
    const int aoff = lds_byte(wr * 64 + fr, fq * 8), boff = lds_byte(wc * 32 + fr, fq * 8);
#define PG8_SA(b, h) (((b) * 2 + (h)) * HTB)
#define PG8_SB(b, h) ((4 + (b) * 2 + (h)) * HTB)
#define PG8_STAGE(bufoff, gbase, voff) do { _Pragma("unroll") for (int _i = 0; _i < 2; ++_i) \
        __builtin_amdgcn_global_load_lds((const unsigned*)((const char*)(gbase) + (voff)[_i]), (LAS unsigned*)(lds + (bufoff) + ldsw + _i * 8192), 16, 0, 0); } while (0)
#define PG8_LDA(dst, b, h) do { _Pragma("unroll") for (int m = 0; m < 4; ++m) _Pragma("unroll") for (int k = 0; k < 2; ++k) dst[m][k] = *(const LAS bf16x8*)(lds + PG8_SA(b, h) + aoff + m * 2048 + k * 1024); } while (0)
#define PG8_LDB(dst, b, h) do { _Pragma("unroll") for (int n = 0; n < 2; ++n) _Pragma("unroll") for (int k = 0; k < 2; ++k) dst[n][k] = *(const LAS bf16x8*)(lds + PG8_SB(b, h) + boff + n * 2048 + k * 1024); } while (0)
#define PG8_MMA(ai, bj, At, Bt) do { __builtin_amdgcn_s_setprio(1); _Pragma("unroll") for (int m = 0; m < 4; ++m) _Pragma("unroll") for (int n = 0; n < 2; ++n) _Pragma("unroll") for (int k = 0; k < 2; ++k) \
        acc[ai][bj][m][n] = __builtin_amdgcn_mfma_f32_16x16x32_bf16(Bt[n][k], At[m][k], acc[ai][bj][m][n], 0, 0, 0); __builtin_amdgcn_s_setprio(0); } while (0)
#define PG8_WAIT_V(n) asm volatile("s_waitcnt vmcnt(" #n ")" ::: "memory")
#define PG8_WAIT_L(n) asm volatile("s_waitcnt lgkmcnt(" #n ")" ::: "memory")
#define PG8_BAR __builtin_amdgcn_s_barrier()
#define PG8_SCHED __builtin_amdgcn_sched_barrier(0)
    Unit cur, nxt; int ui = 0;
    if (!S.next(0, cur)) return;
    int tag0 = -1, tag1 = -1, tag2 = -1, tag3 = -1; LAS float* rstab = (LAS float*)(lds + STAGE_BYTES);
    if constexpr (Epi::RSTD) {
        { Unit t_; for (int i = 0; S.next(i, t_); ++i) { const int pm = t_.pm; if (pm == tag0 || pm == tag1 || pm == tag2 || pm == tag3) continue;
                if (tag0 < 0) tag0 = pm; else if (tag1 < 0) tag1 = pm; else if (tag2 < 0) tag2 = pm; else tag3 = pm; } }
#pragma unroll
        for (int sl = 0; sl < 2; ++sl) { const int slot = (tid >> 8) + 2 * sl; const int pm = slot == 0 ? tag0 : slot == 1 ? tag1 : slot == 2 ? tag2 : tag3;
            if (pm >= 0) { const f32x4* p = (const f32x4*)(E.SS + ((size_t)pm * 256 + (tid & 255)) * 16); const f32x4 a = p[0], b = p[1], c = p[2], d = p[3]; const f32x4 t = (a + b) + (c + d);
                rstab[slot * 256 + (tid & 255)] = rsqrtf(((t[0] + t[1]) + (t[2] + t[3])) * (1.0f / 1024.0f) + 1e-6f); } }
        __syncthreads();
    }
    f32x4 acc[2][2][4][2];
#pragma unroll
    for (int a = 0; a < 2; ++a)
#pragma unroll
        for (int b = 0; b < 2; ++b)
#pragma unroll
            for (int m = 0; m < 4; ++m)
#pragma unroll
                for (int n = 0; n < 2; ++n) acc[a][b][m][n] = (f32x4){0.f, 0.f, 0.f, 0.f};
    bf16x8 At[4][2], B0[2][2], B1[2][2];
    const char* cA = (const char*)g.A + (size_t)cur.bz * g.strideA * 2 + (size_t)cur.pm * tstepA;
    const char* cB = (const char*)g.Bt + (size_t)cur.bz * g.strideB * 2 + (size_t)cur.pn * tstepB;
    PG8_STAGE(PG8_SB(0, 0), cB, voffB); PG8_STAGE(PG8_SB(0, 1), cB + hstepB, voffB); PG8_STAGE(PG8_SA(0, 0), cA, voffA); PG8_STAGE(PG8_SA(0, 1), cA + hstepA, voffA);
    if (wr == 1) PG8_BAR;
    PG8_WAIT_V(2); PG8_BAR;
    PG8_STAGE(PG8_SB(1, 0), cB + kstep, voffB); PG8_STAGE(PG8_SA(1, 0), cA + kstep, voffA); PG8_STAGE(PG8_SB(1, 1), cB + hstepB + kstep, voffB);
    PG8_WAIT_V(6); PG8_BAR;
    for (;;) {
        const bool has_next = S.next(ui + 1, nxt);
        const char* nA = has_next ? (const char*)g.A + (size_t)nxt.bz * g.strideA * 2 + (size_t)nxt.pm * tstepA : cA;
        const char* nB = has_next ? (const char*)g.Bt + (size_t)nxt.bz * g.strideB * 2 + (size_t)nxt.pn * tstepB : cB;
        for (int t = 0; t < nt; t += 2) {
            const bool last = (t == nt - 2);
            const char* a1 = cA + (size_t)(t + 1) * kstep;
            const char* a2 = last ? nA : cA + (size_t)(t + 2) * kstep; const char* b2 = last ? nB : cB + (size_t)(t + 2) * kstep;
            const char* a3 = a2 + kstep; const char* b3 = b2 + kstep;
            PG8_LDB(B0, 0, 0); PG8_LDB(B1, 0, 1); PG8_SCHED; PG8_LDA(At, 0, 0); PG8_STAGE(PG8_SA(1, 1), a1 + hstepA, voffA);
            PG8_WAIT_V(8); PG8_WAIT_L(0); PG8_BAR; PG8_MMA(0, 0, At, B0); PG8_MMA(0, 1, At, B1); PG8_BAR; PG8_SCHED;
            PG8_LDA(At, 0, 1); PG8_STAGE(PG8_SB(0, 0), b2, voffB); PG8_STAGE(PG8_SB(0, 1), b2 + hstepB, voffB); PG8_STAGE(PG8_SA(0, 0), a2, voffA);
            PG8_WAIT_V(8); PG8_WAIT_L(0); PG8_BAR; PG8_MMA(1, 0, At, B0); PG8_MMA(1, 1, At, B1); PG8_BAR; PG8_SCHED;
            PG8_LDB(B0, 1, 0); PG8_LDB(B1, 1, 1); PG8_SCHED; PG8_LDA(At, 1, 0); PG8_STAGE(PG8_SA(0, 1), a2 + hstepA, voffA);
            PG8_WAIT_V(8); PG8_WAIT_L(0); PG8_BAR; PG8_MMA(0, 0, At, B0); PG8_MMA(0, 1, At, B1); PG8_BAR; PG8_SCHED;
            PG8_LDA(At, 1, 1); PG8_STAGE(PG8_SB(1, 0), b3, voffB); PG8_STAGE(PG8_SB(1, 1), b3 + hstepB, voffB); PG8_STAGE(PG8_SA(1, 0), a3, voffA);
            PG8_WAIT_V(8); PG8_WAIT_L(0); PG8_BAR; PG8_MMA(1, 0, At, B0); PG8_MMA(1, 1, At, B1); PG8_BAR; PG8_SCHED;
        }
        if (wr == 0) PG8_BAR;
        E(acc, cur, wr, wc, fr, fq, rstab + (cur.pm == tag1 ? 256 : cur.pm == tag2 ? 512 : cur.pm == tag3 ? 768 : 0));
        if (!has_next) break;
#pragma unroll
        for (int a = 0; a < 2; ++a)
#pragma unroll
            for (int b = 0; b < 2; ++b)
#pragma unroll
                for (int m = 0; m < 4; ++m)
#pragma unroll
                    for (int n = 0; n < 2; ++n) acc[a][b][m][n] = (f32x4){0.f, 0.f, 0.f, 0.f};
        cur = nxt; cA = nA; cB = nB; ++ui;
        if (wr == 1) PG8_BAR;
    }
    PG8_WAIT_V(0);
    PG8_BAR;
#undef PG8_SA
#undef PG8_SB
#undef PG8_STAGE
#undef PG8_LDA
#undef PG8_LDB
#undef PG8_MMA
#undef PG8_WAIT_V
#undef PG8_WAIT_L
#undef PG8_BAR
#undef PG8_SCHED
}
}
using pg8::Unit;
typedef const f32x4 (&AccRef)[2][2][4][2];

struct EpiSwiGLU {
    static constexpr bool PERM = true, RSTD = true;
    bf16_t* O; const float* SS;
    __device__ __forceinline__ void operator()(AccRef acc, const Unit& u, int wr, int wc, int fr, int fq, const LAS float* rsl) const {
        const int row0 = u.pm * 256 + wr * 64 + fr, col0 = u.pn * 128 + wc * 32 + 8 * fq;
#pragma unroll
        for (int ai = 0; ai < 2; ++ai)
#pragma unroll
            for (int m = 0; m < 4; ++m) { bf16_t* rowp = O + (size_t)(row0 + ai * 128 + m * 16) * 2816 + col0; uint4 w; const float rs = rsl[ai * 128 + wr * 64 + m * 16 + fr];
                { const f32x4 gt = rs * acc[ai][0][m][0], up = rs * acc[ai][1][m][0]; w.x = pack2(silu_f(gt[0]) * up[0], silu_f(gt[1]) * up[1]); w.y = pack2(silu_f(gt[2]) * up[2], silu_f(gt[3]) * up[3]); }
                { const f32x4 gt = rs * acc[ai][0][m][1], up = rs * acc[ai][1][m][1]; w.z = pack2(silu_f(gt[0]) * up[0], silu_f(gt[1]) * up[1]); w.w = pack2(silu_f(gt[2]) * up[2], silu_f(gt[3]) * up[3]); }
                *(uint4*)rowp = w; }
    }
};
template <bool STATS, bool XF32> struct EpiResid {
    static constexpr bool PERM = true, RSTD = false;
    const float* Xin; bf16_t* XB; float* SS; float alpha;
    __device__ __forceinline__ void operator()(AccRef acc, const Unit& u, int wr, int wc, int fr, int fq, const LAS float* rsl) const {
        const int row0 = u.pm * 256 + wr * 64 + fr, col0 = u.pn * 256 + wc * 32 + 8 * fq;
#pragma unroll
        for (int ai = 0; ai < 2; ++ai)
#pragma unroll
            for (int mp = 0; mp < 2; ++mp) {
                f32x4 xo[2][2][2];
#pragma unroll
                for (int mm = 0; mm < 2; ++mm)
#pragma unroll
                    for (int bj = 0; bj < 2; ++bj) { const size_t o = (size_t)(row0 + ai * 128 + (mp * 2 + mm) * 16) * 1024 + col0 + bj * 128;
                        if (XF32) { xo[mm][bj][0] = *(const f32x4*)(Xin + o); xo[mm][bj][1] = *(const f32x4*)(Xin + o + 4); }
                        else { const uint4 w = *(const uint4*)(XB + o); xo[mm][bj][0] = (f32x4){bflo(w.x), bfhi(w.x), bflo(w.y), bfhi(w.y)}; xo[mm][bj][1] = (f32x4){bflo(w.z), bfhi(w.z), bflo(w.w), bfhi(w.w)}; } }
#pragma unroll
                for (int mm = 0; mm < 2; ++mm) { const int m = mp * 2 + mm; const size_t ro = (size_t)(row0 + ai * 128 + m * 16) * 1024 + col0; float sq = 0.f;
#pragma unroll
                    for (int bj = 0; bj < 2; ++bj) { const size_t o = ro + bj * 128;
                        const f32x4 y0 = xo[mm][bj][0] + alpha * acc[ai][bj][m][0], y1 = xo[mm][bj][1] + alpha * acc[ai][bj][m][1];
                        uint4 w; w.x = pack2(y0[0], y0[1]); w.y = pack2(y0[2], y0[3]); w.z = pack2(y1[0], y1[1]); w.w = pack2(y1[2], y1[3]); *(uint4*)(XB + o) = w;
                        if (STATS) sq += y0[0] * y0[0] + y0[1] * y0[1] + y0[2] * y0[2] + y0[3] * y0[3] + y1[0] * y1[0] + y1[1] * y1[1] + y1[2] * y1[2] + y1[3] * y1[3]; }
                    if (STATS) { sq += __shfl_xor(sq, 16); sq += __shfl_xor(sq, 32); if (fq == 0) SS[(size_t)(row0 + ai * 128 + m * 16) * 16 + u.pn * 4 + wc] = sq; } } }
    }
};
struct EpiBf16 {
    static constexpr bool PERM = true, RSTD = true;
    bf16_t* O; int ldc; const float* SS;
    __device__ __forceinline__ void operator()(AccRef acc, const Unit& u, int wr, int wc, int fr, int fq, const LAS float* rsl) const {
        const int row0 = u.pm * 256 + wr * 64 + fr, col0 = u.pn * 256 + wc * 32 + 8 * fq;
#pragma unroll
        for (int ai = 0; ai < 2; ++ai)
#pragma unroll
            for (int m = 0; m < 4; ++m) { bf16_t* rowp = O + (size_t)(row0 + ai * 128 + m * 16) * ldc + col0; const float rs = rsl[ai * 128 + wr * 64 + m * 16 + fr];
#pragma unroll
                for (int bj = 0; bj < 2; ++bj) { const f32x4 v0 = rs * acc[ai][bj][m][0], v1 = rs * acc[ai][bj][m][1]; uint4 w; w.x = pack2(v0[0], v0[1]); w.y = pack2(v0[2], v0[3]); w.z = pack2(v1[0], v1[1]); w.w = pack2(v1[2], v1[3]);
                    *(uint4*)(rowp + bj * 128) = w; } }
    }
};
struct EpiRetIn {
    static constexpr bool PERM = true, RSTD = true;
    bf16_t* O; int ldc; const float* SS; const float* cs; const float* sn; int rowbase;
    __device__ __forceinline__ void operator()(AccRef acc, const Unit& u, int wr, int wc, int fr, int fq, const LAS float* rsl) const {
        const int row0 = u.pm * 256 + wr * 64 + fr, col0 = u.pn * 256 + wc * 32 + 8 * fq, f = 16 * wc + 4 * fq;
#pragma unroll
        for (int ai = 0; ai < 2; ++ai)
#pragma unroll
            for (int m = 0; m < 4; ++m) { const int r = row0 + ai * 128 + m * 16; bf16_t* rowp = O + (size_t)r * ldc + col0; const float rs = rsl[ai * 128 + wr * 64 + m * 16 + fr];
                f32x4 c4 = (f32x4){1.f, 1.f, 1.f, 1.f}, s4 = (f32x4){0.f, 0.f, 0.f, 0.f};
                if (u.pn < 8) { const int pos = (rowbase + r) & 8191; c4 = *(const f32x4*)(cs + pos * 64 + f); s4 = *(const f32x4*)(sn + pos * 64 + f);
                    if (u.pn >= 4) { c4 *= 0.08838834764831845f; s4 *= 0.08838834764831845f; } }
#pragma unroll
                for (int bj = 0; bj < 2; ++bj) { const f32x4 t1 = rs * acc[ai][bj][m][0], t2 = rs * acc[ai][bj][m][1]; const f32x4 v0 = t1 * c4 - t2 * s4, v1 = t1 * s4 + t2 * c4;
                    uint4 w; w.x = pack2(v0[0], v0[1]); w.y = pack2(v0[2], v0[3]); w.z = pack2(v1[0], v1[1]); w.w = pack2(v1[2], v1[3]);
                    *(uint4*)(rowp + bj * 128) = w; } }
    }
};
struct EpiWin0 {
    static constexpr bool PERM = true, RSTD = true;
    bf16_t* AS5; bf16_t* PQ; const float* SS;
    __device__ __forceinline__ void operator()(AccRef acc, const Unit& u, int wr, int wc, int fr, int fq, const LAS float* rsl) const {
        const int row0 = u.pm * 256 + wr * 64 + fr, col0 = u.pn * 256 + wc * 32 + 8 * fq;
#pragma unroll
        for (int ai = 0; ai < 2; ++ai)
#pragma unroll
            for (int m = 0; m < 4; ++m) { const int r = row0 + ai * 128 + m * 16; const float rs = rsl[ai * 128 + wr * 64 + m * 16 + fr];
#pragma unroll
                for (int bj = 0; bj < 2; ++bj) { const int c = col0 + bj * 128; const f32x4 v0 = rs * acc[ai][bj][m][0], v1 = rs * acc[ai][bj][m][1];
                    uint4 w; w.x = pack2(v0[0], v0[1]); w.y = pack2(v0[2], v0[3]); w.z = pack2(v1[0], v1[1]); w.w = pack2(v1[2], v1[3]);
                    if (u.pn < 2) *(uint4*)(AS5 + ((size_t)((c >> 4) * 1024 + (r >> 6))) * 1280 + (r & 63) * 16 + (c & 15)) = w;
                    else if (c < 2080) *(uint4*)(PQ + (size_t)r * 1792 + (c - 512)) = w; } }
    }
};
struct EpiGLU {
    static constexpr bool PERM = true, RSTD = false;
    const bf16_t* GY; bf16_t* MIX;
    __device__ __forceinline__ void operator()(AccRef acc, const Unit& u, int wr, int wc, int fr, int fq, const LAS float* rsl) const {
        const int row0 = u.pm * 256 + wr * 64 + fr, col0 = u.pn * 256 + wc * 32 + 8 * fq;
#pragma unroll
        for (int ai = 0; ai < 2; ++ai)
#pragma unroll
            for (int m = 0; m < 4; ++m) { const int r = row0 + ai * 128 + m * 16;
#pragma unroll
                for (int bj = 0; bj < 2; ++bj) { const int c = col0 + bj * 128; const f32x4 v0 = acc[ai][bj][m][0], v1 = acc[ai][bj][m][1];
                    const uint4 gy = *(const uint4*)(GY + (size_t)r * 512 + c); uint4 w;
                    w.x = pack2(bflo(gy.x) * fast_sigmoid(v0[0]), bfhi(gy.x) * fast_sigmoid(v0[1])); w.y = pack2(bflo(gy.y) * fast_sigmoid(v0[2]), bfhi(gy.y) * fast_sigmoid(v0[3]));
                    w.z = pack2(bflo(gy.z) * fast_sigmoid(v1[0]), bfhi(gy.z) * fast_sigmoid(v1[1])); w.w = pack2(bflo(gy.w) * fast_sigmoid(v1[2]), bfhi(gy.w) * fast_sigmoid(v1[3]));
                    *(uint4*)(MIX + (size_t)r * 1024 + c) = w; } }
    }
};
struct EpiS5E {
    static constexpr bool PERM = false, RSTD = false;
    float* E;
    __device__ __forceinline__ void operator()(AccRef acc, const Unit& u, int wr, int wc, int fr, int fq, const LAS float* rsl) const {
        const int row0 = u.pm * 256 + wr * 64 + fr, col0 = wc * 32 + 4 * fq;
#pragma unroll
        for (int ai = 0; ai < 2; ++ai)
#pragma unroll
            for (int m = 0; m < 4; ++m) { float* rowp = E + ((size_t)u.bz * 1024 + row0 + ai * 128 + m * 16) * 256 + col0;
#pragma unroll
                for (int bj = 0; bj < 2; ++bj)
#pragma unroll
                    for (int n = 0; n < 2; ++n) *(f32x4*)(rowp + bj * 128 + n * 16) = acc[ai][bj][m][n]; }
    }
};
struct EpiS5Y {
    static constexpr bool PERM = true, RSTD = false;
    bf16_t* GY;
    __device__ __forceinline__ void operator()(AccRef acc, const Unit& u, int wr, int wc, int fr, int fq, const LAS float* rsl) const {
        const int row0 = u.pm * 256 + wr * 64 + fr, col0 = u.pn * 256 + wc * 32 + 8 * fq;
#pragma unroll
        for (int ai = 0; ai < 2; ++ai)
#pragma unroll
            for (int m = 0; m < 4; ++m) { const int bc = row0 + ai * 128 + m * 16;
#pragma unroll
                for (int bj = 0; bj < 2; ++bj) { const int c = col0 + bj * 128; const f32x4 v0 = acc[ai][bj][m][0], v1 = acc[ai][bj][m][1]; uint4 w;
                    w.x = pack2(gelu_tanh(v0[0]), gelu_tanh(v0[1])); w.y = pack2(gelu_tanh(v0[2]), gelu_tanh(v0[3])); w.z = pack2(gelu_tanh(v1[0]), gelu_tanh(v1[1])); w.w = pack2(gelu_tanh(v1[2]), gelu_tanh(v1[3]));
                    *(uint4*)(GY + ((size_t)bc * 64 + (c >> 4)) * 512 + u.bz * 16 + (c & 15)) = w; } }
    }
};

__device__ void transpose_job(const float* __restrict__ src, int K, int Nsrc, bf16_t* __restrict__ dst, int Ndst, int mode, LAS float* tile, int b0, int nb, const float* __restrict__ gain) {
    const int tid = otid();
    const int ntk = K >> 8, nt = (Ndst >> 6) * ntk;
    for (int t = obid() - b0; t < nt; t += nb) {
        const int tn = t / ntk, tk = t % ntk, n0 = tn * 64, k0 = tk * 256;
        int ns0 = n0;
        if (mode == 1) { const int tt = n0 >> 8, j = n0 & 255; ns0 = (j < 128) ? (tt * 128 + j) : (2816 + tt * 128 + (j - 128)); }
        const int r = tid >> 4; int c4 = (tid & 15) * 4;
        const int c4d = c4;
        if (mode == 2 && n0 < 2048) { const int s_ = (n0 + c4) & 127;
            c4 = ((n0 + c4) & ~127) + 64 * ((s_ >> 2) & 1) + 16 * (s_ >> 5) + 4 * ((s_ >> 3) & 3) - n0; }
        float4 v[8];
#pragma unroll
        for (int rr = 0; rr < 8; ++rr) { v[rr] = make_float4(0.f, 0.f, 0.f, 0.f);
            if (ns0 + c4 + 3 < Nsrc) v[rr] = *(const float4*)(src + (size_t)(k0 + r + rr * 32) * Nsrc + ns0 + c4);
            if (gain) { const float gk = gain[k0 + r + rr * 32]; v[rr].x *= gk; v[rr].y *= gk; v[rr].z *= gk; v[rr].w *= gk; } }
#pragma unroll
        for (int rr = 0; rr < 8; ++rr) { const int kk = r + rr * 32; LAS float* tp = tile + (kk >> 6) * (64 * 65) + (kk & 63) * 65 + c4d;
            tp[0] = v[rr].x; tp[1] = v[rr].y; tp[2] = v[rr].z; tp[3] = v[rr].w; }
        __syncthreads();
        const int n = tid >> 3, kq = (tid & 7) * 8;
#pragma unroll
        for (int kt = 0; kt < 4; ++kt) { const LAS float* tp = tile + kt * (64 * 65); uint4 w;
            w.x = pack2(tp[(kq + 0) * 65 + n], tp[(kq + 1) * 65 + n]); w.y = pack2(tp[(kq + 2) * 65 + n], tp[(kq + 3) * 65 + n]);
            w.z = pack2(tp[(kq + 4) * 65 + n], tp[(kq + 5) * 65 + n]); w.w = pack2(tp[(kq + 6) * 65 + n], tp[(kq + 7) * 65 + n]);
            *(uint4*)(dst + (size_t)(n0 + n) * K + k0 + kt * 64 + kq) = w; }
        __syncthreads();
    }
}

__device__ void s5_pre(CP P, int g, int dir, int part, LAS unsigned char* lds) {
    LAS f32x2* pw = (LAS f32x2*)lds;
    LAS f32x2* Bb = pw + 65 * 64;
    LAS f32x2* Cc = Bb + 64 * 16;
    const int tid = otid();
    float* Ktab = (float*)(P->ws + OFF_KTAB); float* AT = (float*)(P->ws + OFF_S5P);
    bf16_t* KG = (bf16_t*)(P->ws + OFF_KG); bf16_t* H = (bf16_t*)(P->ws + OFF_H);
    if (tid < 64) { const int n = tid, gi = (dir * 32 + g) * 64 + n;
        const double lr = fmin((double)P->in[9][gi], -1e-4), li = (double)P->in[10][gi], dt = (double)expf(P->in[15][dir * 32 + g]);
        const double em1 = (double)expm1f((float)(lr * dt)), mag = 1.0 + em1;
        double rev = li * dt * 0.15915494309189535; rev -= rint(rev); const float th = (float)(rev * 6.283185307179586), thh = 0.5f * th;
        const double sn_ = (double)sinf(th), shalf = (double)sinf(thh), cm1 = -2.0 * shalf * shalf;
        const double ar = mag * (1.0 + cm1), ai = mag * sn_, arm1 = em1 + cm1 + em1 * cm1, den = lr * lr + li * li;
        const double cr = (arm1 * lr + ai * li) / den, ci = (ai * lr - arm1 * li) / den;
#pragma unroll 1
        for (int p = 0; p < 16; ++p) { const double br = (double)P->in[11][gi * 16 + p], bi = (double)P->in[12][gi * 16 + p];
            Bb[n * 16 + p] = mkf2((float)(cr * br - ci * bi), (float)(cr * bi + ci * br)); }
        double xr = 1.0, xi = 0.0;
#pragma unroll 1
        for (int d = 0; d <= 64; ++d) { pw[d * 64 + n] = mkf2((float)xr, (float)xi); const double t0 = xr * ar - xi * ai; xi = xr * ai + xi * ar; xr = t0; }
        const f32x2 a64 = pw[64 * 64 + n];
        if (part == 0) { AT[((g * 2 + dir) * 64 + n) * 2 + 0] = a64.x; AT[((g * 2 + dir) * 64 + n) * 2 + 1] = a64.y; } }
#pragma unroll 1
    for (int idx = tid; idx < 16 * 64; idx += NTHR) { const int p = idx >> 6, n = idx & 63; const int ci_ = ((dir * 32 + g) * 16 + p) * 64 + n;
        Cc[idx] = mkf2(P->in[13][ci_], P->in[14][ci_]); }
    __syncthreads();
    { const int dq = tid >> 8, p = (tid >> 4) & 15, pp = tid & 15;
#pragma unroll 1
        for (int dd = 0; dd < 16; ++dd) { const int d = part * 32 + dq * 16 + dd; float acc = 0.f;
#pragma unroll 4
            for (int n = 0; n < 64; ++n) { const f32x2 w = pw[d * 64 + n], bb = Bb[n * 16 + pp], c = Cc[p * 64 + n];
                const float zr = w.x * bb.x - w.y * bb.y, zi = w.x * bb.y + w.y * bb.x; acc += c.x * zr - c.y * zi; }
            Ktab[((size_t)((g * 2 + dir) * 64 + d)) * 256 + p * 16 + pp] = acc; } }
#pragma unroll 1
    for (int idx = tid; idx < 512 * 64; idx += NTHR) { const int row = part * 512 + (idx >> 6), n = idx & 63, t = row >> 4, p = row & 15, d = dir == 0 ? t + 1 : 64 - t;
        const f32x2 w = pw[d * 64 + n], c = Cc[p * 64 + n]; const float gr = c.x * w.x - c.y * w.y, gi = c.x * w.y + c.y * w.x;
        *(unsigned*)(KG + ((size_t)(g * 1024 + row)) * 1280 + 1024 + dir * 128 + n * 2) = pack2(gr, -gi); }
#pragma unroll 1
    for (int idx = tid; idx < 32 * 64 * 8; idx += NTHR) { const int pp2 = (idx & 7) * 2, s = (idx >> 3) & 63, n = part * 32 + (idx >> 9), d = dir == 0 ? 63 - s : s;
        const f32x2 w = pw[d * 64 + n], b0 = Bb[n * 16 + pp2], b1 = Bb[n * 16 + pp2 + 1];
        const float hr0 = w.x * b0.x - w.y * b0.y, hi0 = w.x * b0.y + w.y * b0.x, hr1 = w.x * b1.x - w.y * b1.y, hi1 = w.x * b1.y + w.y * b1.x;
        const size_t row0 = (size_t)g * 256 + dir * 128 + n * 2;
        *(unsigned*)(H + row0 * 1024 + s * 16 + pp2) = pack2(hr0, hr1); *(unsigned*)(H + (row0 + 1) * 1024 + s * 16 + pp2) = pack2(hi0, hi1); }
    __syncthreads();
}

template <bool FINAL> __device__ void phase_norm(const float* __restrict__ x, const float* __restrict__ g, bf16_t* __restrict__ xb, float* __restrict__ ss_out, float* __restrict__ outf, int b0, int nb, int rbeg, int rend);
__device__ void phase_prologue(CP P, LAS unsigned char* lds) {
    const int tid = otid(), bq = obid();
    if (bq < 128) { if (EN(20)) s5_pre(P, bq >> 2, (bq >> 1) & 1, bq & 1, lds);
        phase_norm<false>(P->in[0], nullptr, (bf16_t*)(P->ws + OFF_XN), (float*)(P->ws + OFF_SSQ), nullptr, 0, 128, 0, 40960); return; }
    const int b0 = 128, nb = (int)gridDim.x - 128;
    if (EN(21)) { float* cs = (float*)(P->ws + OFF_ROPE); float* sn = cs + 8192 * 64;
        for (int idx = (bq - b0) * NTHR + tid; idx < 8192 * 64; idx += nb * NTHR) { const int pos = idx >> 6, f = idx & 63;
            const float inv = expf(-9.210340371976184f * (float)f * (1.0f / 64.0f)); const float ang = (float)pos * inv;
            cs[idx] = cosf(ang); sn[idx] = sinf(ang); } }
    phase_norm<false>(P->in[0], nullptr, (bf16_t*)(P->ws + OFF_XN), (float*)(P->ws + OFF_SSQ), nullptr, b0, nb, 40960, 65536);
    LAS float* tile = (LAS float*)lds;
    if (EN(22)) for (int l = 0; l < 2; ++l) {
        transpose_job(P->in[2] + (size_t)l * 1024 * 5632, 1024, 5632, (bf16_t*)(P->ws + OFF_W1 + (size_t)(2 * l) * SZ_W1), 5632, 1, tile, b0, nb, P->in[1] + l * 1024);
        transpose_job(P->in[6] + (size_t)l * 1024 * 5632, 1024, 5632, (bf16_t*)(P->ws + OFF_W1 + (size_t)(2 * l + 1) * SZ_W1), 5632, 1, tile, b0, nb, P->in[5] + l * 1024);
        transpose_job(P->in[3] + (size_t)l * 2816 * 1024, 2816, 1024, (bf16_t*)(P->ws + OFF_W2 + (size_t)(2 * l) * SZ_W2), 1024, 0, tile, b0, nb, nullptr);
        transpose_job(P->in[7] + (size_t)l * 2816 * 1024, 2816, 1024, (bf16_t*)(P->ws + OFF_W2 + (size_t)(2 * l + 1) * SZ_W2), 1024, 0, tile, b0, nb, nullptr);
    }
    if (EN(22)) transpose_job(P->in[8], 1024, 2080, (bf16_t*)(P->ws + OFF_WIN0), 2304, 0, tile, b0, nb, P->in[4]);
    if (EN(22)) transpose_job(P->in[17], 512, 512, (bf16_t*)(P->ws + OFF_WGLU), 512, 0, tile, b0, nb, nullptr);
    if (EN(22)) transpose_job(P->in[21], 1024, 1024, (bf16_t*)(P->ws + OFF_WOUT0), 1024, 0, tile, b0, nb, nullptr);
    if (EN(22)) transpose_job(P->in[22], 1024, 6144, (bf16_t*)(P->ws + OFF_WIN1), 6144, 2, tile, b0, nb, P->in[4] + 1024);
    if (EN(22)) transpose_job(P->in[24], 2048, 1024, (bf16_t*)(P->ws + OFF_WOUT1), 1024, 0, tile, b0, nb, nullptr);
}

__device__ void phase_kmat(CP P) {
    const float* Ktab = (const float*)(P->ws + OFF_KTAB); bf16_t* KG = (bf16_t*)(P->ws + OFF_KG); const float* dsk = P->in[16];
    for (int idx = obid() * NTHR + otid(); idx < 32 * 1024 * 512; idx += gridDim.x * NTHR) {
        const int kp = idx & 511, row = (idx >> 9) & 1023, g = idx >> 19, t = row >> 4, p = row & 15, k = kp * 2, s = k >> 4, pp = k & 15;
        float v0 = 0.f, v1 = 0.f;
        if (s <= t) { const float* b = Ktab + ((size_t)((g * 2 + 0) * 64 + (t - s))) * 256 + p * 16 + pp; v0 += b[0]; v1 += b[1]; }
        if (s >= t) { const float* b = Ktab + ((size_t)((g * 2 + 1) * 64 + (s - t))) * 256 + p * 16 + pp; v0 += b[0]; v1 += b[1]; }
        if (s == t) { const float dv = dsk[g * 16 + p]; if (pp == p) v0 += dv; if (pp + 1 == p) v1 += dv; }
        *(unsigned*)(KG + ((size_t)(g * 1024 + row)) * 1280 + k) = pack2(v0, v1);
    }
}

template <bool FINAL>
__device__ void phase_norm(const float* __restrict__ x, const float* __restrict__ g, bf16_t* __restrict__ xb, float* __restrict__ ss_out, float* __restrict__ outf, int b0, int nb, int rbeg, int rend) {
    const int tid_ = otid(), lane = tid_ & 63, wid = tid_ >> 6; const int bq = obid() - b0;
    if (bq < 0) return;
    f32x4 gv[4];
#pragma unroll
    for (int i = 0; i < 4; ++i) gv[i] = FINAL ? *(const f32x4*)(g + (lane + 64 * i) * 4) : (f32x4){1.f, 1.f, 1.f, 1.f};
    for (int row0 = rbeg + bq * 8 + wid; row0 < rend; row0 += nb * 16) {
        const int row1 = row0 + nb * 8; const bool has1 = row1 < rend;
        const float* xr0 = x + (size_t)row0 * 1024; const float* xr1 = x + (size_t)(has1 ? row1 : row0) * 1024; f32x4 v[4], u[4]; float ss = 0.f, st = 0.f;
#pragma unroll
        for (int i = 0; i < 4; ++i) { v[i] = *(const f32x4*)(xr0 + (lane + 64 * i) * 4); u[i] = *(const f32x4*)(xr1 + (lane + 64 * i) * 4); }
#pragma unroll
        for (int i = 0; i < 4; ++i) { ss += v[i][0] * v[i][0] + v[i][1] * v[i][1] + v[i][2] * v[i][2] + v[i][3] * v[i][3]; st += u[i][0] * u[i][0] + u[i][1] * u[i][1] + u[i][2] * u[i][2] + u[i][3] * u[i][3]; }
#pragma unroll
        for (int o = 32; o > 0; o >>= 1) { ss += __shfl_xor(ss, o); st += __shfl_xor(st, o); }
#pragma unroll
        for (int rr = 0; rr < 2; ++rr) { if (rr == 1 && !has1) break; const int row = rr ? row1 : row0; const float sv = rr ? st : ss;
            if (FINAL) { const float rstd = rsqrtf(sv * (1.0f / 1024.0f) + 1e-6f);
#pragma unroll
                for (int i = 0; i < 4; ++i) *(f32x4*)(outf + (size_t)row * 1024 + (lane + 64 * i) * 4) = (rr ? u[i] : v[i]) * rstd * gv[i]; }
            else { if (lane < 16) ss_out[(size_t)row * 16 + lane] = lane == 0 ? sv : 0.f;
#pragma unroll
                for (int i = 0; i < 4; ++i) { const f32x4 y = rr ? u[i] : v[i]; uint2 w; w.x = pack2(y[0], y[1]); w.y = pack2(y[2], y[3]); *(uint2*)(xb + (size_t)row * 1024 + (lane + 64 * i) * 4) = w; } } }
    }
}

__device__ void phase_final(const bf16_t* __restrict__ xr, const float* __restrict__ g, float* __restrict__ outf) {
    const int tid_ = otid(), lane = tid_ & 63, wid = tid_ >> 6;
    f32x4 gv[4];
#pragma unroll
    for (int i = 0; i < 4; ++i) gv[i] = *(const f32x4*)(g + lane * 16 + i * 4);
    const int nb8 = (int)gridDim.x * 8;
    for (int row0 = obid() * 8 + wid; row0 < 65536; row0 += nb8 * 2) { const int row1 = row0 + nb8; const bool has1 = row1 < 65536;
        const uint4 a0 = *(const uint4*)(xr + (size_t)row0 * 1024 + lane * 16), a1 = *(const uint4*)(xr + (size_t)row0 * 1024 + lane * 16 + 8);
        const uint4 b0 = *(const uint4*)(xr + (size_t)(has1 ? row1 : row0) * 1024 + lane * 16), b1 = *(const uint4*)(xr + (size_t)(has1 ? row1 : row0) * 1024 + lane * 16 + 8);
        f32x4 v[4] = {(f32x4){bflo(a0.x), bfhi(a0.x), bflo(a0.y), bfhi(a0.y)}, (f32x4){bflo(a0.z), bfhi(a0.z), bflo(a0.w), bfhi(a0.w)}, (f32x4){bflo(a1.x), bfhi(a1.x), bflo(a1.y), bfhi(a1.y)}, (f32x4){bflo(a1.z), bfhi(a1.z), bflo(a1.w), bfhi(a1.w)}};
        f32x4 w[4] = {(f32x4){bflo(b0.x), bfhi(b0.x), bflo(b0.y), bfhi(b0.y)}, (f32x4){bflo(b0.z), bfhi(b0.z), bflo(b0.w), bfhi(b0.w)}, (f32x4){bflo(b1.x), bfhi(b1.x), bflo(b1.y), bfhi(b1.y)}, (f32x4){bflo(b1.z), bfhi(b1.z), bflo(b1.w), bfhi(b1.w)}};
        float ss = 0.f, st = 0.f;
#pragma unroll
        for (int i = 0; i < 4; ++i) { ss += v[i][0] * v[i][0] + v[i][1] * v[i][1] + v[i][2] * v[i][2] + v[i][3] * v[i][3]; st += w[i][0] * w[i][0] + w[i][1] * w[i][1] + w[i][2] * w[i][2] + w[i][3] * w[i][3]; }
#pragma unroll
        for (int o = 32; o > 0; o >>= 1) { ss += __shfl_xor(ss, o); st += __shfl_xor(st, o); }
        const float r0 = rsqrtf(ss * (1.0f / 1024.0f) + 1e-6f), r1 = rsqrtf(st * (1.0f / 1024.0f) + 1e-6f);
#pragma unroll
        for (int i = 0; i < 4; ++i) *(f32x4*)(outf + (size_t)row0 * 1024 + lane * 16 + i * 4) = v[i] * r0 * gv[i];
        if (has1) {
#pragma unroll
            for (int i = 0; i < 4; ++i) *(f32x4*)(outf + (size_t)row1 * 1024 + lane * 16 + i * 4) = w[i] * r1 * gv[i]; }
    }
}

__device__ __forceinline__ f32x4 mma16(const LAS bf16_t* As, int lda, const LAS bf16_t* Bs, int ldb, int K, f32x4 acc, int lane) {
    const int r = lane & 15, q = lane >> 4;
#pragma unroll
    for (int k = 0; k < K; k += 32) { const bf16x8 a = *(const LAS bf16x8*)(As + r * lda + k + q * 8); const bf16x8 b = *(const LAS bf16x8*)(Bs + r * ldb + k + q * 8);
        acc = __builtin_amdgcn_mfma_f32_16x16x32_bf16(b, a, acc, 0, 0, 0); }
    return acc;
}


typedef short s16x4 __attribute__((ext_vector_type(4)));
__device__ __forceinline__ bf16x8 frag_tr(const LAS bf16_t* T, int ld, int lane) {
    const int g = lane >> 4, qq = (lane & 15) >> 2, p = lane & 3;
    LAS bf16_t* a = (LAS bf16_t*)T + (8 * g + qq) * ld + 4 * p;
    const s16x4 lo = __builtin_amdgcn_ds_read_tr16_b64_v4i16((LAS s16x4*)a);
    const s16x4 hi = __builtin_amdgcn_ds_read_tr16_b64_v4i16((LAS s16x4*)(a + 4 * ld));
    return (bf16x8){lo[0], lo[1], lo[2], lo[3], hi[0], hi[1], hi[2], hi[3]};
}

__device__ __forceinline__ void lds_barrier() { asm volatile("s_waitcnt lgkmcnt(0)" ::: "memory"); __builtin_amdgcn_s_barrier(); asm volatile("" ::: "memory"); }

__device__ void phase_s5_scan(CP P) {
    const float* E = (const float*)(P->ws + OFF_E); const float* AT = (const float*)(P->ws + OFF_S5P); bf16_t* AS5 = (bf16_t*)(P->ws + OFF_AS5);
    const int tid_ = otid(); if (tid_ >= 128) return;
    for (int idx = obid() * 128 + tid_; idx < 32 * 8 * 2 * 64; idx += gridDim.x * 128) {
        const int n = idx & 63, dir = (idx >> 6) & 1, b = (idx >> 7) & 7, g = idx >> 10;
        const float ar = AT[((g * 2 + dir) * 64 + n) * 2], ai = AT[((g * 2 + dir) * 64 + n) * 2 + 1];
        float xr = 0.f, xi = 0.f;
#pragma unroll 1
        for (int c0 = 0; c0 < 128; c0 += 16) { float2 ev[16];
#pragma unroll
            for (int k = 0; k < 16; ++k) { const int c = dir == 0 ? c0 + k : 127 - (c0 + k); const size_t bc = (size_t)g * 1024 + b * 128 + c; ev[k] = *(const float2*)(E + bc * 256 + dir * 128 + n * 2); }
#pragma unroll
            for (int k = 0; k < 16; ++k) { const int c = dir == 0 ? c0 + k : 127 - (c0 + k); const size_t bc = (size_t)g * 1024 + b * 128 + c;
                *(unsigned*)(AS5 + bc * 1280 + 1024 + dir * 128 + n * 2) = pack2(xr, xi);
                const float t0 = ar * xr - ai * xi + ev[k].x; xi = ar * xi + ai * xr + ev[k].y; xr = t0; } }
    }
}

__device__ __forceinline__ void gla_gates(CP P, const bf16_t* PQ, int m0, int h, LAS unsigned char* lds) {
    LAS float* gl = (LAS float*)lds; LAS float* tot = (LAS float*)(lds + 8192); LAS float* G = (LAS float*)(lds + 17408);
    const int tid = otid();
    const int dir = tid >> 8, d = tid & 63, tq = (tid >> 6) & 3;
    { const int idx = tid * 4, t = idx >> 5, r = idx & 31; const uint2 raw = *(const uint2*)(PQ + (size_t)(m0 + t) * 1792 + 1536 + r);
        *(LAS f32x4*)(gl + idx) = (f32x4){bflo(raw.x), bfhi(raw.x), bflo(raw.y), bfhi(raw.y)}; }
    float w[16];
#pragma unroll
    for (int r = 0; r < 16; ++r) w[r] = P->in[18][(dir * 16 + r) * 256 + h * 64 + d];
    const float b = P->in[19][dir * 256 + h * 64 + d];
    lds_barrier();
    float c[16];
#pragma unroll
    for (int i = 0; i < 16; ++i) { const int t = tq * 16 + i; float z = b;
#pragma unroll
        for (int r4 = 0; r4 < 4; ++r4) { const f32x4 g4 = *(const LAS f32x4*)(gl + t * 32 + dir * 16 + r4 * 4);
            z += g4[0] * w[r4 * 4] + g4[1] * w[r4 * 4 + 1] + g4[2] * w[r4 * 4 + 2] + g4[3] * w[r4 * 4 + 3]; }
        c[i] = (fminf(z, 0.f) - __logf(1.0f + __expf(-fabsf(z)))) * (1.0f / 16.0f); }
    if (dir == 0) {
#pragma unroll
        for (int i = 1; i < 16; ++i) c[i] += c[i - 1];
        tot[(dir * 4 + tq) * 64 + d] = c[15]; }
    else {
#pragma unroll
        for (int i = 14; i >= 0; --i) c[i] += c[i + 1];
        tot[(dir * 4 + tq) * 64 + d] = c[0]; }
    lds_barrier();
    float off = 0.f;
#pragma unroll
    for (int q = 0; q < 4; ++q) { const float tv = tot[(dir * 4 + q) * 64 + d]; off += ((dir == 0) ? (q < tq) : (q > tq)) ? tv : 0.f; }
#pragma unroll
    for (int i = 0; i < 16; ++i) G[(dir * 64 + tq * 16 + i) * 64 + d] = c[i] + off;
    lds_barrier();
}

__device__ void gla_a_unit(CP P, int unit, LAS unsigned char* lds) {
    const int c = unit & 127, h = (unit >> 7) & 3, b = unit >> 9, m0 = b * 8192 + c * 64;
    const bf16_t* PQ = (const bf16_t*)(P->ws + OFF_PQ); bf16_t* GST = (bf16_t*)(P->ws + OFF_GST); float* GDEC = (float*)(P->ws + OFF_GDEC);
    const int tid = otid(), lane = tid & 63, wid = tid >> 6;
    const int t = tid >> 3, d8 = (tid & 7) * 8, v16 = (tid & 7) * 16;
    const uint4 kraw = *(const uint4*)(PQ + (size_t)(m0 + t) * 1792 + 256 + h * 64 + d8);
    const uint4 vr0 = *(const uint4*)(PQ + (size_t)(m0 + t) * 1792 + 512 + h * 128 + v16), vr1 = *(const uint4*)(PQ + (size_t)(m0 + t) * 1792 + 512 + h * 128 + v16 + 8);
    gla_gates(P, PQ, m0, h, lds);
    LAS float* G = (LAS float*)(lds + 17408);
    LAS bf16_t* kA = (LAS bf16_t*)(lds + 50176);
    LAS bf16_t* Vs = (LAS bf16_t*)(lds + 67584);
    { const unsigned rw[4] = {kraw.x, kraw.y, kraw.z, kraw.w}; float ef[8], eb[8];
#pragma unroll
        for (int q = 0; q < 2; ++q) { const f32x4 lf = *(const LAS f32x4*)(G + 63 * 64 + d8 + q * 4), cf = *(const LAS f32x4*)(G + t * 64 + d8 + q * 4);
            const f32x4 lb = *(const LAS f32x4*)(G + 64 * 64 + d8 + q * 4), cb = *(const LAS f32x4*)(G + (64 + t) * 64 + d8 + q * 4);
#pragma unroll
            for (int j = 0; j < 4; ++j) { ef[q * 4 + j] = __expf(lf[j] - cf[j]); eb[q * 4 + j] = __expf(lb[j] - cb[j]); } }
        unsigned of[4], ob[4];
#pragma unroll
        for (int i = 0; i < 4; ++i) { const float k0 = bflo(rw[i]), k1 = bfhi(rw[i]); of[i] = pack2(k0 * ef[2 * i], k1 * ef[2 * i + 1]); ob[i] = pack2(k0 * eb[2 * i], k1 * eb[2 * i + 1]); }
        *(LAS u32x4*)(kA + t * 136 + d8) = mk4(of[0], of[1], of[2], of[3]); *(LAS u32x4*)(kA + t * 136 + 64 + d8) = mk4(ob[0], ob[1], ob[2], ob[3]);
        *(LAS u32x4*)(Vs + t * 136 + v16) = mk4(vr0.x, vr0.y, vr0.z, vr0.w); *(LAS u32x4*)(Vs + t * 136 + v16 + 8) = mk4(vr1.x, vr1.y, vr1.z, vr1.w); }
    if (tid < 128) { const int dir = tid >> 6, d = tid & 63; const float last = dir == 0 ? G[63 * 64 + d] : G[64 * 64 + d];
        GDEC[((size_t)(((b * 4 + h) * 2 + dir) * 128 + c)) * 64 + d] = __expf(last); }
    lds_barrier();
    { f32x4 acc[8];
#pragma unroll
        for (int nt = 0; nt < 8; ++nt) acc[nt] = (f32x4){0.f, 0.f, 0.f, 0.f};
#pragma unroll
        for (int ks = 0; ks < 2; ++ks) { const bf16x8 af = frag_tr(kA + ks * 32 * 136 + wid * 16, 136, lane);
#pragma unroll
            for (int nt = 0; nt < 8; ++nt) { const bf16x8 bfr = frag_tr(Vs + ks * 32 * 136 + nt * 16, 136, lane); acc[nt] = __builtin_amdgcn_mfma_f32_16x16x32_bf16(bfr, af, acc[nt], 0, 0, 0); } }
        const int row = wid * 16 + (lane & 15), dir = row >> 6, d = row & 63; bf16_t* out = GST + ((size_t)(((b * 4 + h) * 2 + dir) * 128 + c)) * 8192 + d * 128 + 4 * (lane >> 4);
#pragma unroll
        for (int nt = 0; nt < 8; ++nt) { uint2 w; w.x = pack2(acc[nt][0], acc[nt][1]); w.y = pack2(acc[nt][2], acc[nt][3]); *(uint2*)(out + nt * 16) = w; } }
    lds_barrier();
}

__device__ void phase_gla_b(CP P) {
    bf16_t* GST = (bf16_t*)(P->ws + OFF_GST); const float* GDEC = (const float*)(P->ws + OFF_GDEC);
    for (int idx = obid() * NTHR + otid(); idx < 64 * 1024; idx += gridDim.x * NTHR) {
        const int bhd = idx >> 10, e = (idx & 1023) * 8, d = e >> 7, dir = bhd & 1;
        f32x4 S0 = (f32x4){0.f, 0.f, 0.f, 0.f}, S1 = S0;
        bf16_t* base = GST + ((size_t)bhd * 128) * 8192 + e; const float* dbase = GDEC + ((size_t)bhd * 128) * 64 + d;
#pragma unroll 1
        for (int c0 = 0; c0 < 128; c0 += 8) { uint4 t[8]; float dc[8];
#pragma unroll
            for (int k = 0; k < 8; ++k) { const int c = dir == 0 ? c0 + k : 127 - (c0 + k); t[k] = *(const uint4*)(base + (size_t)c * 8192); dc[k] = dbase[(size_t)c * 64]; }
#pragma unroll
            for (int k = 0; k < 8; ++k) { const int c = dir == 0 ? c0 + k : 127 - (c0 + k);
                uint4 o; o.x = pack2(S0[0], S0[1]); o.y = pack2(S0[2], S0[3]); o.z = pack2(S1[0], S1[1]); o.w = pack2(S1[2], S1[3]); *(uint4*)(base + (size_t)c * 8192) = o;
                S0 = dc[k] * S0 + (f32x4){bflo(t[k].x), bfhi(t[k].x), bflo(t[k].y), bfhi(t[k].y)}; S1 = dc[k] * S1 + (f32x4){bflo(t[k].z), bfhi(t[k].z), bflo(t[k].w), bfhi(t[k].w)}; } }
    }
}

__device__ void gla_c_unit(CP P, int unit, LAS unsigned char* lds) {
    const int c = unit & 127, h = (unit >> 7) & 3, b = unit >> 9, m0 = b * 8192 + c * 64;
    const bf16_t* PQ = (const bf16_t*)(P->ws + OFF_PQ); const bf16_t* GST = (const bf16_t*)(P->ws + OFF_GST); bf16_t* MIX = (bf16_t*)(P->ws + OFF_MIX);
    const int tid = otid(), lane = tid & 63, wid = tid >> 6;
    const int t = tid >> 3, d8 = (tid & 7) * 8, v16 = (tid & 7) * 16;
    const uint4 rq = *(const uint4*)(PQ + (size_t)(m0 + t) * 1792 + h * 64 + d8), rk = *(const uint4*)(PQ + (size_t)(m0 + t) * 1792 + 256 + h * 64 + d8);
    const uint4 vr0 = *(const uint4*)(PQ + (size_t)(m0 + t) * 1792 + 512 + h * 128 + v16), vr1 = *(const uint4*)(PQ + (size_t)(m0 + t) * 1792 + 512 + h * 128 + v16 + 8);
    const uint4 ogr0 = *(const uint4*)(PQ + (size_t)(m0 + t) * 1792 + 1024 + h * 128 + v16), ogr1 = *(const uint4*)(PQ + (size_t)(m0 + t) * 1792 + 1024 + h * 128 + v16 + 8);
    uint4 sr[4];
#pragma unroll
    for (int i = 0; i < 4; ++i) { const int idx = tid + i * NTHR, v8 = (idx & 15) * 8, d = (idx >> 4) & 63, dir = idx >> 10;
        sr[i] = *(const uint4*)(GST + ((size_t)(((b * 4 + h) * 2 + dir) * 128 + c)) * 8192 + d * 128 + v8); }
    gla_gates(P, PQ, m0, h, lds);
    LAS float* G = (LAS float*)(lds + 17408);
    LAS bf16_t* Ps = (LAS bf16_t*)lds;
    LAS bf16_t* qf = (LAS bf16_t*)(lds + 51200);
    LAS bf16_t* kf = qf + 64 * 72; LAS bf16_t* qb = kf + 64 * 72; LAS bf16_t* kb = qb + 64 * 72;
    LAS bf16_t* Vs = (LAS bf16_t*)(lds + 88064);
    LAS bf16_t* Ss = (LAS bf16_t*)(lds + 105472);
    { const unsigned qw[4] = {rq.x, rq.y, rq.z, rq.w}, kw[4] = {rk.x, rk.y, rk.z, rk.w};
        unsigned oqf[4], okf[4], oqb[4], okb[4]; float cf[8], cb[8];
#pragma unroll
        for (int q = 0; q < 2; ++q) { const f32x4 a = *(const LAS f32x4*)(G + t * 64 + d8 + q * 4), bb = *(const LAS f32x4*)(G + (64 + t) * 64 + d8 + q * 4);
#pragma unroll
            for (int j = 0; j < 4; ++j) { cf[q * 4 + j] = a[j]; cb[q * 4 + j] = bb[j]; } }
#pragma unroll
        for (int i = 0; i < 4; ++i) { const float cf0 = cf[2 * i], cf1 = cf[2 * i + 1], cb0 = cb[2 * i], cb1 = cb[2 * i + 1];
            const float q0 = bflo(qw[i]) * 0.125f, q1 = bfhi(qw[i]) * 0.125f, k0 = bflo(kw[i]), k1 = bfhi(kw[i]);
            oqf[i] = pack2(q0 * __expf(cf0), q1 * __expf(cf1)); okf[i] = pack2(k0 * __expf(-cf0), k1 * __expf(-cf1));
            oqb[i] = pack2(q0 * __expf(cb0), q1 * __expf(cb1)); okb[i] = pack2(k0 * __expf(-cb0), k1 * __expf(-cb1)); }
        *(LAS u32x4*)(qf + t * 72 + d8) = mk4(oqf[0], oqf[1], oqf[2], oqf[3]); *(LAS u32x4*)(kf + t * 72 + d8) = mk4(okf[0], okf[1], okf[2], okf[3]);
        *(LAS u32x4*)(qb + t * 72 + d8) = mk4(oqb[0], oqb[1], oqb[2], oqb[3]); *(LAS u32x4*)(kb + t * 72 + d8) = mk4(okb[0], okb[1], okb[2], okb[3]);
        *(LAS u32x4*)(Vs + t * 136 + v16) = mk4(vr0.x, vr0.y, vr0.z, vr0.w); *(LAS u32x4*)(Vs + t * 136 + v16 + 8) = mk4(vr1.x, vr1.y, vr1.z, vr1.w); }
#pragma unroll
    for (int i = 0; i < 4; ++i) { const int idx = tid + i * NTHR, v8 = (idx & 15) * 8, d = (idx >> 4) & 63, dir = idx >> 10;
        *(LAS u32x4*)(Ss + (dir * 64 + d) * 136 + v8) = mk4(sr[i].x, sr[i].y, sr[i].z, sr[i].w); }
    lds_barrier();
#pragma unroll
    for (int tl = 0; tl < 2; ++tl) { const int tile = wid * 2 + tl, mi = tile >> 2, ni = tile & 3; f32x4 pf = (f32x4){0.f, 0.f, 0.f, 0.f}, pb = pf;
        pf = mma16(qf + mi * 16 * 72, 72, kf + ni * 16 * 72, 72, 64, pf, lane); pb = mma16(qb + mi * 16 * 72, 72, kb + ni * 16 * 72, 72, 64, pb, lane);
        const int i = mi * 16 + (lane & 15), j0 = ni * 16 + 4 * (lane >> 4); float pv[4];
#pragma unroll
        for (int jj = 0; jj < 4; ++jj) pv[jj] = (j0 + jj <= i) ? pf[jj] : pb[jj];
        *(LAS u32x2*)(Ps + i * 72 + j0) = mk2(pack2(pv[0], pv[1]), pack2(pv[2], pv[3])); }
    lds_barrier();
    { const int mi = wid & 3, nb = (wid >> 2) * 4; LAS float* ost = G; f32x4 acc[4];
#pragma unroll
        for (int nt = 0; nt < 4; ++nt) acc[nt] = (f32x4){0.f, 0.f, 0.f, 0.f};
#pragma unroll
        for (int ks = 0; ks < 2; ++ks) {
            const bf16x8 ap = *(const LAS bf16x8*)(Ps + (mi * 16 + (lane & 15)) * 72 + ks * 32 + (lane >> 4) * 8);
            const bf16x8 af = *(const LAS bf16x8*)(qf + (mi * 16 + (lane & 15)) * 72 + ks * 32 + (lane >> 4) * 8);
            const bf16x8 ab = *(const LAS bf16x8*)(qb + (mi * 16 + (lane & 15)) * 72 + ks * 32 + (lane >> 4) * 8);
#pragma unroll
            for (int nt = 0; nt < 4; ++nt) { const int ni = nb + nt;
                acc[nt] = __builtin_amdgcn_mfma_f32_16x16x32_bf16(frag_tr(Vs + ks * 32 * 136 + ni * 16, 136, lane), ap, acc[nt], 0, 0, 0);
                acc[nt] = __builtin_amdgcn_mfma_f32_16x16x32_bf16(frag_tr(Ss + ks * 32 * 136 + ni * 16, 136, lane), af, acc[nt], 0, 0, 0);
                acc[nt] = __builtin_amdgcn_mfma_f32_16x16x32_bf16(frag_tr(Ss + (64 + ks * 32) * 136 + ni * 16, 136, lane), ab, acc[nt], 0, 0, 0); } }
#pragma unroll
        for (int nt = 0; nt < 4; ++nt) *(LAS f32x4*)(ost + (mi * 16 + (lane & 15)) * 132 + (nb + nt) * 16 + 4 * (lane >> 4)) = acc[nt]; }
    lds_barrier();
    { LAS float* ost = G; float o[16]; float ss = 0.f;
#pragma unroll
        for (int i = 0; i < 4; ++i) { const f32x4 v = *(const LAS f32x4*)(ost + t * 132 + v16 + i * 4); o[4 * i] = v[0]; o[4 * i + 1] = v[1]; o[4 * i + 2] = v[2]; o[4 * i + 3] = v[3]; ss += v[0] * v[0] + v[1] * v[1] + v[2] * v[2] + v[3] * v[3]; }
        ss += __shfl_xor(ss, 1); ss += __shfl_xor(ss, 2); ss += __shfl_xor(ss, 4);
        const float rstd = rsqrtf(ss * (1.0f / 128.0f) + 1e-6f);
        const float* gn = P->in[20] + h * 128 + v16;
        bf16_t* op = MIX + (size_t)(m0 + t) * 1024 + 512 + h * 128 + v16;
#pragma unroll
        for (int hh = 0; hh < 2; ++hh) { const uint4 raw = hh ? ogr1 : ogr0; const unsigned rw[4] = {raw.x, raw.y, raw.z, raw.w}; unsigned ow[4];
#pragma unroll
            for (int i = 0; i < 4; ++i) { const int e = hh * 8 + 2 * i; const float g0 = bflo(rw[i]), g1 = bfhi(rw[i]);
                ow[i] = pack2(o[e] * rstd * gn[e] * silu_f(g0), o[e + 1] * rstd * gn[e + 1] * silu_f(g1)); }
            *(uint4*)(op + hh * 8) = make_uint4(ow[0], ow[1], ow[2], ow[3]); } }
    lds_barrier();
}

__device__ __forceinline__ float ret_lg(int h) {
    float v = -0.0317486983145803f;
    v = h == 1 ? -0.015748356968139168f : v; v = h == 2 ? -0.007843177461025893f : v; v = h == 3 ? -0.003913899321136329f : v; v = h == 4 ? -0.0019550348358033506f : v;
    v = h == 5 ? -0.0009770396478266127f : v; v = h == 6 ? -0.0004884004981088745f : v; v = h == 7 ? -0.0002441704321739145f : v; return v;
}

struct KRaw { uint4 a, b; };
__device__ __forceinline__ KRaw rot_load(const bf16_t* rowp, const float*, const float*, int dq) { KRaw k; k.a = *(const uint4*)(rowp + dq); k.b = *(const uint4*)(rowp + 64 + dq); return k; }
__device__ __forceinline__ void rot_apply(const KRaw& k, float (&r1)[8], float (&r2)[8]) {
    const unsigned aw[4] = {k.a.x, k.a.y, k.a.z, k.a.w}, bw[4] = {k.b.x, k.b.y, k.b.z, k.b.w};
#pragma unroll
    for (int i = 0; i < 8; ++i) { r1[i] = (i & 1) ? bfhi(aw[i >> 1]) : bflo(aw[i >> 1]); r2[i] = (i & 1) ? bfhi(bw[i >> 1]) : bflo(bw[i >> 1]); }
}

__device__ void ret_a_unit(CP P, int hf, int unit, LAS unsigned char* lds) {
    const int sc = unit & 31, h = (unit >> 5) & 7, bl = unit >> 8;
    const bf16_t* PR = (const bf16_t*)(P->ws + OFF_PROJ1); bf16_t* RST = (bf16_t*)(P->ws + OFF_RST);
    const int tid = otid(), lane = tid & 63, wid = tid >> 6;
    const size_t r0 = (size_t)bl * 8192 + sc * 256;
    const float lgf = ret_lg(h), lgb = ret_lg(7 - h);
    LAS bf16_t* kf = (LAS bf16_t*)lds;
    LAS bf16_t* kb = (LAS bf16_t*)(lds + 17408);
    LAS bf16_t* Vs = (LAS bf16_t*)(lds + 34816);
    f32x4 acc[4][8];
#pragma unroll
    for (int a = 0; a < 4; ++a)
#pragma unroll
        for (int n = 0; n < 8; ++n) acc[a][n] = (f32x4){0.f, 0.f, 0.f, 0.f};
    const int mb = (wid >> 1) * 4, nb = (wid & 1) * 8;
    const LAS bf16_t* kA = (mb >= 8) ? kb : kf; const int dt0 = (mb & 7) * 16;
    const int pj = tid >> 3, pdq = (tid & 7) * 8, pv32 = (tid & 7) * 32;
    const bf16_t* kbase = PR + (r0 + pj) * 6144 + 1024 + h * 128; const bf16_t* vbase = PR + (r0 + pj) * 6144 + 2048 + h * 256 + pv32;
    KRaw kr = rot_load(kbase, nullptr, nullptr, pdq);
    uint4 vr[4];
#pragma unroll
    for (int hh = 0; hh < 4; ++hh) vr[hh] = *(const uint4*)(vbase + hh * 8);
    for (int jb = 0; jb < 4; ++jb) {
        { const int j = pj, dq = pdq, J = jb * 64 + j; float r1[8], r2[8];
            rot_apply(kr, r1, r2);
            const float sf = __expf((float)(255 - J) * lgf), sb = __expf((float)J * lgb);
            *(LAS u32x4*)(kf + j * 136 + dq) = mk4(pack2(r1[0] * sf, r1[1] * sf), pack2(r1[2] * sf, r1[3] * sf), pack2(r1[4] * sf, r1[5] * sf), pack2(r1[6] * sf, r1[7] * sf));
            *(LAS u32x4*)(kf + j * 136 + 64 + dq) = mk4(pack2(r2[0] * sf, r2[1] * sf), pack2(r2[2] * sf, r2[3] * sf), pack2(r2[4] * sf, r2[5] * sf), pack2(r2[6] * sf, r2[7] * sf));
            *(LAS u32x4*)(kb + j * 136 + dq) = mk4(pack2(r1[0] * sb, r1[1] * sb), pack2(r1[2] * sb, r1[3] * sb), pack2(r1[4] * sb, r1[5] * sb), pack2(r1[6] * sb, r1[7] * sb));
            *(LAS u32x4*)(kb + j * 136 + 64 + dq) = mk4(pack2(r2[0] * sb, r2[1] * sb), pack2(r2[2] * sb, r2[3] * sb), pack2(r2[4] * sb, r2[5] * sb), pack2(r2[6] * sb, r2[7] * sb));
#pragma unroll
            for (int hh = 0; hh < 4; ++hh) *(LAS u32x4*)(Vs + j * 264 + pv32 + hh * 8) = mk4(vr[hh].x, vr[hh].y, vr[hh].z, vr[hh].w); }
        lds_barrier();
        if (jb < 3) { kr = rot_load(kbase + (size_t)(jb + 1) * 64 * 6144, nullptr, nullptr, pdq);
#pragma unroll
            for (int hh = 0; hh < 4; ++hh) vr[hh] = *(const uint4*)(vbase + (size_t)(jb + 1) * 64 * 6144 + hh * 8); }
#pragma unroll
        for (int ks = 0; ks < 2; ++ks) { bf16x8 af[4];
#pragma unroll
            for (int a = 0; a < 4; ++a) af[a] = frag_tr(kA + ks * 32 * 136 + dt0 + a * 16, 136, lane);
#pragma unroll
            for (int n = 0; n < 8; ++n) { const bf16x8 bfr = frag_tr(Vs + ks * 32 * 264 + (nb + n) * 16, 264, lane);
#pragma unroll
                for (int a = 0; a < 4; ++a) acc[a][n] = __builtin_amdgcn_mfma_f32_16x16x32_bf16(bfr, af[a], acc[a][n], 0, 0, 0); } }
        lds_barrier();
    }
#pragma unroll
    for (int a = 0; a < 4; ++a) { const int row = (mb + a) * 16 + (lane & 15), dir = row >> 7, d = row & 127;
        bf16_t* out = RST + ((size_t)(((bl * 8 + h) * 2 + dir) * 32 + sc)) * 32768 + d * 256 + 4 * (lane >> 4);
#pragma unroll
        for (int n = 0; n < 8; ++n) { uint2 w; w.x = pack2(acc[a][n][0], acc[a][n][1]); w.y = pack2(acc[a][n][2], acc[a][n][3]); *(uint2*)(out + (nb + n) * 16) = w; } }
}

__device__ void phase_ret_b(CP P) {
    bf16_t* RST = (bf16_t*)(P->ws + OFF_RST);
    for (int idx = obid() * NTHR + otid(); idx < 64 * 4096; idx += gridDim.x * NTHR) {
        const int bhd = idx >> 12, e = (idx & 4095) * 8, dir = bhd & 1, h = (bhd >> 1) & 7;
        const float dec = __expf(256.0f * ret_lg(dir == 0 ? h : 7 - h));
        f32x4 S0 = (f32x4){0.f, 0.f, 0.f, 0.f}, S1 = S0;
        bf16_t* base = RST + ((size_t)bhd * 32) * 32768 + e;
#pragma unroll 1
        for (int c0 = 0; c0 < 32; c0 += 8) { uint4 t[8];
#pragma unroll
            for (int k = 0; k < 8; ++k) { const int c = dir == 0 ? c0 + k : 31 - (c0 + k); t[k] = *(const uint4*)(base + (size_t)c * 32768); }
#pragma unroll
            for (int k = 0; k < 8; ++k) { const int c = dir == 0 ? c0 + k : 31 - (c0 + k);
                uint4 o; o.x = pack2(S0[0], S0[1]); o.y = pack2(S0[2], S0[3]); o.z = pack2(S1[0], S1[1]); o.w = pack2(S1[2], S1[3]); *(uint4*)(base + (size_t)c * 32768) = o;
                S0 = dec * S0 + (f32x4){bflo(t[k].x), bfhi(t[k].x), bflo(t[k].y), bfhi(t[k].y)}; S1 = dec * S1 + (f32x4){bflo(t[k].z), bfhi(t[k].z), bflo(t[k].w), bfhi(t[k].w)}; } }
    }
}

__device__ void ret_c_unit(CP P, int hf, int unit, LAS unsigned char* lds) {
    const int rh = (unit >> 3) & 1, ur = (unit & 7) | ((unit >> 4) << 3), sc = ur & 31, h = (ur >> 5) & 7, bl = ur >> 8;
    const bf16_t* PR = (const bf16_t*)(P->ws + OFF_PROJ1); const bf16_t* RST = (const bf16_t*)(P->ws + OFF_RST);
    const float* cs = (const float*)(P->ws + OFF_ROPE); const float* sn = cs + 8192 * 64;
    const int tid = otid(), lane = tid & 63, wid = tid >> 6;
    const size_t r0 = (size_t)bl * 8192 + sc * 256;
    const float lgf = ret_lg(h), lgb = ret_lg(7 - h);
    LAS bf16_t* qs = (LAS bf16_t*)lds;
    LAS bf16_t* ks = (LAS bf16_t*)(lds + 34816);
    LAS bf16_t* Ps = (LAS bf16_t*)(lds + 52224);
    LAS bf16_t* Vs = (LAS bf16_t*)(lds + 70656);
    LAS float* red = (LAS float*)(lds + 104448);
    LAS bf16_t* qx = ks;
#pragma unroll
    for (int rep = 0; rep < 2; ++rep) { const int i = (tid >> 3) + rep * 64, dq = (tid & 7) * 8, I = rh * 128 + i;
        const KRaw q_ = rot_load(PR + (r0 + I) * 6144 + h * 128, nullptr, nullptr, dq);
        *(LAS u32x4*)(qs + i * 136 + dq) = mk4(q_.a.x, q_.a.y, q_.a.z, q_.a.w); *(LAS u32x4*)(qs + i * 136 + 64 + dq) = mk4(q_.b.x, q_.b.y, q_.b.z, q_.b.w); }
    f32x4 acc[2][8];
#pragma unroll
    for (int r = 0; r < 2; ++r)
#pragma unroll
        for (int n = 0; n < 8; ++n) acc[r][n] = (f32x4){0.f, 0.f, 0.f, 0.f};
    const int mi2 = (wid & 3) * 2, nb = (wid >> 2) * 8;
    const int pj = tid >> 3, pdq = (tid & 7) * 8, pv32 = (tid & 7) * 32;
    const bf16_t* kbase = PR + (r0 + pj) * 6144 + 1024 + h * 128; const bf16_t* vbase = PR + (r0 + pj) * 6144 + 2048 + h * 256 + pv32;
    KRaw kr = rot_load(kbase, cs + (sc * 256 + pj) * 64, sn + (sc * 256 + pj) * 64, pdq);
    uint4 vr[4];
#pragma unroll
    for (int hh = 0; hh < 4; ++hh) vr[hh] = *(const uint4*)(vbase + hh * 8);
    uint4 st[4];
    const bf16_t* sbase = RST + ((size_t)((bl * 8 + h) * 2) * 32 + sc) * 32768;
    for (int kb = 0; kb < 4; ++kb) {
        { const int j = pj, dq = pdq;
            *(LAS u32x4*)(ks + j * 136 + dq) = mk4(kr.a.x, kr.a.y, kr.a.z, kr.a.w); *(LAS u32x4*)(ks + j * 136 + 64 + dq) = mk4(kr.b.x, kr.b.y, kr.b.z, kr.b.w);
#pragma unroll
            for (int hh = 0; hh < 4; ++hh) *(LAS u32x4*)(Vs + j * 264 + pv32 + hh * 8) = mk4(vr[hh].x, vr[hh].y, vr[hh].z, vr[hh].w); }
        lds_barrier();
        if (kb < 3) { const int J = (kb + 1) * 64 + pj; kr = rot_load(kbase + (size_t)(kb + 1) * 64 * 6144, cs + (sc * 256 + J) * 64, sn + (sc * 256 + J) * 64, pdq);
#pragma unroll
            for (int hh = 0; hh < 4; ++hh) vr[hh] = *(const uint4*)(vbase + (size_t)(kb + 1) * 64 * 6144 + hh * 8); }
        else {
#pragma unroll
            for (int i = 0; i < 4; ++i) { const int idx = tid + i * NTHR, v8 = (idx & 31) * 8, dd = idx >> 5; st[i] = *(const uint4*)(sbase + dd * 256 + v8); } }
#pragma unroll
        for (int tr = 0; tr < 2; ++tr)
#pragma unroll
            for (int tc = 0; tc < 2; ++tc) { const int ti = mi2 + tr, tj = (wid >> 2) * 2 + tc; f32x4 s = (f32x4){0.f, 0.f, 0.f, 0.f};
                s = mma16(qs + ti * 16 * 136, 136, ks + tj * 16 * 136, 136, 128, s, lane);
                const int i = ti * 16 + (lane & 15), j0 = tj * 16 + 4 * (lane >> 4), I = rh * 128 + i; float pv[4];
#pragma unroll
                for (int jj = 0; jj < 4; ++jj) { const int df = I - (kb * 64 + j0 + jj); const float dm = df >= 0 ? __expf((float)df * lgf) : __expf((float)(-df) * lgb); pv[jj] = s[jj] * dm; }
                *(LAS u32x2*)(Ps + i * 72 + j0) = mk2(pack2(pv[0], pv[1]), pack2(pv[2], pv[3])); }
        lds_barrier();
#pragma unroll
        for (int k2 = 0; k2 < 2; ++k2) { bf16x8 af[2], bfr[8];
#pragma unroll
            for (int r = 0; r < 2; ++r) af[r] = *(const LAS bf16x8*)(Ps + ((mi2 + r) * 16 + (lane & 15)) * 72 + k2 * 32 + (lane >> 4) * 8);
#pragma unroll
            for (int n = 0; n < 8; ++n) bfr[n] = frag_tr(Vs + k2 * 32 * 264 + (nb + n) * 16, 264, lane);
#pragma unroll
            for (int r = 0; r < 2; ++r)
#pragma unroll
                for (int n = 0; n < 8; ++n) acc[r][n] = __builtin_amdgcn_mfma_f32_16x16x32_bf16(bfr[n], af[r], acc[r][n], 0, 0, 0); }
        lds_barrier();
    }
    uint2 ogr[2][8];
#pragma unroll
    for (int r = 0; r < 2; ++r) { const bf16_t* ogp = PR + (r0 + rh * 128 + (mi2 + r) * 16 + (lane & 15)) * 6144 + 4096 + h * 256 + 4 * (lane >> 4);
#pragma unroll
        for (int n = 0; n < 8; ++n) ogr[r][n] = *(const uint2*)(ogp + (nb + n) * 16); }
    for (int sl = 0; sl < 4; ++sl) { const int dir = sl >> 1, dh = sl & 1;
        if (dh == 0) { const int i = tid >> 2, c32 = (tid & 3) * 32, I = rh * 128 + i; const float xs = dir == 0 ? __expf((float)(I + 1) * lgf) : __expf((float)(256 - I) * lgb);
#pragma unroll
            for (int hh = 0; hh < 4; ++hh) { const u32x4 w = *(const LAS u32x4*)(qs + i * 136 + c32 + hh * 8);
                *(LAS u32x4*)(qx + i * 136 + c32 + hh * 8) = mk4(pack2(bflo(w[0]) * xs, bfhi(w[0]) * xs), pack2(bflo(w[1]) * xs, bfhi(w[1]) * xs), pack2(bflo(w[2]) * xs, bfhi(w[2]) * xs), pack2(bflo(w[3]) * xs, bfhi(w[3]) * xs)); } }
#pragma unroll
        for (int i = 0; i < 4; ++i) { const int idx = tid + i * NTHR, v8 = (idx & 31) * 8, dd = idx >> 5; *(LAS u32x4*)(Vs + dd * 264 + v8) = mk4(st[i].x, st[i].y, st[i].z, st[i].w); }
        lds_barrier();
        if (sl < 3) { const int nd = (sl + 1) >> 1, nh = (sl + 1) & 1; const bf16_t* sp = sbase + (size_t)nd * 32 * 32768 + (size_t)nh * 64 * 256;
#pragma unroll
            for (int i = 0; i < 4; ++i) { const int idx = tid + i * NTHR, v8 = (idx & 31) * 8, dd = idx >> 5; st[i] = *(const uint4*)(sp + dd * 256 + v8); } }
#pragma unroll
        for (int k2 = 0; k2 < 2; ++k2) { bf16x8 af[2], bfr[8];
#pragma unroll
            for (int r = 0; r < 2; ++r) af[r] = *(const LAS bf16x8*)(qx + ((mi2 + r) * 16 + (lane & 15)) * 136 + dh * 64 + k2 * 32 + (lane >> 4) * 8);
#pragma unroll
            for (int n = 0; n < 8; ++n) bfr[n] = frag_tr(Vs + k2 * 32 * 264 + (nb + n) * 16, 264, lane);
#pragma unroll
            for (int r = 0; r < 2; ++r)
#pragma unroll
                for (int n = 0; n < 8; ++n) acc[r][n] = __builtin_amdgcn_mfma_f32_16x16x32_bf16(bfr[n], af[r], acc[r][n], 0, 0, 0); }
        lds_barrier();
    }
    { float ss[2];
#pragma unroll
        for (int r = 0; r < 2; ++r) { ss[r] = 0.f;
#pragma unroll
            for (int n = 0; n < 8; ++n) ss[r] += acc[r][n][0] * acc[r][n][0] + acc[r][n][1] * acc[r][n][1] + acc[r][n][2] * acc[r][n][2] + acc[r][n][3] * acc[r][n][3];
            ss[r] += __shfl_xor(ss[r], 16); ss[r] += __shfl_xor(ss[r], 32);
            if ((lane >> 4) == 0) red[((mi2 + r) * 16 + (lane & 15)) * 2 + (wid >> 2)] = ss[r]; }
        lds_barrier();
#pragma unroll
        for (int r = 0; r < 2; ++r) { const int i = (mi2 + r) * 16 + (lane & 15);
            const float rstd = rsqrtf((red[i * 2] + red[i * 2 + 1]) * (1.0f / 256.0f) + 1e-6f);
            const float* gn = P->in[23] + h * 256 + 4 * (lane >> 4);
            bf16_t* op = (bf16_t*)(P->ws + OFF_OBUF) + (r0 + rh * 128 + i) * 2048 + h * 256 + 4 * (lane >> 4);
#pragma unroll
            for (int n = 0; n < 8; ++n) { const int v = (nb + n) * 16; const uint2 og = ogr[r][n]; const f32x4 g4 = *(const f32x4*)(gn + v);
                uint2 w; w.x = pack2(acc[r][n][0] * rstd * g4[0] * silu_f(bflo(og.x)), acc[r][n][1] * rstd * g4[1] * silu_f(bfhi(og.x)));
                w.y = pack2(acc[r][n][2] * rstd * g4[2] * silu_f(bflo(og.y)), acc[r][n][3] * rstd * g4[3] * silu_f(bfhi(og.y)));
                *(uint2*)(op + v) = w; } } }
    lds_barrier();
}

#define XB_TMO      128
#define XB_XCNT(j)  (256  + 64 * (j))
#define XB_XSUB(j)  (1280 + 64 * (j))
#define XB_XGEN(j)  (2304 + 64 * (j))
#define XB_TOP      3328
#define XB_TOPGEN   3392
#define XCD_BAR_WORDS 3456
#define XB_SPIN_CAP (1u << 18)
__device__ __forceinline__ unsigned xb_ld(unsigned* p)              { return __hip_atomic_load(p, __ATOMIC_RELAXED, __HIP_MEMORY_SCOPE_AGENT); }
__device__ __forceinline__ unsigned xb_add(unsigned* p, unsigned v) { return __hip_atomic_fetch_add(p, v, __ATOMIC_RELAXED, __HIP_MEMORY_SCOPE_AGENT); }
__device__ __forceinline__ unsigned xb_xcc_id() { return (unsigned)__builtin_amdgcn_s_getreg((3 << 11) | 20) & 0xFu; }
#define XB_SPIN(cond, bar) do { unsigned _sp = 0; while (cond) { __builtin_amdgcn_s_sleep(1); \
    if ((++_sp & 255u) == 0u) { if (xb_ld(&(bar)[XB_TMO])) break; if (_sp > XB_SPIN_CAP) { atomicAdd(&(bar)[XB_TMO], 1u); break; } } } } while (0)
__device__ __forceinline__ void xcd_barrier_complete(unsigned* bar, unsigned x, unsigned& nloc, unsigned& nx) {
    const unsigned G = gridDim.x * gridDim.y * gridDim.z;
    unsigned sum, cnt, mine, sp = 0u;
    for (;;) {
        sum = 0u; cnt = 0u; mine = 0u;
#pragma unroll
        for (unsigned j = 0; j < 16; ++j) { const unsigned c = xb_ld(&bar[XB_XCNT(j)]); sum += c; cnt += (c > 0u) ? 1u : 0u; mine = (j == x) ? c : mine; }
        if (sum == G) break;
        __builtin_amdgcn_s_sleep(1);
        if ((++sp & 255u) == 0u) { if (xb_ld(&bar[XB_TMO])) break; if (sp > XB_SPIN_CAP) { atomicAdd(&bar[XB_TMO], 1u); break; } }
    }
    nloc = mine > 0u ? mine : 1u; nx = cnt > 0u ? cnt : 1u;
}
__device__ __forceinline__ void xcd_barrier(unsigned* bar, unsigned x, volatile LAS unsigned* st) {
    asm volatile("s_waitcnt vmcnt(0)" ::: "memory");
    __syncthreads();
    if (threadIdx.x == 0) {
        __builtin_amdgcn_s_waitcnt(0);
        unsigned nloc = st[0], nx = st[1];
        if (nloc == 0u) { xcd_barrier_complete(bar, x, nloc, nx); st[0] = nloc; st[1] = nx; }
        const unsigned old = xb_add(&bar[XB_XSUB(x)], 1u);
        const unsigned gen = old / nloc;
        if (old + 1u == (gen + 1u) * nloc) {
            __builtin_amdgcn_fence(__ATOMIC_RELEASE, "agent");
            asm volatile("s_waitcnt vmcnt(0)" ::: "memory");
            const unsigned og = xb_add(&bar[XB_TOP], 1u);
            const unsigned tg = og / nx;
            if (og + 1u == (tg + 1u) * nx) xb_add(&bar[XB_TOPGEN], 1u);
            else XB_SPIN(xb_ld(&bar[XB_TOPGEN]) == tg, bar);
            __builtin_amdgcn_fence(__ATOMIC_ACQUIRE, "agent");
            xb_add(&bar[XB_XGEN(x)], 1u);
            asm volatile("s_waitcnt vmcnt(0)" ::: "memory");
        } else {
            XB_SPIN(xb_ld(&bar[XB_XGEN(x)]) == gen, bar);
            __builtin_amdgcn_fence(__ATOMIC_ACQUIRE, "agent");
            asm volatile("s_waitcnt vmcnt(0)" ::: "memory");
        }
    }
    __syncthreads();
}

__global__ void __launch_bounds__(NTHR, 2) mega(Params Pval, int ph0, int ph1) {
    extern __shared__ __attribute__((aligned(16))) unsigned char lds_raw[];
    LAS unsigned char* lds = (LAS unsigned char*)lds_raw;
    volatile LAS unsigned* xb_st = (volatile LAS unsigned*)(lds + LDS_BYTES - 16);
    unsigned xb_x = 0;
    if (ph1 - ph0 > 1) { if (threadIdx.x == 0) { xb_st[0] = 0u; xb_st[1] = 0u; } __syncthreads();
        xb_x = xb_xcc_id(); if (threadIdx.x == 0) (void)xb_add((unsigned*)(Pval.ws + OFF_BAR) + XB_XCNT(xb_x), 1u); }
    for (int ph = ph0; ph < ph1; ++ph) {
        CP P = (CP)__builtin_amdgcn_kernarg_segment_ptr(); asm volatile("" : "+s"(P));
        unsigned char* ws = P->ws;
        bf16_t* XN = (bf16_t*)(ws + OFF_XN); bf16_t* ACT = (bf16_t*)(ws + OFF_ACT);
        if (ph == 1 || ph == 4 || ph == 11 || ph == 14 || ph == 17 || ph == 28) continue;
        const int reps = (((unsigned long long)(PROBE_MASK) >> ph) & 1ull) ? 2 : 1;
        for (int rep = 0; rep < reps; ++rep) {
        float* SSQ = (float*)(ws + OFF_SSQ); bf16_t* MIXB = (bf16_t*)(ws + OFF_MIX);
        int ffn = -1, sub = 0;
        if (ph >= 2 && ph <= 3) { ffn = 0; sub = ph - 1; } else if (ph >= 12 && ph <= 13) { ffn = 1; sub = ph - 11; }
        else if (ph >= 15 && ph <= 16) { ffn = 2; sub = ph - 14; } else if (ph >= 29 && ph <= 30) { ffn = 3; sub = ph - 28; }
        if (ph == 0) { if (EN(0)) phase_prologue(P, lds); }
        else if (ffn >= 0) {
            const float* ssin = SSQ + (size_t)(ffn == 0 ? 0 : ffn == 1 ? 2 : ffn == 2 ? 3 : 5) * SSN;
            if (sub == 1) { if (EN(2)) { if (ffn == 0) phase_kmat(P);
                pg8::Gemm g{XN, (const bf16_t*)(ws + OFF_W1 + (size_t)ffn * SZ_W1), 1024, 1024, 1024, 256, 22, 1, 0, 0}; EpiSwiGLU e{ACT, ssin}; pg8::gemm_phase(lds, g, e); } }
            else { if (EN(3)) { pg8::Gemm g{ACT, (const bf16_t*)(ws + OFF_W2 + (size_t)ffn * SZ_W2), 2816, 2816, 2816, 256, 4, 1, 0, 0};
                float* ssout = SSQ + (size_t)(ffn == 0 ? 1 : ffn == 1 ? 3 : 4) * SSN;
                if (ffn == 3) { EpiResid<false, false> e{nullptr, XN, nullptr, 0.5f}; pg8::gemm_phase(lds, g, e); }
                else { EpiResid<true, false> e{nullptr, XN, ssout, 0.5f}; pg8::gemm_phase(lds, g, e); } } }
        }
        else if (ph == 5) { if (EN(4)) { pg8::Gemm g{XN, (const bf16_t*)(ws + OFF_WIN0), 1024, 1024, 1024, 256, 9, 1, 0, 0}; EpiWin0 e{(bf16_t*)(ws + OFF_AS5), (bf16_t*)(ws + OFF_PQ), SSQ + SSN}; pg8::gemm_phase(lds, g, e); } }
        else if (ph == 6) { if (EN(5)) {
            if (EN(16)) { pg8::Gemm g{(const bf16_t*)(ws + OFF_AS5), (const bf16_t*)(ws + OFF_H), 1280, 1024, 1024, 4, 1, 32, (size_t)1024 * 1280, (size_t)256 * 1024}; EpiS5E e{(float*)(ws + OFF_E)}; pg8::gemm_phase(lds, g, e); }
            __syncthreads();
            if (EN(17)) for (int u = obid(); u < 4096; u += gridDim.x) gla_a_unit(P, u, lds);
        } }
        else if (ph == 7) { if (EN(6)) { phase_s5_scan(P); phase_gla_b(P); } }
        else if (ph == 8) { if (EN(7)) {
            if (EN(18)) { pg8::Gemm g{(const bf16_t*)(ws + OFF_AS5), (const bf16_t*)(ws + OFF_KG), 1280, 1280, 1280, 4, 4, 32, (size_t)1024 * 1280, (size_t)1024 * 1280}; EpiS5Y e{(bf16_t*)(ws + OFF_GY)}; pg8::gemm_phase(lds, g, e); }
            __syncthreads();
            if (EN(19)) for (int u = obid(); u < 4096; u += gridDim.x) gla_c_unit(P, u, lds);
        } }
        else if (ph == 9) { if (EN(8)) { pg8::Gemm g{(const bf16_t*)(ws + OFF_GY), (const bf16_t*)(ws + OFF_WGLU), 512, 512, 512, 256, 2, 1, 0, 0}; EpiGLU e{(const bf16_t*)(ws + OFF_GY), MIXB}; pg8::gemm_phase(lds, g, e); } }
        else if (ph == 10) { if (EN(9)) { pg8::Gemm g{MIXB, (const bf16_t*)(ws + OFF_WOUT0), 1024, 1024, 1024, 256, 4, 1, 0, 0}; EpiResid<true, false> e{nullptr, XN, SSQ + 2 * SSN, 1.0f}; pg8::gemm_phase(lds, g, e); } }
        else if (ph >= 18 && ph <= 27) {
            const int hf = (ph - 18) / 5, s = (ph - 18) % 5;
            if (s == 0) { if (EN(10)) { pg8::Gemm g{XN + (size_t)hf * 32768 * 1024, (const bf16_t*)(ws + OFF_WIN1), 1024, 1024, 1024, 128, 24, 1, 0, 0}; EpiRetIn e{(bf16_t*)(ws + OFF_PROJ1), 6144, SSQ + 4 * SSN + (size_t)hf * 32768 * 16, (const float*)(ws + OFF_ROPE), (const float*)(ws + OFF_ROPE) + 8192 * 64, hf * 32768}; pg8::gemm_phase(lds, g, e); } }
            else if (s == 1) { if (EN(11)) for (int u = obid(); u < 1024; u += gridDim.x) ret_a_unit(P, hf, u, lds); }
            else if (s == 2) { if (EN(12)) phase_ret_b(P); }
            else if (s == 3) { if (EN(13)) for (int u = obid(); u < 2048; u += gridDim.x) ret_c_unit(P, hf, u, lds); }
            else { if (EN(14)) { pg8::Gemm g{(const bf16_t*)(ws + OFF_OBUF), (const bf16_t*)(ws + OFF_WOUT1), 2048, 2048, 2048, 128, 4, 1, 0, 0};
                EpiResid<true, false> e{nullptr, XN + (size_t)hf * 32768 * 1024, SSQ + 5 * SSN + (size_t)hf * 32768 * 16, 1.0f}; pg8::gemm_phase(lds, g, e); } }
        }
        else if (ph == 31) { if (EN(15)) phase_final(XN, P->in[25], P->out); }
        if (rep + 1 < reps) __syncthreads();
        }
        if (ph + 1 < ph1) { if (ph == 0) cg::this_grid().sync();
            else xcd_barrier((unsigned*)(P->ws + OFF_BAR), xb_x, xb_st); }
    }
}

extern "C" void kernel_launch(void* const* d_in, const int* in_sizes, int n_in, void* d_out, int out_size, void* d_ws, size_t ws_size, hipStream_t stream) {
    static int inited = 0;
    if (!inited) { (void)hipFuncSetAttribute((const void*)mega, hipFuncAttributeMaxDynamicSharedMemorySize, LDS_BYTES); inited = 1; }
    Params p{};
    for (int i = 0; i < 26; ++i) p.in[i] = (const float*)d_in[i];
    p.out = (float*)d_out; p.ws = (unsigned char*)d_ws;
    if (ws_size < OFF_R + 770 * MiB) fprintf(stderr, "kernel_launch: workspace too small (%zu)\n", ws_size);
    const int grid = 256;
#if ONE_LAUNCH
    (void)hipMemsetAsync((unsigned char*)d_ws + OFF_BAR, 0, 16384, stream);
    int ph0 = 0, ph1 = NPHASE; void* args[] = {&p, &ph0, &ph1};
    hipError_t e = hipLaunchCooperativeKernel((const void*)mega, dim3(grid), dim3(NTHR), args, LDS_BYTES, stream);
    if (e != hipSuccess) fprintf(stderr, "cooperative launch failed: %s\n", hipGetErrorString(e));
#else
    for (int ph = 0; ph < NPHASE; ++ph) hipLaunchKernelGGL(mega, dim3(grid), dim3(NTHR), LDS_BYTES, stream, p, ph, ph + 1);
#endif
}
```

```cpp
#include <hip/hip_runtime.h>
#include <hip/hip_cooperative_groups.h>
#include <cstdio>
#include <cstdint>
namespace cg = cooperative_groups;

#ifndef ONE_LAUNCH
#define ONE_LAUNCH 1
#endif

#ifndef PHASE_MASK
#define PHASE_MASK 0xffffffffffull
#endif
#define EN(n) (((PHASE_MASK) >> (n)) & 1ull)
#ifndef PROBE_MASK
#define PROBE_MASK 0ull
#endif
#define LAS __attribute__((address_space(3)))
typedef unsigned short bf16_t;
typedef short bf16x8 __attribute__((ext_vector_type(8)));
typedef float f32x4 __attribute__((ext_vector_type(4)));
typedef float f32x2 __attribute__((ext_vector_type(2)));
typedef unsigned u32x2 __attribute__((ext_vector_type(2)));
typedef unsigned u32x4 __attribute__((ext_vector_type(4)));
__device__ __forceinline__ u32x4 mk4(unsigned a, unsigned b, unsigned c, unsigned d) { return (u32x4){a, b, c, d}; }
__device__ __forceinline__ u32x2 mk2(unsigned a, unsigned b) { return (u32x2){a, b}; }
__device__ __forceinline__ f32x2 mkf2(float a, float b) { return (f32x2){a, b}; }

constexpr int NTHR = 512;
constexpr int LDS_BYTES = 147456;
constexpr int NPHASE = 32;

struct Params { const float* in[26]; float* out; unsigned char* ws; };
typedef const __attribute__((address_space(4))) Params* CP;

constexpr size_t MiB = 1ull << 20;
constexpr size_t OFF_W1 = 0, SZ_W1 = 11 * MiB;
constexpr size_t OFF_W2 = 44 * MiB, SZ_W2 = 5 * MiB + MiB / 2;
constexpr size_t OFF_WIN0 = 66 * MiB;
constexpr size_t OFF_WGLU = 70 * MiB + MiB / 2;
constexpr size_t OFF_WOUT0 = 71 * MiB;
constexpr size_t OFF_WIN1 = 73 * MiB;
constexpr size_t OFF_WOUT1 = 85 * MiB;
constexpr size_t OFF_ROPE = 89 * MiB;
constexpr size_t OFF_KTAB = 93 * MiB;
constexpr size_t OFF_S5P = 97 * MiB;
constexpr size_t OFF_XN = 98 * MiB;
constexpr size_t OFF_R = 226 * MiB;
constexpr size_t OFF_ACT = OFF_R;
constexpr size_t OFF_PQ = OFF_R;
constexpr size_t OFF_AS5 = OFF_R + 224 * MiB;
constexpr size_t OFF_E = OFF_R + 304 * MiB;
constexpr size_t OFF_KG = OFF_R + 352 * MiB;
constexpr size_t OFF_H = OFF_R + 432 * MiB;
constexpr size_t OFF_GST = OFF_R + 448 * MiB;
constexpr size_t OFF_GDEC = OFF_R + 704 * MiB;
constexpr size_t OFF_GY = OFF_R + 706 * MiB;
constexpr size_t OFF_PROJ1 = OFF_R;
constexpr size_t OFF_RST = OFF_R + 384 * MiB;
constexpr size_t OFF_SSQ = 998 * MiB;
constexpr int SSN = 65536 * 16;
constexpr size_t OFF_MIX = OFF_R + 576 * MiB;
constexpr size_t OFF_BAR = 1023 * MiB;
constexpr size_t OFF_OBUF = OFF_R + 640 * MiB;

__device__ __forceinline__ int otid() { int t = threadIdx.x; asm volatile("" : "+v"(t)); return t; }
__device__ __forceinline__ int obid() { int t = blockIdx.x; asm volatile("" : "+s"(t)); return t; }
__device__ __forceinline__ bf16_t f2bf(float f) { unsigned u = __float_as_uint(f); u += 0x7FFFu + ((u >> 16) & 1u); return (bf16_t)(u >> 16); }
__device__ __forceinline__ float bf2f(unsigned b) { return __uint_as_float(b << 16); }
typedef __bf16 bf16x2_t __attribute__((ext_vector_type(2)));
typedef float f32x2_t __attribute__((ext_vector_type(2)));
__device__ __forceinline__ unsigned pack2(float lo, float hi) { const f32x2_t v = {lo, hi}; const bf16x2_t b = __builtin_convertvector(v, bf16x2_t); return __builtin_bit_cast(unsigned, b); }
__device__ __forceinline__ float bflo(unsigned w) { return __uint_as_float(w << 16); }
__device__ __forceinline__ float bfhi(unsigned w) { return __uint_as_float(w & 0xffff0000u); }
__device__ __forceinline__ float fast_sigmoid(float x) { return __builtin_amdgcn_rcpf(1.0f + __expf(-x)); }
__device__ __forceinline__ float silu_f(float x) { return x * fast_sigmoid(x); }
__device__ __forceinline__ float gelu_tanh(float x) { const float u = 0.7978845608028654f * (x + 0.044715f * x * x * x); return x * fast_sigmoid(2.0f * u); }

namespace pg8 {
constexpr int BM = 256, BK = 64, HALF = 128, HTB = HALF * BK * 2, STAGE_BYTES = 8 * HTB, NXCD = 8, WGM = 8;
__device__ __forceinline__ int lds_byte(int r, int c) { const int st = (r >> 4) * 2 + (c >> 5), rr = r & 15, cc = c & 31, ob = rr * 64 + cc * 2; return st * 1024 + (ob ^ (((ob >> 9) & 1) << 5)); }
__device__ __forceinline__ void stage_rc(int b, int& R, int& C) { const int st = b / 1024, sb = b % 1024, swz = sb ^ (((sb >> 9) & 1) << 5); R = (st >> 1) * 16 + swz / 64; C = (st & 1) * 32 + (swz % 64) / 2; }

__device__ __forceinline__ int perm32(int rho) { const int n = rho >> 4, i = rho & 15; return 8 * (i >> 2) + 4 * n + (i & 3); }
struct Unit { int pm, pn, bz; };
struct Gemm { const bf16_t* A; const bf16_t* Bt; int lda, ldb, K, nM, nN, nB; size_t strideA, strideB; };

struct Sched {
    int nM, nN, nwg, total, G, c;
    __device__ void init(int nM_, int nN_, int nB_, int G_, int c_) { nM = nM_; nN = nN_; nwg = nM * nN; total = nwg * nB_; G = G_; c = c_; }
    __device__ bool next(int i, Unit& u) const {
        const long L = (long)i * G + c; if (L >= total) return false;
        u.bz = (int)(L / nwg); int wgid = (int)(L % nwg);
        { const int q = nwg / NXCD, r = nwg % NXCD, xcd = wgid % NXCD, off = wgid / NXCD; wgid = (xcd < r ? xcd * (q + 1) : r * (q + 1) + (xcd - r) * q) + off; }
        const int nig = WGM * nN, gid = wgid / nig, fm = gid * WGM, gsz = (nM - fm) < WGM ? (nM - fm) : WGM;
        u.pm = fm + ((wgid % nig) % gsz); u.pn = (wgid % nig) / gsz; return true;
    }
};

template <class Epi>
__device__ __forceinline__ void gemm_phase(LAS unsigned char* lds, const Gemm g, const Epi& E) {
    const int tid = otid(), wid = __builtin_amdgcn_readfirstlane(tid >> 6), lane = tid & 63, wr = wid >> 2, wc = wid & 3, fr = lane & 15, fq = lane >> 4;
    const int nt = g.K / BK;
    Sched S; S.init(g.nM, g.nN, g.nB, (int)gridDim.x, obid());
    unsigned voffA[2], voffB[2];
#pragma unroll
    for (int i = 0; i < 2; ++i) { int R, C; stage_rc(tid * 16 + i * 8192, R, C); const int Rb = Epi::PERM ? ((R & ~31) + perm32(R & 31)) : R;
        voffA[i] = (unsigned)(R * g.lda + C) * 2u; voffB[i] = (unsigned)(Rb * g.ldb + C) * 2u; }
    const size_t kstep = (size_t)(BK * 2);
    const size_t hstepA = (size_t)HALF * g.lda * 2, hstepB = (size_t)HALF * g.ldb * 2;
    const size_t tstepA = 2 * hstepA, tstepB = 2 * hstepB;
    const unsigned ldsw = (unsigned)wid * 1024u;
    const int aoff = lds_byte(wr * 64 + fr, fq * 8), boff = lds_byte(wc * 32 + fr, fq * 8);
#define PG8_SA(b, h) (((b) * 2 + (h)) * HTB)
#define PG8_SB(b, h) ((4 + (b) * 2 + (h)) * HTB)
#define PG8_STAGE(bufoff, gbase, voff) do { _Pragma("unroll") for (int _i = 0; _i < 2; ++_i) \
        __builtin_amdgcn_global_load_lds((const unsigned*)((const char*)(gbase) + (voff)[_i]), (LAS unsigned*)(lds + (bufoff) + ldsw + _i * 8192), 16, 0, 0); } while (0)
#define PG8_LDA(dst, b, h) do { _Pragma("unroll") for (int m = 0; m < 4; ++m) _Pragma("unroll") for (int k = 0; k < 2; ++k) dst[m][k] = *(const LAS bf16x8*)(lds + PG8_SA(b, h) + aoff + m * 2048 + k * 1024); } while (0)
#define PG8_LDB(dst, b, h) do { _Pragma("unroll") for (int n = 0; n < 2; ++n) _Pragma("unroll") for (int k = 0; k < 2; ++k) dst[n][k] = *(const LAS bf16x8*)(lds + PG8_SB(b, h) + boff + n * 2048 + k * 1024); } while (0)
#define PG8_MMA(ai, bj, At, Bt) do { __builtin_amdgcn_s_setprio(1); _Pragma("unroll") for (int m = 0; m < 4; ++m) _Pragma("unroll") for (int n = 0; n < 2; ++n) _Pragma("unroll") for (int k = 0; k < 2; ++k) \
        acc[ai][bj][m][n] = __builtin_amdgcn_mfma_f32_16x16x32_bf16(Bt[n][k], At[m][k], acc[ai][bj][m][n], 0, 0, 0); __builtin_amdgcn_s_setprio(0); } while (0)
#define PG8_WAIT_V(n) asm volatile("s_waitcnt vmcnt(" #n ")" ::: "memory")
#define PG8_WAIT_L(n) asm volatile("s_waitcnt lgkmcnt(" #n ")" ::: "memory")
#define PG8_BAR __builtin_amdgcn_s_barrier()
#define PG8_SCHED __builtin_amdgcn_sched_barrier(0)
    Unit cur, nxt; int ui = 0;
    if (!S.next(0, cur)) return;
    int tag0 = -1, tag1 = -1, tag2 = -1, tag3 = -1; LAS float* rstab = (LAS float*)(lds + STAGE_BYTES);
    if constexpr (Epi::RSTD) {
        { Unit t_; for (int i = 0; S.next(i, t_); ++i) { const int pm = t_.pm; if (pm == tag0 || pm == tag1 || pm == tag2 || pm == tag3) continue;
                if (tag0 < 0) tag0 = pm; else if (tag1 < 0) tag1 = pm; else if (tag2 < 0) tag2 = pm; else tag3 = pm; } }
#pragma unroll
        for (int sl = 0; sl < 2; ++sl) { const int slot = (tid >> 8) + 2 * sl; const int pm = slot == 0 ? tag0 : slot == 1 ? tag1 : slot == 2 ? tag2 : tag3;
            if (pm >= 0) { const f32x4* p = (const f32x4*)(E.SS + ((size_t)pm * 256 + (tid & 255)) * 16); const f32x4 a = p[0], b = p[1], c = p[2], d = p[3]; const f32x4 t = (a + b) + (c + d);
                rstab[slot * 256 + (tid & 255)] = rsqrtf(((t[0] + t[1]) + (t[2] + t[3])) * (1.0f / 1024.0f) + 1e-6f); } }
        __syncthreads();
    }
    f32x4 acc[2][2][4][2];
#pragma unroll
    for (int a = 0; a < 2; ++a)
#pragma unroll
        for (int b = 0; b < 2; ++b)
#pragma unroll
            for (int m = 0; m < 4; ++m)
#pragma unroll
                for (int n = 0; n < 2; ++n) acc[a][b][m][n] = (f32x4){0.f, 0.f, 0.f, 0.f};
    bf16x8 At[4][2], B0[2][2], B1[2][2];
    const char* cA = (const char*)g.A + (size_t)cur.bz * g.strideA * 2 + (size_t)cur.pm * tstepA;
    const char* cB = (const char*)g.Bt + (size_t)cur.bz * g.strideB * 2 + (size_t)cur.pn * tstepB;
    PG8_STAGE(PG8_SB(0, 0), cB, voffB); PG8_STAGE(PG8_SB(0, 1), cB + hstepB, voffB); PG8_STAGE(PG8_SA(0, 0), cA, voffA); PG8_STAGE(PG8_SA(0, 1), cA + hstepA, voffA);
    if (wr == 1) PG8_BAR;
    PG8_WAIT_V(2); PG8_BAR;
    PG8_STAGE(PG8_SB(1, 0), cB + kstep, voffB); PG8_STAGE(PG8_SA(1, 0), cA + kstep, voffA); PG8_STAGE(PG8_SB(1, 1), cB + hstepB + kstep, voffB);
    PG8_WAIT_V(6); PG8_BAR;
    for (;;) {
        const bool has_next = S.next(ui + 1, nxt);
        const char* nA = has_next ? (const char*)g.A + (size_t)nxt.bz * g.strideA * 2 + (size_t)nxt.pm * tstepA : cA;
        const char* nB = has_next ? (const char*)g.Bt + (size_t)nxt.bz * g.strideB * 2 + (size_t)nxt.pn * tstepB : cB;
        for (int t = 0; t < nt; t += 2) {
            const bool last = (t == nt - 2);
            const char* a1 = cA + (size_t)(t + 1) * kstep;
            const char* a2 = last ? nA : cA + (size_t)(t + 2) * kstep; const char* b2 = last ? nB : cB + (size_t)(t + 2) * kstep;
            const char* a3 = a2 + kstep; const char* b3 = b2 + kstep;
            PG8_LDB(B0, 0, 0); PG8_LDB(B1, 0, 1); PG8_SCHED; PG8_LDA(At, 0, 0); PG8_STAGE(PG8_SA(1, 1), a1 + hstepA, voffA);
            PG8_WAIT_V(8); PG8_WAIT_L(0); PG8_BAR; PG8_MMA(0, 0, At, B0); PG8_MMA(0, 1, At, B1); PG8_BAR; PG8_SCHED;
            PG8_LDA(At, 0, 1); PG8_STAGE(PG8_SB(0, 0), b2, voffB); PG8_STAGE(PG8_SB(0, 1), b2 + hstepB, voffB); PG8_STAGE(PG8_SA(0, 0), a2, voffA);
            PG8_WAIT_V(8); PG8_WAIT_L(0); PG8_BAR; PG8_MMA(1, 0, At, B0); PG8_MMA(1, 1, At, B1); PG8_BAR; PG8_SCHED;
            PG8_LDB(B0, 1, 0); PG8_LDB(B1, 1, 1); PG8_SCHED; PG8_LDA(At, 1, 0); PG8_STAGE(PG8_SA(0, 1), a2 + hstepA, voffA);
            PG8_WAIT_V(8); PG8_WAIT_L(0); PG8_BAR; PG8_MMA(0, 0, At, B0); PG8_MMA(0, 1, At, B1); PG8_BAR; PG8_SCHED;
            PG8_LDA(At, 1, 1); PG8_STAGE(PG8_SB(1, 0), b3, voffB); PG8_STAGE(PG8_SB(1, 1), b3 + hstepB, voffB); PG8_STAGE(PG8_SA(1, 0), a3, voffA);
            PG8_WAIT_V(8); PG8_WAIT_L(0); PG8_BAR; PG8_MMA(1, 0, At, B0); PG8_MMA(1, 1, At, B1); PG8_BAR; PG8_SCHED;
        }
        if (wr == 0) PG8_BAR;
        E(acc, cur, wr, wc, fr, fq, rstab + (cur.pm == tag1 ? 256 : cur.pm == tag2 ? 512 : cur.pm == tag3 ? 768 : 0));
        if (!has_next) break;
#pragma unroll
        for (int a = 0; a < 2; ++a)
#pragma unroll
            for (int b = 0; b < 2; ++b)
#pragma unroll
                for (int m = 0; m < 4; ++m)
#pragma unroll
                    for (int n = 0; n < 2; ++n) acc[a][b][m][n] = (f32x4){0.f, 0.f, 0.f, 0.f};
        cur = nxt; cA = nA; cB = nB; ++ui;
        if (wr == 1) PG8_BAR;
    }
    PG8_WAIT_V(0);
    PG8_BAR;
#undef PG8_SA
#undef PG8_SB
#undef PG8_STAGE
#undef PG8_LDA
#undef PG8_LDB
#undef PG8_MMA
#undef PG8_WAIT_V
#undef PG8_WAIT_L
#undef PG8_BAR
#undef PG8_SCHED
}
}
using pg8::Unit;
typedef const f32x4 (&AccRef)[2][2][4][2];

struct EpiSwiGLU {
    static constexpr bool PERM = true, RSTD = true;
    bf16_t* O; const float* SS;
    __device__ __forceinline__ void operator()(AccRef acc, const Unit& u, int wr, int wc, int fr, int fq, const LAS float* rsl) const {
        const int row0 = u.pm * 256 + wr * 64 + fr, col0 = u.pn * 128 + wc * 32 + 8 * fq;
#pragma unroll
        for (int ai = 0; ai < 2; ++ai)
#pragma unroll
            for (int m = 0; m < 4; ++m) { bf16_t* rowp = O + (size_t)(row0 + ai * 128 + m * 16) * 2816 + col0; uint4 w; const float rs = rsl[ai * 128 + wr * 64 + m * 16 + fr];
                { const f32x4 gt = rs * acc[ai][0][m][0], up = rs * acc[ai][1][m][0]; w.x = pack2(silu_f(gt[0]) * up[0], silu_f(gt[1]) * up[1]); w.y = pack2(silu_f(gt[2]) * up[2], silu_f(gt[3]) * up[3]); }
                { const f32x4 gt = rs * acc[ai][0][m][1], up = rs * acc[ai][1][m][1]; w.z = pack2(silu_f(gt[0]) * up[0], silu_f(gt[1]) * up[1]); w.w = pack2(silu_f(gt[2]) * up[2], silu_f(gt[3]) * up[3]); }
                *(uint4*)rowp = w; }
    }
};
template <bool STATS, bool XF32> struct EpiResid {
    static constexpr bool PERM = true, RSTD = false;
    const float* Xin; bf16_t* XB; float* SS; float alpha;
    __device__ __forceinline__ void operator()(AccRef acc, const Unit& u, int wr, int wc, int fr, int fq, const LAS float* rsl) const {
        const int row0 = u.pm * 256 + wr * 64 + fr, col0 = u.pn * 256 + wc * 32 + 8 * fq;
#pragma unroll
        for (int ai = 0; ai < 2; ++ai)
#pragma unroll
            for (int mp = 0; mp < 2; ++mp) {
                f32x4 xo[2][2][2];
#pragma unroll
                for (int mm = 0; mm < 2; ++mm)
#pragma unroll
                    for (int bj = 0; bj < 2; ++bj) { const size_t o = (size_t)(row0 + ai * 128 + (mp * 2 + mm) * 16) * 1024 + col0 + bj * 128;
                        if (XF32) { xo[mm][bj][0] = *(const f32x4*)(Xin + o); xo[mm][bj][1] = *(const f32x4*)(Xin + o + 4); }
                        else { const uint4 w = *(const uint4*)(XB + o); xo[mm][bj][0] = (f32x4){bflo(w.x), bfhi(w.x), bflo(w.y), bfhi(w.y)}; xo[mm][bj][1] = (f32x4){bflo(w.z), bfhi(w.z), bflo(w.w), bfhi(w.w)}; } }
#pragma unroll
                for (int mm = 0; mm < 2; ++mm) { const int m = mp * 2 + mm; const size_t ro = (size_t)(row0 + ai * 128 + m * 16) * 1024 + col0; float sq = 0.f;
#pragma unroll
                    for (int bj = 0; bj < 2; ++bj) { const size_t o = ro + bj * 128;
                        const f32x4 y0 = xo[mm][bj][0] + alpha * acc[ai][bj][m][0], y1 = xo[mm][bj][1] + alpha * acc[ai][bj][m][1];
                        uint4 w; w.x = pack2(y0[0], y0[1]); w.y = pack2(y0[2], y0[3]); w.z = pack2(y1[0], y1[1]); w.w = pack2(y1[2], y1[3]); *(uint4*)(XB + o) = w;
                        if (STATS) sq += y0[0] * y0[0] + y0[1] * y0[1] + y0[2] * y0[2] + y0[3] * y0[3] + y1[0] * y1[0] + y1[1] * y1[1] + y1[2] * y1[2] + y1[3] * y1[3]; }
                    if (STATS) { sq += __shfl_xor(sq, 16); sq += __shfl_xor(sq, 32); if (fq == 0) SS[(size_t)(row0 + ai * 128 + m * 16) * 16 + u.pn * 4 + wc] = sq; } } }
    }
};
struct EpiBf16 {
    static constexpr bool PERM = true, RSTD = true;
    bf16_t* O; int ldc; const float* SS;
    __device__ __forceinline__ void operator()(AccRef acc, const Unit& u, int wr, int wc, int fr, int fq, const LAS float* rsl) const {
        const int row0 = u.pm * 256 + wr * 64 + fr, col0 = u.pn * 256 + wc * 32 + 8 * fq;
#pragma unroll
        for (int ai = 0; ai < 2; ++ai)
#pragma unroll
            for (int m = 0; m < 4; ++m) { bf16_t* rowp = O + (size_t)(row0 + ai * 128 + m * 16) * ldc + col0; const float rs = rsl[ai * 128 + wr * 64 + m * 16 + fr];
#pragma unroll
                for (int bj = 0; bj < 2; ++bj) { const f32x4 v0 = rs * acc[ai][bj][m][0], v1 = rs * acc[ai][bj][m][1]; uint4 w; w.x = pack2(v0[0], v0[1]); w.y = pack2(v0[2], v0[3]); w.z = pack2(v1[0], v1[1]); w.w = pack2(v1[2], v1[3]);
                    *(uint4*)(rowp + bj * 128) = w; } }
    }
};
struct EpiRetIn {
    static constexpr bool PERM = true, RSTD = true;
    bf16_t* O; int ldc; const float* SS; const float* cs; const float* sn; int rowbase;
    __device__ __forceinline__ void operator()(AccRef acc, const Unit& u, int wr, int wc, int fr, int fq, const LAS float* rsl) const {
        const int row0 = u.pm * 256 + wr * 64 + fr, col0 = u.pn * 256 + wc * 32 + 8 * fq, f = 16 * wc + 4 * fq;
#pragma unroll
        for (int ai = 0; ai < 2; ++ai)
#pragma unroll
            for (int m = 0; m < 4; ++m) { const int r = row0 + ai * 128 + m * 16; bf16_t* rowp = O + (size_t)r * ldc + col0; const float rs = rsl[ai * 128 + wr * 64 + m * 16 + fr];
                f32x4 c4 = (f32x4){1.f, 1.f, 1.f, 1.f}, s4 = (f32x4){0.f, 0.f, 0.f, 0.f};
                if (u.pn < 8) { const int pos = (rowbase + r) & 8191; c4 = *(const f32x4*)(cs + pos * 64 + f); s4 = *(const f32x4*)(sn + pos * 64 + f);
                    if (u.pn >= 4) { c4 *= 0.08838834764831845f; s4 *= 0.08838834764831845f; } }
#pragma unroll
                for (int bj = 0; bj < 2; ++bj) { const f32x4 t1 = rs * acc[ai][bj][m][0], t2 = rs * acc[ai][bj][m][1]; const f32x4 v0 = t1 * c4 - t2 * s4, v1 = t1 * s4 + t2 * c4;
                    uint4 w; w.x = pack2(v0[0], v0[1]); w.y = pack2(v0[2], v0[3]); w.z = pack2(v1[0], v1[1]); w.w = pack2(v1[2], v1[3]);
                    *(uint4*)(rowp + bj * 128) = w; } }
    }
};
struct EpiWin0 {
    static constexpr bool PERM = true, RSTD = true;
    bf16_t* AS5; bf16_t* PQ; const float* SS;
    __device__ __forceinline__ void operator()(AccRef acc, const Unit& u, int wr, int wc, int fr, int fq, const LAS float* rsl) const {
        const int row0 = u.pm * 256 + wr * 64 + fr, col0 = u.pn * 256 + wc * 32 + 8 * fq;
#pragma unroll
        for (int ai = 0; ai < 2; ++ai)
#pragma unroll
            for (int m = 0; m < 4; ++m) { const int r = row0 + ai * 128 + m * 16; const float rs = rsl[ai * 128 + wr * 64 + m * 16 + fr];
#pragma unroll
                for (int bj = 0; bj < 2; ++bj) { const int c = col0 + bj * 128; const f32x4 v0 = rs * acc[ai][bj][m][0], v1 = rs * acc[ai][bj][m][1];
                    uint4 w; w.x = pack2(v0[0], v0[1]); w.y = pack2(v0[2], v0[3]); w.z = pack2(v1[0], v1[1]); w.w = pack2(v1[2], v1[3]);
                    if (u.pn < 2) *(uint4*)(AS5 + ((size_t)((c >> 4) * 1024 + (r >> 6))) * 1280 + (r & 63) * 16 + (c & 15)) = w;
                    else *(uint4*)(PQ + (size_t)r * 1792 + (c - 512)) = w; } }
    }
};
struct EpiGLU {
    static constexpr bool PERM = true, RSTD = false;
    const bf16_t* GY; bf16_t* MIX;
    __device__ __forceinline__ void operator()(AccRef acc, const Unit& u, int wr, int wc, int fr, int fq, const LAS float* rsl) const {
        const int row0 = u.pm * 256 + wr * 64 + fr, col0 = u.pn * 256 + wc * 32 + 8 * fq;
#pragma unroll
        for (int ai = 0; ai < 2; ++ai)
#pragma unroll
            for (int m = 0; m < 4; ++m) { const int r = row0 + ai * 128 + m * 16;
#pragma unroll
                for (int bj = 0; bj < 2; ++bj) { const int c = col0 + bj * 128; const f32x4 v0 = acc[ai][bj][m][0], v1 = acc[ai][bj][m][1];
                    const uint4 gy = *(const uint4*)(GY + (size_t)r * 512 + c); uint4 w;
                    w.x = pack2(bflo(gy.x) * fast_sigmoid(v0[0]), bfhi(gy.x) * fast_sigmoid(v0[1])); w.y = pack2(bflo(gy.y) * fast_sigmoid(v0[2]), bfhi(gy.y) * fast_sigmoid(v0[3]));
                    w.z = pack2(bflo(gy.z) * fast_sigmoid(v1[0]), bfhi(gy.z) * fast_sigmoid(v1[1])); w.w = pack2(bflo(gy.w) * fast_sigmoid(v1[2]), bfhi(gy.w) * fast_sigmoid(v1[3]));
                    *(uint4*)(MIX + (size_t)r * 1024 + c) = w; } }
    }
};
struct EpiS5E {
    static constexpr bool PERM = false, RSTD = false;
    float* E;
    __device__ __forceinline__ void operator()(AccRef acc, const Unit& u, int wr, int wc, int fr, int fq, const LAS float* rsl) const {
        const int row0 = u.pm * 256 + wr * 64 + fr, col0 = wc * 32 + 4 * fq;
#pragma unroll
        for (int ai = 0; ai < 2; ++ai)
#pragma unroll
            for (int m = 0; m < 4; ++m) { float* rowp = E + ((size_t)u.bz * 1024 + row0 + ai * 128 + m * 16) * 256 + col0;
#pragma unroll
                for (int bj = 0; bj < 2; ++bj)
#pragma unroll
                    for (int n = 0; n < 2; ++n) *(f32x4*)(rowp + bj * 128 + n * 16) = acc[ai][bj][m][n]; }
    }
};
struct EpiS5Y {
    static constexpr bool PERM = true, RSTD = false;
    bf16_t* GY;
    __device__ __forceinline__ void operator()(AccRef acc, const Unit& u, int wr, int wc, int fr, int fq, const LAS float* rsl) const {
        const int row0 = u.pm * 256 + wr * 64 + fr, col0 = u.pn * 256 + wc * 32 + 8 * fq;
#pragma unroll
        for (int ai = 0; ai < 2; ++ai)
#pragma unroll
            for (int m = 0; m < 4; ++m) { const int bc = row0 + ai * 128 + m * 16;
#pragma unroll
                for (int bj = 0; bj < 2; ++bj) { const int c = col0 + bj * 128; const f32x4 v0 = acc[ai][bj][m][0], v1 = acc[ai][bj][m][1]; uint4 w;
                    w.x = pack2(gelu_tanh(v0[0]), gelu_tanh(v0[1])); w.y = pack2(gelu_tanh(v0[2]), gelu_tanh(v0[3])); w.z = pack2(gelu_tanh(v1[0]), gelu_tanh(v1[1])); w.w = pack2(gelu_tanh(v1[2]), gelu_tanh(v1[3]));
                    *(uint4*)(GY + ((size_t)bc * 64 + (c >> 4)) * 512 + u.bz * 16 + (c & 15)) = w; } }
    }
};

__device__ void transpose_job(const float* __restrict__ src, int K, int Nsrc, bf16_t* __restrict__ dst, int Ndst, int mode, LAS float* tile, int b0, int nb, const float* __restrict__ gain) {
    const int tid = otid();
    const int ntk = K >> 8, nt = (Ndst >> 6) * ntk;
    for (int t = obid() - b0; t < nt; t += nb) {
        const int tn = t / ntk, tk = t % ntk, n0 = tn * 64, k0 = tk * 256;
        int ns0 = n0;
        if (mode == 1) { const int tt = n0 >> 8, j = n0 & 255; ns0 = (j < 128) ? (tt * 128 + j) : (2816 + tt * 128 + (j - 128)); }
        const int r = tid >> 4; int c4 = (tid & 15) * 4;
        const int c4d = c4;
        if (mode == 2 && n0 < 2048) { const int s_ = (n0 + c4) & 127;
            c4 = ((n0 + c4) & ~127) + 64 * ((s_ >> 2) & 1) + 16 * (s_ >> 5) + 4 * ((s_ >> 3) & 3) - n0; }
        float4 v[8];
#pragma unroll
        for (int rr = 0; rr < 8; ++rr) { v[rr] = make_float4(0.f, 0.f, 0.f, 0.f);
            if (ns0 + c4 + 3 < Nsrc) v[rr] = *(const float4*)(src + (size_t)(k0 + r + rr * 32) * Nsrc + ns0 + c4);
            if (gain) { const float gk = gain[k0 + r + rr * 32]; v[rr].x *= gk; v[rr].y *= gk; v[rr].z *= gk; v[rr].w *= gk; } }
#pragma unroll
        for (int rr = 0; rr < 8; ++rr) { const int kk = r + rr * 32; LAS float* tp = tile + (kk >> 6) * (64 * 65) + (kk & 63) * 65 + c4d;
            tp[0] = v[rr].x; tp[1] = v[rr].y; tp[2] = v[rr].z; tp[3] = v[rr].w; }
        __syncthreads();
        const int n = tid >> 3, kq = (tid & 7) * 8;
#pragma unroll
        for (int kt = 0; kt < 4; ++kt) { const LAS float* tp = tile + kt * (64 * 65); uint4 w;
            w.x = pack2(tp[(kq + 0) * 65 + n], tp[(kq + 1) * 65 + n]); w.y = pack2(tp[(kq + 2) * 65 + n], tp[(kq + 3) * 65 + n]);
            w.z = pack2(tp[(kq + 4) * 65 + n], tp[(kq + 5) * 65 + n]); w.w = pack2(tp[(kq + 6) * 65 + n], tp[(kq + 7) * 65 + n]);
            *(uint4*)(dst + (size_t)(n0 + n) * K + k0 + kt * 64 + kq) = w; }
        __syncthreads();
    }
}

__device__ void s5_pre(CP P, int g, int dir, int part, LAS unsigned char* lds) {
    LAS f32x2* pw = (LAS f32x2*)lds;
    LAS f32x2* Bb = pw + 65 * 64;
    LAS f32x2* Cc = Bb + 64 * 16;
    const int tid = otid();
    float* Ktab = (float*)(P->ws + OFF_KTAB); float* AT = (float*)(P->ws + OFF_S5P);
    bf16_t* KG = (bf16_t*)(P->ws + OFF_KG); bf16_t* H = (bf16_t*)(P->ws + OFF_H);
    if (tid < 64) { const int n = tid, gi = (dir * 32 + g) * 64 + n;
        const double lr = fmin((double)P->in[9][gi], -1e-4), li = (double)P->in[10][gi], dt = (double)expf(P->in[15][dir * 32 + g]);
        const double em1 = (double)expm1f((float)(lr * dt)), mag = 1.0 + em1;
        double rev = li * dt * 0.15915494309189535; rev -= rint(rev); const float th = (float)(rev * 6.283185307179586), thh = 0.5f * th;
        const double sn_ = (double)sinf(th), shalf = (double)sinf(thh), cm1 = -2.0 * shalf * shalf;
        const double ar = mag * (1.0 + cm1), ai = mag * sn_, arm1 = em1 + cm1 + em1 * cm1, den = lr * lr + li * li;
        const double cr = (arm1 * lr + ai * li) / den, ci = (ai * lr - arm1 * li) / den;
#pragma unroll 1
        for (int p = 0; p < 16; ++p) { const double br = (double)P->in[11][gi * 16 + p], bi = (double)P->in[12][gi * 16 + p];
            Bb[n * 16 + p] = mkf2((float)(cr * br - ci * bi), (float)(cr * bi + ci * br)); }
        double xr = 1.0, xi = 0.0;
#pragma unroll 1
        for (int d = 0; d <= 64; ++d) { pw[d * 64 + n] = mkf2((float)xr, (float)xi); const double t0 = xr * ar - xi * ai; xi = xr * ai + xi * ar; xr = t0; }
        const f32x2 a64 = pw[64 * 64 + n];
        if (part == 0) { AT[((g * 2 + dir) * 64 + n) * 2 + 0] = a64.x; AT[((g * 2 + dir) * 64 + n) * 2 + 1] = a64.y; } }
#pragma unroll 1
    for (int idx = tid; idx < 16 * 64; idx += NTHR) { const int p = idx >> 6, n = idx & 63; const int ci_ = ((dir * 32 + g) * 16 + p) * 64 + n;
        Cc[idx] = mkf2(P->in[13][ci_], P->in[14][ci_]); }
    __syncthreads();
    { const int dq = tid >> 8, p = (tid >> 4) & 15, pp = tid & 15;
#pragma unroll 1
        for (int dd = 0; dd < 16; ++dd) { const int d = part * 32 + dq * 16 + dd; float acc = 0.f;
#pragma unroll 4
            for (int n = 0; n < 64; ++n) { const f32x2 w = pw[d * 64 + n], bb = Bb[n * 16 + pp], c = Cc[p * 64 + n];
                const float zr = w.x * bb.x - w.y * bb.y, zi = w.x * bb.y + w.y * bb.x; acc += c.x * zr - c.y * zi; }
            Ktab[((size_t)((g * 2 + dir) * 64 + d)) * 256 + p * 16 + pp] = acc; } }
#pragma unroll 1
    for (int idx = tid; idx < 512 * 64; idx += NTHR) { const int row = part * 512 + (idx >> 6), n = idx & 63, t = row >> 4, p = row & 15, d = dir == 0 ? t + 1 : 64 - t;
        const f32x2 w = pw[d * 64 + n], c = Cc[p * 64 + n]; const float gr = c.x * w.x - c.y * w.y, gi = c.x * w.y + c.y * w.x;
        *(unsigned*)(KG + ((size_t)(g * 1024 + row)) * 1280 + 1024 + dir * 128 + n * 2) = pack2(gr, -gi); }
#pragma unroll 1
    for (int idx = tid; idx < 32 * 64 * 8; idx += NTHR) { const int pp2 = (idx & 7) * 2, s = (idx >> 3) & 63, n = part * 32 + (idx >> 9), d = dir == 0 ? 63 - s : s;
        const f32x2 w = pw[d * 64 + n], b0 = Bb[n * 16 + pp2], b1 = Bb[n * 16 + pp2 + 1];
        const float hr0 = w.x * b0.x - w.y * b0.y, hi0 = w.x * b0.y + w.y * b0.x, hr1 = w.x * b1.x - w.y * b1.y, hi1 = w.x * b1.y + w.y * b1.x;
        const size_t row0 = (size_t)g * 256 + dir * 128 + n * 2;
        *(unsigned*)(H + row0 * 1024 + s * 16 + pp2) = pack2(hr0, hr1); *(unsigned*)(H + (row0 + 1) * 1024 + s * 16 + pp2) = pack2(hi0, hi1); }
    __syncthreads();
}

template <bool FINAL> __device__ void phase_norm(const float* __restrict__ x, const float* __restrict__ g, bf16_t* __restrict__ xb, float* __restrict__ ss_out, float* __restrict__ outf, int b0, int nb, int rbeg, int rend);
__device__ void phase_prologue(CP P, LAS unsigned char* lds) {
    const int tid = otid(), bq = obid();
    if (bq < 128) { if (EN(20)) s5_pre(P, bq >> 2, (bq >> 1) & 1, bq & 1, lds);
        phase_norm<false>(P->in[0], nullptr, (bf16_t*)(P->ws + OFF_XN), (float*)(P->ws + OFF_SSQ), nullptr, 0, 128, 0, 40960); return; }
    const int b0 = 128, nb = (int)gridDim.x - 128;
    if (EN(21)) { float* cs = (float*)(P->ws + OFF_ROPE); float* sn = cs + 8192 * 64;
        for (int idx = (bq - b0) * NTHR + tid; idx < 8192 * 64; idx += nb * NTHR) { const int pos = idx >> 6, f = idx & 63;
            const float inv = expf(-9.210340371976184f * (float)f * (1.0f / 64.0f)); const float ang = (float)pos * inv;
            cs[idx] = cosf(ang); sn[idx] = sinf(ang); } }
    phase_norm<false>(P->in[0], nullptr, (bf16_t*)(P->ws + OFF_XN), (float*)(P->ws + OFF_SSQ), nullptr, b0, nb, 40960, 65536);
    LAS float* tile = (LAS float*)lds;
    if (EN(22)) for (int l = 0; l < 2; ++l) {
        transpose_job(P->in[2] + (size_t)l * 1024 * 5632, 1024, 5632, (bf16_t*)(P->ws + OFF_W1 + (size_t)(2 * l) * SZ_W1), 5632, 1, tile, b0, nb, P->in[1] + l * 1024);
        transpose_job(P->in[6] + (size_t)l * 1024 * 5632, 1024, 5632, (bf16_t*)(P->ws + OFF_W1 + (size_t)(2 * l + 1) * SZ_W1), 5632, 1, tile, b0, nb, P->in[5] + l * 1024);
        transpose_job(P->in[3] + (size_t)l * 2816 * 1024, 2816, 1024, (bf16_t*)(P->ws + OFF_W2 + (size_t)(2 * l) * SZ_W2), 1024, 0, tile, b0, nb, nullptr);
        transpose_job(P->in[7] + (size_t)l * 2816 * 1024, 2816, 1024, (bf16_t*)(P->ws + OFF_W2 + (size_t)(2 * l + 1) * SZ_W2), 1024, 0, tile, b0, nb, nullptr);
    }
    if (EN(22)) transpose_job(P->in[8], 1024, 2080, (bf16_t*)(P->ws + OFF_WIN0), 2304, 0, tile, b0, nb, P->in[4]);
    if (EN(22)) transpose_job(P->in[17], 512, 512, (bf16_t*)(P->ws + OFF_WGLU), 512, 0, tile, b0, nb, nullptr);
    if (EN(22)) transpose_job(P->in[21], 1024, 1024, (bf16_t*)(P->ws + OFF_WOUT0), 1024, 0, tile, b0, nb, nullptr);
    if (EN(22)) transpose_job(P->in[22], 1024, 6144, (bf16_t*)(P->ws + OFF_WIN1), 6144, 2, tile, b0, nb, P->in[4] + 1024);
    if (EN(22)) transpose_job(P->in[24], 2048, 1024, (bf16_t*)(P->ws + OFF_WOUT1), 1024, 0, tile, b0, nb, nullptr);
}

__device__ void phase_kmat(CP P, int t0, int nthr) {
    const float* Ktab = (const float*)(P->ws + OFF_KTAB); bf16_t* KG = (bf16_t*)(P->ws + OFF_KG); const float* dsk = P->in[16];
    const int tl = otid() - t0; if (tl < 0 || tl >= nthr) return;
    for (int idx = obid() * nthr + tl; idx < 32 * 1024 * 512; idx += gridDim.x * nthr) {
        const int kp = idx & 511, row = (idx >> 9) & 1023, g = idx >> 19, t = row >> 4, p = row & 15, k = kp * 2, s = k >> 4, pp = k & 15;
        float v0 = 0.f, v1 = 0.f;
        if (s <= t) { const float* b = Ktab + ((size_t)((g * 2 + 0) * 64 + (t - s))) * 256 + p * 16 + pp; v0 += b[0]; v1 += b[1]; }
        if (s >= t) { const float* b = Ktab + ((size_t)((g * 2 + 1) * 64 + (s - t))) * 256 + p * 16 + pp; v0 += b[0]; v1 += b[1]; }
        if (s == t) { const float dv = dsk[g * 16 + p]; if (pp == p) v0 += dv; if (pp + 1 == p) v1 += dv; }
        *(unsigned*)(KG + ((size_t)(g * 1024 + row)) * 1280 + k) = pack2(v0, v1);
    }
}

template <bool FINAL>
__device__ void phase_norm(const float* __restrict__ x, const float* __restrict__ g, bf16_t* __restrict__ xb, float* __restrict__ ss_out, float* __restrict__ outf, int b0, int nb, int rbeg, int rend) {
    const int tid_ = otid(), lane = tid_ & 63, wid = tid_ >> 6; const int bq = obid() - b0;
    if (bq < 0) return;
    f32x4 gv[4];
#pragma unroll
    for (int i = 0; i < 4; ++i) gv[i] = FINAL ? *(const f32x4*)(g + (lane + 64 * i) * 4) : (f32x4){1.f, 1.f, 1.f, 1.f};
    for (int row0 = rbeg + bq * 8 + wid; row0 < rend; row0 += nb * 16) {
        const int row1 = row0 + nb * 8; const bool has1 = row1 < rend;
        const float* xr0 = x + (size_t)row0 * 1024; const float* xr1 = x + (size_t)(has1 ? row1 : row0) * 1024; f32x4 v[4], u[4]; float ss = 0.f, st = 0.f;
#pragma unroll
        for (int i = 0; i < 4; ++i) { v[i] = *(const f32x4*)(xr0 + (lane + 64 * i) * 4); u[i] = *(const f32x4*)(xr1 + (lane + 64 * i) * 4); }
#pragma unroll
        for (int i = 0; i < 4; ++i) { ss += v[i][0] * v[i][0] + v[i][1] * v[i][1] + v[i][2] * v[i][2] + v[i][3] * v[i][3]; st += u[i][0] * u[i][0] + u[i][1] * u[i][1] + u[i][2] * u[i][2] + u[i][3] * u[i][3]; }
#pragma unroll
        for (int o = 32; o > 0; o >>= 1) { ss += __shfl_xor(ss, o); st += __shfl_xor(st, o); }
#pragma unroll
        for (int rr = 0; rr < 2; ++rr) { if (rr == 1 && !has1) break; const int row = rr ? row1 : row0; const float sv = rr ? st : ss;
            if (FINAL) { const float rstd = rsqrtf(sv * (1.0f / 1024.0f) + 1e-6f);
#pragma unroll
                for (int i = 0; i < 4; ++i) *(f32x4*)(outf + (size_t)row * 1024 + (lane + 64 * i) * 4) = (rr ? u[i] : v[i]) * rstd * gv[i]; }
            else { if (lane < 16) ss_out[(size_t)row * 16 + lane] = lane == 0 ? sv : 0.f;
#pragma unroll
                for (int i = 0; i < 4; ++i) { const f32x4 y = rr ? u[i] : v[i]; uint2 w; w.x = pack2(y[0], y[1]); w.y = pack2(y[2], y[3]); *(uint2*)(xb + (size_t)row * 1024 + (lane + 64 * i) * 4) = w; } } }
    }
}

__device__ void phase_final(const bf16_t* __restrict__ xr, const float* __restrict__ g, float* __restrict__ outf) {
    const int tid_ = otid(), lane = tid_ & 63, wid = tid_ >> 6;
    f32x4 gv[4];
#pragma unroll
    for (int i = 0; i < 4; ++i) gv[i] = *(const f32x4*)(g + lane * 16 + i * 4);
    const int nb8 = (int)gridDim.x * 8;
    for (int row0 = obid() * 8 + wid; row0 < 65536; row0 += nb8 * 2) { const int row1 = row0 + nb8; const bool has1 = row1 < 65536;
        const uint4 a0 = *(const uint4*)(xr + (size_t)row0 * 1024 + lane * 16), a1 = *(const uint4*)(xr + (size_t)row0 * 1024 + lane * 16 + 8);
        const uint4 b0 = *(const uint4*)(xr + (size_t)(has1 ? row1 : row0) * 1024 + lane * 16), b1 = *(const uint4*)(xr + (size_t)(has1 ? row1 : row0) * 1024 + lane * 16 + 8);
        f32x4 v[4] = {(f32x4){bflo(a0.x), bfhi(a0.x), bflo(a0.y), bfhi(a0.y)}, (f32x4){bflo(a0.z), bfhi(a0.z), bflo(a0.w), bfhi(a0.w)}, (f32x4){bflo(a1.x), bfhi(a1.x), bflo(a1.y), bfhi(a1.y)}, (f32x4){bflo(a1.z), bfhi(a1.z), bflo(a1.w), bfhi(a1.w)}};
        f32x4 w[4] = {(f32x4){bflo(b0.x), bfhi(b0.x), bflo(b0.y), bfhi(b0.y)}, (f32x4){bflo(b0.z), bfhi(b0.z), bflo(b0.w), bfhi(b0.w)}, (f32x4){bflo(b1.x), bfhi(b1.x), bflo(b1.y), bfhi(b1.y)}, (f32x4){bflo(b1.z), bfhi(b1.z), bflo(b1.w), bfhi(b1.w)}};
        float ss = 0.f, st = 0.f;
#pragma unroll
        for (int i = 0; i < 4; ++i) { ss += v[i][0] * v[i][0] + v[i][1] * v[i][1] + v[i][2] * v[i][2] + v[i][3] * v[i][3]; st += w[i][0] * w[i][0] + w[i][1] * w[i][1] + w[i][2] * w[i][2] + w[i][3] * w[i][3]; }
#pragma unroll
        for (int o = 32; o > 0; o >>= 1) { ss += __shfl_xor(ss, o); st += __shfl_xor(st, o); }
        const float r0 = rsqrtf(ss * (1.0f / 1024.0f) + 1e-6f), r1 = rsqrtf(st * (1.0f / 1024.0f) + 1e-6f);
#pragma unroll
        for (int i = 0; i < 4; ++i) *(f32x4*)(outf + (size_t)row0 * 1024 + lane * 16 + i * 4) = v[i] * r0 * gv[i];
        if (has1) {
#pragma unroll
            for (int i = 0; i < 4; ++i) *(f32x4*)(outf + (size_t)row1 * 1024 + lane * 16 + i * 4) = w[i] * r1 * gv[i]; }
    }
}

__device__ __forceinline__ f32x4 mma16(const LAS bf16_t* As, int lda, const LAS bf16_t* Bs, int ldb, int K, f32x4 acc, int lane) {
    const int r = lane & 15, q = lane >> 4;
#pragma unroll
    for (int k = 0; k < K; k += 32) { const bf16x8 a = *(const LAS bf16x8*)(As + r * lda + k + q * 8); const bf16x8 b = *(const LAS bf16x8*)(Bs + r * ldb + k + q * 8);
        acc = __builtin_amdgcn_mfma_f32_16x16x32_bf16(b, a, acc, 0, 0, 0); }
    return acc;
}


typedef short s16x4 __attribute__((ext_vector_type(4)));
__device__ __forceinline__ bf16x8 frag_tr(const LAS bf16_t* T, int ld, int lane) {
    const int g = lane >> 4, qq = (lane & 15) >> 2, p = lane & 3;
    LAS bf16_t* a = (LAS bf16_t*)T + (8 * g + qq) * ld + 4 * p;
    const s16x4 lo = __builtin_amdgcn_ds_read_tr16_b64_v4i16((LAS s16x4*)a);
    const s16x4 hi = __builtin_amdgcn_ds_read_tr16_b64_v4i16((LAS s16x4*)(a + 4 * ld));
    return (bf16x8){lo[0], lo[1], lo[2], lo[3], hi[0], hi[1], hi[2], hi[3]};
}

__device__ __forceinline__ void lds_barrier() { asm volatile("s_waitcnt lgkmcnt(0)" ::: "memory"); __builtin_amdgcn_s_barrier(); asm volatile("" ::: "memory"); }

__device__ void phase_s5_scan(CP P) {
    const float* E = (const float*)(P->ws + OFF_E); const float* AT = (const float*)(P->ws + OFF_S5P); bf16_t* AS5 = (bf16_t*)(P->ws + OFF_AS5);
    const int tid_ = otid(); if (tid_ >= 128) return;
    for (int idx = obid() * 128 + tid_; idx < 32 * 8 * 2 * 64; idx += gridDim.x * 128) {
        const int n = idx & 63, dir = (idx >> 6) & 1, b = (idx >> 7) & 7, g = idx >> 10;
        const float ar = AT[((g * 2 + dir) * 64 + n) * 2], ai = AT[((g * 2 + dir) * 64 + n) * 2 + 1];
        float xr = 0.f, xi = 0.f;
#pragma unroll 1
        for (int c0 = 0; c0 < 128; c0 += 16) { float2 ev[16];
#pragma unroll
            for (int k = 0; k < 16; ++k) { const int c = dir == 0 ? c0 + k : 127 - (c0 + k); const size_t bc = (size_t)g * 1024 + b * 128 + c; ev[k] = *(const float2*)(E + bc * 256 + dir * 128 + n * 2); }
#pragma unroll
            for (int k = 0; k < 16; ++k) { const int c = dir == 0 ? c0 + k : 127 - (c0 + k); const size_t bc = (size_t)g * 1024 + b * 128 + c;
                *(unsigned*)(AS5 + bc * 1280 + 1024 + dir * 128 + n * 2) = pack2(xr, xi);
                const float t0 = ar * xr - ai * xi + ev[k].x; xi = ar * xi + ai * xr + ev[k].y; xr = t0; } }
    }
}

__device__ __forceinline__ void gla_gates(CP P, const bf16_t* PQ, int m0, int h, LAS unsigned char* lds) {
    LAS float* gl = (LAS float*)lds; LAS float* tot = (LAS float*)(lds + 8192); LAS float* G = (LAS float*)(lds + 17408);
    const int tid = otid();
    const int dir = tid >> 8, d = tid & 63, tq = (tid >> 6) & 3;
    { const int idx = tid * 4, t = idx >> 5, r = idx & 31; const uint2 raw = *(const uint2*)(PQ + (size_t)(m0 + t) * 1792 + 1536 + r);
        *(LAS f32x4*)(gl + idx) = (f32x4){bflo(raw.x), bfhi(raw.x), bflo(raw.y), bfhi(raw.y)}; }
    float w[16];
#pragma unroll
    for (int r = 0; r < 16; ++r) w[r] = P->in[18][(dir * 16 + r) * 256 + h * 64 + d];
    const float b = P->in[19][dir * 256 + h * 64 + d];
    lds_barrier();
    float c[16];
#pragma unroll
    for (int i = 0; i < 16; ++i) { const int t = tq * 16 + i; float z = b;
#pragma unroll
        for (int r4 = 0; r4 < 4; ++r4) { const f32x4 g4 = *(const LAS f32x4*)(gl + t * 32 + dir * 16 + r4 * 4);
            z += g4[0] * w[r4 * 4] + g4[1] * w[r4 * 4 + 1] + g4[2] * w[r4 * 4 + 2] + g4[3] * w[r4 * 4 + 3]; }
        c[i] = (fminf(z, 0.f) - __logf(1.0f + __expf(-fabsf(z)))) * (1.0f / 16.0f); }
    if (dir == 0) {
#pragma unroll
        for (int i = 1; i < 16; ++i) c[i] += c[i - 1];
        tot[(dir * 4 + tq) * 64 + d] = c[15]; }
    else {
#pragma unroll
        for (int i = 14; i >= 0; --i) c[i] += c[i + 1];
        tot[(dir * 4 + tq) * 64 + d] = c[0]; }
    lds_barrier();
    float off = 0.f;
#pragma unroll
    for (int q = 0; q < 4; ++q) { const float tv = tot[(dir * 4 + q) * 64 + d]; off += ((dir == 0) ? (q < tq) : (q > tq)) ? tv : 0.f; }
#pragma unroll
    for (int i = 0; i < 16; ++i) G[(dir * 64 + tq * 16 + i) * 64 + d] = c[i] + off;
    lds_barrier();
}

__device__ void gla_a_unit(CP P, int unit, LAS unsigned char* lds) {
    const int c = unit & 127, h = (unit >> 7) & 3, b = unit >> 9, m0 = b * 8192 + c * 64;
    const bf16_t* PQ = (const bf16_t*)(P->ws + OFF_PQ); bf16_t* GST = (bf16_t*)(P->ws + OFF_GST); float* GDEC = (float*)(P->ws + OFF_GDEC);
    const int tid = otid(), lane = tid & 63, wid = tid >> 6;
    const int t = tid >> 3, d8 = (tid & 7) * 8, v16 = (tid & 7) * 16;
    const uint4 kraw = *(const uint4*)(PQ + (size_t)(m0 + t) * 1792 + 256 + h * 64 + d8);
    const uint4 vr0 = *(const uint4*)(PQ + (size_t)(m0 + t) * 1792 + 512 + h * 128 + v16), vr1 = *(const uint4*)(PQ + (size_t)(m0 + t) * 1792 + 512 + h * 128 + v16 + 8);
    gla_gates(P, PQ, m0, h, lds);
    LAS float* G = (LAS float*)(lds + 17408);
    LAS bf16_t* kA = (LAS bf16_t*)(lds + 50176);
    LAS bf16_t* Vs = (LAS bf16_t*)(lds + 67584);
    { const unsigned rw[4] = {kraw.x, kraw.y, kraw.z, kraw.w}; float ef[8], eb[8];
#pragma unroll
        for (int q = 0; q < 2; ++q) { const f32x4 lf = *(const LAS f32x4*)(G + 63 * 64 + d8 + q * 4), cf = *(const LAS f32x4*)(G + t * 64 + d8 + q * 4);
            const f32x4 lb = *(const LAS f32x4*)(G + 64 * 64 + d8 + q * 4), cb = *(const LAS f32x4*)(G + (64 + t) * 64 + d8 + q * 4);
#pragma unroll
            for (int j = 0; j < 4; ++j) { ef[q * 4 + j] = __expf(lf[j] - cf[j]); eb[q * 4 + j] = __expf(lb[j] - cb[j]); } }
        unsigned of[4], ob[4];
#pragma unroll
        for (int i = 0; i < 4; ++i) { const float k0 = bflo(rw[i]), k1 = bfhi(rw[i]); of[i] = pack2(k0 * ef[2 * i], k1 * ef[2 * i + 1]); ob[i] = pack2(k0 * eb[2 * i], k1 * eb[2 * i + 1]); }
        *(LAS u32x4*)(kA + t * 136 + d8) = mk4(of[0], of[1], of[2], of[3]); *(LAS u32x4*)(kA + t * 136 + 64 + d8) = mk4(ob[0], ob[1], ob[2], ob[3]);
        *(LAS u32x4*)(Vs + t * 136 + v16) = mk4(vr0.x, vr0.y, vr0.z, vr0.w); *(LAS u32x4*)(Vs + t * 136 + v16 + 8) = mk4(vr1.x, vr1.y, vr1.z, vr1.w); }
    if (tid < 128) { const int dir = tid >> 6, d = tid & 63; const float last = dir == 0 ? G[63 * 64 + d] : G[64 * 64 + d];
        GDEC[((size_t)(((b * 4 + h) * 2 + dir) * 128 + c)) * 64 + d] = __expf(last); }
    lds_barrier();
    { f32x4 acc[8];
#pragma unroll
        for (int nt = 0; nt < 8; ++nt) acc[nt] = (f32x4){0.f, 0.f, 0.f, 0.f};
#pragma unroll
        for (int ks = 0; ks < 2; ++ks) { const bf16x8 af = frag_tr(kA + ks * 32 * 136 + wid * 16, 136, lane);
#pragma unroll
            for (int nt = 0; nt < 8; ++nt) { const bf16x8 bfr = frag_tr(Vs + ks * 32 * 136 + nt * 16, 136, lane); acc[nt] = __builtin_amdgcn_mfma_f32_16x16x32_bf16(bfr, af, acc[nt], 0, 0, 0); } }
        const int row = wid * 16 + (lane & 15), dir = row >> 6, d = row & 63; bf16_t* out = GST + ((size_t)(((b * 4 + h) * 2 + dir) * 128 + c)) * 8192 + d * 128 + 4 * (lane >> 4);
#pragma unroll
        for (int nt = 0; nt < 8; ++nt) { uint2 w; w.x = pack2(acc[nt][0], acc[nt][1]); w.y = pack2(acc[nt][2], acc[nt][3]); *(uint2*)(out + nt * 16) = w; } }
    lds_barrier();
}

__device__ void phase_gla_b(CP P) {
    bf16_t* GST = (bf16_t*)(P->ws + OFF_GST); const float* GDEC = (const float*)(P->ws + OFF_GDEC);
    for (int idx = obid() * NTHR + otid(); idx < 64 * 1024; idx += gridDim.x * NTHR) {
        const int bhd = idx >> 10, e = (idx & 1023) * 8, d = e >> 7, dir = bhd & 1;
        f32x4 S0 = (f32x4){0.f, 0.f, 0.f, 0.f}, S1 = S0;
        bf16_t* base = GST + ((size_t)bhd * 128) * 8192 + e; const float* dbase = GDEC + ((size_t)bhd * 128) * 64 + d;
#pragma unroll 1
        for (int c0 = 0; c0 < 128; c0 += 8) { uint4 t[8]; float dc[8];
#pragma unroll
            for (int k = 0; k < 8; ++k) { const int c = dir == 0 ? c0 + k : 127 - (c0 + k); t[k] = *(const uint4*)(base + (size_t)c * 8192); dc[k] = dbase[(size_t)c * 64]; }
#pragma unroll
            for (int k = 0; k < 8; ++k) { const int c = dir == 0 ? c0 + k : 127 - (c0 + k);
                uint4 o; o.x = pack2(S0[0], S0[1]); o.y = pack2(S0[2], S0[3]); o.z = pack2(S1[0], S1[1]); o.w = pack2(S1[2], S1[3]); *(uint4*)(base + (size_t)c * 8192) = o;
                S0 = dc[k] * S0 + (f32x4){bflo(t[k].x), bfhi(t[k].x), bflo(t[k].y), bfhi(t[k].y)}; S1 = dc[k] * S1 + (f32x4){bflo(t[k].z), bfhi(t[k].z), bflo(t[k].w), bfhi(t[k].w)}; } }
    }
}

__device__ void gla_c_unit(CP P, int unit, LAS unsigned char* lds) {
    const int c = unit & 127, h = (unit >> 7) & 3, b = unit >> 9, m0 = b * 8192 + c * 64;
    const bf16_t* PQ = (const bf16_t*)(P->ws + OFF_PQ); const bf16_t* GST = (const bf16_t*)(P->ws + OFF_GST); bf16_t* MIX = (bf16_t*)(P->ws + OFF_MIX);
    const int tid = otid(), lane = tid & 63, wid = tid >> 6;
    const int t = tid >> 3, d8 = (tid & 7) * 8, v16 = (tid & 7) * 16;
    const uint4 rq = *(const uint4*)(PQ + (size_t)(m0 + t) * 1792 + h * 64 + d8), rk = *(const uint4*)(PQ + (size_t)(m0 + t) * 1792 + 256 + h * 64 + d8);
    const uint4 vr0 = *(const uint4*)(PQ + (size_t)(m0 + t) * 1792 + 512 + h * 128 + v16), vr1 = *(const uint4*)(PQ + (size_t)(m0 + t) * 1792 + 512 + h * 128 + v16 + 8);
    const uint4 ogr0 = *(const uint4*)(PQ + (size_t)(m0 + t) * 1792 + 1024 + h * 128 + v16), ogr1 = *(const uint4*)(PQ + (size_t)(m0 + t) * 1792 + 1024 + h * 128 + v16 + 8);
    uint4 sr[4];
#pragma unroll
    for (int i = 0; i < 4; ++i) { const int idx = tid + i * NTHR, v8 = (idx & 15) * 8, d = (idx >> 4) & 63, dir = idx >> 10;
        sr[i] = *(const uint4*)(GST + ((size_t)(((b * 4 + h) * 2 + dir) * 128 + c)) * 8192 + d * 128 + v8); }
    gla_gates(P, PQ, m0, h, lds);
    LAS float* G = (LAS float*)(lds + 17408);
    LAS bf16_t* Ps = (LAS bf16_t*)lds;
    LAS bf16_t* qf = (LAS bf16_t*)(lds + 51200);
    LAS bf16_t* kf = qf + 64 * 72; LAS bf16_t* qb = kf + 64 * 72; LAS bf16_t* kb = qb + 64 * 72;
    LAS bf16_t* Vs = (LAS bf16_t*)(lds + 88064);
    LAS bf16_t* Ss = (LAS bf16_t*)(lds + 105472);
    { const unsigned qw[4] = {rq.x, rq.y, rq.z, rq.w}, kw[4] = {rk.x, rk.y, rk.z, rk.w};
        unsigned oqf[4], okf[4], oqb[4], okb[4]; float cf[8], cb[8];
#pragma unroll
        for (int q = 0; q < 2; ++q) { const f32x4 a = *(const LAS f32x4*)(G + t * 64 + d8 + q * 4), bb = *(const LAS f32x4*)(G + (64 + t) * 64 + d8 + q * 4);
#pragma unroll
            for (int j = 0; j < 4; ++j) { cf[q * 4 + j] = a[j]; cb[q * 4 + j] = bb[j]; } }
#pragma unroll
        for (int i = 0; i < 4; ++i) { const float cf0 = cf[2 * i], cf1 = cf[2 * i + 1], cb0 = cb[2 * i], cb1 = cb[2 * i + 1];
            const float q0 = bflo(qw[i]) * 0.125f, q1 = bfhi(qw[i]) * 0.125f, k0 = bflo(kw[i]), k1 = bfhi(kw[i]);
            oqf[i] = pack2(q0 * __expf(cf0), q1 * __expf(cf1)); okf[i] = pack2(k0 * __expf(-cf0), k1 * __expf(-cf1));
            oqb[i] = pack2(q0 * __expf(cb0), q1 * __expf(cb1)); okb[i] = pack2(k0 * __expf(-cb0), k1 * __expf(-cb1)); }
        *(LAS u32x4*)(qf + t * 72 + d8) = mk4(oqf[0], oqf[1], oqf[2], oqf[3]); *(LAS u32x4*)(kf + t * 72 + d8) = mk4(okf[0], okf[1], okf[2], okf[3]);
        *(LAS u32x4*)(qb + t * 72 + d8) = mk4(oqb[0], oqb[1], oqb[2], oqb[3]); *(LAS u32x4*)(kb + t * 72 + d8) = mk4(okb[0], okb[1], okb[2], okb[3]);
        *(LAS u32x4*)(Vs + t * 136 + v16) = mk4(vr0.x, vr0.y, vr0.z, vr0.w); *(LAS u32x4*)(Vs + t * 136 + v16 + 8) = mk4(vr1.x, vr1.y, vr1.z, vr1.w); }
#pragma unroll
    for (int i = 0; i < 4; ++i) { const int idx = tid + i * NTHR, v8 = (idx & 15) * 8, d = (idx >> 4) & 63, dir = idx >> 10;
        *(LAS u32x4*)(Ss + (dir * 64 + d) * 136 + v8) = mk4(sr[i].x, sr[i].y, sr[i].z, sr[i].w); }
    lds_barrier();
#pragma unroll
    for (int tl = 0; tl < 2; ++tl) { const int tile = wid * 2 + tl, mi = tile >> 2, ni = tile & 3; f32x4 pf = (f32x4){0.f, 0.f, 0.f, 0.f}, pb = pf;
        pf = mma16(qf + mi * 16 * 72, 72, kf + ni * 16 * 72, 72, 64, pf, lane); pb = mma16(qb + mi * 16 * 72, 72, kb + ni * 16 * 72, 72, 64, pb, lane);
        const int i = mi * 16 + (lane & 15), j0 = ni * 16 + 4 * (lane >> 4); float pv[4];
#pragma unroll
        for (int jj = 0; jj < 4; ++jj) pv[jj] = (j0 + jj <= i) ? pf[jj] : pb[jj];
        *(LAS u32x2*)(Ps + i * 72 + j0) = mk2(pack2(pv[0], pv[1]), pack2(pv[2], pv[3])); }
    lds_barrier();
    { const int mi = wid & 3, nb = (wid >> 2) * 4; LAS float* ost = G; f32x4 acc[4];
#pragma unroll
        for (int nt = 0; nt < 4; ++nt) acc[nt] = (f32x4){0.f, 0.f, 0.f, 0.f};
#pragma unroll
        for (int ks = 0; ks < 2; ++ks) {
            const bf16x8 ap = *(const LAS bf16x8*)(Ps + (mi * 16 + (lane & 15)) * 72 + ks * 32 + (lane >> 4) * 8);
            const bf16x8 af = *(const LAS bf16x8*)(qf + (mi * 16 + (lane & 15)) * 72 + ks * 32 + (lane >> 4) * 8);
            const bf16x8 ab = *(const LAS bf16x8*)(qb + (mi * 16 + (lane & 15)) * 72 + ks * 32 + (lane >> 4) * 8);
#pragma unroll
            for (int nt = 0; nt < 4; ++nt) { const int ni = nb + nt;
                acc[nt] = __builtin_amdgcn_mfma_f32_16x16x32_bf16(frag_tr(Vs + ks * 32 * 136 + ni * 16, 136, lane), ap, acc[nt], 0, 0, 0);
                acc[nt] = __builtin_amdgcn_mfma_f32_16x16x32_bf16(frag_tr(Ss + ks * 32 * 136 + ni * 16, 136, lane), af, acc[nt], 0, 0, 0);
                acc[nt] = __builtin_amdgcn_mfma_f32_16x16x32_bf16(frag_tr(Ss + (64 + ks * 32) * 136 + ni * 16, 136, lane), ab, acc[nt], 0, 0, 0); } }
#pragma unroll
        for (int nt = 0; nt < 4; ++nt) *(LAS f32x4*)(ost + (mi * 16 + (lane & 15)) * 132 + (nb + nt) * 16 + 4 * (lane >> 4)) = acc[nt]; }
    lds_barrier();
    { LAS float* ost = G; float o[16]; float ss = 0.f;
#pragma unroll
        for (int i = 0; i < 4; ++i) { const f32x4 v = *(const LAS f32x4*)(ost + t * 132 + v16 + i * 4); o[4 * i] = v[0]; o[4 * i + 1] = v[1]; o[4 * i + 2] = v[2]; o[4 * i + 3] = v[3]; ss += v[0] * v[0] + v[1] * v[1] + v[2] * v[2] + v[3] * v[3]; }
        ss += __shfl_xor(ss, 1); ss += __shfl_xor(ss, 2); ss += __shfl_xor(ss, 4);
        const float rstd = rsqrtf(ss * (1.0f / 128.0f) + 1e-6f);
        const float* gn = P->in[20] + h * 128 + v16;
        bf16_t* op = MIX + (size_t)(m0 + t) * 1024 + 512 + h * 128 + v16;
#pragma unroll
        for (int hh = 0; hh < 2; ++hh) { const uint4 raw = hh ? ogr1 : ogr0; const unsigned rw[4] = {raw.x, raw.y, raw.z, raw.w}; unsigned ow[4];
#pragma unroll
            for (int i = 0; i < 4; ++i) { const int e = hh * 8 + 2 * i; const float g0 = bflo(rw[i]), g1 = bfhi(rw[i]);
                ow[i] = pack2(o[e] * rstd * gn[e] * silu_f(g0), o[e + 1] * rstd * gn[e + 1] * silu_f(g1)); }
            *(uint4*)(op + hh * 8) = make_uint4(ow[0], ow[1], ow[2], ow[3]); } }
    lds_barrier();
}

__device__ __forceinline__ float ret_lg(int h) {
    float v = -0.0317486983145803f;
    v = h == 1 ? -0.015748356968139168f : v; v = h == 2 ? -0.007843177461025893f : v; v = h == 3 ? -0.003913899321136329f : v; v = h == 4 ? -0.0019550348358033506f : v;
    v = h == 5 ? -0.0009770396478266127f : v; v = h == 6 ? -0.0004884004981088745f : v; v = h == 7 ? -0.0002441704321739145f : v; return v;
}

struct KRaw { uint4 a, b; };
__device__ __forceinline__ KRaw rot_load(const bf16_t* rowp, const float*, const float*, int dq) { KRaw k; k.a = *(const uint4*)(rowp + dq); k.b = *(const uint4*)(rowp + 64 + dq); return k; }
__device__ __forceinline__ void rot_apply(const KRaw& k, float (&r1)[8], float (&r2)[8]) {
    const unsigned aw[4] = {k.a.x, k.a.y, k.a.z, k.a.w}, bw[4] = {k.b.x, k.b.y, k.b.z, k.b.w};
#pragma unroll
    for (int i = 0; i < 8; ++i) { r1[i] = (i & 1) ? bfhi(aw[i >> 1]) : bflo(aw[i >> 1]); r2[i] = (i & 1) ? bfhi(bw[i >> 1]) : bflo(bw[i >> 1]); }
}

__device__ void ret_a_unit(CP P, int hf, int unit, LAS unsigned char* lds) {
    const int sc = unit & 31, h = (unit >> 5) & 7, bl = unit >> 8;
    const bf16_t* PR = (const bf16_t*)(P->ws + OFF_PROJ1); bf16_t* RST = (bf16_t*)(P->ws + OFF_RST);
    const int tid = otid(), lane = tid & 63, wid = tid >> 6;
    const size_t r0 = (size_t)bl * 8192 + sc * 256;
    const float lgf = ret_lg(h), lgb = ret_lg(7 - h);
    LAS bf16_t* kf = (LAS bf16_t*)lds;
    LAS bf16_t* kb = (LAS bf16_t*)(lds + 17408);
    LAS bf16_t* Vs = (LAS bf16_t*)(lds + 34816);
    f32x4 acc[4][8];
#pragma unroll
    for (int a = 0; a < 4; ++a)
#pragma unroll
        for (int n = 0; n < 8; ++n) acc[a][n] = (f32x4){0.f, 0.f, 0.f, 0.f};
    const int mb = (wid >> 1) * 4, nb = (wid & 1) * 8;
    const LAS bf16_t* kA = (mb >= 8) ? kb : kf; const int dt0 = (mb & 7) * 16;
    const int pj = tid >> 3, pdq = (tid & 7) * 8, pv32 = (tid & 7) * 32;
    const bf16_t* kbase = PR + (r0 + pj) * 6144 + 1024 + h * 128; const bf16_t* vbase = PR + (r0 + pj) * 6144 + 2048 + h * 256 + pv32;
    KRaw kr = rot_load(kbase, nullptr, nullptr, pdq);
    uint4 vr[4];
#pragma unroll
    for (int hh = 0; hh < 4; ++hh) vr[hh] = *(const uint4*)(vbase + hh * 8);
    for (int jb = 0; jb < 4; ++jb) {
        { const int j = pj, dq = pdq, J = jb * 64 + j; float r1[8], r2[8];
            rot_apply(kr, r1, r2);
            const float sf = __expf((float)(255 - J) * lgf), sb = __expf((float)J * lgb);
            *(LAS u32x4*)(kf + j * 136 + dq) = mk4(pack2(r1[0] * sf, r1[1] * sf), pack2(r1[2] * sf, r1[3] * sf), pack2(r1[4] * sf, r1[5] * sf), pack2(r1[6] * sf, r1[7] * sf));
            *(LAS u32x4*)(kf + j * 136 + 64 + dq) = mk4(pack2(r2[0] * sf, r2[1] * sf), pack2(r2[2] * sf, r2[3] * sf), pack2(r2[4] * sf, r2[5] * sf), pack2(r2[6] * sf, r2[7] * sf));
            *(LAS u32x4*)(kb + j * 136 + dq) = mk4(pack2(r1[0] * sb, r1[1] * sb), pack2(r1[2] * sb, r1[3] * sb), pack2(r1[4] * sb, r1[5] * sb), pack2(r1[6] * sb, r1[7] * sb));
            *(LAS u32x4*)(kb + j * 136 + 64 + dq) = mk4(pack2(r2[0] * sb, r2[1] * sb), pack2(r2[2] * sb, r2[3] * sb), pack2(r2[4] * sb, r2[5] * sb), pack2(r2[6] * sb, r2[7] * sb));
#pragma unroll
            for (int hh = 0; hh < 4; ++hh) *(LAS u32x4*)(Vs + j * 264 + pv32 + hh * 8) = mk4(vr[hh].x, vr[hh].y, vr[hh].z, vr[hh].w); }
        lds_barrier();
        if (jb < 3) { kr = rot_load(kbase + (size_t)(jb + 1) * 64 * 6144, nullptr, nullptr, pdq);
#pragma unroll
            for (int hh = 0; hh < 4; ++hh) vr[hh] = *(const uint4*)(vbase + (size_t)(jb + 1) * 64 * 6144 + hh * 8); }
#pragma unroll
        for (int ks = 0; ks < 2; ++ks) { bf16x8 af[4];
#pragma unroll
            for (int a = 0; a < 4; ++a) af[a] = frag_tr(kA + ks * 32 * 136 + dt0 + a * 16, 136, lane);
#pragma unroll
            for (int n = 0; n < 8; ++n) { const bf16x8 bfr = frag_tr(Vs + ks * 32 * 264 + (nb + n) * 16, 264, lane);
#pragma unroll
                for (int a = 0; a < 4; ++a) acc[a][n] = __builtin_amdgcn_mfma_f32_16x16x32_bf16(bfr, af[a], acc[a][n], 0, 0, 0); } }
        lds_barrier();
    }
#pragma unroll
    for (int a = 0; a < 4; ++a) { const int row = (mb + a) * 16 + (lane & 15), dir = row >> 7, d = row & 127;
        bf16_t* out = RST + ((size_t)(((bl * 8 + h) * 2 + dir) * 32 + sc)) * 32768 + d * 256 + 4 * (lane >> 4);
#pragma unroll
        for (int n = 0; n < 8; ++n) { uint2 w; w.x = pack2(acc[a][n][0], acc[a][n][1]); w.y = pack2(acc[a][n][2], acc[a][n][3]); *(uint2*)(out + (nb + n) * 16) = w; } }
}

__device__ void phase_ret_b(CP P) {
    bf16_t* RST = (bf16_t*)(P->ws + OFF_RST);
    for (int idx = obid() * NTHR + otid(); idx < 64 * 4096; idx += gridDim.x * NTHR) {
        const int bhd = idx >> 12, e = (idx & 4095) * 8, dir = bhd & 1, h = (bhd >> 1) & 7;
        const float dec = __expf(256.0f * ret_lg(dir == 0 ? h : 7 - h));
        f32x4 S0 = (f32x4){0.f, 0.f, 0.f, 0.f}, S1 = S0;
        bf16_t* base = RST + ((size_t)bhd * 32) * 32768 + e;
#pragma unroll 1
        for (int c0 = 0; c0 < 32; c0 += 8) { uint4 t[8];
#pragma unroll
            for (int k = 0; k < 8; ++k) { const int c = dir == 0 ? c0 + k : 31 - (c0 + k); t[k] = *(const uint4*)(base + (size_t)c * 32768); }
#pragma unroll
            for (int k = 0; k < 8; ++k) { const int c = dir == 0 ? c0 + k : 31 - (c0 + k);
                uint4 o; o.x = pack2(S0[0], S0[1]); o.y = pack2(S0[2], S0[3]); o.z = pack2(S1[0], S1[1]); o.w = pack2(S1[2], S1[3]); *(uint4*)(base + (size_t)c * 32768) = o;
                S0 = dec * S0 + (f32x4){bflo(t[k].x), bfhi(t[k].x), bflo(t[k].y), bfhi(t[k].y)}; S1 = dec * S1 + (f32x4){bflo(t[k].z), bfhi(t[k].z), bflo(t[k].w), bfhi(t[k].w)}; } }
    }
}

__device__ void ret_c_unit(CP P, int hf, int unit, LAS unsigned char* lds) {
    const int rh = (unit >> 3) & 1, ur = (unit & 7) | ((unit >> 4) << 3), sc = ur & 31, h = (ur >> 5) & 7, bl = ur >> 8;
    const bf16_t* PR = (const bf16_t*)(P->ws + OFF_PROJ1); const bf16_t* RST = (const bf16_t*)(P->ws + OFF_RST);
    const float* cs = (const float*)(P->ws + OFF_ROPE); const float* sn = cs + 8192 * 64;
    const int tid = otid(), lane = tid & 63, wid = tid >> 6;
    const size_t r0 = (size_t)bl * 8192 + sc * 256;
    const float lgf = ret_lg(h), lgb = ret_lg(7 - h);
    LAS bf16_t* qs = (LAS bf16_t*)lds;
    LAS bf16_t* ks = (LAS bf16_t*)(lds + 34816);
    LAS bf16_t* Ps = (LAS bf16_t*)(lds + 52224);
    LAS bf16_t* Vs = (LAS bf16_t*)(lds + 70656);
    LAS float* red = (LAS float*)(lds + 104448);
    LAS bf16_t* qx = ks;
#pragma unroll
    for (int rep = 0; rep < 2; ++rep) { const int i = (tid >> 3) + rep * 64, dq = (tid & 7) * 8, I = rh * 128 + i;
        const KRaw q_ = rot_load(PR + (r0 + I) * 6144 + h * 128, nullptr, nullptr, dq);
        *(LAS u32x4*)(qs + i * 136 + dq) = mk4(q_.a.x, q_.a.y, q_.a.z, q_.a.w); *(LAS u32x4*)(qs + i * 136 + 64 + dq) = mk4(q_.b.x, q_.b.y, q_.b.z, q_.b.w); }
    f32x4 acc[2][8];
#pragma unroll
    for (int r = 0; r < 2; ++r)
#pragma unroll
        for (int n = 0; n < 8; ++n) acc[r][n] = (f32x4){0.f, 0.f, 0.f, 0.f};
    const int mi2 = (wid & 3) * 2, nb = (wid >> 2) * 8;
    const int pj = tid >> 3, pdq = (tid & 7) * 8, pv32 = (tid & 7) * 32;
    const bf16_t* kbase = PR + (r0 + pj) * 6144 + 1024 + h * 128; const bf16_t* vbase = PR + (r0 + pj) * 6144 + 2048 + h * 256 + pv32;
    KRaw kr = rot_load(kbase, cs + (sc * 256 + pj) * 64, sn + (sc * 256 + pj) * 64, pdq);
    uint4 vr[4];
#pragma unroll
    for (int hh = 0; hh < 4; ++hh) vr[hh] = *(const uint4*)(vbase + hh * 8);
    uint4 st[4];
    const bf16_t* sbase = RST + ((size_t)((bl * 8 + h) * 2) * 32 + sc) * 32768;
    for (int kb = 0; kb < 4; ++kb) {
        { const int j = pj, dq = pdq;
            *(LAS u32x4*)(ks + j * 136 + dq) = mk4(kr.a.x, kr.a.y, kr.a.z, kr.a.w); *(LAS u32x4*)(ks + j * 136 + 64 + dq) = mk4(kr.b.x, kr.b.y, kr.b.z, kr.b.w);
#pragma unroll
            for (int hh = 0; hh < 4; ++hh) *(LAS u32x4*)(Vs + j * 264 + pv32 + hh * 8) = mk4(vr[hh].x, vr[hh].y, vr[hh].z, vr[hh].w); }
        lds_barrier();
        if (kb < 3) { const int J = (kb + 1) * 64 + pj; kr = rot_load(kbase + (size_t)(kb + 1) * 64 * 6144, cs + (sc * 256 + J) * 64, sn + (sc * 256 + J) * 64, pdq);
#pragma unroll
            for (int hh = 0; hh < 4; ++hh) vr[hh] = *(const uint4*)(vbase + (size_t)(kb + 1) * 64 * 6144 + hh * 8); }
        else {
#pragma unroll
            for (int i = 0; i < 4; ++i) { const int idx = tid + i * NTHR, v8 = (idx & 31) * 8, dd = idx >> 5; st[i] = *(const uint4*)(sbase + dd * 256 + v8); } }
#pragma unroll
        for (int tr = 0; tr < 2; ++tr)
#pragma unroll
            for (int tc = 0; tc < 2; ++tc) { const int ti = mi2 + tr, tj = (wid >> 2) * 2 + tc; f32x4 s = (f32x4){0.f, 0.f, 0.f, 0.f};
                s = mma16(qs + ti * 16 * 136, 136, ks + tj * 16 * 136, 136, 128, s, lane);
                const int i = ti * 16 + (lane & 15), j0 = tj * 16 + 4 * (lane >> 4), I = rh * 128 + i; float pv[4];
#pragma unroll
                for (int jj = 0; jj < 4; ++jj) { const int df = I - (kb * 64 + j0 + jj); const float dm = df >= 0 ? __expf((float)df * lgf) : __expf((float)(-df) * lgb); pv[jj] = s[jj] * dm; }
                *(LAS u32x2*)(Ps + i * 72 + j0) = mk2(pack2(pv[0], pv[1]), pack2(pv[2], pv[3])); }
        lds_barrier();
#pragma unroll
        for (int k2 = 0; k2 < 2; ++k2) { bf16x8 af[2], bfr[8];
#pragma unroll
            for (int r = 0; r < 2; ++r) af[r] = *(const LAS bf16x8*)(Ps + ((mi2 + r) * 16 + (lane & 15)) * 72 + k2 * 32 + (lane >> 4) * 8);
#pragma unroll
            for (int n = 0; n < 8; ++n) bfr[n] = frag_tr(Vs + k2 * 32 * 264 + (nb + n) * 16, 264, lane);
#pragma unroll
            for (int r = 0; r < 2; ++r)
#pragma unroll
                for (int n = 0; n < 8; ++n) acc[r][n] = __builtin_amdgcn_mfma_f32_16x16x32_bf16(bfr[n], af[r], acc[r][n], 0, 0, 0); }
        lds_barrier();
    }
    uint2 ogr[2][8];
#pragma unroll
    for (int r = 0; r < 2; ++r) { const bf16_t* ogp = PR + (r0 + rh * 128 + (mi2 + r) * 16 + (lane & 15)) * 6144 + 4096 + h * 256 + 4 * (lane >> 4);
#pragma unroll
        for (int n = 0; n < 8; ++n) ogr[r][n] = *(const uint2*)(ogp + (nb + n) * 16); }
    for (int sl = 0; sl < 4; ++sl) { const int dir = sl >> 1, dh = sl & 1;
        if (dh == 0) { const int i = tid >> 2, c32 = (tid & 3) * 32, I = rh * 128 + i; const float xs = dir == 0 ? __expf((float)(I + 1) * lgf) : __expf((float)(256 - I) * lgb);
#pragma unroll
            for (int hh = 0; hh < 4; ++hh) { const u32x4 w = *(const LAS u32x4*)(qs + i * 136 + c32 + hh * 8);
                *(LAS u32x4*)(qx + i * 136 + c32 + hh * 8) = mk4(pack2(bflo(w[0]) * xs, bfhi(w[0]) * xs), pack2(bflo(w[1]) * xs, bfhi(w[1]) * xs), pack2(bflo(w[2]) * xs, bfhi(w[2]) * xs), pack2(bflo(w[3]) * xs, bfhi(w[3]) * xs)); } }
#pragma unroll
        for (int i = 0; i < 4; ++i) { const int idx = tid + i * NTHR, v8 = (idx & 31) * 8, dd = idx >> 5; *(LAS u32x4*)(Vs + dd * 264 + v8) = mk4(st[i].x, st[i].y, st[i].z, st[i].w); }
        lds_barrier();
        if (sl < 3) { const int nd = (sl + 1) >> 1, nh = (sl + 1) & 1; const bf16_t* sp = sbase + (size_t)nd * 32 * 32768 + (size_t)nh * 64 * 256;
#pragma unroll
            for (int i = 0; i < 4; ++i) { const int idx = tid + i * NTHR, v8 = (idx & 31) * 8, dd = idx >> 5; st[i] = *(const uint4*)(sp + dd * 256 + v8); } }
#pragma unroll
        for (int k2 = 0; k2 < 2; ++k2) { bf16x8 af[2], bfr[8];
#pragma unroll
            for (int r = 0; r < 2; ++r) af[r] = *(const LAS bf16x8*)(qx + ((mi2 + r) * 16 + (lane & 15)) * 136 + dh * 64 + k2 * 32 + (lane >> 4) * 8);
#pragma unroll
            for (int n = 0; n < 8; ++n) bfr[n] = frag_tr(Vs + k2 * 32 * 264 + (nb + n) * 16, 264, lane);
#pragma unroll
            for (int r = 0; r < 2; ++r)
#pragma unroll
                for (int n = 0; n < 8; ++n) acc[r][n] = __builtin_amdgcn_mfma_f32_16x16x32_bf16(bfr[n], af[r], acc[r][n], 0, 0, 0); }
        lds_barrier();
    }
    { float ss[2];
#pragma unroll
        for (int r = 0; r < 2; ++r) { ss[r] = 0.f;
#pragma unroll
            for (int n = 0; n < 8; ++n) ss[r] += acc[r][n][0] * acc[r][n][0] + acc[r][n][1] * acc[r][n][1] + acc[r][n][2] * acc[r][n][2] + acc[r][n][3] * acc[r][n][3];
            ss[r] += __shfl_xor(ss[r], 16); ss[r] += __shfl_xor(ss[r], 32);
            if ((lane >> 4) == 0) red[((mi2 + r) * 16 + (lane & 15)) * 2 + (wid >> 2)] = ss[r]; }
        lds_barrier();
#pragma unroll
        for (int r = 0; r < 2; ++r) { const int i = (mi2 + r) * 16 + (lane & 15);
            const float rstd = rsqrtf((red[i * 2] + red[i * 2 + 1]) * (1.0f / 256.0f) + 1e-6f);
            const float* gn = P->in[23] + h * 256 + 4 * (lane >> 4);
            bf16_t* op = (bf16_t*)(P->ws + OFF_OBUF) + (r0 + rh * 128 + i) * 2048 + h * 256 + 4 * (lane >> 4);
#pragma unroll
            for (int n = 0; n < 8; ++n) { const int v = (nb + n) * 16; const uint2 og = ogr[r][n]; const f32x4 g4 = *(const f32x4*)(gn + v);
                uint2 w; w.x = pack2(acc[r][n][0] * rstd * g4[0] * silu_f(bflo(og.x)), acc[r][n][1] * rstd * g4[1] * silu_f(bfhi(og.x)));
                w.y = pack2(acc[r][n][2] * rstd * g4[2] * silu_f(bflo(og.y)), acc[r][n][3] * rstd * g4[3] * silu_f(bfhi(og.y)));
                *(uint2*)(op + v) = w; } } }
    lds_barrier();
}

#define XB_TMO      128
#define XB_XCNT(j)  (256  + 64 * (j))
#define XB_XSUB(j)  (1280 + 64 * (j))
#define XB_XGEN(j)  (2304 + 64 * (j))
#define XB_TOP      3328
#define XB_TOPGEN   3392
#define XCD_BAR_WORDS 3456
#define XB_SPIN_CAP (1u << 18)
__device__ __forceinline__ unsigned xb_ld(unsigned* p)              { return __hip_atomic_load(p, __ATOMIC_RELAXED, __HIP_MEMORY_SCOPE_AGENT); }
__device__ __forceinline__ unsigned xb_add(unsigned* p, unsigned v) { return __hip_atomic_fetch_add(p, v, __ATOMIC_RELAXED, __HIP_MEMORY_SCOPE_AGENT); }
__device__ __forceinline__ unsigned xb_xcc_id() { return (unsigned)__builtin_amdgcn_s_getreg((3 << 11) | 20) & 0xFu; }
#define XB_SPIN(cond, bar) do { unsigned _sp = 0; while (cond) { __builtin_amdgcn_s_sleep(1); \
    if ((++_sp & 255u) == 0u) { if (xb_ld(&(bar)[XB_TMO])) break; if (_sp > XB_SPIN_CAP) { atomicAdd(&(bar)[XB_TMO], 1u); break; } } } } while (0)
__device__ __forceinline__ void xcd_barrier_complete(unsigned* bar, unsigned x, unsigned& nloc, unsigned& nx) {
    const unsigned G = gridDim.x * gridDim.y * gridDim.z;
    unsigned sum, cnt, mine, sp = 0u;
    for (;;) {
        sum = 0u; cnt = 0u; mine = 0u;
#pragma unroll
        for (unsigned j = 0; j < 16; ++j) { const unsigned c = xb_ld(&bar[XB_XCNT(j)]); sum += c; cnt += (c > 0u) ? 1u : 0u; mine = (j == x) ? c : mine; }
        if (sum == G) break;
        __builtin_amdgcn_s_sleep(1);
        if ((++sp & 255u) == 0u) { if (xb_ld(&bar[XB_TMO])) break; if (sp > XB_SPIN_CAP) { atomicAdd(&bar[XB_TMO], 1u); break; } }
    }
    nloc = mine > 0u ? mine : 1u; nx = cnt > 0u ? cnt : 1u;
}
__device__ __forceinline__ void xcd_barrier(unsigned* bar, unsigned x, volatile LAS unsigned* st) {
    asm volatile("s_waitcnt vmcnt(0)" ::: "memory");
    __syncthreads();
    if (threadIdx.x == 0) {
        __builtin_amdgcn_s_waitcnt(0);
        unsigned nloc = st[0], nx = st[1];
        if (nloc == 0u) { xcd_barrier_complete(bar, x, nloc, nx); st[0] = nloc; st[1] = nx; }
        const unsigned old = xb_add(&bar[XB_XSUB(x)], 1u);
        const unsigned gen = old / nloc;
        if (old + 1u == (gen + 1u) * nloc) {
            __builtin_amdgcn_fence(__ATOMIC_RELEASE, "agent");
            asm volatile("s_waitcnt vmcnt(0)" ::: "memory");
            const unsigned og = xb_add(&bar[XB_TOP], 1u);
            const unsigned tg = og / nx;
            if (og + 1u == (tg + 1u) * nx) xb_add(&bar[XB_TOPGEN], 1u);
            else XB_SPIN(xb_ld(&bar[XB_TOPGEN]) == tg, bar);
            __builtin_amdgcn_fence(__ATOMIC_ACQUIRE, "agent");
            xb_add(&bar[XB_XGEN(x)], 1u);
            asm volatile("s_waitcnt vmcnt(0)" ::: "memory");
        } else {
            XB_SPIN(xb_ld(&bar[XB_XGEN(x)]) == gen, bar);
            __builtin_amdgcn_fence(__ATOMIC_ACQUIRE, "agent");
            asm volatile("s_waitcnt vmcnt(0)" ::: "memory");
        }
    }
    __syncthreads();
}

__global__ void __launch_bounds__(NTHR, 2) mega(Params Pval, int ph0, int ph1) {
    extern __shared__ __attribute__((aligned(16))) unsigned char lds_raw[];
    LAS unsigned char* lds = (LAS unsigned char*)lds_raw;
    volatile LAS unsigned* xb_st = (volatile LAS unsigned*)(lds + LDS_BYTES - 16);
    unsigned xb_x = 0;
    if (ph1 - ph0 > 1) { if (threadIdx.x == 0) { xb_st[0] = 0u; xb_st[1] = 0u; } __syncthreads();
        xb_x = xb_xcc_id(); if (threadIdx.x == 0) (void)xb_add((unsigned*)(Pval.ws + OFF_BAR) + XB_XCNT(xb_x), 1u); }
    for (int ph = ph0; ph < ph1; ++ph) {
        CP P = (CP)__builtin_amdgcn_kernarg_segment_ptr(); asm volatile("" : "+s"(P));
        unsigned char* ws = P->ws;
        bf16_t* XN = (bf16_t*)(ws + OFF_XN); bf16_t* ACT = (bf16_t*)(ws + OFF_ACT);
        if (ph == 1 || ph == 4 || ph == 11 || ph == 14 || ph == 17 || ph == 28) continue;
        const int reps = (((unsigned long long)(PROBE_MASK) >> ph) & 1ull) ? 2 : 1;
        for (int rep = 0; rep < reps; ++rep) {
        float* SSQ = (float*)(ws + OFF_SSQ); bf16_t* MIXB = (bf16_t*)(ws + OFF_MIX);
        int ffn = -1, sub = 0;
        if (ph >= 2 && ph <= 3) { ffn = 0; sub = ph - 1; } else if (ph >= 12 && ph <= 13) { ffn = 1; sub = ph - 11; }
        else if (ph >= 15 && ph <= 16) { ffn = 2; sub = ph - 14; } else if (ph >= 29 && ph <= 30) { ffn = 3; sub = ph - 28; }
        if (ph == 0) { if (EN(0)) phase_prologue(P, lds); }
        else if (ffn >= 0) {
            const float* ssin = SSQ + (size_t)(ffn == 0 ? 0 : ffn == 1 ? 2 : ffn == 2 ? 3 : 5) * SSN;
            if (sub == 1) { if (EN(2)) {
                pg8::Gemm g{XN, (const bf16_t*)(ws + OFF_W1 + (size_t)ffn * SZ_W1), 1024, 1024, 1024, 256, 22, 1, 0, 0}; EpiSwiGLU e{ACT, ssin}; pg8::gemm_phase(lds, g, e); } }
            else { if (EN(3)) { pg8::Gemm g{ACT, (const bf16_t*)(ws + OFF_W2 + (size_t)ffn * SZ_W2), 2816, 2816, 2816, 256, 4, 1, 0, 0};
                float* ssout = SSQ + (size_t)(ffn == 0 ? 1 : ffn == 1 ? 3 : 4) * SSN;
                if (ffn == 3) { EpiResid<false, false> e{nullptr, XN, nullptr, 0.5f}; pg8::gemm_phase(lds, g, e); }
                else if (ffn == 0) { EpiResid<true, true> e{P->in[0], XN, ssout, 0.5f}; pg8::gemm_phase(lds, g, e); }
                else { EpiResid<true, false> e{nullptr, XN, ssout, 0.5f}; pg8::gemm_phase(lds, g, e); } } }
        }
        else if (ph == 5) { if (EN(4)) { pg8::Gemm g{XN, (const bf16_t*)(ws + OFF_WIN0), 1024, 1024, 1024, 256, 9, 1, 0, 0}; EpiWin0 e{(bf16_t*)(ws + OFF_AS5), (bf16_t*)(ws + OFF_PQ), SSQ + SSN}; pg8::gemm_phase(lds, g, e); } }
        else if (ph == 6) { if (EN(5)) {
            if (EN(16)) { pg8::Gemm g{(const bf16_t*)(ws + OFF_AS5), (const bf16_t*)(ws + OFF_H), 1280, 1024, 1024, 4, 1, 32, (size_t)1024 * 1280, (size_t)256 * 1024}; EpiS5E e{(float*)(ws + OFF_E)}; pg8::gemm_phase(lds, g, e); }
            __syncthreads();
            if (EN(17)) for (int u = obid(); u < 4096; u += gridDim.x) gla_a_unit(P, u, lds);
        } }
        else if (ph == 7) { if (EN(6)) { phase_s5_scan(P); phase_kmat(P, 128, 384); phase_gla_b(P); } }
        else if (ph == 8) { if (EN(7)) {
            if (EN(18)) { pg8::Gemm g{(const bf16_t*)(ws + OFF_AS5), (const bf16_t*)(ws + OFF_KG), 1280, 1280, 1280, 4, 4, 32, (size_t)1024 * 1280, (size_t)1024 * 1280}; EpiS5Y e{(bf16_t*)(ws + OFF_GY)}; pg8::gemm_phase(lds, g, e); }
            __syncthreads();
            if (EN(19)) for (int u = obid(); u < 4096; u += gridDim.x) gla_c_unit(P, u, lds);
        } }
        else if (ph == 9) { if (EN(8)) { pg8::Gemm g{(const bf16_t*)(ws + OFF_GY), (const bf16_t*)(ws + OFF_WGLU), 512, 512, 512, 256, 2, 1, 0, 0}; EpiGLU e{(const bf16_t*)(ws + OFF_GY), MIXB}; pg8::gemm_phase(lds, g, e); } }
        else if (ph == 10) { if (EN(9)) { pg8::Gemm g{MIXB, (const bf16_t*)(ws + OFF_WOUT0), 1024, 1024, 1024, 256, 4, 1, 0, 0}; EpiResid<true, false> e{nullptr, XN, SSQ + 2 * SSN, 1.0f}; pg8::gemm_phase(lds, g, e); } }
        else if (ph >= 18 && ph <= 27) {
            const int hf = (ph - 18) / 5, s = (ph - 18) % 5;
            if (s == 0) { if (EN(10)) { pg8::Gemm g{XN + (size_t)hf * 32768 * 1024, (const bf16_t*)(ws + OFF_WIN1), 1024, 1024, 1024, 128, 24, 1, 0, 0}; EpiRetIn e{(bf16_t*)(ws + OFF_PROJ1), 6144, SSQ + 4 * SSN + (size_t)hf * 32768 * 16, (const float*)(ws + OFF_ROPE), (const float*)(ws + OFF_ROPE) + 8192 * 64, hf * 32768}; pg8::gemm_phase(lds, g, e); } }
            else if (s == 1) { if (EN(11)) for (int u = obid(); u < 1024; u += gridDim.x) ret_a_unit(P, hf, u, lds); }
            else if (s == 2) { if (EN(12)) phase_ret_b(P); }
            else if (s == 3) { if (EN(13)) for (int u = obid(); u < 2048; u += gridDim.x) ret_c_unit(P, hf, u, lds); }
            else { if (EN(14)) { pg8::Gemm g{(const bf16_t*)(ws + OFF_OBUF), (const bf16_t*)(ws + OFF_WOUT1), 2048, 2048, 2048, 128, 4, 1, 0, 0};
                EpiResid<true, false> e{nullptr, XN + (size_t)hf * 32768 * 1024, SSQ + 5 * SSN + (size_t)hf * 32768 * 16, 1.0f}; pg8::gemm_phase(lds, g, e); } }
        }
        else if (ph == 31) { if (EN(15)) phase_final(XN, P->in[25], P->out); }
        if (rep + 1 < reps) __syncthreads();
        }
        if (ph + 1 < ph1) { if (ph == 0) cg::this_grid().sync();
            else xcd_barrier((unsigned*)(P->ws + OFF_BAR), xb_x, xb_st); }
    }
}

extern "C" void kernel_launch(void* const* d_in, const int* in_sizes, int n_in, void* d_out, int out_size, void* d_ws, size_t ws_size, hipStream_t stream) {
    static int inited = 0;
    if (!inited) { (void)hipFuncSetAttribute((const void*)mega, hipFuncAttributeMaxDynamicSharedMemorySize, LDS_BYTES); inited = 1; }
    Params p{};
    for (int i = 0; i < 26; ++i) p.in[i] = (const float*)d_in[i];
    p.out = (float*)d_out; p.ws = (unsigned char*)d_ws;
    if (ws_size < OFF_R + 770 * MiB) fprintf(stderr, "kernel_launch: workspace too small (%zu)\n", ws_size);
    const int grid = 256;
#if ONE_LAUNCH
    (void)hipMemsetAsync((unsigned char*)d_ws + OFF_BAR, 0, 16384, stream);
    int ph0 = 0, ph1 = NPHASE; void* args[] = {&p, &ph0, &ph1};
    hipError_t e = hipLaunchCooperativeKernel((const void*)mega, dim3(grid), dim3(NTHR), args, LDS_BYTES, stream);
    if (e != hipSuccess) fprintf(stderr, "cooperative launch failed: %s\n", hipGetErrorString(e));
#else
    for (int ph = 0; ph < NPHASE; ++ph) hipLaunchKernelGGL(mega, dim3(grid), dim3(NTHR), LDS_BYTES, stream, p, ph, ph + 1);
#endif
}
```
